# Optimizing an MI355X kernel written in HIP

```python
import jax, jax.numpy as jnp
from jax import lax
import numpy as np

D_MODEL = 2048
BATCH = 4
SEQ = 4096
DEPTH = 4
DEC_BATCH = 16
DEC_SEQ = 16
PAST_LEN = 2048

CHUNK = 64
N_A = DEPTH // 2
N_B = DEPTH - N_A
EXPAND_A = 2
E_A = EXPAND_A * D_MODEL
POOL_WINDOWS = (2, 4, 8, 16)
N_POOL_GROUPS = len(POOL_WINDOWS)
G_A = E_A // N_POOL_GROUPS
POOL_PAD = max(POOL_WINDOWS) - 1
N_HEADS = 16
HEAD_DIM = D_MODEL // N_HEADS
W_B = N_HEADS * HEAD_DIM
Q_BLOCK = 128
EPS = 1e-6
F_BIAS_MEAN = 3.0

kernel_name = 'yoco_pool_fox_streaming_step'


def rmsnorm(x, g):
    xf = x.astype(jnp.float32)
    r = lax.rsqrt(jnp.mean(xf * xf, axis=-1, keepdims=True) + EPS)
    return (xf * r).astype(x.dtype) * g


def pool_mix(u, prev, pos0, w_grp, scale):
    B, T, _ = u.shape
    full = jnp.concatenate([prev.astype(u.dtype), u], axis=1)
    cs = jnp.cumsum(full.astype(jnp.float32), axis=1)
    cs = jnp.pad(cs, ((0, 0), (1, 0), (0, 0)))
    end = cs[:, POOL_PAD + 1:]
    uf = u.astype(jnp.float32)
    pos = pos0 + jnp.arange(T)
    outs = []
    for g, w in enumerate(POOL_WINDOWS):
        sl = slice(g * G_A, (g + 1) * G_A)
        start = lax.slice_in_dim(cs, POOL_PAD + 1 - w, POOL_PAD + 1 - w + T, axis=1)[..., sl]
        cnt = jnp.minimum(pos + 1, w).astype(jnp.float32)
        d = (end[..., sl] - start) / cnt[None, :, None] - uf[..., sl]
        outs.append(jnp.einsum('btc,cd->btd', d, w_grp[g].astype(jnp.float32)))
    y = jnp.concatenate(outs, axis=-1) * scale.astype(jnp.float32)
    return y.astype(u.dtype), full[:, -POOL_PAD:]


def fox_attention(q, k, v, Fq, Fk, q_pos, k_pos):
    B, T, H, Dh = q.shape
    scale = HEAD_DIM ** -0.5
    Fk_t = jnp.transpose(Fk, (0, 2, 1))

    def block(args):
        qb, Fqb, pb = args
        s = jnp.einsum('bqhd,bkhd->bhqk', qb, k, preferred_element_type=jnp.float32) * scale
        s = s + jnp.transpose(Fqb, (0, 2, 1))[..., None] - Fk_t[:, :, None, :]
        mask = k_pos[None, :] <= pb[:, None]
        s = jnp.where(mask[None, None], s, -jnp.inf)
        p = jax.nn.softmax(s, axis=-1)
        o = jnp.einsum('bhqk,bkhd->bqhd', p.astype(v.dtype), v, preferred_element_type=jnp.float32)
        return o.astype(q.dtype)

    if T > Q_BLOCK and T % Q_BLOCK == 0:
        nb = T // Q_BLOCK
        qb = jnp.moveaxis(q.reshape(B, nb, Q_BLOCK, H, Dh), 1, 0)
        Fqb = jnp.moveaxis(Fq.reshape(B, nb, Q_BLOCK, H), 1, 0)
        pb = q_pos.reshape(nb, Q_BLOCK)
        o = lax.map(block, (qb, Fqb, pb))
        return jnp.moveaxis(o, 0, 1).reshape(B, T, H, Dh)
    return block((q, Fq, q_pos))


def trunk(x, pos0, pool_prev, past_k, past_v, past_logf, norm_a, w_in_a, w_grp_a, scale_a, w_out_a,
          norm_kv, w_kv, b_f, norm_b, w_in_b, w_out_b, norm_f):
    B, T, _ = x.shape
    new_pool = []
    for l in range(N_A):
        h = rmsnorm(x, norm_a[l])
        z = h @ w_in_a[l]
        u, gate = z[..., :E_A], z[..., E_A:]
        y, st = pool_mix(u, pool_prev[l], pos0, w_grp_a[l], scale_a[l])
        x = x + (y * jax.nn.silu(gate)) @ w_out_a[l]
        new_pool.append(st)
    hk = rmsnorm(x, norm_kv)
    kvf = hk @ w_kv
    k = kvf[..., :W_B].reshape(B, T, N_HEADS, HEAD_DIM)
    v = kvf[..., W_B:2 * W_B].reshape(B, T, N_HEADS, HEAD_DIM)
    logf = jax.nn.log_sigmoid(kvf[..., 2 * W_B:].astype(jnp.float32) + b_f.astype(jnp.float32))
    if past_k is None:
        k_all, v_all, logf_all = k, v, logf
    else:
        k_all = jnp.concatenate([past_k.astype(k.dtype), k], axis=1)
        v_all = jnp.concatenate([past_v.astype(v.dtype), v], axis=1)
        logf_all = jnp.concatenate([past_logf.astype(jnp.float32), logf], axis=1)
    F_all = jnp.cumsum(logf_all, axis=1)
    P = k_all.shape[1] - T
    q_pos = pos0 + jnp.arange(T)
    k_pos = jnp.arange(P + T)
    Fq = F_all[:, P:]
    for l in range(N_B):
        h = rmsnorm(x, norm_b[l])
        z = h @ w_in_b[l]
        q = z[..., :W_B].reshape(B, T, N_HEADS, HEAD_DIM)
        gate = z[..., W_B:]
        o = fox_attention(q, k_all, v_all, Fq, F_all, q_pos, k_pos).reshape(B, T, W_B)
        x = x + (o * jax.nn.silu(gate)) @ w_out_b[l]
    return rmsnorm(x, norm_f), k, v, logf, jnp.stack(new_pool)


def setup_inputs(seed: int = 0) -> dict:
    key = jax.random.key(seed)
    ks = jax.random.split(key, 20)
    f32 = jnp.float32
    nrm = lambda k, s: jax.random.normal(k, s, f32)
    return {
        'x_prompt': nrm(ks[0], (BATCH, SEQ, D_MODEL)),
        'x_sample': nrm(ks[1], (DEC_BATCH, DEC_SEQ, D_MODEL)),
        'cache_k': nrm(ks[2], (DEC_BATCH, PAST_LEN, N_HEADS, HEAD_DIM)),
        'cache_v': nrm(ks[3], (DEC_BATCH, PAST_LEN, N_HEADS, HEAD_DIM)),
        'cache_logf': jax.nn.log_sigmoid(F_BIAS_MEAN + nrm(ks[4], (DEC_BATCH, PAST_LEN, N_HEADS))),
        'state_pool': nrm(ks[5], (N_A, DEC_BATCH, POOL_PAD, E_A)),
        'norm_a': 1.0 + 0.02 * nrm(ks[6], (N_A, D_MODEL)),
        'w_in_a': nrm(ks[7], (N_A, D_MODEL, 2 * E_A)) * D_MODEL ** -0.5,
        'w_grp_a': nrm(ks[8], (N_A, N_POOL_GROUPS, G_A, G_A)) * G_A ** -0.5,
        'scale_a': 1.0 + 0.02 * nrm(ks[9], (N_A, E_A)),
        'w_out_a': nrm(ks[10], (N_A, E_A, D_MODEL)) * E_A ** -0.5,
        'norm_kv': 1.0 + 0.02 * nrm(ks[11], (D_MODEL,)),
        'w_kv': nrm(ks[12], (D_MODEL, 2 * W_B + N_HEADS)) * D_MODEL ** -0.5,
        'b_f': F_BIAS_MEAN + 0.1 * nrm(ks[13], (N_HEADS,)),
        'norm_b': 1.0 + 0.02 * nrm(ks[14], (N_B, D_MODEL)),
        'w_in_b': nrm(ks[15], (N_B, D_MODEL, 2 * W_B)) * D_MODEL ** -0.5,
        'w_out_b': nrm(ks[16], (N_B, W_B, D_MODEL)) * W_B ** -0.5,
        'norm_f': 1.0 + 0.02 * nrm(ks[17], (D_MODEL,)),
    }


def reference(x_prompt, x_sample, cache_k, cache_v, cache_logf, state_pool, norm_a, w_in_a, w_grp_a,
              scale_a, w_out_a, norm_kv, w_kv, b_f, norm_b, w_in_b, w_out_b, norm_f):
    pool_zero = jnp.zeros((N_A, x_prompt.shape[0], POOL_PAD, E_A), x_prompt.dtype)
    y_prompt, k_prompt, v_prompt, logf_prompt, pool_prompt = trunk(
        x_prompt, 0, pool_zero, None, None, None, norm_a, w_in_a, w_grp_a, scale_a, w_out_a,
        norm_kv, w_kv, b_f, norm_b, w_in_b, w_out_b, norm_f)
    y_sample, k_sample, v_sample, logf_sample, pool_sample = trunk(
        x_sample, cache_k.shape[1], state_pool, cache_k, cache_v, cache_logf, norm_a, w_in_a, w_grp_a,
        scale_a, w_out_a, norm_kv, w_kv, b_f, norm_b, w_in_b, w_out_b, norm_f)
    return (y_prompt, y_sample, k_prompt, v_prompt, logf_prompt, pool_prompt,
            k_sample, v_sample, logf_sample, pool_sample)
```

```cpp
#include <hip/hip_runtime.h>
#include <hip/hip_cooperative_groups.h>
#include <cstdio>
#include <cstdint>
namespace cg = cooperative_groups;

#ifndef MULTI_LAUNCH
#define MULTI_LAUNCH 0
#endif

#define LAS __attribute__((address_space(3)))
typedef unsigned short bf16_t;
typedef short bf16x8 __attribute__((ext_vector_type(8)));
typedef short s16x4 __attribute__((ext_vector_type(4)));
typedef float f32x4 __attribute__((ext_vector_type(4)));
typedef float f32x16 __attribute__((ext_vector_type(16)));
typedef unsigned u32x4 __attribute__((ext_vector_type(4)));
typedef unsigned u32x2 __attribute__((ext_vector_type(2)));

constexpr int DM = 2048, NBATCH = 4, SEQ = 4096, NDB = 16, DSEQ = 16, PAST = 2048, EA = 4096, NH = 16, HD = 128, PPAD = 15;
constexpr int MP = NBATCH * SEQ, MS = NDB * DSEQ, MT = MP + MS;
constexpr float EPS = 1e-6f;
constexpr float LOG2E = 1.4426950408889634f;
constexpr float QSCALE = 0.08838834764831845f * 1.4426950408889634f;
constexpr int NTHREADS = 512, NWAVES = 8;
constexpr int LDS_BYTES = 131072;

constexpr size_t O_YP = 0, O_YS = O_YP + (size_t)MP * DM, O_KP = O_YS + (size_t)MS * DM, O_VP = O_KP + (size_t)MP * DM,
                 O_LFP = O_VP + (size_t)MP * DM, O_PP = O_LFP + (size_t)MP * NH, O_KS = O_PP + (size_t)2 * NBATCH * PPAD * EA,
                 O_VS = O_KS + (size_t)MS * DM, O_LFS = O_VS + (size_t)MS * DM, O_PS = O_LFS + (size_t)MS * NH, O_END = O_PS + (size_t)2 * NDB * PPAD * EA;

constexpr size_t al256(size_t x) { return (x + 255) & ~(size_t)255; }
constexpr size_t WS_WINA = 0;
constexpr size_t WS_WGRP = WS_WINA + (size_t)2 * 8192 * 2048 * 2;
constexpr size_t WS_WOUTA = WS_WGRP + (size_t)2 * 4096 * 1024 * 2;
constexpr size_t WS_W4 = WS_WOUTA + (size_t)2 * 2048 * 4096 * 2;
constexpr size_t WS_WINB1 = WS_W4 + (size_t)8448 * 2048 * 2;
constexpr size_t WS_WOUTB = WS_WINB1 + (size_t)4096 * 2048 * 2;
constexpr size_t WS_XB = WS_WOUTB + (size_t)2 * 2048 * 2048 * 2;
constexpr size_t WS_XRES = WS_XB + (size_t)MT * DM * 2;
constexpr size_t WS_SSQ = WS_XRES + (size_t)MT * DM * 4;
constexpr size_t WS_LFTP = al256(WS_SSQ + (size_t)5 * MT * 4);
constexpr size_t WS_LFTS = WS_LFTP + (size_t)NBATCH * NH * SEQ * 4;
constexpr size_t WS_ACT = al256(WS_LFTS + (size_t)NDB * NH * DSEQ * 4);
constexpr size_t SZ_A = (size_t)MT * EA * 2, SZ_B = (size_t)MT * DM * 2;
constexpr size_t WS_U = WS_ACT, WS_SG = WS_U + SZ_A, WS_D = WS_SG + SZ_A;
constexpr size_t WS_KB = WS_ACT, WS_VB = WS_KB + SZ_B, WS_QB = WS_VB + SZ_B, WS_SGB = WS_QB + SZ_B, WS_OG = WS_SGB + SZ_B;
constexpr size_t WS_END = (WS_D + SZ_A) > (WS_OG + SZ_B) ? (WS_D + SZ_A) : (WS_OG + SZ_B);

struct Params { const float* in[18]; float* out; unsigned char* ws; int ph_lo, ph_hi; };

__device__ __forceinline__ unsigned cvtpk(float lo, float hi) { unsigned r; asm volatile("v_cvt_pk_bf16_f32 %0, %1, %2" : "=v"(r) : "v"(lo), "v"(hi)); return r; }
__device__ __forceinline__ bf16x8 pack8(f32x4 a, f32x4 b) { u32x4 w = {cvtpk(a[0], a[1]), cvtpk(a[2], a[3]), cvtpk(b[0], b[1]), cvtpk(b[2], b[3])}; return *reinterpret_cast<bf16x8*>(&w); }
__device__ __forceinline__ float bflo(unsigned w) { return __uint_as_float(w << 16); }
__device__ __forceinline__ float bfhi(unsigned w) { return __uint_as_float(w & 0xffff0000u); }
__device__ __forceinline__ float silu_f(float x) { return x * __builtin_amdgcn_rcpf(1.0f + __builtin_amdgcn_exp2f(-x * LOG2E)); }
__device__ __forceinline__ float wave_sum(float v) {
#pragma unroll
    for (int o = 1; o < 64; o <<= 1) v += __shfl_xor(v, o);
    return v;
}
__device__ __forceinline__ int otid() { int t = threadIdx.x; asm volatile("" : "+v"(t)); return t; }
__device__ __forceinline__ float logsig(float x) { return fminf(x, 0.f) - log1pf(__expf(-fabsf(x))); }

namespace pg8 {
constexpr int BM = 256, BK = 64, HALF = 128, HTB = HALF * BK * 2, NXCD = 8, WGM = 8;
__device__ __forceinline__ int lds_byte(int r, int c) { const int st = (r >> 4) * 2 + (c >> 5), rr = r & 15, cc = c & 31, ob = rr * 64 + cc * 2; return st * 1024 + (ob ^ (((ob >> 9) & 1) << 5)); }
__device__ __forceinline__ void stage_rc(int b, int& R, int& C) { const int st = b / 1024, sb = b % 1024, swz = sb ^ (((sb >> 9) & 1) << 5); R = (st >> 1) * 16 + swz / 64; C = (st & 1) * 32 + (swz % 64) / 2; }
__device__ __forceinline__ int perm32(int rho) { const int n = rho >> 4, i = rho & 15; return 8 * (i >> 2) + 4 * n + (i & 3); }
struct Unit { int pm, pn; };
struct Gemm { const bf16_t* A; const bf16_t* Bt; int nM, nN, K, lda, ashift; };
struct StaticOrder {
    int nM, nN, nwg, G, c;
    __device__ void init(int nM_, int nN_, int G_, int c_) { nM = nM_; nN = nN_; nwg = nM * nN; G = G_; c = c_; }
    __device__ bool next(int i, Unit& u) const {
        const long L = (long)i * G + c; if (L >= nwg) return false;
        int wgid = (int)L; { const int q = nwg / NXCD, r = nwg % NXCD, xcd = wgid % NXCD, off = wgid / NXCD; wgid = (xcd < r ? xcd * (q + 1) : r * (q + 1) + (xcd - r) * q) + off; }
        const int nig = WGM * nN, gid = wgid / nig, fm = gid * WGM, gsz = (nM - fm) < WGM ? (nM - fm) : WGM;
        u.pm = fm + ((wgid % nig) % gsz); u.pn = (wgid % nig) / gsz; return true;
    }
};

template <class Epi>
__device__ __forceinline__ void gemm_phase(LAS unsigned char* lds, const Gemm g, const StaticOrder& S, const Epi& E) {
    const int tid = otid(), wid = __builtin_amdgcn_readfirstlane(tid >> 6), lane = tid & 63, wr = wid >> 2, wc = wid & 3, fr = lane & 15, fq = lane >> 4;
    const int K = g.K, nt = K / BK;
    unsigned voffA[2], voffB[2];
#pragma unroll
    for (int i = 0; i < 2; ++i) { int R, C; stage_rc(tid * 16 + i * 8192, R, C); const int Rb = Epi::PERM ? ((R & ~31) + perm32(R & 31)) : R;
        voffA[i] = (unsigned)(R * g.lda + C) * 2u; voffB[i] = (unsigned)(Rb * K + C) * 2u; }
    const size_t kstep = (size_t)(BK * 2);
    const size_t hstepA = (size_t)HALF * g.lda * 2, tstepA = 2 * hstepA;
    const size_t hstepB = (size_t)HALF * K * 2, tstepB = 2 * hstepB;
    const unsigned ldsw = (unsigned)wid * 1024u;
    const int aoff = lds_byte(wr * 64 + fr, fq * 8), boff = lds_byte(wc * 32 + fr, fq * 8);
#define PG8_SA(b, h) (((b) * 2 + (h)) * HTB)
#define PG8_SB(b, h) ((4 + (b) * 2 + (h)) * HTB)
#define PG8_STAGE(bufoff, gbase, voff) do { _Pragma("unroll") for (int _i = 0; _i < 2; ++_i) \
        __builtin_amdgcn_global_load_lds((const unsigned*)((const char*)(gbase) + (voff)[_i]), (LAS unsigned*)(lds + (bufoff) + ldsw + _i * 8192), 16, 0, 0); } while (0)
#define PG8_LDA(dst, b, h) do { _Pragma("unroll") for (int m = 0; m < 4; ++m) _Pragma("unroll") for (int k = 0; k < 2; ++k) dst[m][k] = *(const LAS bf16x8*)(lds + PG8_SA(b, h) + aoff + m * 2048 + k * 1024); } while (0)
#define PG8_LDB(dst, b, h) do { _Pragma("unroll") for (int n = 0; n < 2; ++n) _Pragma("unroll") for (int k = 0; k < 2; ++k) dst[n][k] = *(const LAS bf16x8*)(lds + PG8_SB(b, h) + boff + n * 2048 + k * 1024); } while (0)
#define PG8_MMA(ai, bj, At, Bt) do { __builtin_amdgcn_s_setprio(1); _Pragma("unroll") for (int m = 0; m < 4; ++m) _Pragma("unroll") for (int n = 0; n < 2; ++n) _Pragma("unroll") for (int k = 0; k < 2; ++k) \
        acc[ai][bj][m][n] = __builtin_amdgcn_mfma_f32_16x16x32_bf16(Bt[n][k], At[m][k], acc[ai][bj][m][n], 0, 0, 0); __builtin_amdgcn_s_setprio(0); } while (0)
#define PG8_WAIT_V(n) asm volatile("s_waitcnt vmcnt(" #n ")" ::: "memory")
#define PG8_WAIT_L(n) asm volatile("s_waitcnt lgkmcnt(" #n ")" ::: "memory")
#define PG8_BAR __builtin_amdgcn_s_barrier()
#define PG8_SCHED __builtin_amdgcn_sched_barrier(0)
#define PG8_ACOL(u) (g.ashift >= 0 ? (size_t)((u).pn >> g.ashift) * (size_t)K * 2 : (size_t)0)
    Unit cur, nxt; int ui = 0;
    if (!S.next(0, cur)) return;
    f32x4 acc[2][2][4][2];
#pragma unroll
    for (int a = 0; a < 2; ++a)
#pragma unroll
        for (int b = 0; b < 2; ++b)
#pragma unroll
            for (int m = 0; m < 4; ++m)
#pragma unroll
                for (int n = 0; n < 2; ++n) acc[a][b][m][n] = (f32x4){0.f, 0.f, 0.f, 0.f};
    bf16x8 At[4][2], B0[2][2], B1[2][2];
    const char* cA = (const char*)g.A + (size_t)cur.pm * tstepA + PG8_ACOL(cur); const char* cB = (const char*)g.Bt + (size_t)cur.pn * tstepB;
    PG8_STAGE(PG8_SB(0, 0), cB, voffB); PG8_STAGE(PG8_SA(0, 0), cA, voffA); PG8_STAGE(PG8_SB(0, 1), cB + hstepB, voffB); PG8_STAGE(PG8_SA(0, 1), cA + hstepA, voffA);
    if (wr == 1) PG8_BAR;
    PG8_WAIT_V(4); PG8_BAR;
    PG8_STAGE(PG8_SB(1, 0), cB + kstep, voffB); PG8_STAGE(PG8_SA(1, 0), cA + kstep, voffA); PG8_STAGE(PG8_SB(1, 1), cB + hstepB + kstep, voffB);
    PG8_WAIT_V(6); PG8_BAR;
    for (;;) {
        const bool has_next = S.next(ui + 1, nxt);
        const char* nA = has_next ? (const char*)g.A + (size_t)nxt.pm * tstepA + PG8_ACOL(nxt) : cA; const char* nB = has_next ? (const char*)g.Bt + (size_t)nxt.pn * tstepB : cB;
        for (int t = 0; t < nt; t += 2) {
            const bool last = (t == nt - 2);
            const char* a1 = cA + (size_t)(t + 1) * kstep;
            const char* a2 = last ? nA : cA + (size_t)(t + 2) * kstep; const char* b2 = last ? nB : cB + (size_t)(t + 2) * kstep;
            const char* a3 = a2 + kstep; const char* b3 = b2 + kstep;
            PG8_LDB(B0, 0, 0); PG8_SCHED; PG8_LDA(At, 0, 0); PG8_STAGE(PG8_SA(1, 1), a1 + hstepA, voffA);
            PG8_WAIT_L(8); PG8_BAR; PG8_WAIT_L(0); PG8_MMA(0, 0, At, B0); PG8_BAR; PG8_SCHED;
            PG8_LDB(B1, 0, 1); PG8_STAGE(PG8_SB(0, 0), b2, voffB);
            PG8_BAR; PG8_WAIT_L(0); PG8_MMA(0, 1, At, B1); PG8_BAR;
            PG8_LDA(At, 0, 1); PG8_STAGE(PG8_SA(0, 0), a2, voffA);
            PG8_BAR; PG8_WAIT_L(0); PG8_MMA(1, 0, At, B0); PG8_BAR; PG8_SCHED;
            PG8_STAGE(PG8_SB(0, 1), b2 + hstepB, voffB);
            PG8_WAIT_V(6); PG8_BAR; PG8_MMA(1, 1, At, B1); PG8_BAR;
            PG8_LDB(B0, 1, 0); PG8_SCHED; PG8_LDA(At, 1, 0); PG8_STAGE(PG8_SA(0, 1), a2 + hstepA, voffA);
            PG8_WAIT_L(8); PG8_BAR; PG8_WAIT_L(0); PG8_MMA(0, 0, At, B0); PG8_BAR; PG8_SCHED;
            PG8_LDB(B1, 1, 1); PG8_STAGE(PG8_SB(1, 0), b3, voffB);
            PG8_BAR; PG8_WAIT_L(0); PG8_MMA(0, 1, At, B1); PG8_BAR;
            PG8_LDA(At, 1, 1); PG8_STAGE(PG8_SA(1, 0), a3, voffA);
            PG8_BAR; PG8_WAIT_L(0); PG8_MMA(1, 0, At, B0); PG8_BAR; PG8_SCHED;
            PG8_STAGE(PG8_SB(1, 1), b3 + hstepB, voffB);
            PG8_WAIT_V(6); PG8_BAR; PG8_MMA(1, 1, At, B1); PG8_BAR;
        }
        E(acc, cur, wr, wc, fr, fq);
        if (!has_next) break;
#pragma unroll
        for (int a = 0; a < 2; ++a)
#pragma unroll
            for (int b = 0; b < 2; ++b)
#pragma unroll
                for (int m = 0; m < 4; ++m)
#pragma unroll
                    for (int n = 0; n < 2; ++n) acc[a][b][m][n] = (f32x4){0.f, 0.f, 0.f, 0.f};
        cur = nxt; cA = nA; cB = nB; ++ui;
    }
    PG8_WAIT_V(0);
    if (wr == 0) PG8_BAR;
    PG8_BAR;
#undef PG8_SA
#undef PG8_SB
#undef PG8_STAGE
#undef PG8_LDA
#undef PG8_LDB
#undef PG8_MMA
#undef PG8_WAIT_V
#undef PG8_WAIT_L
#undef PG8_BAR
#undef PG8_SCHED
#undef PG8_ACOL
}

typedef const f32x4 (&AccRef)[2][2][4][2];

struct EpiInA {
    static constexpr bool PERM = true;
    const float* ssq; bf16_t* u; bf16_t* sg; float* pool_p; float* pool_s;
    __device__ __forceinline__ void operator()(AccRef acc, const Unit& un, int wr, int wc, int fr, int fq) const {
        const int row0 = un.pm * BM + wr * 64 + fr, colt = un.pn * BM + wc * 32 + 8 * fq;
        const bool is_u = un.pn < 16;
        const bool has_pool = is_u && (un.pm == 64 || (un.pm & 15) == 15);
#pragma unroll
        for (int ai = 0; ai < 2; ++ai)
#pragma unroll
            for (int m = 0; m < 4; ++m) { const int row = row0 + ai * HALF + m * 16; const float rr = rsqrtf(ssq[row] * (1.0f / DM) + EPS);
                float* pp = nullptr;
                if (has_pool) { if (row < MP) { const int t = row & (SEQ - 1); if (t >= SEQ - PPAD) pp = pool_p + ((size_t)(row >> 12) * PPAD + (t - (SEQ - PPAD))) * EA; }
                                else { const int rs = row - MP, t = rs & 15; if (t >= 1) pp = pool_s + ((size_t)(rs >> 4) * PPAD + (t - 1)) * EA; } }
#pragma unroll
                for (int bj = 0; bj < 2; ++bj) { f32x4 v0 = acc[ai][bj][m][0] * rr, v1 = acc[ai][bj][m][1] * rr; const int col = colt + bj * HALF;
                    if (is_u) { if (pp) { *(f32x4*)(pp + col) = v0; *(f32x4*)(pp + col + 4) = v1; }
                        *(bf16x8*)(u + (size_t)row * EA + col) = pack8(v0, v1); }
                    else {
#pragma unroll
                        for (int j = 0; j < 4; ++j) { v0[j] = silu_f(v0[j]); v1[j] = silu_f(v1[j]); }
                        *(bf16x8*)(sg + (size_t)row * EA + (col - EA)) = pack8(v0, v1); } } }
    }
};
struct EpiPool {
    static constexpr bool PERM = true;
    const float* scale; const bf16_t* sg; bf16_t* yg;
    __device__ __forceinline__ void operator()(AccRef acc, const Unit& un, int wr, int wc, int fr, int fq) const {
        const int row0 = un.pm * BM + wr * 64 + fr, colt = un.pn * BM + wc * 32 + 8 * fq;
        f32x4 sc[2][2];
#pragma unroll
        for (int bj = 0; bj < 2; ++bj) { sc[bj][0] = *(const f32x4*)(scale + colt + bj * HALF); sc[bj][1] = *(const f32x4*)(scale + colt + bj * HALF + 4); }
#pragma unroll
        for (int ai = 0; ai < 2; ++ai)
#pragma unroll
            for (int m = 0; m < 4; ++m) { const size_t ro = (size_t)(row0 + ai * HALF + m * 16) * EA + colt;
#pragma unroll
                for (int bj = 0; bj < 2; ++bj) { const u32x4 gw = *(const u32x4*)(sg + ro + bj * HALF);
                    f32x4 v0 = acc[ai][bj][m][0] * sc[bj][0], v1 = acc[ai][bj][m][1] * sc[bj][1];
                    v0[0] *= bflo(gw.x); v0[1] *= bfhi(gw.x); v0[2] *= bflo(gw.y); v0[3] *= bfhi(gw.y);
                    v1[0] *= bflo(gw.z); v1[1] *= bfhi(gw.z); v1[2] *= bflo(gw.w); v1[3] *= bfhi(gw.w);
                    *(bf16x8*)(yg + ro + bj * HALF) = pack8(v0, v1); } }
    }
};
struct EpiRes {
    static constexpr bool PERM = false;
    const float* base_p; const float* base_s; float* xres; bf16_t* xb; float* ssq_next;
    __device__ __forceinline__ void operator()(AccRef acc, const Unit& un, int wr, int wc, int fr, int fq) const {
        const int row0 = un.pm * BM + wr * 64 + fr, col0 = un.pn * BM + wc * 32 + 4 * fq;
#pragma unroll
        for (int ai = 0; ai < 2; ++ai)
#pragma unroll
            for (int m = 0; m < 4; ++m) { const int row = row0 + ai * HALF + m * 16;
                const float* bp = (row < MP ? base_p + (size_t)row * DM : base_s + (size_t)(row - MP) * DM) + col0;
                float* xo = xres + (size_t)row * DM + col0; bf16_t* bo = xb + (size_t)row * DM + col0; float s = 0.f;
#pragma unroll
                for (int bj = 0; bj < 2; ++bj)
#pragma unroll
                    for (int n = 0; n < 2; ++n) { const f32x4 x = *(const f32x4*)(bp + bj * HALF + n * 16) + acc[ai][bj][m][n];
                        *(f32x4*)(xo + bj * HALF + n * 16) = x; u32x2 w; w.x = cvtpk(x[0], x[1]); w.y = cvtpk(x[2], x[3]); *(u32x2*)(bo + bj * HALF + n * 16) = w;
                        s += (x[0] * x[0] + x[1] * x[1]) + (x[2] * x[2] + x[3] * x[3]); }
                s += __shfl_xor(s, 16); s += __shfl_xor(s, 32);
                if (fq == 0) atomicAdd(ssq_next + row, s); }
    }
};
struct EpiKVQ {
    static constexpr bool PERM = true;
    int pn_off; const float* ssq; float* out; unsigned char* ws; const float* b_f;
    __device__ __forceinline__ void operator()(AccRef acc, const Unit& un, int wr, int wc, int fr, int fq) const {
        const int tt = un.pn + pn_off;
        const int row0 = un.pm * BM + wr * 64 + fr, cw = wc * 32 + 8 * fq;
        if (tt == 16) {
            if (wc == 0 && fq < 2) {
            const f32x4 bf0 = *(const f32x4*)(b_f + 8 * fq), bf1 = *(const f32x4*)(b_f + 8 * fq + 4);
            float* lft_p = (float*)(ws + WS_LFTP); float* lft_s = (float*)(ws + WS_LFTS);
#pragma unroll
            for (int ai = 0; ai < 2; ++ai)
#pragma unroll
                for (int m = 0; m < 4; ++m) { const int row = row0 + ai * HALF + m * 16; const float rr = rsqrtf(ssq[row] * (1.0f / DM) + EPS);
                    f32x4 v0 = acc[ai][0][m][0] * rr + bf0, v1 = acc[ai][0][m][1] * rr + bf1;
#pragma unroll
                    for (int j = 0; j < 4; ++j) { v0[j] = logsig(v0[j]); v1[j] = logsig(v1[j]); }
                    if (row < MP) { float* o = out + O_LFP + (size_t)row * NH + 8 * fq; *(f32x4*)o = v0; *(f32x4*)(o + 4) = v1;
                        float* tp = lft_p + ((size_t)(row >> 12) * NH + 8 * fq) * SEQ + (row & (SEQ - 1));
#pragma unroll
                        for (int j = 0; j < 4; ++j) { tp[(size_t)j * SEQ] = v0[j]; tp[(size_t)(j + 4) * SEQ] = v1[j]; } }
                    else { const int rs = row - MP; float* o = out + O_LFS + (size_t)rs * NH + 8 * fq; *(f32x4*)o = v0; *(f32x4*)(o + 4) = v1;
                        float* tp = lft_s + ((size_t)(rs >> 4) * NH + 8 * fq) * DSEQ + (rs & 15);
#pragma unroll
                        for (int j = 0; j < 4; ++j) { tp[j * DSEQ] = v0[j]; tp[(j + 4) * DSEQ] = v1[j]; } } }
            }
        } else {
        const int kind = tt < 8 ? 0 : (tt < 16 ? 1 : (tt < 25 ? 2 : 3));
        const int colt = (tt - (kind == 0 ? 0 : kind == 1 ? 8 : kind == 2 ? 17 : 25)) * BM + cw;
        float* fo_p = out + (kind == 0 ? O_KP : O_VP); float* fo_s = out + (kind == 0 ? O_KS : O_VS);
        bf16_t* bo = (bf16_t*)(ws + (kind == 0 ? WS_KB : (kind == 1 ? WS_VB : (kind == 2 ? WS_QB : WS_SGB))));
#pragma unroll
        for (int ai = 0; ai < 2; ++ai)
#pragma unroll
            for (int m = 0; m < 4; ++m) { const int row = row0 + ai * HALF + m * 16; float rr = rsqrtf(ssq[row] * (1.0f / DM) + EPS);
                if (kind == 2) rr *= QSCALE;
                float* fo = (row < MP ? fo_p + (size_t)row * DM : fo_s + (size_t)(row - MP) * DM) + colt;
#pragma unroll
                for (int bj = 0; bj < 2; ++bj) { f32x4 v0 = acc[ai][bj][m][0] * rr, v1 = acc[ai][bj][m][1] * rr;
                    if (kind < 2) { *(f32x4*)(fo + bj * HALF) = v0; *(f32x4*)(fo + bj * HALF + 4) = v1; }
                    if (kind == 3) {
#pragma unroll
                        for (int j = 0; j < 4; ++j) { v0[j] = silu_f(v0[j]); v1[j] = silu_f(v1[j]); } }
                    *(bf16x8*)(bo + (size_t)row * DM + colt + bj * HALF) = pack8(v0, v1); } }
        }
    }
};
}

namespace att {
constexpr int NW = 8, QBLK = 32, KVBLK = 64, QB = NW * QBLK, D = 128, LD = 2048;
constexpr int SHM_V = KVBLK * D * 2, SHM_K = KVBLK * D * 2;
constexpr int OFF_WS = 2 * SHM_V + 2 * SHM_K, OFF_F = OFF_WS + NW * 64 * 4, OFF_SC = OFF_F + SEQ * 4;
constexpr float THR2 = 11.5f;
#define KSWZ(row, colB) ((row) * 256 + ((colB) ^ (((row) & 7) << 4)))
#define SBAR() __builtin_amdgcn_sched_barrier(0)
__device__ __forceinline__ int v_st(int k, int c) { const int kk = (k & ~0xC) | ((k & 4) << 1) | ((k & 8) >> 1); return ((kk >> 3) * 4 + (c >> 5)) * 512 + ((kk & 7) * 32 + (c & 31)) * 2; }
__device__ __forceinline__ int v_rd_base(int lane) { return ((lane & 3) << 3) | (((lane >> 2) & 3) << 6) | (((lane >> 4) & 1) << 5) | (((lane >> 5) & 1) << 8); }
constexpr int v_rd_off(int d0, int ks, int half) { return d0 * 512 + ks * 4096 + half * 2048; }
__device__ __forceinline__ int crow(int r, int hi) { return (r & 3) + 8 * (r >> 2) + 4 * hi; }
__device__ __forceinline__ void mask_tile(f32x16& p0, f32x16& p1, int dq) {
    const float NEG = -__builtin_inff();
#pragma unroll
    for (int r = 0; r < 16; ++r) { const int c = (r & 3) + 8 * (r >> 2);
        if (dq - c < 0) p0[r] = NEG;
        if (dq - c - 32 < 0) p1[r] = NEG; }
}
__device__ __forceinline__ void partialSM(f32x16& p0, f32x16& p1, float& m_reg, float& mn, float& alpha) {
    float pmax = p0[0];
#pragma unroll
    for (int r = 1; r < 16; ++r) pmax = fmaxf(pmax, p0[r]);
#pragma unroll
    for (int r = 0; r < 16; ++r) pmax = fmaxf(pmax, p1[r]);
    { auto rr = __builtin_amdgcn_permlane32_swap(__float_as_uint(pmax), __float_as_uint(pmax), false, false);
      pmax = fmaxf(__uint_as_float(rr[0]), __uint_as_float(rr[1])); }
    if (__builtin_expect(__all((pmax - m_reg) <= THR2), 1)) { mn = m_reg; alpha = 1.f; }
    else { mn = fmaxf(m_reg, pmax); alpha = __builtin_amdgcn_exp2f(m_reg - mn); m_reg = mn; }
#pragma unroll
    for (int r = 0; r < 16; ++r) p0[r] = p0[r] - mn;
#pragma unroll
    for (int r = 0; r < 16; ++r) p1[r] = p1[r] - mn;
#pragma unroll
    for (int r = 0; r < 16; ++r) p0[r] = __builtin_amdgcn_exp2f(p0[r]);
}
__device__ __forceinline__ void finishSM(f32x16& p0, f32x16& p1, float alpha, float& l_reg, bf16x8& pa0, bf16x8& pa1, bf16x8& pa2, bf16x8& pa3) {
#pragma unroll
    for (int r = 0; r < 16; ++r) p1[r] = __builtin_amdgcn_exp2f(p1[r]);
    float ps = 0;
#pragma unroll
    for (int r = 0; r < 16; ++r) ps += p0[r];
#pragma unroll
    for (int r = 0; r < 16; ++r) ps += p1[r];
    { auto rr = __builtin_amdgcn_permlane32_swap(__float_as_uint(ps), __float_as_uint(ps), false, false);
      ps = __uint_as_float(rr[0]) + __uint_as_float(rr[1]); }
    l_reg = l_reg * alpha + ps;
#define PK4(P, B_, OUT) do { unsigned a0 = cvtpk(P[B_+0], P[B_+1]), a1 = cvtpk(P[B_+2], P[B_+3]);                          \
        unsigned b0 = cvtpk(P[B_+4], P[B_+5]), b1 = cvtpk(P[B_+6], P[B_+7]);                                             \
        auto r0 = __builtin_amdgcn_permlane32_swap(a0, b0, false, false); auto r1 = __builtin_amdgcn_permlane32_swap(a1, b1, false, false); \
        u32x4 w = {r0[0], r1[0], r0[1], r1[1]}; OUT = *reinterpret_cast<bf16x8*>(&w); } while (0)
    PK4(p0, 0, pa0); PK4(p0, 8, pa1); PK4(p1, 0, pa2); PK4(p1, 8, pa3);
#undef PK4
}
template <int KB>
__device__ __forceinline__ void qkt(f32x16& p0, f32x16& p1, const char* K_lds, const float* fl, int r32, int hi, const bf16x8* qr) {
    { const f32x4 a0 = *(const f32x4*)(fl), a1 = *(const f32x4*)(fl + 8), a2 = *(const f32x4*)(fl + 16), a3 = *(const f32x4*)(fl + 24);
      const f32x4 b0 = *(const f32x4*)(fl + 32), b1 = *(const f32x4*)(fl + 40), b2 = *(const f32x4*)(fl + 48), b3 = *(const f32x4*)(fl + 56);
      p0 = (f32x16){a0[0], a0[1], a0[2], a0[3], a1[0], a1[1], a1[2], a1[3], a2[0], a2[1], a2[2], a2[3], a3[0], a3[1], a3[2], a3[3]};
      p1 = (f32x16){b0[0], b0[1], b0[2], b0[3], b1[0], b1[1], b1[2], b1[3], b2[0], b2[1], b2[2], b2[3], b3[0], b3[1], b3[2], b3[3]}; }
    const char* kb[4];
#pragma unroll
    for (int dd = 0; dd < 4; ++dd) kb[dd] = K_lds + KB * SHM_K + KSWZ(r32, (dd * 16 + hi * 8) * 2);
#pragma unroll
    for (int d0 = 0; d0 < 8; ++d0) { const char* a = kb[d0 & 3] + (d0 >> 2) * 128;
        bf16x8 b0 = *reinterpret_cast<const bf16x8*>(a);
        bf16x8 b1 = *reinterpret_cast<const bf16x8*>(a + 32 * 256);
        p0 = __builtin_amdgcn_mfma_f32_32x32x16_bf16(b0, qr[d0], p0, 0, 0, 0);
        p1 = __builtin_amdgcn_mfma_f32_32x32x16_bf16(b1, qr[d0], p1, 0, 0, 0); }
}
template <int VB>
__device__ __forceinline__ void pv_tile(f32x16* o, int vb0, bf16x8 pa0, bf16x8 pa1, bf16x8 pa2, bf16x8 pa3) {
#define TRRD(dst, off) asm volatile("ds_read_b64_tr_b16 %0, %1 offset:%2" : "=&v"(dst) : "v"(vb0), "i"(off) : "memory")
#define PV_D0(d0) do { s16x4 l0, l1, l2, l3, h0, h1, h2, h3; constexpr int b_ = VB * SHM_V + v_rd_off(d0, 0, 0);   \
        TRRD(l0, b_); TRRD(h0, b_ + 2048); TRRD(l1, b_ + 4096); TRRD(h1, b_ + 6144); TRRD(l2, b_ + 8192); TRRD(h2, b_ + 10240); TRRD(l3, b_ + 12288); TRRD(h3, b_ + 14336); \
        asm volatile("s_waitcnt lgkmcnt(0)" ::: "memory"); SBAR();   \
        o[d0] = __builtin_amdgcn_mfma_f32_32x32x16_bf16(pa0, (bf16x8){l0[0], l0[1], l0[2], l0[3], h0[0], h0[1], h0[2], h0[3]}, o[d0], 0, 0, 0);   \
        o[d0] = __builtin_amdgcn_mfma_f32_32x32x16_bf16(pa1, (bf16x8){l1[0], l1[1], l1[2], l1[3], h1[0], h1[1], h1[2], h1[3]}, o[d0], 0, 0, 0);   \
        o[d0] = __builtin_amdgcn_mfma_f32_32x32x16_bf16(pa2, (bf16x8){l2[0], l2[1], l2[2], l2[3], h2[0], h2[1], h2[2], h2[3]}, o[d0], 0, 0, 0);   \
        o[d0] = __builtin_amdgcn_mfma_f32_32x32x16_bf16(pa3, (bf16x8){l3[0], l3[1], l3[2], l3[3], h3[0], h3[1], h3[2], h3[3]}, o[d0], 0, 0, 0); } while (0)
    PV_D0(0); PV_D0(1); PV_D0(2); PV_D0(3);
#undef PV_D0
#undef TRRD
}
struct Tensors { const bf16_t* q; const bf16_t* k; const bf16_t* v; bf16_t* og; const bf16_t* sg; const float* lft; };
struct BlockRef { unsigned q0, s0; int P0, lfo; };
struct Seam { bf16x8 qr[8]; bf16x8 st_v0, st_v1, st_k0, st_k1; };
#define ROWP(p, k0) ((p) + (unsigned)(k0) * (unsigned)LD)
#define VMW() asm volatile("s_waitcnt vmcnt(0)" ::: "memory")
#define VMWN(n) asm volatile("s_waitcnt vmcnt(%0)" :: "i"(n) : "memory")
#define LD8(p) (*reinterpret_cast<const bf16x8*>(p))
#define SLOAD_H(Kp, Vp, k0) do { S.st_v0 = LD8(ROWP(Vp, k0) + voff); S.st_v1 = LD8(ROWP(Vp, (k0) + 32) + voff);              \
                         S.st_k0 = LD8(ROWP(Kp, k0) + voff); S.st_k1 = LD8(ROWP(Kp, (k0) + 32) + voff); } while (0)
#define SWRITE_HK(bf) do { *(bf16x8*)(K_lds + (bf) * SHM_K + kws) = S.st_k0; *(bf16x8*)(K_lds + (bf) * SHM_K + kws + 32 * 256) = S.st_k1; } while (0)
#define SWRITE_HV(bf) do { *(bf16x8*)(V_lds + (bf) * SHM_V + vst0) = S.st_v0; *(bf16x8*)(V_lds + (bf) * SHM_V + vst1) = S.st_v1; } while (0)
#define SWRITE_H(bf) do { SWRITE_HV(bf); SWRITE_HK(bf); } while (0)
__device__ __forceinline__ void prime(const Tensors& T, const BlockRef& cur, char* lds, Seam& S) {
    const int tid = otid(), wid = __builtin_amdgcn_readfirstlane(tid >> 6), lane = tid & 63, r32 = lane & 31, hi = lane >> 5;
    const int sr = tid >> 4, sc = (tid & 15) * 8, kws = KSWZ(sr, sc * 2); char* K_lds = lds + 2 * SHM_V;
    const unsigned voff = (unsigned)sr * LD + sc, qoff = (unsigned)(wid * QBLK + r32) * LD + hi * 8;
    const bf16_t* Qp = T.q + cur.q0; const bf16_t* Kh = T.k + cur.s0; const bf16_t* Vh = T.v + cur.s0;
#pragma unroll
    for (int d0 = 0; d0 < 8; ++d0) S.qr[d0] = LD8(Qp + qoff + d0 * 16);
    SLOAD_H(Kh, Vh, 0); VMW(); SWRITE_HK(0);
    __syncthreads();
}
__device__ __forceinline__ void block(const Tensors& T, const BlockRef& cur, const BlockRef& nxt, char* lds, Seam& S) {
    const int tid = otid(), wid = __builtin_amdgcn_readfirstlane(tid >> 6), lane = tid & 63, r32 = lane & 31, hi = lane >> 5;
    const int NT = (cur.P0 + QB) / KVBLK;
    const int qlo = cur.P0 + wid * QBLK, qm = qlo + r32 - 4 * hi;
    char* V_lds = lds; char* K_lds = lds + 2 * SHM_V;
    float* wsl = (float*)(lds + OFF_WS) + wid * 64; float* li_l = wsl, * al_l = wsl + 32;
    float* Fl = (float*)(lds + OFF_F);
    { float* scn = (float*)(lds + OFF_SC); const int nkeys = cur.P0 + QB, t0 = tid * 8;
      f32x4 a = {0.f, 0.f, 0.f, 0.f}, b = {0.f, 0.f, 0.f, 0.f};
      const float* LF = T.lft + cur.lfo;
      if (t0 < nkeys) { a = *(const f32x4*)(LF + t0); b = *(const f32x4*)(LF + t0 + 4); }
      a[1] += a[0]; a[2] += a[1]; a[3] += a[2]; b[0] += a[3]; b[1] += b[0]; b[2] += b[1]; b[3] += b[2];
      const float tot = b[3]; float inc = tot;
#pragma unroll
      for (int o = 1; o < 64; o <<= 1) { const float v = __shfl_up(inc, o); if (lane >= o) inc += v; }
      if (lane == 63) scn[wid] = inc;
      __syncthreads();
      float base = inc - tot;
      for (int w = 0; w < wid; ++w) base += scn[w];
      a = (a + base) * (-LOG2E); b = (b + base) * (-LOG2E);
      if (t0 < nkeys) { *(f32x4*)(Fl + t0) = a; *(f32x4*)(Fl + t0 + 4) = b; }
      __syncthreads(); }
    float m_reg = -1e30f, l_reg = 0; f32x16 o[4] = {};
    const int sr = tid >> 4, sc = (tid & 15) * 8, vst0 = v_st(sr, sc), vst1 = v_st(32 + sr, sc), kws = KSWZ(sr, sc * 2);
    const int vb0 = (int)(uintptr_t)V_lds + v_rd_base(lane);
    const bf16_t* Kh = T.k + cur.s0; const bf16_t* Vh = T.v + cur.s0;
    const unsigned voff = (unsigned)sr * LD + sc, qoff = (unsigned)(wid * QBLK + r32) * LD + hi * 8;
    const float* flb = Fl + 4 * hi;
#define RESC(a) do { if (__any((a) < 1.f)) { if (hi == 0) al_l[r32] = (a); asm volatile("s_waitcnt lgkmcnt(0)" ::: "memory");              \
                     for (int d_ = 0; d_ < 4; ++d_) for (int r = 0; r < 16; ++r) o[d_][r] *= al_l[crow(r, hi)]; } } while (0)
#define KBASE(t) ((t) * KVBLK)
#define MASKT(P0_, P1_, t) do { const int kb_ = KBASE(t); if (kb_ + KVBLK - 1 > qlo) mask_tile(P0_, P1_, qm - kb_); } while (0)
#define SEAM_K0() do { VMWN(8); SWRITE_HK(0); SBAR(); } while (0)
    f32x16 pA0, pA1, pB0, pB1; float mnA, mnB, alA, alB; bf16x8 pa0, pa1, pa2, pa3;
    SWRITE_HV(0); SBAR();
    if (NT > 1) { SLOAD_H(Kh, Vh, KBASE(1)); }
    SBAR(); qkt<0>(pA0, pA1, K_lds, flb + KBASE(0), r32, hi, S.qr);
    MASKT(pA0, pA1, 0); partialSM(pA0, pA1, m_reg, mnA, alA);
    if (NT > 1) { VMW(); SWRITE_H(1); }
    __syncthreads();
#define HALF_STEP(PX0, PX1, mnX, alX, PY0, PY1, alY, t, KB, VB, SB) do {                                                      \
        SBAR(); qkt<KB>(PX0, PX1, K_lds, flb + KBASE(t), r32, hi, S.qr);                                             \
        finishSM(PY0, PY1, alY, l_reg, pa0, pa1, pa2, pa3); SBAR();                                                           \
        if ((t) + 1 < NT) { SLOAD_H(Kh, Vh, KBASE((t) + 1)); SBAR(); }                                               \
        pv_tile<VB>(o, vb0, pa0, pa1, pa2, pa3); MASKT(PX0, PX1, (t)); partialSM(PX0, PX1, m_reg, mnX, alX);                                        \
        __syncthreads();                                                                                                      \
        if ((t) + 1 < NT) { VMW(); SWRITE_H(SB); }                                                                          \
        RESC(alX); __syncthreads(); } while (0)
    for (int t = 1; t + 1 < NT; t += 2) {
        HALF_STEP(pB0, pB1, mnB, alB, pA0, pA1, alA, t, 1, 0, 0);
        HALF_STEP(pA0, pA1, mnA, alA, pB0, pB1, alB, t + 1, 0, 1, 1);
    }
    const bool even = (NT & 1) == 0;
    if (even) { SBAR(); qkt<1>(pB0, pB1, K_lds, flb + KBASE(NT - 1), r32, hi, S.qr); SBAR(); }
    { const bf16_t* Kn = T.k + nxt.s0; const bf16_t* Vn = T.v + nxt.s0; SLOAD_H(Kn, Vn, 0); } SBAR();
    { const bf16_t* Qn = T.q + nxt.q0;
#pragma unroll
      for (int d0 = 0; d0 < 8; ++d0) S.qr[d0] = LD8(Qn + qoff + d0 * 16); }
    SBAR();
    finishSM(pA0, pA1, alA, l_reg, pa0, pa1, pa2, pa3); SBAR();
    pv_tile<0>(o, vb0, pa0, pa1, pa2, pa3);
    if (even) { MASKT(pB0, pB1, NT - 1); partialSM(pB0, pB1, m_reg, mnB, alB); __syncthreads(); RESC(alB);
        finishSM(pB0, pB1, alB, l_reg, pa0, pa1, pa2, pa3); SBAR(); pv_tile<1>(o, vb0, pa0, pa1, pa2, pa3); }
    SBAR(); SEAM_K0();
    if (hi == 0) li_l[r32] = l_reg; asm volatile("s_waitcnt lgkmcnt(0)" ::: "memory");
    float rli[16];
#pragma unroll
    for (int r = 0; r < 16; ++r) rli[r] = __builtin_amdgcn_rcpf(li_l[crow(r, hi)]);
    { const unsigned eoff = (unsigned)(4 * hi) * LD + r32;
#pragma unroll
      for (int r = 0; r < 16; ++r) { const unsigned ro = cur.q0 + (unsigned)(wid * QBLK + (r & 3) + 8 * (r >> 2)) * LD;
        bf16_t* Orow = T.og + ro; const bf16_t* Grow = T.sg + ro;
#pragma unroll
        for (int d0 = 0; d0 < 4; ++d0) { const float v = o[d0][r] * rli[r];
            const float vn = __shfl_xor(v, 1);
            if ((r32 & 1) == 0) { const unsigned gg = *(const unsigned*)(Grow + eoff + d0 * 32);
                *(unsigned*)(Orow + eoff + d0 * 32) = cvtpk(v * bflo(gg), vn * bfhi(gg)); } } } }
    __syncthreads();
#undef RESC
#undef KBASE
#undef MASKT
#undef SEAM_K0
#undef HALF_STEP
}
#undef ROWP
#undef VMW
#undef VMWN
#undef SLOAD_H
#undef SWRITE_HK
#undef SWRITE_HV
#undef SWRITE_H
#undef LD8

__device__ __forceinline__ BlockRef mkref(int bh, int qb) {
    const int b = bh >> 4, h = bh & 15; BlockRef r; r.s0 = (unsigned)b * SEQ * LD + h * D; r.q0 = r.s0 + (unsigned)qb * QB * LD; r.lfo = bh * SEQ; r.P0 = qb * QB; return r;
}
__device__ __forceinline__ void prompt_phase(char* lds, const Tensors& T, int vw, int G) {
    constexpr int TOTAL = NBATCH * NH * 8;
    int L = vw; if (L >= TOTAL) return;
    int pass = 0;
    BlockRef cur = mkref(L >> 3, L & 7);
    Seam S;
    prime(T, cur, lds, S);
    for (;;) {
        const bool more_pass = pass == 0, more_item = L + G < TOTAL, last = !more_pass && !more_item;
        int passn = pass + 1, Ln = L;
        if (!more_pass) { passn = 0; Ln = more_item ? L + G : L; }
        const int x = Ln & 7;
        const BlockRef nxt = last ? cur : mkref(Ln >> 3, passn ? 15 - x : x);
        block(T, cur, nxt, lds, S);
        if (last) break;
        cur = nxt; pass = passn; L = Ln;
    }
}
}

namespace sat {
constexpr int OFF_F = 0, OFF_SC = 8448, OFF_P = 8704, OFF_A = OFF_P + 8 * 4096, OFF_ML = OFF_A + 512, OFF_O = OFF_ML + 1024;
struct Tensors { const bf16_t* q; const bf16_t* kb; const bf16_t* vb; bf16_t* og; const bf16_t* sg; const float* ck; const float* cv; const float* clf; const float* lfts; };
__device__ __forceinline__ void item(char* lds, const Tensors& T, int b, int h) {
    const int tid = otid(), wid = __builtin_amdgcn_readfirstlane(tid >> 6), lane = tid & 63, fr = lane & 15, fq = lane >> 4, half = lane >> 5, dl = (lane & 31) * 4;
    float* Fl = (float*)(lds + OFF_F); float* scn = (float*)(lds + OFF_SC);
    float* Pw = (float*)(lds + OFF_P) + wid * 1024; float* Aw = (float*)(lds + OFF_A) + wid * 16; float* ML = (float*)(lds + OFF_ML); float* Op = (float*)(lds + OFF_O);
    { const float* cl = T.clf + ((size_t)b * PAST + tid * 4) * NH + h;
      float a0 = cl[0], a1 = cl[NH], a2 = cl[2 * NH], a3 = cl[3 * NH];
      a1 += a0; a2 += a1; a3 += a2;
      const float tot = a3; float inc = tot;
#pragma unroll
      for (int o = 1; o < 64; o <<= 1) { const float v = __shfl_up(inc, o); if (lane >= o) inc += v; }
      if (lane == 63) scn[wid] = inc;
      __syncthreads();
      float base = inc - tot, all = 0.f;
      for (int w = 0; w < 8; ++w) { const float sw = scn[w]; if (w < wid) base += sw; all += sw; }
      *(f32x4*)(Fl + tid * 4) = (f32x4){(a0 + base) * (-LOG2E), (a1 + base) * (-LOG2E), (a2 + base) * (-LOG2E), (a3 + base) * (-LOG2E)};
      if (tid < DSEQ) { const float* nl = T.lfts + ((size_t)b * NH + h) * DSEQ; float s = all; for (int i = 0; i <= tid; ++i) s += nl[i]; Fl[PAST + tid] = s * (-LOG2E); }
      __syncthreads(); }
    const size_t qrow = (size_t)(MP + b * DSEQ);
    bf16x8 qf[4];
#pragma unroll
    for (int dc = 0; dc < 4; ++dc) qf[dc] = *(const bf16x8*)(T.q + (qrow + fr) * DM + h * HD + dc * 32 + fq * 8);
    float m_run = -1e30f, l_run = 0.f;
    f32x4 oacc[16];
#pragma unroll
    for (int q = 0; q < 16; ++q) oacc[q] = (f32x4){0.f, 0.f, 0.f, 0.f};
    for (int ch = 0; ch < 4; ++ch) {
        const int key0 = (ch * 8 + wid) * 64;
        f32x4 s4[4];
#pragma unroll
        for (int tl = 0; tl < 4; ++tl) { const int kbase = key0 + tl * 16;
            const float* kp = T.ck + (((size_t)b * PAST + kbase + fr) * NH + h) * HD + fq * 8;
            f32x4 acc = *(const f32x4*)(Fl + kbase + fq * 4);
#pragma unroll
            for (int dc = 0; dc < 4; ++dc) { const f32x4 x0 = *(const f32x4*)(kp + dc * 32), x1 = *(const f32x4*)(kp + dc * 32 + 4);
                acc = __builtin_amdgcn_mfma_f32_16x16x32_bf16(pack8(x0, x1), qf[dc], acc, 0, 0, 0); }
            s4[tl] = acc; }
        float cm = s4[0][0];
#pragma unroll
        for (int tl = 0; tl < 4; ++tl)
#pragma unroll
            for (int j = 0; j < 4; ++j) cm = fmaxf(cm, s4[tl][j]);
        cm = fmaxf(cm, __shfl_xor(cm, 16)); cm = fmaxf(cm, __shfl_xor(cm, 32));
        const float mn = fmaxf(m_run, cm), alpha = __builtin_amdgcn_exp2f(m_run - mn); m_run = mn;
        float ps = 0.f;
#pragma unroll
        for (int tl = 0; tl < 4; ++tl)
#pragma unroll
            for (int j = 0; j < 4; ++j) { const float p = __builtin_amdgcn_exp2f(s4[tl][j] - mn); ps += p; Pw[(tl * 16 + fq * 4 + j) * 16 + fr] = p; }
        ps += __shfl_xor(ps, 16); ps += __shfl_xor(ps, 32);
        l_run = l_run * alpha + ps;
        if (fq == 0) Aw[fr] = alpha;
        asm volatile("s_waitcnt lgkmcnt(0)" ::: "memory");
        { const f32x4 a0 = *(const f32x4*)(Aw), a1 = *(const f32x4*)(Aw + 4), a2 = *(const f32x4*)(Aw + 8), a3 = *(const f32x4*)(Aw + 12);
#pragma unroll
          for (int j = 0; j < 4; ++j) { oacc[j] *= a0[j]; oacc[4 + j] *= a1[j]; oacc[8 + j] *= a2[j]; oacc[12 + j] *= a3[j]; } }
        const float* vp = T.cv + (((size_t)b * PAST + key0 + half) * NH + h) * HD + dl;
#pragma unroll 8
        for (int kp2 = 0; kp2 < 32; ++kp2) { const f32x4 v = *(const f32x4*)(vp + (size_t)kp2 * 2 * NH * HD);
            const float* pr = Pw + (2 * kp2 + half) * 16;
            const f32x4 p0 = *(const f32x4*)(pr), p1 = *(const f32x4*)(pr + 4), p2 = *(const f32x4*)(pr + 8), p3 = *(const f32x4*)(pr + 12);
#pragma unroll
            for (int j = 0; j < 4; ++j) { oacc[j] += v * p0[j]; oacc[4 + j] += v * p1[j]; oacc[8 + j] += v * p2[j]; oacc[12 + j] += v * p3[j]; } }
        asm volatile("s_waitcnt lgkmcnt(0)" ::: "memory");
    }
    if (wid == 0) {
        f32x4 acc = *(const f32x4*)(Fl + PAST + fq * 4);
        const bf16_t* kp = T.kb + (qrow + fr) * DM + h * HD + fq * 8;
#pragma unroll
        for (int dc = 0; dc < 4; ++dc) acc = __builtin_amdgcn_mfma_f32_16x16x32_bf16(*(const bf16x8*)(kp + dc * 32), qf[dc], acc, 0, 0, 0);
#pragma unroll
        for (int j = 0; j < 4; ++j) if (fq * 4 + j > fr) acc[j] = -__builtin_inff();
        float cm = fmaxf(fmaxf(acc[0], acc[1]), fmaxf(acc[2], acc[3]));
        cm = fmaxf(cm, __shfl_xor(cm, 16)); cm = fmaxf(cm, __shfl_xor(cm, 32));
        const float mn = fmaxf(m_run, cm), alpha = __builtin_amdgcn_exp2f(m_run - mn); m_run = mn;
        float ps = 0.f;
#pragma unroll
        for (int j = 0; j < 4; ++j) { const float p = __builtin_amdgcn_exp2f(acc[j] - mn); ps += p; Pw[(fq * 4 + j) * 16 + fr] = p; }
        ps += __shfl_xor(ps, 16); ps += __shfl_xor(ps, 32);
        l_run = l_run * alpha + ps;
        if (fq == 0) Aw[fr] = alpha;
        asm volatile("s_waitcnt lgkmcnt(0)" ::: "memory");
        { const f32x4 a0 = *(const f32x4*)(Aw), a1 = *(const f32x4*)(Aw + 4), a2 = *(const f32x4*)(Aw + 8), a3 = *(const f32x4*)(Aw + 12);
#pragma unroll
          for (int j = 0; j < 4; ++j) { oacc[j] *= a0[j]; oacc[4 + j] *= a1[j]; oacc[8 + j] *= a2[j]; oacc[12 + j] *= a3[j]; } }
        const bf16_t* vp = T.vb + (qrow + half) * DM + h * HD + dl;
#pragma unroll
        for (int kp2 = 0; kp2 < 8; ++kp2) { const u32x2 vw = *(const u32x2*)(vp + (size_t)kp2 * 2 * DM);
            const f32x4 v = {bflo(vw.x), bfhi(vw.x), bflo(vw.y), bfhi(vw.y)};
            const float* pr = Pw + (2 * kp2 + half) * 16;
            const f32x4 p0 = *(const f32x4*)(pr), p1 = *(const f32x4*)(pr + 4), p2 = *(const f32x4*)(pr + 8), p3 = *(const f32x4*)(pr + 12);
#pragma unroll
            for (int j = 0; j < 4; ++j) { oacc[j] += v * p0[j]; oacc[4 + j] += v * p1[j]; oacc[8 + j] += v * p2[j]; oacc[12 + j] += v * p3[j]; } }
        asm volatile("s_waitcnt lgkmcnt(0)" ::: "memory");
    }
#pragma unroll
    for (int q = 0; q < 16; ++q)
#pragma unroll
        for (int c = 0; c < 4; ++c) oacc[q][c] += __shfl_xor(oacc[q][c], 32);
    if (lane < 32) {
#pragma unroll
        for (int q = 0; q < 16; ++q) *(f32x4*)(Op + (wid * 16 + q) * HD + dl) = oacc[q]; }
    if (fq == 0) { ML[(wid * 16 + fr) * 2] = m_run; ML[(wid * 16 + fr) * 2 + 1] = l_run; }
    __syncthreads();
    { const int q = tid >> 5, d4 = (tid & 31) * 4;
      float mx = ML[q * 2];
#pragma unroll
      for (int w = 1; w < 8; ++w) mx = fmaxf(mx, ML[(w * 16 + q) * 2]);
      float L = 0.f; f32x4 O = {0.f, 0.f, 0.f, 0.f};
#pragma unroll
      for (int w = 0; w < 8; ++w) { const float s = __builtin_amdgcn_exp2f(ML[(w * 16 + q) * 2] - mx); L += s * ML[(w * 16 + q) * 2 + 1]; O += *(const f32x4*)(Op + (w * 16 + q) * HD + d4) * s; }
      const float il = 1.0f / L; const size_t off = (qrow + q) * DM + h * HD + d4;
      const u32x2 gw = *(const u32x2*)(T.sg + off);
      u32x2 w; w.x = cvtpk(O[0] * il * bflo(gw.x), O[1] * il * bfhi(gw.x)); w.y = cvtpk(O[2] * il * bflo(gw.y), O[3] * il * bfhi(gw.y));
      *(u32x2*)(T.og + off) = w; }
    __syncthreads();
}
}

__device__ __forceinline__ void transpose_item(const float* W, int N, bf16_t* WT, int K, const float* g, float* scr, int item, int lane) {
    const int nblk = (N + 31) / 32, kb = item / nblk, nb = item % nblk, k0 = 64 * kb, n0 = 32 * nb;
    const int n = n0 + (lane & 31); const bool nok = n < N;
#pragma unroll 8
    for (int i = 0; i < 32; ++i) { const int kk = 2 * i + (lane >> 5); float v = nok ? W[(size_t)(k0 + kk) * N + n] : 0.f; if (g) v *= g[k0 + kk]; scr[kk * 33 + (lane & 31)] = v; }
    asm volatile("s_waitcnt lgkmcnt(0)" ::: "memory");
    const int c = lane & 7;
#pragma unroll
    for (int j = 0; j < 4; ++j) { const int nn = (lane >> 3) + 8 * j; const float* s = scr + (8 * c) * 33 + nn;
        u32x4 o; o.x = cvtpk(s[0 * 33], s[1 * 33]); o.y = cvtpk(s[2 * 33], s[3 * 33]); o.z = cvtpk(s[4 * 33], s[5 * 33]); o.w = cvtpk(s[6 * 33], s[7 * 33]);
        if (n0 + nn < N) *(u32x4*)(WT + (size_t)(n0 + nn) * K + k0 + 8 * c) = o; }
    asm volatile("s_waitcnt lgkmcnt(0)" ::: "memory");
}
struct TJob { const float* W; bf16_t* WT; const float* g; int K, N; };
__device__ __forceinline__ TJob get_job(const Params& p, int j) {
    unsigned char* ws = p.ws; TJob t; t.g = nullptr;
    if (j < 2) { t.W = p.in[7] + (size_t)j * DM * 2 * EA; t.WT = (bf16_t*)(ws + WS_WINA) + (size_t)j * 2 * EA * DM; t.g = p.in[6] + j * DM; t.K = DM; t.N = 2 * EA; }
    else if (j < 10) { const int i = j - 2; t.W = p.in[8] + (size_t)i * 1024 * 1024; t.WT = (bf16_t*)(ws + WS_WGRP) + (size_t)i * 1024 * 1024; t.K = 1024; t.N = 1024; }
    else if (j < 12) { const int l = j - 10; t.W = p.in[10] + (size_t)l * EA * DM; t.WT = (bf16_t*)(ws + WS_WOUTA) + (size_t)l * DM * EA; t.K = EA; t.N = DM; }
    else if (j == 12) { t.W = p.in[12]; t.WT = (bf16_t*)(ws + WS_W4); t.g = p.in[11]; t.K = DM; t.N = 2 * DM + NH; }
    else if (j == 13) { t.W = p.in[15]; t.WT = (bf16_t*)(ws + WS_W4) + (size_t)4352 * DM; t.g = p.in[14]; t.K = DM; t.N = 2 * DM; }
    else if (j == 14) { t.W = p.in[15] + (size_t)DM * 2 * DM; t.WT = (bf16_t*)(ws + WS_WINB1); t.g = p.in[14] + DM; t.K = DM; t.N = 2 * DM; }
    else { const int l = j - 15; t.W = p.in[16] + (size_t)l * DM * DM; t.WT = (bf16_t*)(ws + WS_WOUTB) + (size_t)l * DM * DM; t.K = DM; t.N = DM; }
    return t;
}
__device__ __forceinline__ void prologue_phase(const Params& p, char* lds) {
    const int tid = otid(), lane = tid & 63, wid = tid >> 6, G = gridDim.x;
    const int gw = blockIdx.x * NWAVES + wid, NGW = G * NWAVES;
    float* scr = (float*)(lds + wid * 8704);
    int rot = 0;
    for (int j = 0; j < 17; ++j) { const TJob t = get_job(p, j); const int nitems = (t.K / 64) * ((t.N + 31) / 32);
        int start = gw - rot; if (start < 0) start += NGW;
        for (int it = start; it < nitems; it += NGW) transpose_item(t.W, t.N, t.WT, t.K, t.g, scr, it, lane);
        rot = (rot + nitems) % NGW; }
    float* ssq = (float*)(p.ws + WS_SSQ); bf16_t* xb = (bf16_t*)(p.ws + WS_XB);
    for (int m = gw; m < MT; m += NGW) { const float* xr = m < MP ? p.in[0] + (size_t)m * DM : p.in[1] + (size_t)(m - MP) * DM;
        float s = 0.f; unsigned long long* o8 = (unsigned long long*)(xb + (size_t)m * DM) + lane;
#pragma unroll
        for (int j = 0; j < 8; ++j) { const f32x4 v = *((const f32x4*)xr + lane + 64 * j); s += (v[0] * v[0] + v[1] * v[1]) + (v[2] * v[2] + v[3] * v[3]);
            o8[64 * j] = (unsigned long long)cvtpk(v[0], v[1]) | ((unsigned long long)cvtpk(v[2], v[3]) << 32); }
        s = wave_sum(s); if (lane == 0) ssq[m] = s; }
    for (int i = blockIdx.x * NTHREADS + tid; i < 4 * MT; i += G * NTHREADS) ssq[MT + i] = 0.f;
}
__device__ __forceinline__ void poold_phase(const Params& p, int l) {
    const bf16_t* u = (const bf16_t*)(p.ws + WS_U); bf16_t* d = (bf16_t*)(p.ws + WS_D);
    const float* prev = p.in[5] + (size_t)l * NDB * PPAD * EA;
    const int nth = gridDim.x * NTHREADS;
    for (int idx = blockIdx.x * NTHREADS + otid(); idx < MT * (EA / 8); idx += nth) {
        const int row = idx >> 9, ch = (idx & 511) * 8, w = 2 << (ch >> 10);
        float s[8] = {0.f, 0.f, 0.f, 0.f, 0.f, 0.f, 0.f, 0.f}; float cnt; float u0[8];
        const bf16_t* up = u + (size_t)row * EA + ch;
        int nrows, t, bs = 0;
        if (row < MP) { t = row & (SEQ - 1); nrows = (t + 1 < w) ? t + 1 : w; cnt = (float)nrows; }
        else { const int rs = row - MP; bs = rs >> 4; t = rs & 15; nrows = (t + 1 < w) ? t + 1 : w; cnt = (float)w; }
        for (int i = 0; i < nrows; ++i) { const u32x4 v = *(const u32x4*)(up - (size_t)i * EA);
            const float f[8] = {bflo(v.x), bfhi(v.x), bflo(v.y), bfhi(v.y), bflo(v.z), bfhi(v.z), bflo(v.w), bfhi(v.w)};
#pragma unroll
            for (int c = 0; c < 8; ++c) { s[c] += f[c]; if (i == 0) u0[c] = f[c]; } }
        if (row >= MP) { for (int i = nrows; i < w; ++i) { const float* pp = prev + ((size_t)bs * PPAD + (PPAD + t - i)) * EA + ch;
                const f32x4 a = *(const f32x4*)pp, b = *(const f32x4*)(pp + 4);
                s[0] += a[0]; s[1] += a[1]; s[2] += a[2]; s[3] += a[3]; s[4] += b[0]; s[5] += b[1]; s[6] += b[2]; s[7] += b[3]; } }
        const float ic = 1.0f / cnt;
        u32x4 o; o.x = cvtpk(s[0] * ic - u0[0], s[1] * ic - u0[1]); o.y = cvtpk(s[2] * ic - u0[2], s[3] * ic - u0[3]);
        o.z = cvtpk(s[4] * ic - u0[4], s[5] * ic - u0[5]); o.w = cvtpk(s[6] * ic - u0[6], s[7] * ic - u0[7]);
        *(u32x4*)(d + (size_t)row * EA + ch) = o;
    }
}
__device__ __forceinline__ void final_phase(const Params& p) {
    const int tid = otid(), lane = tid & 63, gw = blockIdx.x * NWAVES + (tid >> 6), NGW = gridDim.x * NWAVES;
    const float* xres = (const float*)(p.ws + WS_XRES); const float* ssq = (const float*)(p.ws + WS_SSQ) + (size_t)4 * MT; const float* g = p.in[17];
    for (int m = gw; m < MT; m += NGW) { const float rr = rsqrtf(ssq[m] * (1.0f / DM) + EPS);
        const f32x4* xr = (const f32x4*)(xres + (size_t)m * DM) + lane; f32x4* o = (f32x4*)(p.out + (m < MP ? O_YP + (size_t)m * DM : O_YS + (size_t)(m - MP) * DM)) + lane;
#pragma unroll
        for (int j = 0; j < 8; ++j) o[64 * j] = xr[64 * j] * rr * ((const f32x4*)g)[lane + 64 * j]; }
}

constexpr int NPHASES = 16;
__global__ void __launch_bounds__(NTHREADS, 2) yoco_fwd(Params p) {
    extern __shared__ __attribute__((aligned(16))) unsigned char lds_raw[];
    char* lds = (char*)lds_raw; LAS unsigned char* ldsl = (LAS unsigned char*)lds_raw;
    unsigned char* ws = p.ws; const int G = gridDim.x, bx = blockIdx.x;
    const int vw = (G % 8 == 0) ? (bx % 8) * (G / 8) + bx / 8 : bx;
    float* ssq = (float*)(ws + WS_SSQ); bf16_t* xb = (bf16_t*)(ws + WS_XB); float* xres = (float*)(ws + WS_XRES);
#ifndef ONLY_PHASE
#define ONLY_PHASE -1
#endif
#define IN(k) ((ONLY_PHASE < 0 || ONLY_PHASE == (k)) && p.ph_lo <= (k) && (k) < p.ph_hi)
#define SEAM(k) do { if ((k) + 1 < p.ph_hi) cg::this_grid().sync(); } while (0)
    if (IN(0)) { prologue_phase(p, lds); SEAM(0); }
#pragma unroll 1
    for (int l = 0; l < 2; ++l) {
        bf16_t* u = (bf16_t*)(ws + WS_U); bf16_t* sg = (bf16_t*)(ws + WS_SG); bf16_t* d = (bf16_t*)(ws + WS_D);
        if (IN(1 + 4 * l)) { pg8::Gemm g{xb, (const bf16_t*)(ws + WS_WINA) + (size_t)l * 2 * EA * DM, 65, 32, DM, DM, -1}; pg8::StaticOrder S; S.init(65, 32, G, bx);
            pg8::EpiInA E{ssq + (size_t)l * MT, u, sg, p.out + O_PP + (size_t)l * NBATCH * PPAD * EA, p.out + O_PS + (size_t)l * NDB * PPAD * EA};
            pg8::gemm_phase<pg8::EpiInA>(ldsl, g, S, E); SEAM(1 + 4 * l); }
        if (IN(2 + 4 * l)) { poold_phase(p, l); SEAM(2 + 4 * l); }
        if (IN(3 + 4 * l)) { pg8::Gemm g{d, (const bf16_t*)(ws + WS_WGRP) + (size_t)l * EA * 1024, 65, 16, 1024, EA, 2}; pg8::StaticOrder S; S.init(65, 16, G, bx);
            pg8::EpiPool E{p.in[9] + (size_t)l * EA, sg, u};
            pg8::gemm_phase<pg8::EpiPool>(ldsl, g, S, E); SEAM(3 + 4 * l); }
        if (IN(4 + 4 * l)) { pg8::Gemm g{u, (const bf16_t*)(ws + WS_WOUTA) + (size_t)l * DM * EA, 65, 8, EA, EA, -1}; pg8::StaticOrder S; S.init(65, 8, G, bx);
            pg8::EpiRes E{l == 0 ? p.in[0] : xres, l == 0 ? p.in[1] : xres + (size_t)MP * DM, xres, xb, ssq + (size_t)(l + 1) * MT};
            pg8::gemm_phase<pg8::EpiRes>(ldsl, g, S, E); SEAM(4 + 4 * l); }
    }
#pragma unroll 1
    for (int lb = 0; lb < 2; ++lb) {
        if (IN(9 + 3 * lb)) {
            pg8::Gemm g{xb, lb == 0 ? (const bf16_t*)(ws + WS_W4) : (const bf16_t*)(ws + WS_WINB1), 65, lb == 0 ? 33 : 16, DM, DM, -1};
            pg8::StaticOrder S; S.init(65, g.nN, G, bx);
            pg8::EpiKVQ E{lb == 0 ? 0 : 17, ssq + (size_t)(2 + lb) * MT, p.out, ws, p.in[13]};
            pg8::gemm_phase<pg8::EpiKVQ>(ldsl, g, S, E); SEAM(9 + 3 * lb); }
        if (IN(10 + 3 * lb)) {
            sat::Tensors ST{(const bf16_t*)(ws + WS_QB), (const bf16_t*)(ws + WS_KB), (const bf16_t*)(ws + WS_VB), (bf16_t*)(ws + WS_OG), (const bf16_t*)(ws + WS_SGB),
                            p.in[2], p.in[3], p.in[4], (const float*)(ws + WS_LFTS)};
            att::Tensors AT{(const bf16_t*)(ws + WS_QB), (const bf16_t*)(ws + WS_KB), (const bf16_t*)(ws + WS_VB), (bf16_t*)(ws + WS_OG), (const bf16_t*)(ws + WS_SGB), (const float*)(ws + WS_LFTP)};
#if !defined(NO_SAT)
            for (int it = bx; it < NDB * NH; it += G) sat::item(lds, ST, it >> 4, it & 15);
#endif
#if !defined(NO_ATT)
            att::prompt_phase(lds, AT, vw, G);
#endif
            SEAM(10 + 3 * lb); }
        if (IN(11 + 3 * lb)) {
            pg8::Gemm g{(const bf16_t*)(ws + WS_OG), (const bf16_t*)(ws + WS_WOUTB) + (size_t)lb * DM * DM, 65, 8, DM, DM, -1}; pg8::StaticOrder S; S.init(65, 8, G, bx);
            pg8::EpiRes E{xres, xres + (size_t)MP * DM, xres, xb, ssq + (size_t)(3 + lb) * MT};
            pg8::gemm_phase<pg8::EpiRes>(ldsl, g, S, E); SEAM(11 + 3 * lb); }
    }
    if (IN(15)) final_phase(p);
#undef IN
#undef SEAM
}

extern "C" void kernel_launch(void* const* d_in, const int* in_sizes, int n_in, void* d_out, int out_size, void* d_ws, size_t ws_size, hipStream_t stream) {
    static int grid = 0;
    if (grid == 0) {
        if (n_in != 18 || (size_t)out_size != O_END || ws_size < WS_END) { fprintf(stderr, "kernel_launch: unexpected shapes: n_in %d out %d (want %zu) ws %zu (need %zu)\n", n_in, out_size, (size_t)O_END, ws_size, (size_t)WS_END); grid = -1; return; }
        int dev = 0, cus = 0, per_cu = 0;
        (void)hipGetDevice(&dev); (void)hipDeviceGetAttribute(&cus, hipDeviceAttributeMultiprocessorCount, dev);
        if (hipFuncSetAttribute((const void*)yoco_fwd, hipFuncAttributeMaxDynamicSharedMemorySize, LDS_BYTES) != hipSuccess) { fprintf(stderr, "kernel_launch: hipFuncSetAttribute failed\n"); grid = -1; return; }
        if (hipOccupancyMaxActiveBlocksPerMultiprocessor(&per_cu, (const void*)yoco_fwd, NTHREADS, LDS_BYTES) != hipSuccess || per_cu < 1) { fprintf(stderr, "kernel_launch: occupancy query gave %d\n", per_cu); per_cu = 1; }
        (void)hipGetLastError();
        grid = cus > 0 ? cus : 256;
    }
    if (grid < 0) return;
    Params p{};
    for (int i = 0; i < 18; ++i) p.in[i] = (const float*)d_in[i];
    p.out = (float*)d_out; p.ws = (unsigned char*)d_ws;
#if MULTI_LAUNCH
    for (int ph = 0; ph < NPHASES; ++ph) { p.ph_lo = ph; p.ph_hi = ph + 1; hipLaunchKernelGGL(yoco_fwd, dim3(grid), dim3(NTHREADS), LDS_BYTES, stream, p); }
#else
    p.ph_lo = 0; p.ph_hi = NPHASES;
    void* args[] = {&p};
    hipError_t e = hipLaunchCooperativeKernel((const void*)yoco_fwd, dim3(grid), dim3(NTHREADS), args, LDS_BYTES, stream);
    if (e != hipSuccess) fprintf(stderr, "kernel_launch: cooperative launch failed: %s (grid %d)\n", hipGetErrorString(e), grid);
#endif
}
```

```cpp
#include <hip/hip_runtime.h>
#include <hip/hip_cooperative_groups.h>
#include <cstdio>
#include <cstdint>
namespace cg = cooperative_groups;

#ifndef MULTI_LAUNCH
#define MULTI_LAUNCH 0
#endif

#define LAS __attribute__((address_space(3)))
typedef unsigned short bf16_t;
typedef short bf16x8 __attribute__((ext_vector_type(8)));
typedef short s16x4 __attribute__((ext_vector_type(4)));
typedef float f32x4 __attribute__((ext_vector_type(4)));
typedef float f32x16 __attribute__((ext_vector_type(16)));
typedef unsigned u32x4 __attribute__((ext_vector_type(4)));
typedef unsigned u32x2 __attribute__((ext_vector_type(2)));

constexpr int DM = 2048, NBATCH = 4, SEQ = 4096, NDB = 16, DSEQ = 16, PAST = 2048, EA = 4096, NH = 16, HD = 128, PPAD = 15;
constexpr int MP = NBATCH * SEQ, MS = NDB * DSEQ, MT = MP + MS;
constexpr float EPS = 1e-6f;
constexpr float LOG2E = 1.4426950408889634f;
constexpr float QSCALE = 0.08838834764831845f * 1.4426950408889634f;
constexpr int NTHREADS = 512, NWAVES = 8;
constexpr int LDS_BYTES = 131072;

constexpr size_t O_YP = 0, O_YS = O_YP + (size_t)MP * DM, O_KP = O_YS + (size_t)MS * DM, O_VP = O_KP + (size_t)MP * DM,
                 O_LFP = O_VP + (size_t)MP * DM, O_PP = O_LFP + (size_t)MP * NH, O_KS = O_PP + (size_t)2 * NBATCH * PPAD * EA,
                 O_VS = O_KS + (size_t)MS * DM, O_LFS = O_VS + (size_t)MS * DM, O_PS = O_LFS + (size_t)MS * NH, O_END = O_PS + (size_t)2 * NDB * PPAD * EA;

constexpr size_t al256(size_t x) { return (x + 255) & ~(size_t)255; }
constexpr size_t WS_WINA = 0;
constexpr size_t WS_WGRP = WS_WINA + (size_t)2 * 8192 * 2048 * 2;
constexpr size_t WS_WOUTA = WS_WGRP + (size_t)2 * 4096 * 1024 * 2;
constexpr size_t WS_W4 = WS_WOUTA + (size_t)2 * 2048 * 4096 * 2;
constexpr size_t WS_WINB1 = WS_W4 + (size_t)8448 * 2048 * 2;
constexpr size_t WS_WOUTB = WS_WINB1 + (size_t)4096 * 2048 * 2;
constexpr size_t WS_XB = WS_WOUTB + (size_t)2 * 2048 * 2048 * 2;
constexpr size_t WS_XRES = WS_XB + (size_t)MT * DM * 2;
constexpr size_t WS_SSQ = WS_XRES + (size_t)MT * DM * 4;
constexpr size_t WS_LFTP = al256(WS_SSQ + (size_t)5 * MT * 4);
constexpr size_t WS_LFTS = WS_LFTP + (size_t)NBATCH * NH * SEQ * 4;
constexpr size_t WS_ACT = al256(WS_LFTS + (size_t)NDB * NH * DSEQ * 4);
constexpr size_t SZ_A = (size_t)MT * EA * 2, SZ_B = (size_t)MT * DM * 2;
constexpr size_t WS_U = WS_ACT, WS_SG = WS_U + SZ_A, WS_D = WS_SG + SZ_A;
constexpr size_t WS_KB = WS_ACT, WS_VB = WS_KB + SZ_B, WS_QB = WS_VB + SZ_B, WS_SGB = WS_QB + SZ_B, WS_OG = WS_SGB + SZ_B;
constexpr size_t WS_END = (WS_D + SZ_A) > (WS_OG + SZ_B) ? (WS_D + SZ_A) : (WS_OG + SZ_B);

struct Params { const float* in[18]; float* out; unsigned char* ws; int ph_lo, ph_hi; };

__device__ __forceinline__ unsigned cvtpk(float lo, float hi) { unsigned r; asm volatile("v_cvt_pk_bf16_f32 %0, %1, %2" : "=v"(r) : "v"(lo), "v"(hi)); return r; }
__device__ __forceinline__ bf16x8 pack8(f32x4 a, f32x4 b) { u32x4 w = {cvtpk(a[0], a[1]), cvtpk(a[2], a[3]), cvtpk(b[0], b[1]), cvtpk(b[2], b[3])}; return *reinterpret_cast<bf16x8*>(&w); }
__device__ __forceinline__ float bflo(unsigned w) { return __uint_as_float(w << 16); }
__device__ __forceinline__ float bfhi(unsigned w) { return __uint_as_float(w & 0xffff0000u); }
__device__ __forceinline__ float silu_f(float x) { return x * __builtin_amdgcn_rcpf(1.0f + __builtin_amdgcn_exp2f(-x * LOG2E)); }
__device__ __forceinline__ float wave_sum(float v) {
#pragma unroll
    for (int o = 1; o < 64; o <<= 1) v += __shfl_xor(v, o);
    return v;
}
__device__ __forceinline__ int otid(int wv) { int t = wv * 64 + (int)__builtin_amdgcn_mbcnt_hi(~0u, __builtin_amdgcn_mbcnt_lo(~0u, 0u)); asm volatile("" : "+v"(t)); return t; }
__device__ __forceinline__ float logsig(float x) { return fminf(x, 0.f) - log1pf(__expf(-fabsf(x))); }

namespace pg8 {
constexpr int BM = 256, BK = 64, HALF = 128, HTB = HALF * BK * 2, NXCD = 8, WGM = 8;
__device__ __forceinline__ int lds_byte(int r, int c) { const int st = (r >> 4) * 2 + (c >> 5), rr = r & 15, cc = c & 31, ob = rr * 64 + cc * 2; return st * 1024 + (ob ^ (((ob >> 9) & 1) << 5)); }
__device__ __forceinline__ void stage_rc(int b, int& R, int& C) { const int st = b / 1024, sb = b % 1024, swz = sb ^ (((sb >> 9) & 1) << 5); R = (st >> 1) * 16 + swz / 64; C = (st & 1) * 32 + (swz % 64) / 2; }
__device__ __forceinline__ int perm32(int rho) { const int n = rho >> 4, i = rho & 15; return 8 * (i >> 2) + 4 * n + (i & 3); }
struct Unit { int pm, pn; };
struct Gemm { const bf16_t* A; const bf16_t* Bt; int nM, nN, K, lda, ashift; };
struct StaticOrder {
    int nM, nN, nwg, G, c;
    __device__ void init(int nM_, int nN_, int G_, int c_) { nM = nM_; nN = nN_; nwg = nM * nN; G = G_; c = c_; }
    __device__ bool next(int i, Unit& u) const {
        const long L = (long)i * G + c; if (L >= nwg) return false;
        int wgid = (int)L; { const int q = nwg / NXCD, r = nwg % NXCD, xcd = wgid % NXCD, off = wgid / NXCD; wgid = (xcd < r ? xcd * (q + 1) : r * (q + 1) + (xcd - r) * q) + off; }
        const int nig = WGM * nN, gid = wgid / nig, fm = gid * WGM, gsz = (nM - fm) < WGM ? (nM - fm) : WGM;
        u.pm = fm + ((wgid % nig) % gsz); u.pn = (wgid % nig) / gsz; return true;
    }
};

template <class Epi>
__device__ __forceinline__ void gemm_phase(int wv, LAS unsigned char* lds, const Gemm g, const StaticOrder& S, const Epi& E) {
    const int tid = otid(wv), wid = __builtin_amdgcn_readfirstlane(tid >> 6), lane = tid & 63, wr = wid >> 2, wc = wid & 3, fr = lane & 15, fq = lane >> 4;
    const int K = g.K, nt = K / BK;
    unsigned voffA[2], voffB[2];
#pragma unroll
    for (int i = 0; i < 2; ++i) { int R, C; stage_rc(tid * 16 + i * 8192, R, C); const int Rb = Epi::PERM ? ((R & ~31) + perm32(R & 31)) : R;
        voffA[i] = (unsigned)(R * g.lda + C) * 2u; voffB[i] = (unsigned)(Rb * K + C) * 2u; }
    const size_t kstep = (size_t)(BK * 2);
    const size_t hstepA = (size_t)HALF * g.lda * 2, tstepA = 2 * hstepA;
    const size_t hstepB = (size_t)HALF * K * 2, tstepB = 2 * hstepB;
    const unsigned ldsw = (unsigned)wid * 1024u;
    const int aoff = lds_byte(wr * 64 + fr, fq * 8), boff = lds_byte(wc * 32 + fr, fq * 8);
#define PG8_SA(b, h) (((b) * 2 + (h)) * HTB)
#define PG8_SB(b, h) ((4 + (b) * 2 + (h)) * HTB)
#define PG8_STAGE(bufoff, gbase, voff) do { _Pragma("unroll") for (int _i = 0; _i < 2; ++_i) \
        __builtin_amdgcn_global_load_lds((const unsigned*)((const char*)(gbase) + (voff)[_i]), (LAS unsigned*)(lds + (bufoff) + ldsw + _i * 8192), 16, 0, 0); } while (0)
#define PG8_LDA(dst, b, h) do { _Pragma("unroll") for (int m = 0; m < 4; ++m) _Pragma("unroll") for (int k = 0; k < 2; ++k) dst[m][k] = *(const LAS bf16x8*)(lds + PG8_SA(b, h) + aoff + m * 2048 + k * 1024); } while (0)
#define PG8_LDB(dst, b, h) do { _Pragma("unroll") for (int n = 0; n < 2; ++n) _Pragma("unroll") for (int k = 0; k < 2; ++k) dst[n][k] = *(const LAS bf16x8*)(lds + PG8_SB(b, h) + boff + n * 2048 + k * 1024); } while (0)
#define PG8_MMA(ai, bj, At, Bt) do { __builtin_amdgcn_s_setprio(1); _Pragma("unroll") for (int m = 0; m < 4; ++m) _Pragma("unroll") for (int n = 0; n < 2; ++n) _Pragma("unroll") for (int k = 0; k < 2; ++k) \
        acc[ai][bj][m][n] = __builtin_amdgcn_mfma_f32_16x16x32_bf16(Bt[n][k], At[m][k], acc[ai][bj][m][n], 0, 0, 0); __builtin_amdgcn_s_setprio(0); } while (0)
#define PG8_WAIT_V(n) asm volatile("s_waitcnt vmcnt(" #n ")" ::: "memory")
#define PG8_WAIT_L(n) asm volatile("s_waitcnt lgkmcnt(" #n ")" ::: "memory")
#define PG8_BAR __builtin_amdgcn_s_barrier()
#define PG8_SCHED __builtin_amdgcn_sched_barrier(0)
#define PG8_ACOL(u) (g.ashift >= 0 ? (size_t)((u).pn >> g.ashift) * (size_t)K * 2 : (size_t)0)
    Unit cur, nxt; int ui = 0;
    if (!S.next(0, cur)) return;
    f32x4 acc[2][2][4][2];
#pragma unroll
    for (int a = 0; a < 2; ++a)
#pragma unroll
        for (int b = 0; b < 2; ++b)
#pragma unroll
            for (int m = 0; m < 4; ++m)
#pragma unroll
                for (int n = 0; n < 2; ++n) acc[a][b][m][n] = (f32x4){0.f, 0.f, 0.f, 0.f};
    bf16x8 At[4][2], B0[2][2], B1[2][2];
    const char* cA = (const char*)g.A + (size_t)cur.pm * tstepA + PG8_ACOL(cur); const char* cB = (const char*)g.Bt + (size_t)cur.pn * tstepB;
    PG8_STAGE(PG8_SB(0, 0), cB, voffB); PG8_STAGE(PG8_SA(0, 0), cA, voffA); PG8_STAGE(PG8_SB(0, 1), cB + hstepB, voffB); PG8_STAGE(PG8_SA(0, 1), cA + hstepA, voffA);
    if (wr == 1) PG8_BAR;
    PG8_WAIT_V(4); PG8_BAR;
    PG8_STAGE(PG8_SB(1, 0), cB + kstep, voffB); PG8_STAGE(PG8_SA(1, 0), cA + kstep, voffA); PG8_STAGE(PG8_SB(1, 1), cB + hstepB + kstep, voffB);
    PG8_WAIT_V(6); PG8_BAR;
    for (;;) {
        const bool has_next = S.next(ui + 1, nxt);
        const char* nA = has_next ? (const char*)g.A + (size_t)nxt.pm * tstepA + PG8_ACOL(nxt) : cA; const char* nB = has_next ? (const char*)g.Bt + (size_t)nxt.pn * tstepB : cB;
        for (int t = 0; t < nt; t += 2) {
            const bool last = (t == nt - 2);
            const char* a1 = cA + (size_t)(t + 1) * kstep;
            const char* a2 = last ? nA : cA + (size_t)(t + 2) * kstep; const char* b2 = last ? nB : cB + (size_t)(t + 2) * kstep;
            const char* a3 = a2 + kstep; const char* b3 = b2 + kstep;
            PG8_LDB(B0, 0, 0); PG8_SCHED; PG8_LDA(At, 0, 0); PG8_STAGE(PG8_SA(1, 1), a1 + hstepA, voffA);
            PG8_WAIT_L(8); PG8_BAR; PG8_WAIT_L(0); PG8_MMA(0, 0, At, B0); PG8_BAR; PG8_SCHED;
            PG8_LDB(B1, 0, 1); PG8_STAGE(PG8_SB(0, 0), b2, voffB);
            PG8_BAR; PG8_WAIT_L(0); PG8_MMA(0, 1, At, B1); PG8_BAR;
            PG8_LDA(At, 0, 1); PG8_STAGE(PG8_SA(0, 0), a2, voffA);
            PG8_BAR; PG8_WAIT_L(0); PG8_MMA(1, 0, At, B0); PG8_BAR; PG8_SCHED;
            PG8_STAGE(PG8_SB(0, 1), b2 + hstepB, voffB);
            PG8_WAIT_V(6); PG8_BAR; PG8_MMA(1, 1, At, B1); PG8_BAR;
            PG8_LDB(B0, 1, 0); PG8_SCHED; PG8_LDA(At, 1, 0); PG8_STAGE(PG8_SA(0, 1), a2 + hstepA, voffA);
            PG8_WAIT_L(8); PG8_BAR; PG8_WAIT_L(0); PG8_MMA(0, 0, At, B0); PG8_BAR; PG8_SCHED;
            PG8_LDB(B1, 1, 1); PG8_STAGE(PG8_SB(1, 0), b3, voffB);
            PG8_BAR; PG8_WAIT_L(0); PG8_MMA(0, 1, At, B1); PG8_BAR;
            PG8_LDA(At, 1, 1); PG8_STAGE(PG8_SA(1, 0), a3, voffA);
            PG8_BAR; PG8_WAIT_L(0); PG8_MMA(1, 0, At, B0); PG8_BAR; PG8_SCHED;
            PG8_STAGE(PG8_SB(1, 1), b3 + hstepB, voffB);
            PG8_WAIT_V(6); PG8_BAR; PG8_MMA(1, 1, At, B1); PG8_BAR;
        }
        E(acc, cur, wr, wc, fr, fq);
        if (!has_next) break;
#pragma unroll
        for (int a = 0; a < 2; ++a)
#pragma unroll
            for (int b = 0; b < 2; ++b)
#pragma unroll
                for (int m = 0; m < 4; ++m)
#pragma unroll
                    for (int n = 0; n < 2; ++n) acc[a][b][m][n] = (f32x4){0.f, 0.f, 0.f, 0.f};
        cur = nxt; cA = nA; cB = nB; ++ui;
    }
    PG8_WAIT_V(0);
    if (wr == 0) PG8_BAR;
    PG8_BAR;
#undef PG8_SA
#undef PG8_SB
#undef PG8_STAGE
#undef PG8_LDA
#undef PG8_LDB
#undef PG8_MMA
#undef PG8_WAIT_V
#undef PG8_WAIT_L
#undef PG8_BAR
#undef PG8_SCHED
#undef PG8_ACOL
}

typedef const f32x4 (&AccRef)[2][2][4][2];

struct EpiInA {
    static constexpr bool PERM = true;
    const float* ssq; bf16_t* u; bf16_t* sg; float* pool_p; float* pool_s;
    __device__ __forceinline__ void operator()(AccRef acc, const Unit& un, int wr, int wc, int fr, int fq) const {
        const int row0 = un.pm * BM + wr * 64 + fr, colt = un.pn * BM + wc * 32 + 8 * fq;
        const bool is_u = un.pn < 16;
        const bool has_pool = is_u && (un.pm == 64 || (un.pm & 15) == 15);
        float rrs[2][4];
#pragma unroll
        for (int ai = 0; ai < 2; ++ai)
#pragma unroll
            for (int m = 0; m < 4; ++m) rrs[ai][m] = ssq[row0 + ai * HALF + m * 16];
#pragma unroll
        for (int ai = 0; ai < 2; ++ai)
#pragma unroll
            for (int m = 0; m < 4; ++m) { const int row = row0 + ai * HALF + m * 16; const float rr = rsqrtf(rrs[ai][m] * (1.0f / DM) + EPS);
                float* pp = nullptr;
                if (has_pool) { if (row < MP) { const int t = row & (SEQ - 1); if (t >= SEQ - PPAD) pp = pool_p + ((size_t)(row >> 12) * PPAD + (t - (SEQ - PPAD))) * EA; }
                                else { const int rs = row - MP, t = rs & 15; if (t >= 1) pp = pool_s + ((size_t)(rs >> 4) * PPAD + (t - 1)) * EA; } }
#pragma unroll
                for (int bj = 0; bj < 2; ++bj) { f32x4 v0 = acc[ai][bj][m][0] * rr, v1 = acc[ai][bj][m][1] * rr; const int col = colt + bj * HALF;
                    if (is_u) { if (pp) { *(f32x4*)(pp + col) = v0; *(f32x4*)(pp + col + 4) = v1; }
                        *(bf16x8*)(u + (size_t)row * EA + col) = pack8(v0, v1); }
                    else {
#pragma unroll
                        for (int j = 0; j < 4; ++j) { v0[j] = silu_f(v0[j]); v1[j] = silu_f(v1[j]); }
                        *(bf16x8*)(sg + (size_t)row * EA + (col - EA)) = pack8(v0, v1); } } }
    }
};
struct EpiPool {
    static constexpr bool PERM = true;
    const float* scale; const bf16_t* sg; bf16_t* yg;
    __device__ __forceinline__ void operator()(AccRef acc, const Unit& un, int wr, int wc, int fr, int fq) const {
        const int row0 = un.pm * BM + wr * 64 + fr, colt = un.pn * BM + wc * 32 + 8 * fq;
        f32x4 sc[2][2]; u32x4 gws[2][4][2];
#pragma unroll
        for (int bj = 0; bj < 2; ++bj) { sc[bj][0] = *(const f32x4*)(scale + colt + bj * HALF); sc[bj][1] = *(const f32x4*)(scale + colt + bj * HALF + 4); }
#pragma unroll
        for (int ai = 0; ai < 2; ++ai)
#pragma unroll
            for (int m = 0; m < 4; ++m)
#pragma unroll
                for (int bj = 0; bj < 2; ++bj) gws[ai][m][bj] = *(const u32x4*)(sg + (size_t)(row0 + ai * HALF + m * 16) * EA + colt + bj * HALF);
#pragma unroll
        for (int ai = 0; ai < 2; ++ai)
#pragma unroll
            for (int m = 0; m < 4; ++m) { const size_t ro = (size_t)(row0 + ai * HALF + m * 16) * EA + colt;
#pragma unroll
                for (int bj = 0; bj < 2; ++bj) { const u32x4 gw = gws[ai][m][bj];
                    f32x4 v0 = acc[ai][bj][m][0] * sc[bj][0], v1 = acc[ai][bj][m][1] * sc[bj][1];
                    v0[0] *= bflo(gw.x); v0[1] *= bfhi(gw.x); v0[2] *= bflo(gw.y); v0[3] *= bfhi(gw.y);
                    v1[0] *= bflo(gw.z); v1[1] *= bfhi(gw.z); v1[2] *= bflo(gw.w); v1[3] *= bfhi(gw.w);
                    *(bf16x8*)(yg + ro + bj * HALF) = pack8(v0, v1); } }
    }
};
struct EpiRes {
    static constexpr bool PERM = false;
    const float* base_p; const float* base_s; float* xres; bf16_t* xb; float* ssq_next;
    __device__ __forceinline__ void operator()(AccRef acc, const Unit& un, int wr, int wc, int fr, int fq) const {
        const int row0 = un.pm * BM + wr * 64 + fr, col0 = un.pn * BM + wc * 32 + 4 * fq;
#pragma unroll
        for (int ai = 0; ai < 2; ++ai) {
            f32x4 bx_[4][2][2];
#pragma unroll
            for (int m = 0; m < 4; ++m) { const int row = row0 + ai * HALF + m * 16;
                const float* bp = (row < MP ? base_p + (size_t)row * DM : base_s + (size_t)(row - MP) * DM) + col0;
#pragma unroll
                for (int bj = 0; bj < 2; ++bj)
#pragma unroll
                    for (int n = 0; n < 2; ++n) bx_[m][bj][n] = *(const f32x4*)(bp + bj * HALF + n * 16); }
#pragma unroll
            for (int m = 0; m < 4; ++m) { const int row = row0 + ai * HALF + m * 16;
                float* xo = xres + (size_t)row * DM + col0; bf16_t* bo = xb + (size_t)row * DM + col0; float s = 0.f;
#pragma unroll
                for (int bj = 0; bj < 2; ++bj)
#pragma unroll
                    for (int n = 0; n < 2; ++n) { const f32x4 x = bx_[m][bj][n] + acc[ai][bj][m][n];
                        *(f32x4*)(xo + bj * HALF + n * 16) = x; u32x2 w; w.x = cvtpk(x[0], x[1]); w.y = cvtpk(x[2], x[3]); *(u32x2*)(bo + bj * HALF + n * 16) = w;
                        s += (x[0] * x[0] + x[1] * x[1]) + (x[2] * x[2] + x[3] * x[3]); }
                s += __shfl_xor(s, 16); s += __shfl_xor(s, 32);
                if (fq == 0) atomicAdd(ssq_next + row, s); } }
    }
};
struct EpiKVQ {
    static constexpr bool PERM = true;
    int pn_off; const float* ssq; float* out; unsigned char* ws; const float* b_f;
    __device__ __forceinline__ void operator()(AccRef acc, const Unit& un, int wr, int wc, int fr, int fq) const {
        const int tt = un.pn + pn_off;
        const int row0 = un.pm * BM + wr * 64 + fr, cw = wc * 32 + 8 * fq;
        float rrs[2][4];
#pragma unroll
        for (int ai = 0; ai < 2; ++ai)
#pragma unroll
            for (int m = 0; m < 4; ++m) rrs[ai][m] = ssq[row0 + ai * HALF + m * 16];
        if (tt == 16) {
            if (wc == 0 && fq < 2) {
            const f32x4 bf0 = *(const f32x4*)(b_f + 8 * fq), bf1 = *(const f32x4*)(b_f + 8 * fq + 4);
            float* lft_p = (float*)(ws + WS_LFTP); float* lft_s = (float*)(ws + WS_LFTS);
#pragma unroll
            for (int ai = 0; ai < 2; ++ai)
#pragma unroll
                for (int m = 0; m < 4; ++m) { const int row = row0 + ai * HALF + m * 16; const float rr = rsqrtf(rrs[ai][m] * (1.0f / DM) + EPS);
                    f32x4 v0 = acc[ai][0][m][0] * rr + bf0, v1 = acc[ai][0][m][1] * rr + bf1;
#pragma unroll
                    for (int j = 0; j < 4; ++j) { v0[j] = logsig(v0[j]); v1[j] = logsig(v1[j]); }
                    if (row < MP) { float* o = out + O_LFP + (size_t)row * NH + 8 * fq; *(f32x4*)o = v0; *(f32x4*)(o + 4) = v1;
                        float* tp = lft_p + ((size_t)(row >> 12) * NH + 8 * fq) * SEQ + (row & (SEQ - 1));
#pragma unroll
                        for (int j = 0; j < 4; ++j) { tp[(size_t)j * SEQ] = v0[j]; tp[(size_t)(j + 4) * SEQ] = v1[j]; } }
                    else { const int rs = row - MP; float* o = out + O_LFS + (size_t)rs * NH + 8 * fq; *(f32x4*)o = v0; *(f32x4*)(o + 4) = v1;
                        float* tp = lft_s + ((size_t)(rs >> 4) * NH + 8 * fq) * DSEQ + (rs & 15);
#pragma unroll
                        for (int j = 0; j < 4; ++j) { tp[j * DSEQ] = v0[j]; tp[(j + 4) * DSEQ] = v1[j]; } } }
            }
        } else {
        const int kind = tt < 8 ? 0 : (tt < 16 ? 1 : (tt < 25 ? 2 : 3));
        const int colt = (tt - (kind == 0 ? 0 : kind == 1 ? 8 : kind == 2 ? 17 : 25)) * BM + cw;
        float* fo_p = out + (kind == 0 ? O_KP : O_VP); float* fo_s = out + (kind == 0 ? O_KS : O_VS);
        bf16_t* bo = (bf16_t*)(ws + (kind == 0 ? WS_KB : (kind == 1 ? WS_VB : (kind == 2 ? WS_QB : WS_SGB))));
#pragma unroll
        for (int ai = 0; ai < 2; ++ai)
#pragma unroll
            for (int m = 0; m < 4; ++m) { const int row = row0 + ai * HALF + m * 16; float rr = rsqrtf(rrs[ai][m] * (1.0f / DM) + EPS);
                if (kind == 2) rr *= QSCALE;
                float* fo = (row < MP ? fo_p + (size_t)row * DM : fo_s + (size_t)(row - MP) * DM) + colt;
#pragma unroll
                for (int bj = 0; bj < 2; ++bj) { f32x4 v0 = acc[ai][bj][m][0] * rr, v1 = acc[ai][bj][m][1] * rr;
                    if (kind < 2) { *(f32x4*)(fo + bj * HALF) = v0; *(f32x4*)(fo + bj * HALF + 4) = v1; }
                    if (kind == 3) {
#pragma unroll
                        for (int j = 0; j < 4; ++j) { v0[j] = silu_f(v0[j]); v1[j] = silu_f(v1[j]); } }
                    *(bf16x8*)(bo + (size_t)row * DM + colt + bj * HALF) = pack8(v0, v1); } }
        }
    }
};
}

namespace att {
constexpr int NW = 8, QBLK = 32, KVBLK = 64, QB = NW * QBLK, D = 128, LD = 2048;
constexpr int SHM_V = KVBLK * D * 2, SHM_K = KVBLK * D * 2;
constexpr int OFF_WS = 2 * SHM_V + 2 * SHM_K, OFF_F = OFF_WS + NW * 64 * 4, OFF_SC = OFF_F + SEQ * 4;
constexpr float THR2 = 11.5f;
#define KSWZ(row, colB) ((row) * 256 + ((colB) ^ (((row) & 7) << 4)))
#define SBAR() __builtin_amdgcn_sched_barrier(0)
__device__ __forceinline__ int v_st(int k, int c) { const int kk = (k & ~0xC) | ((k & 4) << 1) | ((k & 8) >> 1); return ((kk >> 3) * 4 + (c >> 5)) * 512 + ((kk & 7) * 32 + (c & 31)) * 2; }
__device__ __forceinline__ int v_rd_base(int lane) { return ((lane & 3) << 3) | (((lane >> 2) & 3) << 6) | (((lane >> 4) & 1) << 5) | (((lane >> 5) & 1) << 8); }
constexpr int v_rd_off(int d0, int ks, int half) { return d0 * 512 + ks * 4096 + half * 2048; }
__device__ __forceinline__ int crow(int r, int hi) { return (r & 3) + 8 * (r >> 2) + 4 * hi; }
__device__ __forceinline__ void mask_tile(f32x16& p0, f32x16& p1, int dq) {
    const float NEG = -__builtin_inff();
#pragma unroll
    for (int r = 0; r < 16; ++r) { const int c = (r & 3) + 8 * (r >> 2);
        if (dq - c < 0) p0[r] = NEG;
        if (dq - c - 32 < 0) p1[r] = NEG; }
}
__device__ __forceinline__ void partialSM(f32x16& p0, f32x16& p1, float& m_reg, float& mn, float& alpha) {
    float pmax = p0[0];
#pragma unroll
    for (int r = 1; r < 16; ++r) pmax = fmaxf(pmax, p0[r]);
#pragma unroll
    for (int r = 0; r < 16; ++r) pmax = fmaxf(pmax, p1[r]);
    { auto rr = __builtin_amdgcn_permlane32_swap(__float_as_uint(pmax), __float_as_uint(pmax), false, false);
      pmax = fmaxf(__uint_as_float(rr[0]), __uint_as_float(rr[1])); }
    if (__builtin_expect(__all((pmax - m_reg) <= THR2), 1)) { mn = m_reg; alpha = 1.f; }
    else { mn = fmaxf(m_reg, pmax); alpha = __builtin_amdgcn_exp2f(m_reg - mn); m_reg = mn; }
#pragma unroll
    for (int r = 0; r < 16; ++r) p0[r] = p0[r] - mn;
#pragma unroll
    for (int r = 0; r < 16; ++r) p1[r] = p1[r] - mn;
#pragma unroll
    for (int r = 0; r < 16; ++r) p0[r] = __builtin_amdgcn_exp2f(p0[r]);
}
__device__ __forceinline__ void finishSM(f32x16& p0, f32x16& p1, float alpha, float& l_reg, bf16x8& pa0, bf16x8& pa1, bf16x8& pa2, bf16x8& pa3) {
#pragma unroll
    for (int r = 0; r < 16; ++r) p1[r] = __builtin_amdgcn_exp2f(p1[r]);
    float ps = 0;
#pragma unroll
    for (int r = 0; r < 16; ++r) ps += p0[r];
#pragma unroll
    for (int r = 0; r < 16; ++r) ps += p1[r];
    { auto rr = __builtin_amdgcn_permlane32_swap(__float_as_uint(ps), __float_as_uint(ps), false, false);
      ps = __uint_as_float(rr[0]) + __uint_as_float(rr[1]); }
    l_reg = l_reg * alpha + ps;
#define PK4(P, B_, OUT) do { unsigned a0 = cvtpk(P[B_+0], P[B_+1]), a1 = cvtpk(P[B_+2], P[B_+3]);                          \
        unsigned b0 = cvtpk(P[B_+4], P[B_+5]), b1 = cvtpk(P[B_+6], P[B_+7]);                                             \
        auto r0 = __builtin_amdgcn_permlane32_swap(a0, b0, false, false); auto r1 = __builtin_amdgcn_permlane32_swap(a1, b1, false, false); \
        u32x4 w = {r0[0], r1[0], r0[1], r1[1]}; OUT = *reinterpret_cast<bf16x8*>(&w); } while (0)
    PK4(p0, 0, pa0); PK4(p0, 8, pa1); PK4(p1, 0, pa2); PK4(p1, 8, pa3);
#undef PK4
}
template <int KB>
__device__ __forceinline__ void qkt(f32x16& p0, f32x16& p1, const char* K_lds, const float* fl, int r32, int hi, const bf16x8* qr) {
    { const f32x4 a0 = *(const f32x4*)(fl), a1 = *(const f32x4*)(fl + 8), a2 = *(const f32x4*)(fl + 16), a3 = *(const f32x4*)(fl + 24);
      const f32x4 b0 = *(const f32x4*)(fl + 32), b1 = *(const f32x4*)(fl + 40), b2 = *(const f32x4*)(fl + 48), b3 = *(const f32x4*)(fl + 56);
      p0 = (f32x16){a0[0], a0[1], a0[2], a0[3], a1[0], a1[1], a1[2], a1[3], a2[0], a2[1], a2[2], a2[3], a3[0], a3[1], a3[2], a3[3]};
      p1 = (f32x16){b0[0], b0[1], b0[2], b0[3], b1[0], b1[1], b1[2], b1[3], b2[0], b2[1], b2[2], b2[3], b3[0], b3[1], b3[2], b3[3]}; }
    const char* kb[4];
#pragma unroll
    for (int dd = 0; dd < 4; ++dd) kb[dd] = K_lds + KB * SHM_K + KSWZ(r32, (dd * 16 + hi * 8) * 2);
#pragma unroll
    for (int d0 = 0; d0 < 8; ++d0) { const char* a = kb[d0 & 3] + (d0 >> 2) * 128;
        bf16x8 b0 = *reinterpret_cast<const bf16x8*>(a);
        bf16x8 b1 = *reinterpret_cast<const bf16x8*>(a + 32 * 256);
        p0 = __builtin_amdgcn_mfma_f32_32x32x16_bf16(b0, qr[d0], p0, 0, 0, 0);
        p1 = __builtin_amdgcn_mfma_f32_32x32x16_bf16(b1, qr[d0], p1, 0, 0, 0); }
}
template <int VB>
__device__ __forceinline__ void pv_tile(f32x16* o, int vb0, bf16x8 pa0, bf16x8 pa1, bf16x8 pa2, bf16x8 pa3) {
#define TRRD(dst, off) asm volatile("ds_read_b64_tr_b16 %0, %1 offset:%2" : "=&v"(dst) : "v"(vb0), "i"(off) : "memory")
#define PV_D0(d0) do { s16x4 l0, l1, l2, l3, h0, h1, h2, h3; constexpr int b_ = VB * SHM_V + v_rd_off(d0, 0, 0);   \
        TRRD(l0, b_); TRRD(h0, b_ + 2048); TRRD(l1, b_ + 4096); TRRD(h1, b_ + 6144); TRRD(l2, b_ + 8192); TRRD(h2, b_ + 10240); TRRD(l3, b_ + 12288); TRRD(h3, b_ + 14336); \
        asm volatile("s_waitcnt lgkmcnt(0)" ::: "memory"); SBAR();   \
        o[d0] = __builtin_amdgcn_mfma_f32_32x32x16_bf16(pa0, (bf16x8){l0[0], l0[1], l0[2], l0[3], h0[0], h0[1], h0[2], h0[3]}, o[d0], 0, 0, 0);   \
        o[d0] = __builtin_amdgcn_mfma_f32_32x32x16_bf16(pa1, (bf16x8){l1[0], l1[1], l1[2], l1[3], h1[0], h1[1], h1[2], h1[3]}, o[d0], 0, 0, 0);   \
        o[d0] = __builtin_amdgcn_mfma_f32_32x32x16_bf16(pa2, (bf16x8){l2[0], l2[1], l2[2], l2[3], h2[0], h2[1], h2[2], h2[3]}, o[d0], 0, 0, 0);   \
        o[d0] = __builtin_amdgcn_mfma_f32_32x32x16_bf16(pa3, (bf16x8){l3[0], l3[1], l3[2], l3[3], h3[0], h3[1], h3[2], h3[3]}, o[d0], 0, 0, 0); } while (0)
    PV_D0(0); PV_D0(1); PV_D0(2); PV_D0(3);
#undef PV_D0
#undef TRRD
}
struct Tensors { const bf16_t* q; const bf16_t* k; const bf16_t* v; bf16_t* og; const bf16_t* sg; const float* lft; };
struct BlockRef { unsigned q0, s0; int P0, lfo; };
struct Seam { bf16x8 qr[8]; bf16x8 st_v0, st_v1, st_k0, st_k1; };
#define ROWP(p, k0) ((p) + (unsigned)(k0) * (unsigned)LD)
#define VMW() asm volatile("s_waitcnt vmcnt(0)" ::: "memory")
#define VMWN(n) asm volatile("s_waitcnt vmcnt(%0)" :: "i"(n) : "memory")
#define LD8(p) (*reinterpret_cast<const bf16x8*>(p))
#define SLOAD_H(Kp, Vp, k0) do { S.st_v0 = LD8(ROWP(Vp, k0) + voff); S.st_v1 = LD8(ROWP(Vp, (k0) + 32) + voff);              \
                         S.st_k0 = LD8(ROWP(Kp, k0) + voff); S.st_k1 = LD8(ROWP(Kp, (k0) + 32) + voff); } while (0)
#define SWRITE_HK(bf) do { *(bf16x8*)(K_lds + (bf) * SHM_K + kws) = S.st_k0; *(bf16x8*)(K_lds + (bf) * SHM_K + kws + 32 * 256) = S.st_k1; } while (0)
#define SWRITE_HV(bf) do { *(bf16x8*)(V_lds + (bf) * SHM_V + vst0) = S.st_v0; *(bf16x8*)(V_lds + (bf) * SHM_V + vst0 + VST1) = S.st_v1; } while (0)
#define SWRITE_H(bf) do { SWRITE_HV(bf); SWRITE_HK(bf); } while (0)
__device__ __forceinline__ void prime(int wv, const Tensors& T, const BlockRef& cur, char* lds, Seam& S) {
    const int tid = otid(wv), wid = __builtin_amdgcn_readfirstlane(tid >> 6), lane = tid & 63, r32 = lane & 31, hi = lane >> 5;
    const int sr = tid >> 4, sc = (tid & 15) * 8, kws = KSWZ(sr, sc * 2); char* K_lds = lds + 2 * SHM_V;
    const unsigned voff = (unsigned)sr * LD + sc, qoff = (unsigned)(wid * QBLK + r32) * LD + hi * 8;
    const bf16_t* Qp = T.q + cur.q0; const bf16_t* Kh = T.k + cur.s0; const bf16_t* Vh = T.v + cur.s0;
#pragma unroll
    for (int d0 = 0; d0 < 8; ++d0) S.qr[d0] = LD8(Qp + qoff + d0 * 16);
    SLOAD_H(Kh, Vh, 0); VMW(); SWRITE_HK(0);
    __syncthreads();
}
__device__ __forceinline__ void block(int wv, const Tensors& T, const BlockRef& cur, const BlockRef& nxt, char* lds, Seam& S) {
    const int tid = otid(wv), wid = __builtin_amdgcn_readfirstlane(tid >> 6), lane = tid & 63, r32 = lane & 31, hi = lane >> 5;
    const int NT = (cur.P0 + QB) / KVBLK;
    const int qlo = cur.P0 + wid * QBLK, qm = qlo + r32 - 4 * hi;
    char* V_lds = lds; char* K_lds = lds + 2 * SHM_V;
    float* wsl = (float*)(lds + OFF_WS) + wid * 64; float* li_l = wsl, * al_l = wsl + 32;
    float* Fl = (float*)(lds + OFF_F);
    { float* scn = (float*)(lds + OFF_SC); const int nkeys = cur.P0 + QB, t0 = tid * 8;
      f32x4 a = {0.f, 0.f, 0.f, 0.f}, b = {0.f, 0.f, 0.f, 0.f};
      const float* LF = T.lft + cur.lfo;
      if (t0 < nkeys) { a = *(const f32x4*)(LF + t0); b = *(const f32x4*)(LF + t0 + 4); }
      a[1] += a[0]; a[2] += a[1]; a[3] += a[2]; b[0] += a[3]; b[1] += b[0]; b[2] += b[1]; b[3] += b[2];
      const float tot = b[3]; float inc = tot;
#pragma unroll
      for (int o = 1; o < 64; o <<= 1) { const float v = __shfl_up(inc, o); if (lane >= o) inc += v; }
      if (lane == 63) scn[wid] = inc;
      __syncthreads();
      float base = inc - tot;
      for (int w = 0; w < wid; ++w) base += scn[w];
      a = (a + base) * (-LOG2E); b = (b + base) * (-LOG2E);
      if (t0 < nkeys) { *(f32x4*)(Fl + t0) = a; *(f32x4*)(Fl + t0 + 4) = b; }
      __syncthreads(); }
    float m_reg = -1e30f, l_reg = 0; f32x16 o[4] = {};
    const int sr = tid >> 4, sc = (tid & 15) * 8, vst0 = v_st(sr, sc), kws = KSWZ(sr, sc * 2); constexpr int VST1 = 8192;
    const int vb0 = (int)(uintptr_t)V_lds + v_rd_base(lane);
    const bf16_t* Kh = T.k + cur.s0; const bf16_t* Vh = T.v + cur.s0;
    const unsigned voff = (unsigned)sr * LD + sc, qoff = (unsigned)(wid * QBLK + r32) * LD + hi * 8;
    const float* flb = Fl + 4 * hi;
#define RESC(a) do { if (__any((a) < 1.f)) { if (hi == 0) al_l[r32] = (a); asm volatile("s_waitcnt lgkmcnt(0)" ::: "memory");              \
                     for (int d_ = 0; d_ < 4; ++d_) for (int r = 0; r < 16; ++r) o[d_][r] *= al_l[crow(r, hi)]; } } while (0)
#define KBASE(t) ((t) * KVBLK)
#define MASKT(P0_, P1_, t) do { const int kb_ = KBASE(t); if (kb_ + KVBLK - 1 > qlo) mask_tile(P0_, P1_, qm - kb_); } while (0)
#define SEAM_K0() do { VMWN(8); SWRITE_HK(0); SBAR(); } while (0)
    f32x16 pA0, pA1, pB0, pB1; float mnA, mnB, alA, alB; bf16x8 pa0, pa1, pa2, pa3;
    SWRITE_HV(0); SBAR();
    if (NT > 1) { SLOAD_H(Kh, Vh, KBASE(1)); }
    SBAR(); qkt<0>(pA0, pA1, K_lds, flb + KBASE(0), r32, hi, S.qr);
    MASKT(pA0, pA1, 0); partialSM(pA0, pA1, m_reg, mnA, alA);
    if (NT > 1) { VMW(); SWRITE_H(1); }
    __syncthreads();
#define HALF_STEP(PX0, PX1, mnX, alX, PY0, PY1, alY, t, KB, VB, SB) do {                                                      \
        SBAR(); qkt<KB>(PX0, PX1, K_lds, flb + KBASE(t), r32, hi, S.qr);                                             \
        finishSM(PY0, PY1, alY, l_reg, pa0, pa1, pa2, pa3); SBAR();                                                           \
        if ((t) + 1 < NT) { SLOAD_H(Kh, Vh, KBASE((t) + 1)); SBAR(); }                                               \
        pv_tile<VB>(o, vb0, pa0, pa1, pa2, pa3); MASKT(PX0, PX1, (t)); partialSM(PX0, PX1, m_reg, mnX, alX);                                        \
        __syncthreads();                                                                                                      \
        if ((t) + 1 < NT) { VMW(); SWRITE_H(SB); }                                                                          \
        RESC(alX); __syncthreads(); } while (0)
    for (int t = 1; t + 1 < NT; t += 2) {
        HALF_STEP(pB0, pB1, mnB, alB, pA0, pA1, alA, t, 1, 0, 0);
        HALF_STEP(pA0, pA1, mnA, alA, pB0, pB1, alB, t + 1, 0, 1, 1);
    }
    const bool even = (NT & 1) == 0;
    if (even) { SBAR(); qkt<1>(pB0, pB1, K_lds, flb + KBASE(NT - 1), r32, hi, S.qr); SBAR(); }
    { const bf16_t* Kn = T.k + nxt.s0; const bf16_t* Vn = T.v + nxt.s0; SLOAD_H(Kn, Vn, 0); } SBAR();
    { const bf16_t* Qn = T.q + nxt.q0;
#pragma unroll
      for (int d0 = 0; d0 < 8; ++d0) S.qr[d0] = LD8(Qn + qoff + d0 * 16); }
    SBAR();
    finishSM(pA0, pA1, alA, l_reg, pa0, pa1, pa2, pa3); SBAR();
    pv_tile<0>(o, vb0, pa0, pa1, pa2, pa3);
    if (even) { MASKT(pB0, pB1, NT - 1); partialSM(pB0, pB1, m_reg, mnB, alB); __syncthreads(); RESC(alB);
        finishSM(pB0, pB1, alB, l_reg, pa0, pa1, pa2, pa3); SBAR(); pv_tile<1>(o, vb0, pa0, pa1, pa2, pa3); }
    SBAR(); SEAM_K0();
    if (hi == 0) li_l[r32] = l_reg; asm volatile("s_waitcnt lgkmcnt(0)" ::: "memory");
    float rli[16];
#pragma unroll
    for (int r = 0; r < 16; ++r) rli[r] = __builtin_amdgcn_rcpf(li_l[crow(r, hi)]);
    { const unsigned eoff = (unsigned)(4 * hi) * LD + r32;
#pragma unroll
      for (int r = 0; r < 16; ++r) { const unsigned ro = cur.q0 + (unsigned)(wid * QBLK + (r & 3) + 8 * (r >> 2)) * LD;
        bf16_t* Orow = T.og + ro; const bf16_t* Grow = T.sg + ro;
#pragma unroll
        for (int d0 = 0; d0 < 4; ++d0) { const float v = o[d0][r] * rli[r];
            const float vn = __shfl_xor(v, 1);
            if ((r32 & 1) == 0) { const unsigned gg = *(const unsigned*)(Grow + eoff + d0 * 32);
                *(unsigned*)(Orow + eoff + d0 * 32) = cvtpk(v * bflo(gg), vn * bfhi(gg)); } } } }
    __syncthreads();
#undef RESC
#undef KBASE
#undef MASKT
#undef SEAM_K0
#undef HALF_STEP
}
#undef ROWP
#undef VMW
#undef VMWN
#undef SLOAD_H
#undef SWRITE_HK
#undef SWRITE_HV
#undef SWRITE_H
#undef LD8

__device__ __forceinline__ BlockRef mkref(int bh, int qb) {
    const int b = bh >> 4, h = bh & 15; BlockRef r; r.s0 = (unsigned)b * SEQ * LD + h * D; r.q0 = r.s0 + (unsigned)qb * QB * LD; r.lfo = bh * SEQ; r.P0 = qb * QB; return r;
}
__device__ __forceinline__ void prompt_phase(int wv, char* lds, const Tensors& T, int vw, int G) {
    constexpr int TOTAL = NBATCH * NH * 8;
    int L = vw; if (L >= TOTAL) return;
    int pass = 0;
    BlockRef cur = mkref(L >> 3, L & 7);
    Seam S;
    prime(wv, T, cur, lds, S);
    for (;;) {
        const bool more_pass = pass == 0, more_item = L + G < TOTAL, last = !more_pass && !more_item;
        int passn = pass + 1, Ln = L;
        if (!more_pass) { passn = 0; Ln = more_item ? L + G : L; }
        const int x = Ln & 7;
        const BlockRef nxt = last ? cur : mkref(Ln >> 3, passn ? 15 - x : x);
        block(wv, T, cur, nxt, lds, S);
        if (last) break;
        cur = nxt; pass = passn; L = Ln;
    }
}
}

namespace sat {
constexpr int OFF_F = 0, OFF_SC = 8448, OFF_P = 8704, OFF_A = OFF_P + 8 * 4096, OFF_ML = OFF_A + 512, OFF_O = OFF_ML + 1024;
struct Tensors { const bf16_t* q; const bf16_t* kb; const bf16_t* vb; bf16_t* og; const bf16_t* sg; const float* ck; const float* cv; const float* clf; const float* lfts; };
__device__ __forceinline__ void item(int wv, char* lds, const Tensors& T, int b, int h) {
    const int tid = otid(wv), wid = __builtin_amdgcn_readfirstlane(tid >> 6), lane = tid & 63, fr = lane & 15, fq = lane >> 4, half = lane >> 5, dl = (lane & 31) * 4;
    float* Fl = (float*)(lds + OFF_F); float* scn = (float*)(lds + OFF_SC);
    float* Pw = (float*)(lds + OFF_P) + wid * 1024; float* Aw = (float*)(lds + OFF_A) + wid * 16; float* ML = (float*)(lds + OFF_ML); float* Op = (float*)(lds + OFF_O);
    { const float* cl = T.clf + ((size_t)b * PAST + tid * 4) * NH + h;
      float a0 = cl[0], a1 = cl[NH], a2 = cl[2 * NH], a3 = cl[3 * NH];
      a1 += a0; a2 += a1; a3 += a2;
      const float tot = a3; float inc = tot;
#pragma unroll
      for (int o = 1; o < 64; o <<= 1) { const float v = __shfl_up(inc, o); if (lane >= o) inc += v; }
      if (lane == 63) scn[wid] = inc;
      __syncthreads();
      float base = inc - tot, all = 0.f;
      for (int w = 0; w < 8; ++w) { const float sw = scn[w]; if (w < wid) base += sw; all += sw; }
      *(f32x4*)(Fl + tid * 4) = (f32x4){(a0 + base) * (-LOG2E), (a1 + base) * (-LOG2E), (a2 + base) * (-LOG2E), (a3 + base) * (-LOG2E)};
      if (tid < DSEQ) { const float* nl = T.lfts + ((size_t)b * NH + h) * DSEQ; float s = all; for (int i = 0; i <= tid; ++i) s += nl[i]; Fl[PAST + tid] = s * (-LOG2E); }
      __syncthreads(); }
    const size_t qrow = (size_t)(MP + b * DSEQ);
    bf16x8 qf[4];
#pragma unroll
    for (int dc = 0; dc < 4; ++dc) qf[dc] = *(const bf16x8*)(T.q + (qrow + fr) * DM + h * HD + dc * 32 + fq * 8);
    float m_run = -1e30f, l_run = 0.f;
    f32x4 oacc[16];
#pragma unroll
    for (int q = 0; q < 16; ++q) oacc[q] = (f32x4){0.f, 0.f, 0.f, 0.f};
    for (int ch = 0; ch < 4; ++ch) {
        const int key0 = (ch * 8 + wid) * 64;
        f32x4 s4[4];
#pragma unroll
        for (int tl = 0; tl < 4; ++tl) { const int kbase = key0 + tl * 16;
            const float* kp = T.ck + (((size_t)b * PAST + kbase + fr) * NH + h) * HD + fq * 8;
            f32x4 acc = *(const f32x4*)(Fl + kbase + fq * 4);
#pragma unroll
            for (int dc = 0; dc < 4; ++dc) { const f32x4 x0 = *(const f32x4*)(kp + dc * 32), x1 = *(const f32x4*)(kp + dc * 32 + 4);
                acc = __builtin_amdgcn_mfma_f32_16x16x32_bf16(pack8(x0, x1), qf[dc], acc, 0, 0, 0); }
            s4[tl] = acc; }
        float cm = s4[0][0];
#pragma unroll
        for (int tl = 0; tl < 4; ++tl)
#pragma unroll
            for (int j = 0; j < 4; ++j) cm = fmaxf(cm, s4[tl][j]);
        cm = fmaxf(cm, __shfl_xor(cm, 16)); cm = fmaxf(cm, __shfl_xor(cm, 32));
        const float mn = fmaxf(m_run, cm), alpha = __builtin_amdgcn_exp2f(m_run - mn); m_run = mn;
        float ps = 0.f;
#pragma unroll
        for (int tl = 0; tl < 4; ++tl)
#pragma unroll
            for (int j = 0; j < 4; ++j) { const float p = __builtin_amdgcn_exp2f(s4[tl][j] - mn); ps += p; Pw[(tl * 16 + fq * 4 + j) * 16 + fr] = p; }
        ps += __shfl_xor(ps, 16); ps += __shfl_xor(ps, 32);
        l_run = l_run * alpha + ps;
        if (fq == 0) Aw[fr] = alpha;
        asm volatile("s_waitcnt lgkmcnt(0)" ::: "memory");
        { const f32x4 a0 = *(const f32x4*)(Aw), a1 = *(const f32x4*)(Aw + 4), a2 = *(const f32x4*)(Aw + 8), a3 = *(const f32x4*)(Aw + 12);
#pragma unroll
          for (int j = 0; j < 4; ++j) { oacc[j] *= a0[j]; oacc[4 + j] *= a1[j]; oacc[8 + j] *= a2[j]; oacc[12 + j] *= a3[j]; } }
        const float* vp = T.cv + (((size_t)b * PAST + key0 + half) * NH + h) * HD + dl;
#pragma unroll 8
        for (int kp2 = 0; kp2 < 32; ++kp2) { const f32x4 v = *(const f32x4*)(vp + (size_t)kp2 * 2 * NH * HD);
            const float* pr = Pw + (2 * kp2 + half) * 16;
            const f32x4 p0 = *(const f32x4*)(pr), p1 = *(const f32x4*)(pr + 4), p2 = *(const f32x4*)(pr + 8), p3 = *(const f32x4*)(pr + 12);
#pragma unroll
            for (int j = 0; j < 4; ++j) { oacc[j] += v * p0[j]; oacc[4 + j] += v * p1[j]; oacc[8 + j] += v * p2[j]; oacc[12 + j] += v * p3[j]; } }
        asm volatile("s_waitcnt lgkmcnt(0)" ::: "memory");
    }
    if (wid == 0) {
        f32x4 acc = *(const f32x4*)(Fl + PAST + fq * 4);
        const bf16_t* kp = T.kb + (qrow + fr) * DM + h * HD + fq * 8;
#pragma unroll
        for (int dc = 0; dc < 4; ++dc) acc = __builtin_amdgcn_mfma_f32_16x16x32_bf16(*(const bf16x8*)(kp + dc * 32), qf[dc], acc, 0, 0, 0);
#pragma unroll
        for (int j = 0; j < 4; ++j) if (fq * 4 + j > fr) acc[j] = -__builtin_inff();
        float cm = fmaxf(fmaxf(acc[0], acc[1]), fmaxf(acc[2], acc[3]));
        cm = fmaxf(cm, __shfl_xor(cm, 16)); cm = fmaxf(cm, __shfl_xor(cm, 32));
        const float mn = fmaxf(m_run, cm), alpha = __builtin_amdgcn_exp2f(m_run - mn); m_run = mn;
        float ps = 0.f;
#pragma unroll
        for (int j = 0; j < 4; ++j) { const float p = __builtin_amdgcn_exp2f(acc[j] - mn); ps += p; Pw[(fq * 4 + j) * 16 + fr] = p; }
        ps += __shfl_xor(ps, 16); ps += __shfl_xor(ps, 32);
        l_run = l_run * alpha + ps;
        if (fq == 0) Aw[fr] = alpha;
        asm volatile("s_waitcnt lgkmcnt(0)" ::: "memory");
        { const f32x4 a0 = *(const f32x4*)(Aw), a1 = *(const f32x4*)(Aw + 4), a2 = *(const f32x4*)(Aw + 8), a3 = *(const f32x4*)(Aw + 12);
#pragma unroll
          for (int j = 0; j < 4; ++j) { oacc[j] *= a0[j]; oacc[4 + j] *= a1[j]; oacc[8 + j] *= a2[j]; oacc[12 + j] *= a3[j]; } }
        const bf16_t* vp = T.vb + (qrow + half) * DM + h * HD + dl;
#pragma unroll
        for (int kp2 = 0; kp2 < 8; ++kp2) { const u32x2 vw = *(const u32x2*)(vp + (size_t)kp2 * 2 * DM);
            const f32x4 v = {bflo(vw.x), bfhi(vw.x), bflo(vw.y), bfhi(vw.y)};
            const float* pr = Pw + (2 * kp2 + half) * 16;
            const f32x4 p0 = *(const f32x4*)(pr), p1 = *(const f32x4*)(pr + 4), p2 = *(const f32x4*)(pr + 8), p3 = *(const f32x4*)(pr + 12);
#pragma unroll
            for (int j = 0; j < 4; ++j) { oacc[j] += v * p0[j]; oacc[4 + j] += v * p1[j]; oacc[8 + j] += v * p2[j]; oacc[12 + j] += v * p3[j]; } }
        asm volatile("s_waitcnt lgkmcnt(0)" ::: "memory");
    }
#pragma unroll
    for (int q = 0; q < 16; ++q)
#pragma unroll
        for (int c = 0; c < 4; ++c) oacc[q][c] += __shfl_xor(oacc[q][c], 32);
    if (lane < 32) {
#pragma unroll
        for (int q = 0; q < 16; ++q) *(f32x4*)(Op + (wid * 16 + q) * HD + dl) = oacc[q]; }
    if (fq == 0) { ML[(wid * 16 + fr) * 2] = m_run; ML[(wid * 16 + fr) * 2 + 1] = l_run; }
    __syncthreads();
    { const int q = tid >> 5, d4 = (tid & 31) * 4;
      float mx = ML[q * 2];
#pragma unroll
      for (int w = 1; w < 8; ++w) mx = fmaxf(mx, ML[(w * 16 + q) * 2]);
      float L = 0.f; f32x4 O = {0.f, 0.f, 0.f, 0.f};
#pragma unroll
      for (int w = 0; w < 8; ++w) { const float s = __builtin_amdgcn_exp2f(ML[(w * 16 + q) * 2] - mx); L += s * ML[(w * 16 + q) * 2 + 1]; O += *(const f32x4*)(Op + (w * 16 + q) * HD + d4) * s; }
      const float il = 1.0f / L; const size_t off = (qrow + q) * DM + h * HD + d4;
      const u32x2 gw = *(const u32x2*)(T.sg + off);
      u32x2 w; w.x = cvtpk(O[0] * il * bflo(gw.x), O[1] * il * bfhi(gw.x)); w.y = cvtpk(O[2] * il * bflo(gw.y), O[3] * il * bfhi(gw.y));
      *(u32x2*)(T.og + off) = w; }
    __syncthreads();
}
}

__device__ __forceinline__ void transpose_item(const float* W, int N, bf16_t* WT, int K, const float* g, float* scr, int item, int lane) {
    const int nblk = (N + 31) / 32, kb = item / nblk, nb = item % nblk, k0 = 64 * kb, n0 = 32 * nb;
    const int c4 = (lane & 7) * 4, kr = lane >> 3; const bool nok = n0 + c4 < N;
    f32x4 v[8];
#pragma unroll
    for (int i = 0; i < 8; ++i) v[i] = nok ? *(const f32x4*)(W + (size_t)(k0 + 8 * i + kr) * N + n0 + c4) : (f32x4){0.f, 0.f, 0.f, 0.f};
    if (g) {
#pragma unroll
        for (int i = 0; i < 8; ++i) v[i] *= g[k0 + 8 * i + kr]; }
#pragma unroll
    for (int i = 0; i < 8; ++i) { float* s = scr + (8 * i + kr) * 33 + c4; s[0] = v[i][0]; s[1] = v[i][1]; s[2] = v[i][2]; s[3] = v[i][3]; }
    asm volatile("s_waitcnt lgkmcnt(0)" ::: "memory");
    const int c = lane & 7;
#pragma unroll
    for (int j = 0; j < 4; ++j) { const int nn = (lane >> 3) + 8 * j; const float* s = scr + (8 * c) * 33 + nn;
        u32x4 o; o.x = cvtpk(s[0 * 33], s[1 * 33]); o.y = cvtpk(s[2 * 33], s[3 * 33]); o.z = cvtpk(s[4 * 33], s[5 * 33]); o.w = cvtpk(s[6 * 33], s[7 * 33]);
        if (n0 + nn < N) *(u32x4*)(WT + (size_t)(n0 + nn) * K + k0 + 8 * c) = o; }
    asm volatile("s_waitcnt lgkmcnt(0)" ::: "memory");
}
struct TJob { const float* W; bf16_t* WT; const float* g; int K, N; };
__device__ __forceinline__ TJob get_job(const Params& p, int j) {
    unsigned char* ws = p.ws; TJob t; t.g = nullptr;
    if (j < 2) { t.W = p.in[7] + (size_t)j * DM * 2 * EA; t.WT = (bf16_t*)(ws + WS_WINA) + (size_t)j * 2 * EA * DM; t.g = p.in[6] + j * DM; t.K = DM; t.N = 2 * EA; }
    else if (j < 10) { const int i = j - 2; t.W = p.in[8] + (size_t)i * 1024 * 1024; t.WT = (bf16_t*)(ws + WS_WGRP) + (size_t)i * 1024 * 1024; t.K = 1024; t.N = 1024; }
    else if (j < 12) { const int l = j - 10; t.W = p.in[10] + (size_t)l * EA * DM; t.WT = (bf16_t*)(ws + WS_WOUTA) + (size_t)l * DM * EA; t.K = EA; t.N = DM; }
    else if (j == 12) { t.W = p.in[12]; t.WT = (bf16_t*)(ws + WS_W4); t.g = p.in[11]; t.K = DM; t.N = 2 * DM + NH; }
    else if (j == 13) { t.W = p.in[15]; t.WT = (bf16_t*)(ws + WS_W4) + (size_t)4352 * DM; t.g = p.in[14]; t.K = DM; t.N = 2 * DM; }
    else if (j == 14) { t.W = p.in[15] + (size_t)DM * 2 * DM; t.WT = (bf16_t*)(ws + WS_WINB1); t.g = p.in[14] + DM; t.K = DM; t.N = 2 * DM; }
    else { const int l = j - 15; t.W = p.in[16] + (size_t)l * DM * DM; t.WT = (bf16_t*)(ws + WS_WOUTB) + (size_t)l * DM * DM; t.K = DM; t.N = DM; }
    return t;
}
__device__ __forceinline__ void prologue_phase(int wv, const Params& p, char* lds) {
    const int tid = otid(wv), lane = tid & 63, wid = tid >> 6, G = gridDim.x;
    const int gw = blockIdx.x * NWAVES + wid, NGW = G * NWAVES;
    float* scr = (float*)(lds + wid * 8704);
    int rot = 0;
    for (int j = 0; j < 17; ++j) { const TJob t = get_job(p, j); const int nitems = (t.K / 64) * ((t.N + 31) / 32);
        int start = gw - rot; if (start < 0) start += NGW;
        for (int it = start; it < nitems; it += NGW) transpose_item(t.W, t.N, t.WT, t.K, t.g, scr, it, lane);
        rot = (rot + nitems) % NGW; }
    float* ssq = (float*)(p.ws + WS_SSQ); bf16_t* xb = (bf16_t*)(p.ws + WS_XB);
    for (int m = gw; m < MT; m += NGW) { const float* xr = m < MP ? p.in[0] + (size_t)m * DM : p.in[1] + (size_t)(m - MP) * DM;
        float s = 0.f; unsigned long long* o8 = (unsigned long long*)(xb + (size_t)m * DM) + lane;
#pragma unroll
        for (int j = 0; j < 8; ++j) { const f32x4 v = *((const f32x4*)xr + lane + 64 * j); s += (v[0] * v[0] + v[1] * v[1]) + (v[2] * v[2] + v[3] * v[3]);
            o8[64 * j] = (unsigned long long)cvtpk(v[0], v[1]) | ((unsigned long long)cvtpk(v[2], v[3]) << 32); }
        s = wave_sum(s); if (lane == 0) ssq[m] = s; }
    for (int i = blockIdx.x * NTHREADS + tid; i < 4 * MT; i += G * NTHREADS) ssq[MT + i] = 0.f;
}
template <int W>
__device__ __forceinline__ void poold_item(const bf16_t* u, bf16_t* d, const float* prev, int row0, int ch) {
    constexpr int NR = 16 + W - 1;
    u32x4 rows[NR];
    const bool samp = row0 >= MP; const int t0 = samp ? 0 : (row0 & (SEQ - 1));
    const bf16_t* up = u + (size_t)row0 * EA + ch;
    if (t0 != 0) {
#pragma unroll
        for (int i = 0; i < NR; ++i) rows[i] = *(const u32x4*)(up + (ptrdiff_t)(i - (W - 1)) * EA);
    } else {
#pragma unroll
        for (int i = W - 1; i < NR; ++i) rows[i] = *(const u32x4*)(up + (ptrdiff_t)(i - (W - 1)) * EA);
        if (samp) { const float* pp = prev + ((size_t)((row0 - MP) >> 4) * PPAD + (PPAD - (W - 1))) * EA + ch;
#pragma unroll
            for (int i = 0; i < W - 1; ++i) { const f32x4 a = *(const f32x4*)(pp + (size_t)i * EA), b = *(const f32x4*)(pp + (size_t)i * EA + 4);
                rows[i] = (u32x4){cvtpk(a[0], a[1]), cvtpk(a[2], a[3]), cvtpk(b[0], b[1]), cvtpk(b[2], b[3])}; } }
        else {
#pragma unroll
            for (int i = 0; i < W - 1; ++i) rows[i] = (u32x4){0u, 0u, 0u, 0u}; }
    }
    float s[8] = {0.f, 0.f, 0.f, 0.f, 0.f, 0.f, 0.f, 0.f};
#define ROWF(v, f) const float f[8] = {bflo(v.x), bfhi(v.x), bflo(v.y), bfhi(v.y), bflo(v.z), bfhi(v.z), bflo(v.w), bfhi(v.w)}
#pragma unroll
    for (int i = 0; i < W - 1; ++i) { ROWF(rows[i], f);
#pragma unroll
        for (int c = 0; c < 8; ++c) s[c] += f[c]; }
#pragma unroll
    for (int j = 0; j < 16; ++j) { ROWF(rows[j + W - 1], f);
#pragma unroll
        for (int c = 0; c < 8; ++c) s[c] += f[c];
        const int nv = (!samp && t0 + j + 1 < W) ? t0 + j + 1 : W; const float ic = 1.0f / (float)nv;
        u32x4 o; o.x = cvtpk(s[0] * ic - f[0], s[1] * ic - f[1]); o.y = cvtpk(s[2] * ic - f[2], s[3] * ic - f[3]);
        o.z = cvtpk(s[4] * ic - f[4], s[5] * ic - f[5]); o.w = cvtpk(s[6] * ic - f[6], s[7] * ic - f[7]);
        *(u32x4*)(d + (size_t)(row0 + j) * EA + ch) = o;
        ROWF(rows[j], g);
#pragma unroll
        for (int c = 0; c < 8; ++c) s[c] -= g[c]; }
#undef ROWF
}
__device__ __forceinline__ void poold_phase(int wv, const Params& p, int l) {
    const bf16_t* u = (const bf16_t*)(p.ws + WS_U); bf16_t* d = (bf16_t*)(p.ws + WS_D);
    const float* prev = p.in[5] + (size_t)l * NDB * PPAD * EA;
    const int nth = gridDim.x * NTHREADS;
    for (int idx = blockIdx.x * NTHREADS + otid(wv); idx < (MT / 16) * (EA / 8); idx += nth) {
        const int row0 = (idx >> 9) * 16, ch = (idx & 511) * 8, grp = __builtin_amdgcn_readfirstlane(ch >> 10);
        if (grp == 0) poold_item<2>(u, d, prev, row0, ch);
        else if (grp == 1) poold_item<4>(u, d, prev, row0, ch);
        else if (grp == 2) poold_item<8>(u, d, prev, row0, ch);
        else poold_item<16>(u, d, prev, row0, ch);
    }
}
__device__ __forceinline__ void final_phase(int wv, const Params& p) {
    const int tid = otid(wv), lane = tid & 63, gw = blockIdx.x * NWAVES + (tid >> 6), NGW = gridDim.x * NWAVES;
    const float* xres = (const float*)(p.ws + WS_XRES); const float* ssq = (const float*)(p.ws + WS_SSQ) + (size_t)4 * MT; const float* g = p.in[17];
    for (int m = gw; m < MT; m += NGW) { const float rr = rsqrtf(ssq[m] * (1.0f / DM) + EPS);
        const f32x4* xr = (const f32x4*)(xres + (size_t)m * DM) + lane; f32x4* o = (f32x4*)(p.out + (m < MP ? O_YP + (size_t)m * DM : O_YS + (size_t)(m - MP) * DM)) + lane;
#pragma unroll
        for (int j = 0; j < 8; ++j) o[64 * j] = xr[64 * j] * rr * ((const f32x4*)g)[lane + 64 * j]; }
}

constexpr int NPHASES = 16;
typedef const __attribute__((address_space(4))) Params* KArgPtr;
#if defined(__HIP_DEVICE_COMPILE__)
#define LOADP_() KArgPtr kp_ = (KArgPtr)__builtin_amdgcn_kernarg_segment_ptr(); asm volatile("" : "+s"(kp_)); Params lp; _Pragma("unroll") for (int i_ = 0; i_ < 18; ++i_) lp.in[i_] = kp_->in[i_]; lp.out = kp_->out; lp.ws = kp_->ws; lp.ph_lo = 0; lp.ph_hi = 0
#else
#define LOADP_() const Params lp = p
#endif
#define LOADP() LOADP_(); unsigned char* const ws = lp.ws; \
    float* const ssq = (float*)(ws + WS_SSQ); bf16_t* const xb = (bf16_t*)(ws + WS_XB); float* const xres = (float*)(ws + WS_XRES); (void)ssq; (void)xb; (void)xres
__global__ void __launch_bounds__(NTHREADS, 2) yoco_fwd(Params p) {
    extern __shared__ __attribute__((aligned(16))) unsigned char lds_raw[];
    char* lds = (char*)lds_raw; LAS unsigned char* ldsl = (LAS unsigned char*)lds_raw;
    const int G = gridDim.x, bx = blockIdx.x, wv = __builtin_amdgcn_readfirstlane(threadIdx.x >> 6);
#ifndef ONLY_PHASE
#define ONLY_PHASE -1
#endif
#define IN(k) ((ONLY_PHASE < 0 || ONLY_PHASE == (k)) && p.ph_lo <= (k) && (k) < p.ph_hi)
#ifndef REPEAT_MASK
#define REPEAT_MASK 0
#endif
#define NREP(k) (1 + (int)(((unsigned)(REPEAT_MASK) >> (k)) & 1u))
#define SEAM(k) do { if (rep_ + 1 < NREP(k) || (k) + 1 < p.ph_hi) cg::this_grid().sync(); } while (0)
    if (IN(0)) for (int rep_ = 0; rep_ < NREP(0); ++rep_) { { LOADP(); prologue_phase(wv, lp, lds); } SEAM(0); }
#pragma unroll 1
    for (int l = 0; l < 2; ++l) {
        if (IN(1 + 4 * l)) for (int rep_ = 0; rep_ < NREP(1 + 4 * l); ++rep_) { { LOADP(); bf16_t* u = (bf16_t*)(ws + WS_U); bf16_t* sg = (bf16_t*)(ws + WS_SG);
            pg8::Gemm g{xb, (const bf16_t*)(ws + WS_WINA) + (size_t)l * 2 * EA * DM, 65, 32, DM, DM, -1}; pg8::StaticOrder S; S.init(65, 32, G, bx);
            pg8::EpiInA E{ssq + (size_t)l * MT, u, sg, lp.out + O_PP + (size_t)l * NBATCH * PPAD * EA, lp.out + O_PS + (size_t)l * NDB * PPAD * EA};
            pg8::gemm_phase<pg8::EpiInA>(wv, ldsl, g, S, E); } SEAM(1 + 4 * l); }
        if (IN(2 + 4 * l)) for (int rep_ = 0; rep_ < NREP(2 + 4 * l); ++rep_) { { LOADP(); poold_phase(wv, lp, l); } SEAM(2 + 4 * l); }
        if (IN(3 + 4 * l)) for (int rep_ = 0; rep_ < NREP(3 + 4 * l); ++rep_) { { LOADP(); bf16_t* u = (bf16_t*)(ws + WS_U); bf16_t* sg = (bf16_t*)(ws + WS_SG); bf16_t* d = (bf16_t*)(ws + WS_D);
            pg8::Gemm g{d, (const bf16_t*)(ws + WS_WGRP) + (size_t)l * EA * 1024, 65, 16, 1024, EA, 2}; pg8::StaticOrder S; S.init(65, 16, G, bx);
            pg8::EpiPool E{lp.in[9] + (size_t)l * EA, sg, u};
            pg8::gemm_phase<pg8::EpiPool>(wv, ldsl, g, S, E); } SEAM(3 + 4 * l); }
        if (IN(4 + 4 * l)) for (int rep_ = 0; rep_ < NREP(4 + 4 * l); ++rep_) { { LOADP(); bf16_t* u = (bf16_t*)(ws + WS_U);
            pg8::Gemm g{u, (const bf16_t*)(ws + WS_WOUTA) + (size_t)l * DM * EA, 65, 8, EA, EA, -1}; pg8::StaticOrder S; S.init(65, 8, G, bx);
            pg8::EpiRes E{l == 0 ? lp.in[0] : xres, l == 0 ? lp.in[1] : xres + (size_t)MP * DM, xres, xb, ssq + (size_t)(l + 1) * MT};
            pg8::gemm_phase<pg8::EpiRes>(wv, ldsl, g, S, E); } SEAM(4 + 4 * l); }
    }
#pragma unroll 1
    for (int lb = 0; lb < 2; ++lb) {
        if (IN(9 + 3 * lb)) for (int rep_ = 0; rep_ < NREP(9 + 3 * lb); ++rep_) { { LOADP();
            pg8::Gemm g{xb, lb == 0 ? (const bf16_t*)(ws + WS_W4) : (const bf16_t*)(ws + WS_WINB1), 65, lb == 0 ? 33 : 16, DM, DM, -1};
            pg8::StaticOrder S; S.init(65, g.nN, G, bx);
            pg8::EpiKVQ E{lb == 0 ? 0 : 17, ssq + (size_t)(2 + lb) * MT, lp.out, ws, lp.in[13]};
            pg8::gemm_phase<pg8::EpiKVQ>(wv, ldsl, g, S, E); } SEAM(9 + 3 * lb); }
        if (IN(10 + 3 * lb)) for (int rep_ = 0; rep_ < NREP(10 + 3 * lb); ++rep_) {
#if !defined(NO_SAT)
            { LOADP();
            sat::Tensors ST{(const bf16_t*)(ws + WS_QB), (const bf16_t*)(ws + WS_KB), (const bf16_t*)(ws + WS_VB), (bf16_t*)(ws + WS_OG), (const bf16_t*)(ws + WS_SGB),
                            lp.in[2], lp.in[3], lp.in[4], (const float*)(ws + WS_LFTS)};
            for (int it = bx; it < NDB * NH; it += G) sat::item(wv, lds, ST, it >> 4, it & 15); }
#endif
#if !defined(NO_ATT)
            { LOADP(); const int vw = (G % 8 == 0) ? (bx % 8) * (G / 8) + bx / 8 : bx;
            att::Tensors AT{(const bf16_t*)(ws + WS_QB), (const bf16_t*)(ws + WS_KB), (const bf16_t*)(ws + WS_VB), (bf16_t*)(ws + WS_OG), (const bf16_t*)(ws + WS_SGB), (const float*)(ws + WS_LFTP)};
            att::prompt_phase(wv, lds, AT, vw, G); }
#endif
            SEAM(10 + 3 * lb); }
        if (IN(11 + 3 * lb)) for (int rep_ = 0; rep_ < NREP(11 + 3 * lb); ++rep_) { { LOADP();
            pg8::Gemm g{(const bf16_t*)(ws + WS_OG), (const bf16_t*)(ws + WS_WOUTB) + (size_t)lb * DM * DM, 65, 8, DM, DM, -1}; pg8::StaticOrder S; S.init(65, 8, G, bx);
            pg8::EpiRes E{xres, xres + (size_t)MP * DM, xres, xb, ssq + (size_t)(3 + lb) * MT};
            pg8::gemm_phase<pg8::EpiRes>(wv, ldsl, g, S, E); } SEAM(11 + 3 * lb); }
    }
    if (IN(15)) { LOADP(); final_phase(wv, lp); }
#undef IN
#undef SEAM
}

extern "C" void kernel_launch(void* const* d_in, const int* in_sizes, int n_in, void* d_out, int out_size, void* d_ws, size_t ws_size, hipStream_t stream) {
    static int grid = 0;
    if (grid == 0) {
        if (n_in != 18 || (size_t)out_size != O_END || ws_size < WS_END) { fprintf(stderr, "kernel_launch: unexpected shapes: n_in %d out %d (want %zu) ws %zu (need %zu)\n", n_in, out_size, (size_t)O_END, ws_size, (size_t)WS_END); grid = -1; return; }
        int dev = 0, cus = 0, per_cu = 0;
        (void)hipGetDevice(&dev); (void)hipDeviceGetAttribute(&cus, hipDeviceAttributeMultiprocessorCount, dev);
        if (hipFuncSetAttribute((const void*)yoco_fwd, hipFuncAttributeMaxDynamicSharedMemorySize, LDS_BYTES) != hipSuccess) { fprintf(stderr, "kernel_launch: hipFuncSetAttribute failed\n"); grid = -1; return; }
        if (hipOccupancyMaxActiveBlocksPerMultiprocessor(&per_cu, (const void*)yoco_fwd, NTHREADS, LDS_BYTES) != hipSuccess || per_cu < 1) { fprintf(stderr, "kernel_launch: occupancy query gave %d\n", per_cu); per_cu = 1; }
        (void)hipGetLastError();
        grid = cus > 0 ? cus : 256;
    }
    if (grid < 0) return;
    Params p{};
    for (int i = 0; i < 18; ++i) p.in[i] = (const float*)d_in[i];
    p.out = (float*)d_out; p.ws = (unsigned char*)d_ws;
#if MULTI_LAUNCH
    for (int ph = 0; ph < NPHASES; ++ph) { p.ph_lo = ph; p.ph_hi = ph + 1; hipLaunchKernelGGL(yoco_fwd, dim3(grid), dim3(NTHREADS), LDS_BYTES, stream, p); }
#else
    p.ph_lo = 0; p.ph_hi = NPHASES;
    void* args[] = {&p};
    hipError_t e = hipLaunchCooperativeKernel((const void*)yoco_fwd, dim3(grid), dim3(NTHREADS), args, LDS_BYTES, stream);
    if (e != hipSuccess) fprintf(stderr, "kernel_launch: cooperative launch failed: %s (grid %d)\n", hipGetErrorString(e), grid);
#endif
}
```

```cpp
#include <hip/hip_runtime.h>
#include <hip/hip_cooperative_groups.h>
#include <cstdio>
#include <cstdint>
namespace cg = cooperative_groups;

#ifndef MULTI_LAUNCH
#define MULTI_LAUNCH 0
#endif

#define LAS __attribute__((address_space(3)))
typedef unsigned short bf16_t;
typedef short bf16x8 __attribute__((ext_vector_type(8)));
typedef short s16x4 __attribute__((ext_vector_type(4)));
typedef float f32x4 __attribute__((ext_vector_type(4)));
typedef float f32x16 __attribute__((ext_vector_type(16)));
typedef unsigned u32x4 __attribute__((ext_vector_type(4)));
typedef unsigned u32x2 __attribute__((ext_vector_type(2)));

constexpr int DM = 2048, NBATCH = 4, SEQ = 4096, NDB = 16, DSEQ = 16, PAST = 2048, EA = 4096, NH = 16, HD = 128, PPAD = 15;
constexpr int MP = NBATCH * SEQ, MS = NDB * DSEQ, MT = MP + MS;
constexpr float EPS = 1e-6f;
constexpr float LOG2E = 1.4426950408889634f;
constexpr float QSCALE = 0.08838834764831845f * 1.4426950408889634f;
constexpr int NTHREADS = 512, NWAVES = 8;
constexpr int LDS_BYTES = 131072;

constexpr size_t O_YP = 0, O_YS = O_YP + (size_t)MP * DM, O_KP = O_YS + (size_t)MS * DM, O_VP = O_KP + (size_t)MP * DM,
                 O_LFP = O_VP + (size_t)MP * DM, O_PP = O_LFP + (size_t)MP * NH, O_KS = O_PP + (size_t)2 * NBATCH * PPAD * EA,
                 O_VS = O_KS + (size_t)MS * DM, O_LFS = O_VS + (size_t)MS * DM, O_PS = O_LFS + (size_t)MS * NH, O_END = O_PS + (size_t)2 * NDB * PPAD * EA;

constexpr size_t al256(size_t x) { return (x + 255) & ~(size_t)255; }
constexpr size_t WS_WINA = 0;
constexpr size_t WS_WGRP = WS_WINA + (size_t)2 * 8192 * 2048 * 2;
constexpr size_t WS_WOUTA = WS_WGRP + (size_t)2 * 4096 * 1024 * 2;
constexpr size_t WS_W4 = WS_WOUTA + (size_t)2 * 2048 * 4096 * 2;
constexpr size_t WS_WINB1 = WS_W4 + (size_t)8448 * 2048 * 2;
constexpr size_t WS_WOUTB = WS_WINB1 + (size_t)4096 * 2048 * 2;
constexpr size_t WS_XB = WS_WOUTB + (size_t)2 * 2048 * 2048 * 2;
constexpr size_t WS_XRES = WS_XB + (size_t)MT * DM * 2;
constexpr size_t WS_SSQ = WS_XRES + (size_t)MT * DM * 4;
constexpr size_t WS_LFTP = al256(WS_SSQ + (size_t)5 * MT * 4);
constexpr size_t WS_LFTS = WS_LFTP + (size_t)NBATCH * NH * SEQ * 4;
constexpr size_t WS_KNRM = al256(WS_LFTS + (size_t)NDB * NH * DSEQ * 4);
constexpr size_t WS_QNRM = WS_KNRM + (size_t)MT * NH * 4 * 4;
constexpr size_t WS_ACT = al256(WS_QNRM + (size_t)MT * NH * 4 * 4);
constexpr size_t SZ_A = (size_t)MT * EA * 2, SZ_B = (size_t)MT * DM * 2;
constexpr size_t WS_U = WS_ACT, WS_SG = WS_U + SZ_A, WS_D = WS_SG + SZ_A;
constexpr size_t WS_KB = WS_ACT, WS_VB = WS_KB + SZ_B, WS_QB = WS_VB + SZ_B, WS_SGB = WS_QB + SZ_B, WS_OG = WS_SGB + SZ_B;
constexpr size_t WS_END = (WS_D + SZ_A) > (WS_OG + SZ_B) ? (WS_D + SZ_A) : (WS_OG + SZ_B);

struct Params { const float* in[18]; float* out; unsigned char* ws; int ph_lo, ph_hi; };

__device__ __forceinline__ unsigned cvtpk(float lo, float hi) { unsigned r; asm volatile("v_cvt_pk_bf16_f32 %0, %1, %2" : "=v"(r) : "v"(lo), "v"(hi)); return r; }
__device__ __forceinline__ bf16x8 pack8(f32x4 a, f32x4 b) { u32x4 w = {cvtpk(a[0], a[1]), cvtpk(a[2], a[3]), cvtpk(b[0], b[1]), cvtpk(b[2], b[3])}; return *reinterpret_cast<bf16x8*>(&w); }
__device__ __forceinline__ float bflo(unsigned w) { return __uint_as_float(w << 16); }
__device__ __forceinline__ float bfhi(unsigned w) { return __uint_as_float(w & 0xffff0000u); }
__device__ __forceinline__ float silu_f(float x) { return x * __builtin_amdgcn_rcpf(1.0f + __builtin_amdgcn_exp2f(-x * LOG2E)); }
__device__ __forceinline__ float wave_sum(float v) {
#pragma unroll
    for (int o = 1; o < 64; o <<= 1) v += __shfl_xor(v, o);
    return v;
}
__device__ __forceinline__ int otid(int wv) { int t = wv * 64 + (int)__builtin_amdgcn_mbcnt_hi(~0u, __builtin_amdgcn_mbcnt_lo(~0u, 0u)); asm volatile("" : "+v"(t)); return t; }
__device__ __forceinline__ float xsum16(float v) { auto r = __builtin_amdgcn_permlane16_swap(__float_as_uint(v), __float_as_uint(v), false, false); return __uint_as_float(r[0]) + __uint_as_float(r[1]); }
__device__ __forceinline__ float xsum32(float v) { auto r = __builtin_amdgcn_permlane32_swap(__float_as_uint(v), __float_as_uint(v), false, false); return __uint_as_float(r[0]) + __uint_as_float(r[1]); }
__device__ __forceinline__ float xmax16(float v) { auto r = __builtin_amdgcn_permlane16_swap(__float_as_uint(v), __float_as_uint(v), false, false); return fmaxf(__uint_as_float(r[0]), __uint_as_float(r[1])); }
__device__ __forceinline__ float xmax32(float v) { auto r = __builtin_amdgcn_permlane32_swap(__float_as_uint(v), __float_as_uint(v), false, false); return fmaxf(__uint_as_float(r[0]), __uint_as_float(r[1])); }
__device__ __forceinline__ float bperm(float v, int srclane) { return __uint_as_float((unsigned)__builtin_amdgcn_ds_bpermute(srclane << 2, (int)__float_as_uint(v))); }
__device__ __forceinline__ float logsig(float x) { return fminf(x, 0.f) - log1pf(__expf(-fabsf(x))); }

namespace pg8 {
constexpr int BM = 256, BK = 64, HALF = 128, HTB = HALF * BK * 2, NXCD = 8, WGM = 8;
__device__ __forceinline__ int lds_byte(int r, int c) { const int st = (r >> 4) * 2 + (c >> 5), rr = r & 15, cc = c & 31, ob = rr * 64 + cc * 2; return st * 1024 + (ob ^ (((ob >> 9) & 1) << 5)); }
__device__ __forceinline__ void stage_rc(int b, int& R, int& C) { const int st = b / 1024, sb = b % 1024, swz = sb ^ (((sb >> 9) & 1) << 5); R = (st >> 1) * 16 + swz / 64; C = (st & 1) * 32 + (swz % 64) / 2; }
__device__ __forceinline__ int perm32(int rho) { const int n = rho >> 4, i = rho & 15; return 8 * (i >> 2) + 4 * n + (i & 3); }
struct Unit { int pm, pn; };
struct Gemm { const bf16_t* A; const bf16_t* Bt; int nM, nN, K, lda, ashift; };
struct StaticOrder {
    int nM, nN, nwg, G, c;
    __device__ void init(int nM_, int nN_, int G_, int c_) { nM = nM_; nN = nN_; nwg = nM * nN; G = G_; c = c_; }
    __device__ bool next(int i, Unit& u) const {
        const long L = (long)i * G + c; if (L >= nwg) return false;
        int wgid = (int)L; { const int q = nwg / NXCD, r = nwg % NXCD, xcd = wgid % NXCD, off = wgid / NXCD; wgid = (xcd < r ? xcd * (q + 1) : r * (q + 1) + (xcd - r) * q) + off; }
        const int nig = WGM * nN, gid = wgid / nig, fm = gid * WGM, gsz = (nM - fm) < WGM ? (nM - fm) : WGM;
        u.pm = fm + ((wgid % nig) % gsz); u.pn = (wgid % nig) / gsz; return true;
    }
};

template <class Epi>
__device__ __forceinline__ void gemm_phase(int wv, LAS unsigned char* lds, const Gemm g, const StaticOrder& S, const Epi& E) {
    const int tid = otid(wv), wid = __builtin_amdgcn_readfirstlane(tid >> 6), lane = tid & 63, wr = wid >> 2, wc = wid & 3, fr = lane & 15, fq = lane >> 4;
    const int K = g.K, nt = K / BK;
    unsigned voffA[2], voffB[2];
#pragma unroll
    for (int i = 0; i < 2; ++i) { int R, C; stage_rc(tid * 16 + i * 8192, R, C); const int Rb = Epi::PERM ? ((R & ~31) + perm32(R & 31)) : R;
        voffA[i] = (unsigned)(R * g.lda + C) * 2u; voffB[i] = (unsigned)(Rb * K + C) * 2u; }
    const size_t kstep = (size_t)(BK * 2);
    const size_t hstepA = (size_t)HALF * g.lda * 2, tstepA = 2 * hstepA;
    const size_t hstepB = (size_t)HALF * K * 2, tstepB = 2 * hstepB;
    const unsigned ldsw = (unsigned)wid * 1024u;
    const int aoff = lds_byte(wr * 64 + fr, fq * 8), boff = lds_byte(wc * 32 + fr, fq * 8);
#define PG8_SA(b, h) (((b) * 2 + (h)) * HTB)
#define PG8_SB(b, h) ((4 + (b) * 2 + (h)) * HTB)
#define PG8_STAGE(bufoff, gbase, voff) do { _Pragma("unroll") for (int _i = 0; _i < 2; ++_i) \
        __builtin_amdgcn_global_load_lds((const unsigned*)((const char*)(gbase) + (voff)[_i]), (LAS unsigned*)(lds + (bufoff) + ldsw + _i * 8192), 16, 0, 0); } while (0)
#define PG8_LDA(dst, b, h) do { _Pragma("unroll") for (int m = 0; m < 4; ++m) _Pragma("unroll") for (int k = 0; k < 2; ++k) dst[m][k] = *(const LAS bf16x8*)(lds + PG8_SA(b, h) + aoff + m * 2048 + k * 1024); } while (0)
#define PG8_LDB(dst, b, h) do { _Pragma("unroll") for (int n = 0; n < 2; ++n) _Pragma("unroll") for (int k = 0; k < 2; ++k) dst[n][k] = *(const LAS bf16x8*)(lds + PG8_SB(b, h) + boff + n * 2048 + k * 1024); } while (0)
#define PG8_MMA(ai, bj, At, Bt) do { __builtin_amdgcn_s_setprio(1); _Pragma("unroll") for (int m = 0; m < 4; ++m) _Pragma("unroll") for (int n = 0; n < 2; ++n) _Pragma("unroll") for (int k = 0; k < 2; ++k) \
        acc[ai][bj][m][n] = __builtin_amdgcn_mfma_f32_16x16x32_bf16(Bt[n][k], At[m][k], acc[ai][bj][m][n], 0, 0, 0); __builtin_amdgcn_s_setprio(0); } while (0)
#define PG8_WAIT_V(n) asm volatile("s_waitcnt vmcnt(" #n ")" ::: "memory")
#define PG8_WAIT_L(n) asm volatile("s_waitcnt lgkmcnt(" #n ")" ::: "memory")
#define PG8_BAR __builtin_amdgcn_s_barrier()
#define PG8_SCHED __builtin_amdgcn_sched_barrier(0)
#define PG8_ACOL(u) (g.ashift >= 0 ? (size_t)((u).pn >> g.ashift) * (size_t)K * 2 : (size_t)0)
    Unit cur, nxt; int ui = 0;
    if (!S.next(0, cur)) return;
    f32x4 acc[2][2][4][2];
#pragma unroll
    for (int a = 0; a < 2; ++a)
#pragma unroll
        for (int b = 0; b < 2; ++b)
#pragma unroll
            for (int m = 0; m < 4; ++m)
#pragma unroll
                for (int n = 0; n < 2; ++n) acc[a][b][m][n] = (f32x4){0.f, 0.f, 0.f, 0.f};
    bf16x8 At[4][2], B0[2][2], B1[2][2];
    const char* cA = (const char*)g.A + (size_t)cur.pm * tstepA + PG8_ACOL(cur); const char* cB = (const char*)g.Bt + (size_t)cur.pn * tstepB;
    PG8_STAGE(PG8_SB(0, 0), cB, voffB); PG8_STAGE(PG8_SA(0, 0), cA, voffA); PG8_STAGE(PG8_SB(0, 1), cB + hstepB, voffB); PG8_STAGE(PG8_SA(0, 1), cA + hstepA, voffA);
    if (wr == 1) PG8_BAR;
    PG8_WAIT_V(4); PG8_BAR;
    PG8_STAGE(PG8_SB(1, 0), cB + kstep, voffB); PG8_STAGE(PG8_SA(1, 0), cA + kstep, voffA); PG8_STAGE(PG8_SB(1, 1), cB + hstepB + kstep, voffB);
    PG8_WAIT_V(6); PG8_BAR;
    for (;;) {
        const bool has_next = S.next(ui + 1, nxt);
        const char* nA = has_next ? (const char*)g.A + (size_t)nxt.pm * tstepA + PG8_ACOL(nxt) : cA; const char* nB = has_next ? (const char*)g.Bt + (size_t)nxt.pn * tstepB : cB;
        for (int t = 0; t < nt; t += 2) {
            const bool last = (t == nt - 2);
            const char* a1 = cA + (size_t)(t + 1) * kstep;
            const char* a2 = last ? nA : cA + (size_t)(t + 2) * kstep; const char* b2 = last ? nB : cB + (size_t)(t + 2) * kstep;
            const char* a3 = a2 + kstep; const char* b3 = b2 + kstep;
            PG8_LDB(B0, 0, 0); PG8_SCHED; PG8_LDA(At, 0, 0); PG8_STAGE(PG8_SA(1, 1), a1 + hstepA, voffA);
            PG8_WAIT_L(8); PG8_BAR; PG8_WAIT_L(0); PG8_MMA(0, 0, At, B0); PG8_BAR; PG8_SCHED;
            PG8_LDB(B1, 0, 1); PG8_STAGE(PG8_SB(0, 0), b2, voffB);
            PG8_BAR; PG8_WAIT_L(0); PG8_MMA(0, 1, At, B1); PG8_BAR;
            PG8_LDA(At, 0, 1); PG8_STAGE(PG8_SA(0, 0), a2, voffA);
            PG8_BAR; PG8_WAIT_L(0); PG8_MMA(1, 0, At, B0); PG8_BAR; PG8_SCHED;
            PG8_STAGE(PG8_SB(0, 1), b2 + hstepB, voffB);
            PG8_WAIT_V(6); PG8_BAR; PG8_MMA(1, 1, At, B1); PG8_BAR;
            PG8_LDB(B0, 1, 0); PG8_SCHED; PG8_LDA(At, 1, 0); PG8_STAGE(PG8_SA(0, 1), a2 + hstepA, voffA);
            PG8_WAIT_L(8); PG8_BAR; PG8_WAIT_L(0); PG8_MMA(0, 0, At, B0); PG8_BAR; PG8_SCHED;
            PG8_LDB(B1, 1, 1); PG8_STAGE(PG8_SB(1, 0), b3, voffB);
            PG8_BAR; PG8_WAIT_L(0); PG8_MMA(0, 1, At, B1); PG8_BAR;
            PG8_LDA(At, 1, 1); PG8_STAGE(PG8_SA(1, 0), a3, voffA);
            PG8_BAR; PG8_WAIT_L(0); PG8_MMA(1, 0, At, B0); PG8_BAR; PG8_SCHED;
            PG8_STAGE(PG8_SB(1, 1), b3 + hstepB, voffB);
            PG8_WAIT_V(6); PG8_BAR; PG8_MMA(1, 1, At, B1); PG8_BAR;
        }
        E(acc, cur, wr, wc, fr, fq);
        if (!has_next) break;
#pragma unroll
        for (int a = 0; a < 2; ++a)
#pragma unroll
            for (int b = 0; b < 2; ++b)
#pragma unroll
                for (int m = 0; m < 4; ++m)
#pragma unroll
                    for (int n = 0; n < 2; ++n) acc[a][b][m][n] = (f32x4){0.f, 0.f, 0.f, 0.f};
        cur = nxt; cA = nA; cB = nB; ++ui;
    }
    PG8_WAIT_V(0);
    if (wr == 0) PG8_BAR;
    PG8_BAR;
#undef PG8_SA
#undef PG8_SB
#undef PG8_STAGE
#undef PG8_LDA
#undef PG8_LDB
#undef PG8_MMA
#undef PG8_WAIT_V
#undef PG8_WAIT_L
#undef PG8_BAR
#undef PG8_SCHED
#undef PG8_ACOL
}

typedef const f32x4 (&AccRef)[2][2][4][2];

struct EpiInA {
    static constexpr bool PERM = true;
    const float* ssq; bf16_t* u; bf16_t* sg; float* pool_p; float* pool_s;
    __device__ __forceinline__ void operator()(AccRef acc, const Unit& un, int wr, int wc, int fr, int fq) const {
        const int row0 = un.pm * BM + wr * 64 + fr, colt = un.pn * BM + wc * 32 + 8 * fq;
        const bool is_u = un.pn < 16;
        const bool has_pool = is_u && (un.pm == 64 || (un.pm & 15) == 15);
        float rrs[2][4];
#pragma unroll
        for (int ai = 0; ai < 2; ++ai)
#pragma unroll
            for (int m = 0; m < 4; ++m) rrs[ai][m] = ssq[row0 + ai * HALF + m * 16];
#pragma unroll
        for (int ai = 0; ai < 2; ++ai)
#pragma unroll
            for (int m = 0; m < 4; ++m) { const int row = row0 + ai * HALF + m * 16; const float rr = rsqrtf(rrs[ai][m] * (1.0f / DM) + EPS);
                float* pp = nullptr;
                if (has_pool) { if (row < MP) { const int t = row & (SEQ - 1); if (t >= SEQ - PPAD) pp = pool_p + ((size_t)(row >> 12) * PPAD + (t - (SEQ - PPAD))) * EA; }
                                else { const int rs = row - MP, t = rs & 15; if (t >= 1) pp = pool_s + ((size_t)(rs >> 4) * PPAD + (t - 1)) * EA; } }
#pragma unroll
                for (int bj = 0; bj < 2; ++bj) { f32x4 v0 = acc[ai][bj][m][0] * rr, v1 = acc[ai][bj][m][1] * rr; const int col = colt + bj * HALF;
                    if (is_u) { if (pp) { *(f32x4*)(pp + col) = v0; *(f32x4*)(pp + col + 4) = v1; }
                        *(bf16x8*)(u + (size_t)row * EA + col) = pack8(v0, v1); }
                    else {
#pragma unroll
                        for (int j = 0; j < 4; ++j) { v0[j] = silu_f(v0[j]); v1[j] = silu_f(v1[j]); }
                        *(bf16x8*)(sg + (size_t)row * EA + (col - EA)) = pack8(v0, v1); } } }
    }
};
struct EpiPool {
    static constexpr bool PERM = true;
    const float* scale; const bf16_t* sg; bf16_t* yg;
    __device__ __forceinline__ void operator()(AccRef acc, const Unit& un, int wr, int wc, int fr, int fq) const {
        const int row0 = un.pm * BM + wr * 64 + fr, colt = un.pn * BM + wc * 32 + 8 * fq;
        f32x4 sc[2][2]; u32x4 gws[2][4][2];
#pragma unroll
        for (int bj = 0; bj < 2; ++bj) { sc[bj][0] = *(const f32x4*)(scale + colt + bj * HALF); sc[bj][1] = *(const f32x4*)(scale + colt + bj * HALF + 4); }
#pragma unroll
        for (int ai = 0; ai < 2; ++ai)
#pragma unroll
            for (int m = 0; m < 4; ++m)
#pragma unroll
                for (int bj = 0; bj < 2; ++bj) gws[ai][m][bj] = *(const u32x4*)(sg + (size_t)(row0 + ai * HALF + m * 16) * EA + colt + bj * HALF);
#pragma unroll
        for (int ai = 0; ai < 2; ++ai)
#pragma unroll
            for (int m = 0; m < 4; ++m) { const size_t ro = (size_t)(row0 + ai * HALF + m * 16) * EA + colt;
#pragma unroll
                for (int bj = 0; bj < 2; ++bj) { const u32x4 gw = gws[ai][m][bj];
                    f32x4 v0 = acc[ai][bj][m][0] * sc[bj][0], v1 = acc[ai][bj][m][1] * sc[bj][1];
                    v0[0] *= bflo(gw.x); v0[1] *= bfhi(gw.x); v0[2] *= bflo(gw.y); v0[3] *= bfhi(gw.y);
                    v1[0] *= bflo(gw.z); v1[1] *= bfhi(gw.z); v1[2] *= bflo(gw.w); v1[3] *= bfhi(gw.w);
                    *(bf16x8*)(yg + ro + bj * HALF) = pack8(v0, v1); } }
    }
};
struct EpiRes {
    static constexpr bool PERM = false;
    const float* base_p; const float* base_s; float* xres; bf16_t* xb; float* ssq_next;
    __device__ __forceinline__ void operator()(AccRef acc, const Unit& un, int wr, int wc, int fr, int fq) const {
        const int row0 = un.pm * BM + wr * 64 + fr, col0 = un.pn * BM + wc * 32 + 4 * fq;
#pragma unroll
        for (int ai = 0; ai < 2; ++ai) {
            f32x4 bx_[4][2][2];
#pragma unroll
            for (int m = 0; m < 4; ++m) { const int row = row0 + ai * HALF + m * 16;
                const float* bp = (row < MP ? base_p + (size_t)row * DM : base_s + (size_t)(row - MP) * DM) + col0;
#pragma unroll
                for (int bj = 0; bj < 2; ++bj)
#pragma unroll
                    for (int n = 0; n < 2; ++n) bx_[m][bj][n] = *(const f32x4*)(bp + bj * HALF + n * 16); }
#pragma unroll
            for (int m = 0; m < 4; ++m) { const int row = row0 + ai * HALF + m * 16;
                float* xo = xres + (size_t)row * DM + col0; bf16_t* bo = xb + (size_t)row * DM + col0; float s = 0.f;
#pragma unroll
                for (int bj = 0; bj < 2; ++bj)
#pragma unroll
                    for (int n = 0; n < 2; ++n) { const f32x4 x = bx_[m][bj][n] + acc[ai][bj][m][n];
                        *(f32x4*)(xo + bj * HALF + n * 16) = x; u32x2 w; w.x = cvtpk(x[0], x[1]); w.y = cvtpk(x[2], x[3]); *(u32x2*)(bo + bj * HALF + n * 16) = w;
                        s += (x[0] * x[0] + x[1] * x[1]) + (x[2] * x[2] + x[3] * x[3]); }
                s = xsum16(s); s = xsum32(s);
                if (fq == 0) atomicAdd(ssq_next + row, s); } }
    }
};
struct EpiKVQ {
    static constexpr bool PERM = true;
    int pn_off; const float* ssq; float* out; unsigned char* ws; const float* b_f;
    __device__ __forceinline__ void operator()(AccRef acc, const Unit& un, int wr, int wc, int fr, int fq) const {
        const int tt = un.pn + pn_off;
        const int row0 = un.pm * BM + wr * 64 + fr, cw = wc * 32 + 8 * fq;
        float rrs[2][4];
#pragma unroll
        for (int ai = 0; ai < 2; ++ai)
#pragma unroll
            for (int m = 0; m < 4; ++m) rrs[ai][m] = ssq[row0 + ai * HALF + m * 16];
        if (tt == 16) {
            if (wc == 0 && fq < 2) {
            const f32x4 bf0 = *(const f32x4*)(b_f + 8 * fq), bf1 = *(const f32x4*)(b_f + 8 * fq + 4);
            float* lft_p = (float*)(ws + WS_LFTP); float* lft_s = (float*)(ws + WS_LFTS);
#pragma unroll
            for (int ai = 0; ai < 2; ++ai)
#pragma unroll
                for (int m = 0; m < 4; ++m) { const int row = row0 + ai * HALF + m * 16; const float rr = rsqrtf(rrs[ai][m] * (1.0f / DM) + EPS);
                    f32x4 v0 = acc[ai][0][m][0] * rr + bf0, v1 = acc[ai][0][m][1] * rr + bf1;
#pragma unroll
                    for (int j = 0; j < 4; ++j) { v0[j] = logsig(v0[j]); v1[j] = logsig(v1[j]); }
                    if (row < MP) { float* o = out + O_LFP + (size_t)row * NH + 8 * fq; *(f32x4*)o = v0; *(f32x4*)(o + 4) = v1;
                        float* tp = lft_p + ((size_t)(row >> 12) * NH + 8 * fq) * SEQ + (row & (SEQ - 1));
#pragma unroll
                        for (int j = 0; j < 4; ++j) { tp[(size_t)j * SEQ] = v0[j]; tp[(size_t)(j + 4) * SEQ] = v1[j]; } }
                    else { const int rs = row - MP; float* o = out + O_LFS + (size_t)rs * NH + 8 * fq; *(f32x4*)o = v0; *(f32x4*)(o + 4) = v1;
                        float* tp = lft_s + ((size_t)(rs >> 4) * NH + 8 * fq) * DSEQ + (rs & 15);
#pragma unroll
                        for (int j = 0; j < 4; ++j) { tp[j * DSEQ] = v0[j]; tp[(j + 4) * DSEQ] = v1[j]; } } }
            }
        } else {
        const int kind = tt < 8 ? 0 : (tt < 16 ? 1 : (tt < 25 ? 2 : 3));
        const int colt = (tt - (kind == 0 ? 0 : kind == 1 ? 8 : kind == 2 ? 17 : 25)) * BM + cw;
        float* fo_p = out + (kind == 0 ? O_KP : O_VP); float* fo_s = out + (kind == 0 ? O_KS : O_VS);
        bf16_t* bo = (bf16_t*)(ws + (kind == 0 ? WS_KB : (kind == 1 ? WS_VB : (kind == 2 ? WS_QB : WS_SGB))));
#pragma unroll
        for (int ai = 0; ai < 2; ++ai)
#pragma unroll
            for (int m = 0; m < 4; ++m) { const int row = row0 + ai * HALF + m * 16; float rr = rsqrtf(rrs[ai][m] * (1.0f / DM) + EPS);
                if (kind == 2) rr *= QSCALE;
                float* fo = (row < MP ? fo_p + (size_t)row * DM : fo_s + (size_t)(row - MP) * DM) + colt;
#pragma unroll
                for (int bj = 0; bj < 2; ++bj) { f32x4 v0 = acc[ai][bj][m][0] * rr, v1 = acc[ai][bj][m][1] * rr;
                    if (kind < 2) { *(f32x4*)(fo + bj * HALF) = v0; *(f32x4*)(fo + bj * HALF + 4) = v1; }
                    if (kind == 3) {
#pragma unroll
                        for (int j = 0; j < 4; ++j) { v0[j] = silu_f(v0[j]); v1[j] = silu_f(v1[j]); } }
                    *(bf16x8*)(bo + (size_t)row * DM + colt + bj * HALF) = pack8(v0, v1);
                    if (kind == 0 || kind == 2) {
                        float ss = (v0[0] * v0[0] + v0[1] * v0[1]) + (v0[2] * v0[2] + v0[3] * v0[3]) + (v1[0] * v1[0] + v1[1] * v1[1]) + (v1[2] * v1[2] + v1[3] * v1[3]);
                        ss = xsum16(ss); ss = xsum32(ss);
                        float* nt = (float*)(ws + (kind == 0 ? WS_KNRM : WS_QNRM));
                        if (fq == 0) nt[((size_t)row * NH + 2 * (colt >> 8) + bj) * 4 + wc] = ss; } } }
        }
    }
};
}

namespace att {
constexpr int NW = 8, QBLK = 32, KVBLK = 64, QB = NW * QBLK, D = 128, LD = 2048;
constexpr int SHM_V = KVBLK * D * 2, SHM_K = KVBLK * D * 2;
constexpr int OFF_WS = 2 * SHM_V + 2 * SHM_K, OFF_F = OFF_WS + NW * 64 * 4, OFF_SC = OFF_F + SEQ * 4, OFF_KT = OFF_SC + 64, OFF_QM = OFF_KT + 256, OFF_JL = OFF_QM + 64;
constexpr float SKIP_T = 32.f;
constexpr float THR2 = 11.5f;
#define KSWZ(row, colB) ((row) * 256 + ((colB) ^ (((row) & 7) << 4)))
#define SBAR() __builtin_amdgcn_sched_barrier(0)
__device__ __forceinline__ int v_st(int k, int c) { const int kk = (k & ~0xC) | ((k & 4) << 1) | ((k & 8) >> 1); return ((kk >> 3) * 4 + (c >> 5)) * 512 + ((kk & 7) * 32 + (c & 31)) * 2; }
__device__ __forceinline__ int v_rd_base(int lane) { return ((lane & 3) << 3) | (((lane >> 2) & 3) << 6) | (((lane >> 4) & 1) << 5) | (((lane >> 5) & 1) << 8); }
constexpr int v_rd_off(int d0, int ks, int half) { return d0 * 512 + ks * 4096 + half * 2048; }
__device__ __forceinline__ int crow(int r, int hi) { return (r & 3) + 8 * (r >> 2) + 4 * hi; }
__device__ __forceinline__ void mask_tile(f32x16& p0, f32x16& p1, int dq) {
    const float NEG = -__builtin_inff();
#pragma unroll
    for (int r = 0; r < 16; ++r) { const int c = (r & 3) + 8 * (r >> 2);
        if (dq - c < 0) p0[r] = NEG;
        if (dq - c - 32 < 0) p1[r] = NEG; }
}
__device__ __forceinline__ void partialSM(f32x16& p0, f32x16& p1, float& m_reg, float& mn, float& alpha) {
    float pmax = p0[0];
#pragma unroll
    for (int r = 1; r < 16; ++r) pmax = fmaxf(pmax, p0[r]);
#pragma unroll
    for (int r = 0; r < 16; ++r) pmax = fmaxf(pmax, p1[r]);
    { auto rr = __builtin_amdgcn_permlane32_swap(__float_as_uint(pmax), __float_as_uint(pmax), false, false);
      pmax = fmaxf(__uint_as_float(rr[0]), __uint_as_float(rr[1])); }
    if (__builtin_expect(__all((pmax - m_reg) <= THR2), 1)) { mn = m_reg; alpha = 1.f; }
    else { mn = fmaxf(m_reg, pmax); alpha = __builtin_amdgcn_exp2f(m_reg - mn); m_reg = mn; }
#pragma unroll
    for (int r = 0; r < 16; ++r) p0[r] = p0[r] - mn;
#pragma unroll
    for (int r = 0; r < 16; ++r) p1[r] = p1[r] - mn;
#pragma unroll
    for (int r = 0; r < 16; ++r) p0[r] = __builtin_amdgcn_exp2f(p0[r]);
}
__device__ __forceinline__ void finishSM(f32x16& p0, f32x16& p1, float alpha, float& l_reg, bf16x8& pa0, bf16x8& pa1, bf16x8& pa2, bf16x8& pa3) {
#pragma unroll
    for (int r = 0; r < 16; ++r) p1[r] = __builtin_amdgcn_exp2f(p1[r]);
    float ps = 0;
#pragma unroll
    for (int r = 0; r < 16; ++r) ps += p0[r];
#pragma unroll
    for (int r = 0; r < 16; ++r) ps += p1[r];
    { auto rr = __builtin_amdgcn_permlane32_swap(__float_as_uint(ps), __float_as_uint(ps), false, false);
      ps = __uint_as_float(rr[0]) + __uint_as_float(rr[1]); }
    l_reg = l_reg * alpha + ps;
#define PK4(P, B_, OUT) do { unsigned a0 = cvtpk(P[B_+0], P[B_+1]), a1 = cvtpk(P[B_+2], P[B_+3]);                          \
        unsigned b0 = cvtpk(P[B_+4], P[B_+5]), b1 = cvtpk(P[B_+6], P[B_+7]);                                             \
        auto r0 = __builtin_amdgcn_permlane32_swap(a0, b0, false, false); auto r1 = __builtin_amdgcn_permlane32_swap(a1, b1, false, false); \
        u32x4 w = {r0[0], r1[0], r0[1], r1[1]}; OUT = *reinterpret_cast<bf16x8*>(&w); } while (0)
    PK4(p0, 0, pa0); PK4(p0, 8, pa1); PK4(p1, 0, pa2); PK4(p1, 8, pa3);
#undef PK4
}
template <int KB>
__device__ __forceinline__ void qkt(f32x16& p0, f32x16& p1, const char* K_lds, const float* fl, int r32, int hi, const bf16x8* qr) {
    { const f32x4 a0 = *(const f32x4*)(fl), a1 = *(const f32x4*)(fl + 8), a2 = *(const f32x4*)(fl + 16), a3 = *(const f32x4*)(fl + 24);
      const f32x4 b0 = *(const f32x4*)(fl + 32), b1 = *(const f32x4*)(fl + 40), b2 = *(const f32x4*)(fl + 48), b3 = *(const f32x4*)(fl + 56);
      p0 = (f32x16){a0[0], a0[1], a0[2], a0[3], a1[0], a1[1], a1[2], a1[3], a2[0], a2[1], a2[2], a2[3], a3[0], a3[1], a3[2], a3[3]};
      p1 = (f32x16){b0[0], b0[1], b0[2], b0[3], b1[0], b1[1], b1[2], b1[3], b2[0], b2[1], b2[2], b2[3], b3[0], b3[1], b3[2], b3[3]}; }
    const char* kb[4];
#pragma unroll
    for (int dd = 0; dd < 4; ++dd) kb[dd] = K_lds + KB * SHM_K + KSWZ(r32, (dd * 16 + hi * 8) * 2);
#pragma unroll
    for (int d0 = 0; d0 < 8; ++d0) { const char* a = kb[d0 & 3] + (d0 >> 2) * 128;
        bf16x8 b0 = *reinterpret_cast<const bf16x8*>(a);
        bf16x8 b1 = *reinterpret_cast<const bf16x8*>(a + 32 * 256);
        p0 = __builtin_amdgcn_mfma_f32_32x32x16_bf16(b0, qr[d0], p0, 0, 0, 0);
        p1 = __builtin_amdgcn_mfma_f32_32x32x16_bf16(b1, qr[d0], p1, 0, 0, 0); }
}
template <int VB>
__device__ __forceinline__ void pv_tile(f32x16* o, int vb0, bf16x8 pa0, bf16x8 pa1, bf16x8 pa2, bf16x8 pa3) {
#define TRRD(dst, off) asm volatile("ds_read_b64_tr_b16 %0, %1 offset:%2" : "=&v"(dst) : "v"(vb0), "i"(off) : "memory")
#define PV_D0(d0) do { s16x4 l0, l1, l2, l3, h0, h1, h2, h3; constexpr int b_ = VB * SHM_V + v_rd_off(d0, 0, 0);   \
        TRRD(l0, b_); TRRD(h0, b_ + 2048); TRRD(l1, b_ + 4096); TRRD(h1, b_ + 6144); TRRD(l2, b_ + 8192); TRRD(h2, b_ + 10240); TRRD(l3, b_ + 12288); TRRD(h3, b_ + 14336); \
        asm volatile("s_waitcnt lgkmcnt(0)" ::: "memory"); SBAR();   \
        o[d0] = __builtin_amdgcn_mfma_f32_32x32x16_bf16(pa0, (bf16x8){l0[0], l0[1], l0[2], l0[3], h0[0], h0[1], h0[2], h0[3]}, o[d0], 0, 0, 0);   \
        o[d0] = __builtin_amdgcn_mfma_f32_32x32x16_bf16(pa1, (bf16x8){l1[0], l1[1], l1[2], l1[3], h1[0], h1[1], h1[2], h1[3]}, o[d0], 0, 0, 0);   \
        o[d0] = __builtin_amdgcn_mfma_f32_32x32x16_bf16(pa2, (bf16x8){l2[0], l2[1], l2[2], l2[3], h2[0], h2[1], h2[2], h2[3]}, o[d0], 0, 0, 0);   \
        o[d0] = __builtin_amdgcn_mfma_f32_32x32x16_bf16(pa3, (bf16x8){l3[0], l3[1], l3[2], l3[3], h3[0], h3[1], h3[2], h3[3]}, o[d0], 0, 0, 0); } while (0)
    PV_D0(0); PV_D0(1); PV_D0(2); PV_D0(3);
#undef PV_D0
#undef TRRD
}
struct Tensors { const bf16_t* q; const bf16_t* k; const bf16_t* v; bf16_t* og; const bf16_t* sg; const float* lft; };
struct BlockRef { unsigned q0, s0; int P0, jlo; };
struct Seam { bf16x8 qr[8]; bf16x8 st_v0, st_v1, st_k0, st_k1; };
#define ROWP(p, k0) ((p) + (unsigned)(k0) * (unsigned)LD)
#define VMW() asm volatile("s_waitcnt vmcnt(0)" ::: "memory")
#define VMWN(n) asm volatile("s_waitcnt vmcnt(%0)" :: "i"(n) : "memory")
#define LD8(p) (*reinterpret_cast<const bf16x8*>(p))
#define SLOAD_H(Kp, Vp, k0) do { S.st_v0 = LD8(ROWP(Vp, k0) + voff); S.st_v1 = LD8(ROWP(Vp, (k0) + 32) + voff);              \
                         S.st_k0 = LD8(ROWP(Kp, k0) + voff); S.st_k1 = LD8(ROWP(Kp, (k0) + 32) + voff); } while (0)
#define SWRITE_HK(bf) do { *(bf16x8*)(K_lds + (bf) * SHM_K + kws) = S.st_k0; *(bf16x8*)(K_lds + (bf) * SHM_K + kws + 32 * 256) = S.st_k1; } while (0)
#define SWRITE_HV(bf) do { *(bf16x8*)(V_lds + (bf) * SHM_V + vst0) = S.st_v0; *(bf16x8*)(V_lds + (bf) * SHM_V + vst0 + VST1) = S.st_v1; } while (0)
#define SWRITE_H(bf) do { SWRITE_HV(bf); SWRITE_HK(bf); } while (0)
__device__ __forceinline__ void prime(int wv, const Tensors& T, const BlockRef& cur, char* lds, Seam& S) {
    const int tid = otid(wv), wid = __builtin_amdgcn_readfirstlane(tid >> 6), lane = tid & 63, r32 = lane & 31, hi = lane >> 5;
    const int sr = tid >> 4, sc = (tid & 15) * 8, kws = KSWZ(sr, sc * 2); char* K_lds = lds + 2 * SHM_V;
    const unsigned voff = (unsigned)sr * LD + sc, qoff = (unsigned)(wid * QBLK + r32) * LD + hi * 8;
    const bf16_t* Qp = T.q + cur.q0; const bf16_t* Kh = T.k + cur.s0; const bf16_t* Vh = T.v + cur.s0;
#pragma unroll
    for (int d0 = 0; d0 < 8; ++d0) S.qr[d0] = LD8(Qp + qoff + d0 * 16);
    SLOAD_H(Kh, Vh, cur.jlo * KVBLK); VMW(); SWRITE_HK(0);
    __syncthreads();
}
__device__ __forceinline__ void block(int wv, const Tensors& T, const BlockRef& cur, const BlockRef& nxt, char* lds, Seam& S) {
    const int tid = otid(wv), wid = __builtin_amdgcn_readfirstlane(tid >> 6), lane = tid & 63, r32 = lane & 31, hi = lane >> 5;
    const int j_lo = cur.jlo, NT = (cur.P0 + QB) / KVBLK - j_lo;
    const int qlo = cur.P0 - j_lo * KVBLK + wid * QBLK, qm = qlo + r32 - 4 * hi;
    char* V_lds = lds; char* K_lds = lds + 2 * SHM_V;
    float* wsl = (float*)(lds + OFF_WS) + wid * 64; float* li_l = wsl, * al_l = wsl + 32;
    float* Fl = (float*)(lds + OFF_F);
    float m_reg = -1e30f, l_reg = 0; f32x16 o[4] = {};
    const int sr = tid >> 4, sc = (tid & 15) * 8, vst0 = v_st(sr, sc), kws = KSWZ(sr, sc * 2); constexpr int VST1 = 8192;
    const int vb0 = (int)(uintptr_t)V_lds + v_rd_base(lane);
    const bf16_t* Kh = T.k + cur.s0 + (unsigned)(j_lo * KVBLK) * LD; const bf16_t* Vh = T.v + cur.s0 + (unsigned)(j_lo * KVBLK) * LD;
    const unsigned voff = (unsigned)sr * LD + sc, qoff = (unsigned)(wid * QBLK + r32) * LD + hi * 8;
    const float* flb = Fl + j_lo * KVBLK + 4 * hi;
#define RESC(a) do { if (__any((a) < 1.f)) { if (hi == 0) al_l[r32] = (a); asm volatile("s_waitcnt lgkmcnt(0)" ::: "memory");              \
                     for (int d_ = 0; d_ < 4; ++d_) for (int r = 0; r < 16; ++r) o[d_][r] *= al_l[crow(r, hi)]; } } while (0)
#define KBASE(t) ((t) * KVBLK)
#define MASKT(P0_, P1_, t) do { const int kb_ = KBASE(t); if (kb_ + KVBLK - 1 > qlo) mask_tile(P0_, P1_, qm - kb_); } while (0)
#define SEAM_K0() do { VMWN(8); SWRITE_HK(0); SBAR(); } while (0)
    f32x16 pA0, pA1, pB0, pB1; float mnA, mnB, alA, alB; bf16x8 pa0, pa1, pa2, pa3;
    SWRITE_HV(0); SBAR();
    if (NT > 1) { SLOAD_H(Kh, Vh, KBASE(1)); }
    SBAR(); qkt<0>(pA0, pA1, K_lds, flb + KBASE(0), r32, hi, S.qr);
    MASKT(pA0, pA1, 0); partialSM(pA0, pA1, m_reg, mnA, alA);
    if (NT > 1) { VMW(); SWRITE_H(1); }
    __syncthreads();
#define HALF_STEP(PX0, PX1, mnX, alX, PY0, PY1, alY, t, KB, VB, SB) do {                                                      \
        SBAR(); qkt<KB>(PX0, PX1, K_lds, flb + KBASE(t), r32, hi, S.qr);                                             \
        finishSM(PY0, PY1, alY, l_reg, pa0, pa1, pa2, pa3); SBAR();                                                           \
        if ((t) + 1 < NT) { SLOAD_H(Kh, Vh, KBASE((t) + 1)); SBAR(); }                                               \
        pv_tile<VB>(o, vb0, pa0, pa1, pa2, pa3); MASKT(PX0, PX1, (t)); partialSM(PX0, PX1, m_reg, mnX, alX);                                        \
        __syncthreads();                                                                                                      \
        if ((t) + 1 < NT) { VMW(); SWRITE_H(SB); }                                                                          \
        RESC(alX); __syncthreads(); } while (0)
    for (int t = 1; t + 1 < NT; t += 2) {
        HALF_STEP(pB0, pB1, mnB, alB, pA0, pA1, alA, t, 1, 0, 0);
        HALF_STEP(pA0, pA1, mnA, alA, pB0, pB1, alB, t + 1, 0, 1, 1);
    }
    const bool even = (NT & 1) == 0;
    if (even) { SBAR(); qkt<1>(pB0, pB1, K_lds, flb + KBASE(NT - 1), r32, hi, S.qr); SBAR(); }
    { const bf16_t* Kn = T.k + nxt.s0; const bf16_t* Vn = T.v + nxt.s0; SLOAD_H(Kn, Vn, nxt.jlo * KVBLK); } SBAR();
    { const bf16_t* Qn = T.q + nxt.q0;
#pragma unroll
      for (int d0 = 0; d0 < 8; ++d0) S.qr[d0] = LD8(Qn + qoff + d0 * 16); }
    SBAR();
    finishSM(pA0, pA1, alA, l_reg, pa0, pa1, pa2, pa3); SBAR();
    pv_tile<0>(o, vb0, pa0, pa1, pa2, pa3);
    if (even) { MASKT(pB0, pB1, NT - 1); partialSM(pB0, pB1, m_reg, mnB, alB); __syncthreads(); RESC(alB);
        finishSM(pB0, pB1, alB, l_reg, pa0, pa1, pa2, pa3); SBAR(); pv_tile<1>(o, vb0, pa0, pa1, pa2, pa3); }
    SBAR(); SEAM_K0();
    if (hi == 0) li_l[r32] = l_reg; asm volatile("s_waitcnt lgkmcnt(0)" ::: "memory");
    float rli[16];
#pragma unroll
    for (int r = 0; r < 16; ++r) rli[r] = __builtin_amdgcn_rcpf(li_l[crow(r, hi)]);
    { const unsigned eoff = (unsigned)(4 * hi) * LD + r32;
#pragma unroll
      for (int r = 0; r < 16; ++r) { const unsigned ro = cur.q0 + (unsigned)(wid * QBLK + (r & 3) + 8 * (r >> 2)) * LD;
        bf16_t* Orow = T.og + ro; const bf16_t* Grow = T.sg + ro;
#pragma unroll
        for (int d0 = 0; d0 < 4; ++d0) { const float v = o[d0][r] * rli[r];
            const float vn = __shfl_xor(v, 1);
            if ((r32 & 1) == 0) { const unsigned gg = *(const unsigned*)(Grow + eoff + d0 * 32);
                *(unsigned*)(Orow + eoff + d0 * 32) = cvtpk(v * bflo(gg), vn * bfhi(gg)); } } } }
    __syncthreads();
#undef RESC
#undef KBASE
#undef MASKT
#undef SEAM_K0
#undef HALF_STEP
}
#undef ROWP
#undef VMW
#undef VMWN
#undef SLOAD_H
#undef SWRITE_HK
#undef SWRITE_HV
#undef SWRITE_H
#undef LD8

__device__ __forceinline__ BlockRef mkref(int bh, int qb) {
    const int b = bh >> 4, h = bh & 15; BlockRef r; r.s0 = (unsigned)b * SEQ * LD + h * D; r.q0 = r.s0 + (unsigned)qb * QB * LD; r.jlo = 0; r.P0 = qb * QB; return r;
}
__device__ __forceinline__ void item_setup(int wv, const Tensors& T, const float* knrm, const float* qnrm, int bh, int xa, int xb, char* lds, int& jloA, int& jloB) {
    const int tid = otid(wv), wid = __builtin_amdgcn_readfirstlane(tid >> 6), lane = tid & 63;
    float* Fl = (float*)(lds + OFF_F); float* scn = (float*)(lds + OFF_SC); float* Kt = (float*)(lds + OFF_KT); float* Qm = (float*)(lds + OFF_QM); int* JL = (int*)(lds + OFF_JL);
    const int b = bh >> 4, h = bh & 15, nkeys = (xb + 1) * QB, t0 = tid * 8;
    const float* LF = T.lft + (size_t)bh * SEQ;
    f32x4 a = {0.f, 0.f, 0.f, 0.f}, c = {0.f, 0.f, 0.f, 0.f};
    float kmx = 0.f;
    if (t0 < nkeys) { a = *(const f32x4*)(LF + t0); c = *(const f32x4*)(LF + t0 + 4);
        const float* kn = knrm + ((size_t)(b * SEQ + t0) * NH + h) * 4;
#pragma unroll
        for (int i = 0; i < 8; ++i) { const f32x4 p = *(const f32x4*)(kn + (size_t)i * NH * 4); kmx = fmaxf(kmx, (p[0] + p[1]) + (p[2] + p[3])); } }
    kmx = fmaxf(kmx, bperm(kmx, lane ^ 1)); kmx = fmaxf(kmx, bperm(kmx, lane ^ 2)); kmx = fmaxf(kmx, bperm(kmx, lane ^ 4));
    if ((tid & 7) == 0 && t0 < nkeys) Kt[tid >> 3] = sqrtf(kmx) * 1.01f;
    { const int qrow = b * SEQ + (tid < 256 ? xa * QB + tid : xb * QB + (tid - 256));
      const f32x4 p = *(const f32x4*)(qnrm + ((size_t)qrow * NH + h) * 4); float qm = (p[0] + p[1]) + (p[2] + p[3]);
#pragma unroll
      for (int o = 1; o < 64; o <<= 1) qm = fmaxf(qm, bperm(qm, lane ^ o));
      if (lane == 0) Qm[wid] = qm; }
    a[1] += a[0]; a[2] += a[1]; a[3] += a[2]; c[0] += a[3]; c[1] += c[0]; c[2] += c[1]; c[3] += c[2];
    const float tot = c[3]; float inc = tot;
#pragma unroll
    for (int o = 1; o < 64; o <<= 1) { const float v = bperm(inc, (lane - o) & 63); if (lane >= o) inc += v; }
    if (lane == 63) scn[wid] = inc;
    if (tid == 0) { JL[0] = xa * 4; JL[1] = xb * 4; }
    __syncthreads();
    float base = inc - tot;
    for (int w = 0; w < wid; ++w) base += scn[w];
    a = (a + base) * (-LOG2E); c = (c + base) * (-LOG2E);
    if (t0 < nkeys) { *(f32x4*)(Fl + t0) = a; *(f32x4*)(Fl + t0 + 4) = c; }
    __syncthreads();
    if (tid < 128) { const int which = tid >> 6, j = tid & 63, x = which ? xb : xa, nd = x * 4;
        if (j < nd) { const float qmax = sqrtf(fmaxf(fmaxf(Qm[which * 4], Qm[which * 4 + 1]), fmaxf(Qm[which * 4 + 2], Qm[which * 4 + 3]))) * 1.01f;
            const float kdiag = fmaxf(fmaxf(Kt[nd], Kt[nd + 1]), fmaxf(Kt[nd + 2], Kt[nd + 3]));
            const bool skip = qmax * (Kt[j] + kdiag) + Fl[64 * j + 63] - Fl[x * QB] < -SKIP_T;
            if (!skip) atomicMin(JL + which, j); } }
    __syncthreads();
    jloA = __builtin_amdgcn_readfirstlane(JL[0]); jloB = __builtin_amdgcn_readfirstlane(JL[1]);
}
__device__ __forceinline__ void prompt_phase(int wv, char* lds, const Tensors& T, const float* knrm, const float* qnrm, int vw, int G) {
    constexpr int TOTAL = NBATCH * NH * 8;
    Seam S;
    for (int L = vw; L < TOTAL; L += G) {
        const int bh = L >> 3, x = (L >= TOTAL / 2) ? 7 - (L & 7) : (L & 7);
        int ja, jb;
        item_setup(wv, T, knrm, qnrm, bh, x, 15 - x, lds, ja, jb);
        BlockRef A = mkref(bh, x), Bk = mkref(bh, 15 - x); A.jlo = ja; Bk.jlo = jb;
        prime(wv, T, A, lds, S);
#pragma unroll 1
        for (int pass = 0; pass < 2; ++pass) { const BlockRef cur = pass ? Bk : A; block(wv, T, cur, Bk, lds, S); }
    }
}
}

namespace sat {
constexpr int OFF_F = 0, OFF_SC = 8448, OFF_P = 8704, OFF_A = OFF_P + 8 * 4096, OFF_ML = OFF_A + 512, OFF_O = OFF_ML + 1024;
struct Tensors { const bf16_t* q; const bf16_t* kb; const bf16_t* vb; bf16_t* og; const bf16_t* sg; const float* ck; const float* cv; const float* clf; const float* lfts; };
__device__ __forceinline__ void item(int wv, char* lds, const Tensors& T, int b, int h) {
    const int tid = otid(wv), wid = __builtin_amdgcn_readfirstlane(tid >> 6), lane = tid & 63, fr = lane & 15, fq = lane >> 4, half = lane >> 5, dl = (lane & 31) * 4;
    float* Fl = (float*)(lds + OFF_F); float* scn = (float*)(lds + OFF_SC);
    float* Pw = (float*)(lds + OFF_P) + wid * 1024; float* Aw = (float*)(lds + OFF_A) + wid * 16; float* ML = (float*)(lds + OFF_ML); float* Op = (float*)(lds + OFF_O);
    { const float* cl = T.clf + ((size_t)b * PAST + tid * 4) * NH + h;
      float a0 = cl[0], a1 = cl[NH], a2 = cl[2 * NH], a3 = cl[3 * NH];
      a1 += a0; a2 += a1; a3 += a2;
      const float tot = a3; float inc = tot;
#pragma unroll
      for (int o = 1; o < 64; o <<= 1) { const float v = bperm(inc, (lane - o) & 63); if (lane >= o) inc += v; }
      if (lane == 63) scn[wid] = inc;
      __syncthreads();
      float base = inc - tot, all = 0.f;
      for (int w = 0; w < 8; ++w) { const float sw = scn[w]; if (w < wid) base += sw; all += sw; }
      *(f32x4*)(Fl + tid * 4) = (f32x4){(a0 + base) * (-LOG2E), (a1 + base) * (-LOG2E), (a2 + base) * (-LOG2E), (a3 + base) * (-LOG2E)};
      if (tid < DSEQ) { const float* nl = T.lfts + ((size_t)b * NH + h) * DSEQ; float s = all; for (int i = 0; i <= tid; ++i) s += nl[i]; Fl[PAST + tid] = s * (-LOG2E); }
      __syncthreads(); }
    const size_t qrow = (size_t)(MP + b * DSEQ);
    bf16x8 qf[4];
#pragma unroll
    for (int dc = 0; dc < 4; ++dc) qf[dc] = *(const bf16x8*)(T.q + (qrow + fr) * DM + h * HD + dc * 32 + fq * 8);
    float m_run = -1e30f, l_run = 0.f;
    f32x4 oacc[16];
#pragma unroll
    for (int q = 0; q < 16; ++q) oacc[q] = (f32x4){0.f, 0.f, 0.f, 0.f};
    for (int ch = 0; ch < 4; ++ch) {
        const int key0 = (ch * 8 + wid) * 64;
        f32x4 s4[4];
#pragma unroll
        for (int tl = 0; tl < 4; ++tl) { const int kbase = key0 + tl * 16;
            const float* kp = T.ck + (((size_t)b * PAST + kbase + fr) * NH + h) * HD + fq * 8;
            f32x4 acc = *(const f32x4*)(Fl + kbase + fq * 4);
#pragma unroll
            for (int dc = 0; dc < 4; ++dc) { const f32x4 x0 = *(const f32x4*)(kp + dc * 32), x1 = *(const f32x4*)(kp + dc * 32 + 4);
                acc = __builtin_amdgcn_mfma_f32_16x16x32_bf16(pack8(x0, x1), qf[dc], acc, 0, 0, 0); }
            s4[tl] = acc; }
        float cm = s4[0][0];
#pragma unroll
        for (int tl = 0; tl < 4; ++tl)
#pragma unroll
            for (int j = 0; j < 4; ++j) cm = fmaxf(cm, s4[tl][j]);
        cm = xmax16(cm); cm = xmax32(cm);
        const float mn = fmaxf(m_run, cm), alpha = __builtin_amdgcn_exp2f(m_run - mn); m_run = mn;
        float ps = 0.f;
#pragma unroll
        for (int tl = 0; tl < 4; ++tl)
#pragma unroll
            for (int j = 0; j < 4; ++j) { const float p = __builtin_amdgcn_exp2f(s4[tl][j] - mn); ps += p; Pw[(tl * 16 + fq * 4 + j) * 16 + fr] = p; }
        ps = xsum16(ps); ps = xsum32(ps);
        l_run = l_run * alpha + ps;
        if (fq == 0) Aw[fr] = alpha;
        asm volatile("s_waitcnt lgkmcnt(0)" ::: "memory");
        { const f32x4 a0 = *(const f32x4*)(Aw), a1 = *(const f32x4*)(Aw + 4), a2 = *(const f32x4*)(Aw + 8), a3 = *(const f32x4*)(Aw + 12);
#pragma unroll
          for (int j = 0; j < 4; ++j) { oacc[j] *= a0[j]; oacc[4 + j] *= a1[j]; oacc[8 + j] *= a2[j]; oacc[12 + j] *= a3[j]; } }
        const float* vp = T.cv + (((size_t)b * PAST + key0 + half) * NH + h) * HD + dl;
#pragma unroll 8
        for (int kp2 = 0; kp2 < 32; ++kp2) { const f32x4 v = *(const f32x4*)(vp + (size_t)kp2 * 2 * NH * HD);
            const float* pr = Pw + (2 * kp2 + half) * 16;
            const f32x4 p0 = *(const f32x4*)(pr), p1 = *(const f32x4*)(pr + 4), p2 = *(const f32x4*)(pr + 8), p3 = *(const f32x4*)(pr + 12);
#pragma unroll
            for (int j = 0; j < 4; ++j) { oacc[j] += v * p0[j]; oacc[4 + j] += v * p1[j]; oacc[8 + j] += v * p2[j]; oacc[12 + j] += v * p3[j]; } }
        asm volatile("s_waitcnt lgkmcnt(0)" ::: "memory");
    }
    if (wid == 0) {
        f32x4 acc = *(const f32x4*)(Fl + PAST + fq * 4);
        const bf16_t* kp = T.kb + (qrow + fr) * DM + h * HD + fq * 8;
#pragma unroll
        for (int dc = 0; dc < 4; ++dc) acc = __builtin_amdgcn_mfma_f32_16x16x32_bf16(*(const bf16x8*)(kp + dc * 32), qf[dc], acc, 0, 0, 0);
#pragma unroll
        for (int j = 0; j < 4; ++j) if (fq * 4 + j > fr) acc[j] = -__builtin_inff();
        float cm = fmaxf(fmaxf(acc[0], acc[1]), fmaxf(acc[2], acc[3]));
        cm = xmax16(cm); cm = xmax32(cm);
        const float mn = fmaxf(m_run, cm), alpha = __builtin_amdgcn_exp2f(m_run - mn); m_run = mn;
        float ps = 0.f;
#pragma unroll
        for (int j = 0; j < 4; ++j) { const float p = __builtin_amdgcn_exp2f(acc[j] - mn); ps += p; Pw[(fq * 4 + j) * 16 + fr] = p; }
        ps = xsum16(ps); ps = xsum32(ps);
        l_run = l_run * alpha + ps;
        if (fq == 0) Aw[fr] = alpha;
        asm volatile("s_waitcnt lgkmcnt(0)" ::: "memory");
        { const f32x4 a0 = *(const f32x4*)(Aw), a1 = *(const f32x4*)(Aw + 4), a2 = *(const f32x4*)(Aw + 8), a3 = *(const f32x4*)(Aw + 12);
#pragma unroll
          for (int j = 0; j < 4; ++j) { oacc[j] *= a0[j]; oacc[4 + j] *= a1[j]; oacc[8 + j] *= a2[j]; oacc[12 + j] *= a3[j]; } }
        const bf16_t* vp = T.vb + (qrow + half) * DM + h * HD + dl;
#pragma unroll
        for (int kp2 = 0; kp2 < 8; ++kp2) { const u32x2 vw = *(const u32x2*)(vp + (size_t)kp2 * 2 * DM);
            const f32x4 v = {bflo(vw.x), bfhi(vw.x), bflo(vw.y), bfhi(vw.y)};
            const float* pr = Pw + (2 * kp2 + half) * 16;
            const f32x4 p0 = *(const f32x4*)(pr), p1 = *(const f32x4*)(pr + 4), p2 = *(const f32x4*)(pr + 8), p3 = *(const f32x4*)(pr + 12);
#pragma unroll
            for (int j = 0; j < 4; ++j) { oacc[j] += v * p0[j]; oacc[4 + j] += v * p1[j]; oacc[8 + j] += v * p2[j]; oacc[12 + j] += v * p3[j]; } }
        asm volatile("s_waitcnt lgkmcnt(0)" ::: "memory");
    }
#pragma unroll
    for (int q = 0; q < 16; ++q)
#pragma unroll
        for (int c = 0; c < 4; ++c) oacc[q][c] = xsum32(oacc[q][c]);
    if (lane < 32) {
#pragma unroll
        for (int q = 0; q < 16; ++q) *(f32x4*)(Op + (wid * 16 + q) * HD + dl) = oacc[q]; }
    if (fq == 0) { ML[(wid * 16 + fr) * 2] = m_run; ML[(wid * 16 + fr) * 2 + 1] = l_run; }
    __syncthreads();
    { const int q = tid >> 5, d4 = (tid & 31) * 4;
      float mx = ML[q * 2];
#pragma unroll
      for (int w = 1; w < 8; ++w) mx = fmaxf(mx, ML[(w * 16 + q) * 2]);
      float L = 0.f; f32x4 O = {0.f, 0.f, 0.f, 0.f};
#pragma unroll
      for (int w = 0; w < 8; ++w) { const float s = __builtin_amdgcn_exp2f(ML[(w * 16 + q) * 2] - mx); L += s * ML[(w * 16 + q) * 2 + 1]; O += *(const f32x4*)(Op + (w * 16 + q) * HD + d4) * s; }
      const float il = 1.0f / L; const size_t off = (qrow + q) * DM + h * HD + d4;
      const u32x2 gw = *(const u32x2*)(T.sg + off);
      u32x2 w; w.x = cvtpk(O[0] * il * bflo(gw.x), O[1] * il * bfhi(gw.x)); w.y = cvtpk(O[2] * il * bflo(gw.y), O[3] * il * bfhi(gw.y));
      *(u32x2*)(T.og + off) = w; }
    __syncthreads();
}
}

__device__ __forceinline__ void transpose_item(const float* W, int N, bf16_t* WT, int K, const float* g, float* scr, int item, int lane) {
    const int nblk = (N + 31) / 32, kb = item / nblk, nb = item % nblk, k0 = 64 * kb, n0 = 32 * nb;
    const int c4 = (lane & 7) * 4, kr = lane >> 3; const bool nok = n0 + c4 < N;
    f32x4 v[8];
#pragma unroll
    for (int i = 0; i < 8; ++i) v[i] = nok ? *(const f32x4*)(W + (size_t)(k0 + 8 * i + kr) * N + n0 + c4) : (f32x4){0.f, 0.f, 0.f, 0.f};
    if (g) {
#pragma unroll
        for (int i = 0; i < 8; ++i) v[i] *= g[k0 + 8 * i + kr]; }
#pragma unroll
    for (int i = 0; i < 8; ++i) { float* s = scr + (8 * i + kr) * 33 + c4; s[0] = v[i][0]; s[1] = v[i][1]; s[2] = v[i][2]; s[3] = v[i][3]; }
    asm volatile("s_waitcnt lgkmcnt(0)" ::: "memory");
    const int c = lane & 7;
#pragma unroll
    for (int j = 0; j < 4; ++j) { const int nn = (lane >> 3) + 8 * j; const float* s = scr + (8 * c) * 33 + nn;
        u32x4 o; o.x = cvtpk(s[0 * 33], s[1 * 33]); o.y = cvtpk(s[2 * 33], s[3 * 33]); o.z = cvtpk(s[4 * 33], s[5 * 33]); o.w = cvtpk(s[6 * 33], s[7 * 33]);
        if (n0 + nn < N) *(u32x4*)(WT + (size_t)(n0 + nn) * K + k0 + 8 * c) = o; }
    asm volatile("s_waitcnt lgkmcnt(0)" ::: "memory");
}
struct TJob { const float* W; bf16_t* WT; const float* g; int K, N; };
__device__ __forceinline__ TJob get_job(const Params& p, int j) {
    unsigned char* ws = p.ws; TJob t; t.g = nullptr;
    if (j < 2) { t.W = p.in[7] + (size_t)j * DM * 2 * EA; t.WT = (bf16_t*)(ws + WS_WINA) + (size_t)j * 2 * EA * DM; t.g = p.in[6] + j * DM; t.K = DM; t.N = 2 * EA; }
    else if (j < 10) { const int i = j - 2; t.W = p.in[8] + (size_t)i * 1024 * 1024; t.WT = (bf16_t*)(ws + WS_WGRP) + (size_t)i * 1024 * 1024; t.K = 1024; t.N = 1024; }
    else if (j < 12) { const int l = j - 10; t.W = p.in[10] + (size_t)l * EA * DM; t.WT = (bf16_t*)(ws + WS_WOUTA) + (size_t)l * DM * EA; t.K = EA; t.N = DM; }
    else if (j == 12) { t.W = p.in[12]; t.WT = (bf16_t*)(ws + WS_W4); t.g = p.in[11]; t.K = DM; t.N = 2 * DM + NH; }
    else if (j == 13) { t.W = p.in[15]; t.WT = (bf16_t*)(ws + WS_W4) + (size_t)4352 * DM; t.g = p.in[14]; t.K = DM; t.N = 2 * DM; }
    else if (j == 14) { t.W = p.in[15] + (size_t)DM * 2 * DM; t.WT = (bf16_t*)(ws + WS_WINB1); t.g = p.in[14] + DM; t.K = DM; t.N = 2 * DM; }
    else { const int l = j - 15; t.W = p.in[16] + (size_t)l * DM * DM; t.WT = (bf16_t*)(ws + WS_WOUTB) + (size_t)l * DM * DM; t.K = DM; t.N = DM; }
    return t;
}
__device__ __forceinline__ void prologue_phase(int wv, const Params& p, char* lds) {
    const int tid = otid(wv), lane = tid & 63, wid = tid >> 6, G = gridDim.x;
    const int gw = blockIdx.x * NWAVES + wid, NGW = G * NWAVES;
    float* scr = (float*)(lds + wid * 8704);
    int rot = 0;
    for (int j = 0; j < 17; ++j) { const TJob t = get_job(p, j); const int nitems = (t.K / 64) * ((t.N + 31) / 32);
        int start = gw - rot; if (start < 0) start += NGW;
        for (int it = start; it < nitems; it += NGW) transpose_item(t.W, t.N, t.WT, t.K, t.g, scr, it, lane);
        rot = (rot + nitems) % NGW; }
    float* ssq = (float*)(p.ws + WS_SSQ); bf16_t* xb = (bf16_t*)(p.ws + WS_XB);
    for (int m = gw; m < MT; m += NGW) { const float* xr = m < MP ? p.in[0] + (size_t)m * DM : p.in[1] + (size_t)(m - MP) * DM;
        float s = 0.f; unsigned long long* o8 = (unsigned long long*)(xb + (size_t)m * DM) + lane;
#pragma unroll
        for (int j = 0; j < 8; ++j) { const f32x4 v = *((const f32x4*)xr + lane + 64 * j); s += (v[0] * v[0] + v[1] * v[1]) + (v[2] * v[2] + v[3] * v[3]);
            o8[64 * j] = (unsigned long long)cvtpk(v[0], v[1]) | ((unsigned long long)cvtpk(v[2], v[3]) << 32); }
        s = wave_sum(s); if (lane == 0) ssq[m] = s; }
    for (int i = blockIdx.x * NTHREADS + tid; i < 4 * MT; i += G * NTHREADS) ssq[MT + i] = 0.f;
}
template <int W>
__device__ __forceinline__ void poold_item(const bf16_t* u, bf16_t* d, const float* prev, int row0, int ch) {
    constexpr int NR = 16 + W - 1;
    u32x4 rows[NR];
    const bool samp = row0 >= MP; const int t0 = samp ? 0 : (row0 & (SEQ - 1));
    const bf16_t* up = u + (size_t)row0 * EA + ch;
    if (t0 != 0) {
#pragma unroll
        for (int i = 0; i < NR; ++i) rows[i] = *(const u32x4*)(up + (ptrdiff_t)(i - (W - 1)) * EA);
    } else {
#pragma unroll
        for (int i = W - 1; i < NR; ++i) rows[i] = *(const u32x4*)(up + (ptrdiff_t)(i - (W - 1)) * EA);
        if (samp) { const float* pp = prev + ((size_t)((row0 - MP) >> 4) * PPAD + (PPAD - (W - 1))) * EA + ch;
#pragma unroll
            for (int i = 0; i < W - 1; ++i) { const f32x4 a = *(const f32x4*)(pp + (size_t)i * EA), b = *(const f32x4*)(pp + (size_t)i * EA + 4);
                rows[i] = (u32x4){cvtpk(a[0], a[1]), cvtpk(a[2], a[3]), cvtpk(b[0], b[1]), cvtpk(b[2], b[3])}; } }
        else {
#pragma unroll
            for (int i = 0; i < W - 1; ++i) rows[i] = (u32x4){0u, 0u, 0u, 0u}; }
    }
    float s[8] = {0.f, 0.f, 0.f, 0.f, 0.f, 0.f, 0.f, 0.f};
#define ROWF(v, f) const float f[8] = {bflo(v.x), bfhi(v.x), bflo(v.y), bfhi(v.y), bflo(v.z), bfhi(v.z), bflo(v.w), bfhi(v.w)}
#pragma unroll
    for (int i = 0; i < W - 1; ++i) { ROWF(rows[i], f);
#pragma unroll
        for (int c = 0; c < 8; ++c) s[c] += f[c]; }
#pragma unroll
    for (int j = 0; j < 16; ++j) { ROWF(rows[j + W - 1], f);
#pragma unroll
        for (int c = 0; c < 8; ++c) s[c] += f[c];
        const int nv = (!samp && t0 + j + 1 < W) ? t0 + j + 1 : W; const float ic = 1.0f / (float)nv;
        u32x4 o; o.x = cvtpk(s[0] * ic - f[0], s[1] * ic - f[1]); o.y = cvtpk(s[2] * ic - f[2], s[3] * ic - f[3]);
        o.z = cvtpk(s[4] * ic - f[4], s[5] * ic - f[5]); o.w = cvtpk(s[6] * ic - f[6], s[7] * ic - f[7]);
        *(u32x4*)(d + (size_t)(row0 + j) * EA + ch) = o;
        ROWF(rows[j], g);
#pragma unroll
        for (int c = 0; c < 8; ++c) s[c] -= g[c]; }
#undef ROWF
}
__device__ __forceinline__ void poold_phase(int wv, const Params& p, int l) {
    const bf16_t* u = (const bf16_t*)(p.ws + WS_U); bf16_t* d = (bf16_t*)(p.ws + WS_D);
    const float* prev = p.in[5] + (size_t)l * NDB * PPAD * EA;
    const int nth = gridDim.x * NTHREADS;
    for (int idx = blockIdx.x * NTHREADS + otid(wv); idx < (MT / 16) * (EA / 8); idx += nth) {
        const int row0 = (idx >> 9) * 16, ch = (idx & 511) * 8, grp = __builtin_amdgcn_readfirstlane(ch >> 10);
        if (grp == 0) poold_item<2>(u, d, prev, row0, ch);
        else if (grp == 1) poold_item<4>(u, d, prev, row0, ch);
        else if (grp == 2) poold_item<8>(u, d, prev, row0, ch);
        else poold_item<16>(u, d, prev, row0, ch);
    }
}
__device__ __forceinline__ void final_phase(int wv, const Params& p) {
    const int tid = otid(wv), lane = tid & 63, gw = blockIdx.x * NWAVES + (tid >> 6), NGW = gridDim.x * NWAVES;
    const float* xres = (const float*)(p.ws + WS_XRES); const float* ssq = (const float*)(p.ws + WS_SSQ) + (size_t)4 * MT; const float* g = p.in[17];
    for (int m = gw; m < MT; m += NGW) { const float rr = rsqrtf(ssq[m] * (1.0f / DM) + EPS);
        const f32x4* xr = (const f32x4*)(xres + (size_t)m * DM) + lane; f32x4* o = (f32x4*)(p.out + (m < MP ? O_YP + (size_t)m * DM : O_YS + (size_t)(m - MP) * DM)) + lane;
#pragma unroll
        for (int j = 0; j < 8; ++j) o[64 * j] = xr[64 * j] * rr * ((const f32x4*)g)[lane + 64 * j]; }
}

constexpr int NPHASES = 16;
typedef const __attribute__((address_space(4))) Params* KArgPtr;
#if defined(__HIP_DEVICE_COMPILE__)
#define LOADP_() KArgPtr kp_ = (KArgPtr)__builtin_amdgcn_kernarg_segment_ptr(); asm volatile("" : "+s"(kp_)); Params lp; _Pragma("unroll") for (int i_ = 0; i_ < 18; ++i_) lp.in[i_] = kp_->in[i_]; lp.out = kp_->out; lp.ws = kp_->ws; lp.ph_lo = 0; lp.ph_hi = 0
#else
#define LOADP_() const Params lp = p
#endif
#define LOADP() LOADP_(); unsigned char* const ws = lp.ws; \
    float* const ssq = (float*)(ws + WS_SSQ); bf16_t* const xb = (bf16_t*)(ws + WS_XB); float* const xres = (float*)(ws + WS_XRES); (void)ssq; (void)xb; (void)xres
__global__ void __launch_bounds__(NTHREADS, 2) yoco_fwd(Params p) {
    extern __shared__ __attribute__((aligned(16))) unsigned char lds_raw[];
    char* lds = (char*)lds_raw; LAS unsigned char* ldsl = (LAS unsigned char*)lds_raw;
    const int G = gridDim.x, bx = blockIdx.x, wv = __builtin_amdgcn_readfirstlane(threadIdx.x >> 6);
#ifndef ONLY_PHASE
#define ONLY_PHASE -1
#endif
#define IN(k) ((ONLY_PHASE < 0 || ONLY_PHASE == (k)) && p.ph_lo <= (k) && (k) < p.ph_hi)
#ifndef SAT_REP
#define SAT_REP 1
#endif
#ifndef REPEAT_MASK
#define REPEAT_MASK 0
#endif
#define NREP(k) (1 + (int)(((unsigned)(REPEAT_MASK) >> (k)) & 1u))
#define SEAM(k) do { if (rep_ + 1 < NREP(k) || (k) + 1 < p.ph_hi) cg::this_grid().sync(); } while (0)
    if (IN(0)) for (int rep_ = 0; rep_ < NREP(0); ++rep_) { { LOADP(); prologue_phase(wv, lp, lds); } SEAM(0); }
#pragma unroll 1
    for (int l = 0; l < 2; ++l) {
        if (IN(1 + 4 * l)) for (int rep_ = 0; rep_ < NREP(1 + 4 * l); ++rep_) { { LOADP(); bf16_t* u = (bf16_t*)(ws + WS_U); bf16_t* sg = (bf16_t*)(ws + WS_SG);
            pg8::Gemm g{xb, (const bf16_t*)(ws + WS_WINA) + (size_t)l * 2 * EA * DM, 65, 32, DM, DM, -1}; pg8::StaticOrder S; S.init(65, 32, G, bx);
            pg8::EpiInA E{ssq + (size_t)l * MT, u, sg, lp.out + O_PP + (size_t)l * NBATCH * PPAD * EA, lp.out + O_PS + (size_t)l * NDB * PPAD * EA};
            pg8::gemm_phase<pg8::EpiInA>(wv, ldsl, g, S, E); } SEAM(1 + 4 * l); }
        if (IN(2 + 4 * l)) for (int rep_ = 0; rep_ < NREP(2 + 4 * l); ++rep_) { { LOADP(); poold_phase(wv, lp, l); } SEAM(2 + 4 * l); }
        if (IN(3 + 4 * l)) for (int rep_ = 0; rep_ < NREP(3 + 4 * l); ++rep_) { { LOADP(); bf16_t* u = (bf16_t*)(ws + WS_U); bf16_t* sg = (bf16_t*)(ws + WS_SG); bf16_t* d = (bf16_t*)(ws + WS_D);
            pg8::Gemm g{d, (const bf16_t*)(ws + WS_WGRP) + (size_t)l * EA * 1024, 65, 16, 1024, EA, 2}; pg8::StaticOrder S; S.init(65, 16, G, bx);
            pg8::EpiPool E{lp.in[9] + (size_t)l * EA, sg, u};
            pg8::gemm_phase<pg8::EpiPool>(wv, ldsl, g, S, E); } SEAM(3 + 4 * l); }
        if (IN(4 + 4 * l)) for (int rep_ = 0; rep_ < NREP(4 + 4 * l); ++rep_) { { LOADP(); bf16_t* u = (bf16_t*)(ws + WS_U);
            pg8::Gemm g{u, (const bf16_t*)(ws + WS_WOUTA) + (size_t)l * DM * EA, 65, 8, EA, EA, -1}; pg8::StaticOrder S; S.init(65, 8, G, bx);
            pg8::EpiRes E{l == 0 ? lp.in[0] : xres, l == 0 ? lp.in[1] : xres + (size_t)MP * DM, xres, xb, ssq + (size_t)(l + 1) * MT};
            pg8::gemm_phase<pg8::EpiRes>(wv, ldsl, g, S, E); } SEAM(4 + 4 * l); }
    }
#pragma unroll 1
    for (int lb = 0; lb < 2; ++lb) {
        if (IN(9 + 3 * lb)) for (int rep_ = 0; rep_ < NREP(9 + 3 * lb); ++rep_) { { LOADP();
            pg8::Gemm g{xb, lb == 0 ? (const bf16_t*)(ws + WS_W4) : (const bf16_t*)(ws + WS_WINB1), 65, lb == 0 ? 33 : 16, DM, DM, -1};
            pg8::StaticOrder S; S.init(65, g.nN, G, bx);
            pg8::EpiKVQ E{lb == 0 ? 0 : 17, ssq + (size_t)(2 + lb) * MT, lp.out, ws, lp.in[13]};
            pg8::gemm_phase<pg8::EpiKVQ>(wv, ldsl, g, S, E); } SEAM(9 + 3 * lb); }
        if (IN(10 + 3 * lb)) for (int rep_ = 0; rep_ < NREP(10 + 3 * lb); ++rep_) {
#if !defined(NO_SAT)
            { LOADP();
            sat::Tensors ST{(const bf16_t*)(ws + WS_QB), (const bf16_t*)(ws + WS_KB), (const bf16_t*)(ws + WS_VB), (bf16_t*)(ws + WS_OG), (const bf16_t*)(ws + WS_SGB),
                            lp.in[2], lp.in[3], lp.in[4], (const float*)(ws + WS_LFTS)};
            for (int sr_ = 0; sr_ < SAT_REP; ++sr_) for (int it = bx; it < NDB * NH; it += G) sat::item(wv, lds, ST, it >> 4, it & 15); }
#endif
#if !defined(NO_ATT)
            { LOADP(); const int vw = (G % 8 == 0) ? (bx % 8) * (G / 8) + bx / 8 : bx;
            att::Tensors AT{(const bf16_t*)(ws + WS_QB), (const bf16_t*)(ws + WS_KB), (const bf16_t*)(ws + WS_VB), (bf16_t*)(ws + WS_OG), (const bf16_t*)(ws + WS_SGB), (const float*)(ws + WS_LFTP)};
            att::prompt_phase(wv, lds, AT, (const float*)(ws + WS_KNRM), (const float*)(ws + WS_QNRM), vw, G); }
#endif
            SEAM(10 + 3 * lb); }
        if (IN(11 + 3 * lb)) for (int rep_ = 0; rep_ < NREP(11 + 3 * lb); ++rep_) { { LOADP();
            pg8::Gemm g{(const bf16_t*)(ws + WS_OG), (const bf16_t*)(ws + WS_WOUTB) + (size_t)lb * DM * DM, 65, 8, DM, DM, -1}; pg8::StaticOrder S; S.init(65, 8, G, bx);
            pg8::EpiRes E{xres, xres + (size_t)MP * DM, xres, xb, ssq + (size_t)(3 + lb) * MT};
            pg8::gemm_phase<pg8::EpiRes>(wv, ldsl, g, S, E); } SEAM(11 + 3 * lb); }
    }
    if (IN(15)) { LOADP(); final_phase(wv, lp); }
#undef IN
#undef SEAM
}

extern "C" void kernel_launch(void* const* d_in, const int* in_sizes, int n_in, void* d_out, int out_size, void* d_ws, size_t ws_size, hipStream_t stream) {
    static int grid = 0;
    if (grid == 0) {
        if (n_in != 18 || (size_t)out_size != O_END || ws_size < WS_END) { fprintf(stderr, "kernel_launch: unexpected shapes: n_in %d out %d (want %zu) ws %zu (need %zu)\n", n_in, out_size, (size_t)O_END, ws_size, (size_t)WS_END); grid = -1; return; }
        int dev = 0, cus = 0, per_cu = 0;
        (void)hipGetDevice(&dev); (void)hipDeviceGetAttribute(&cus, hipDeviceAttributeMultiprocessorCount, dev);
        if (hipFuncSetAttribute((const void*)yoco_fwd, hipFuncAttributeMaxDynamicSharedMemorySize, LDS_BYTES) != hipSuccess) { fprintf(stderr, "kernel_launch: hipFuncSetAttribute failed\n"); grid = -1; return; }
        if (hipOccupancyMaxActiveBlocksPerMultiprocessor(&per_cu, (const void*)yoco_fwd, NTHREADS, LDS_BYTES) != hipSuccess || per_cu < 1) { fprintf(stderr, "kernel_launch: occupancy query gave %d\n", per_cu); per_cu = 1; }
        (void)hipGetLastError();
        grid = cus > 0 ? cus : 256;
    }
    if (grid < 0) return;
    Params p{};
    for (int i = 0; i < 18; ++i) p.in[i] = (const float*)d_in[i];
    p.out = (float*)d_out; p.ws = (unsigned char*)d_ws;
#if MULTI_LAUNCH
    for (int ph = 0; ph < NPHASES; ++ph) { p.ph_lo = ph; p.ph_hi = ph + 1; hipLaunchKernelGGL(yoco_fwd, dim3(grid), dim3(NTHREADS), LDS_BYTES, stream, p); }
#else
    p.ph_lo = 0; p.ph_hi = NPHASES;
    void* args[] = {&p};
    hipError_t e = hipLaunchCooperativeKernel((const void*)yoco_fwd, dim3(grid), dim3(NTHREADS), args, LDS_BYTES, stream);
    if (e != hipSuccess) fprintf(stderr, "kernel_launch: cooperative launch failed: %s (grid %d)\n", hipGetErrorString(e), grid);
#endif
}
```

```cpp
#include <hip/hip_runtime.h>
#include <hip/hip_cooperative_groups.h>
#include <cstdio>
#include <cstdint>
namespace cg = cooperative_groups;

#ifndef MULTI_LAUNCH
#define MULTI_LAUNCH 0
#endif

#define LAS __attribute__((address_space(3)))
typedef unsigned short bf16_t;
typedef short bf16x8 __attribute__((ext_vector_type(8)));
typedef short s16x4 __attribute__((ext_vector_type(4)));
typedef float f32x4 __attribute__((ext_vector_type(4)));
typedef float f32x16 __attribute__((ext_vector_type(16)));
typedef unsigned u32x4 __attribute__((ext_vector_type(4)));
typedef unsigned u32x2 __attribute__((ext_vector_type(2)));

constexpr int DM = 2048, NBATCH = 4, SEQ = 4096, NDB = 16, DSEQ = 16, PAST = 2048, EA = 4096, NH = 16, HD = 128, PPAD = 15;
constexpr int MP = NBATCH * SEQ, MS = NDB * DSEQ, MT = MP + MS;
constexpr float EPS = 1e-6f;
constexpr float LOG2E = 1.4426950408889634f;
constexpr float QSCALE = 0.08838834764831845f * 1.4426950408889634f;
constexpr int NTHREADS = 512, NWAVES = 8;
constexpr int LDS_BYTES = 131072;

constexpr size_t O_YP = 0, O_YS = O_YP + (size_t)MP * DM, O_KP = O_YS + (size_t)MS * DM, O_VP = O_KP + (size_t)MP * DM,
                 O_LFP = O_VP + (size_t)MP * DM, O_PP = O_LFP + (size_t)MP * NH, O_KS = O_PP + (size_t)2 * NBATCH * PPAD * EA,
                 O_VS = O_KS + (size_t)MS * DM, O_LFS = O_VS + (size_t)MS * DM, O_PS = O_LFS + (size_t)MS * NH, O_END = O_PS + (size_t)2 * NDB * PPAD * EA;

constexpr size_t al256(size_t x) { return (x + 255) & ~(size_t)255; }
constexpr size_t WS_WINA = 0;
constexpr size_t WS_WGRP = WS_WINA + (size_t)2 * 8192 * 2048 * 2;
constexpr size_t WS_WOUTA = WS_WGRP + (size_t)2 * 4096 * 1024 * 2;
constexpr size_t WS_W4 = WS_WOUTA + (size_t)2 * 2048 * 4096 * 2;
constexpr size_t WS_WINB1 = WS_W4 + (size_t)8448 * 2048 * 2;
constexpr size_t WS_WOUTB = WS_WINB1 + (size_t)4096 * 2048 * 2;
constexpr size_t WS_XB = WS_WOUTB + (size_t)2 * 2048 * 2048 * 2;
constexpr size_t WS_XRES = WS_XB + (size_t)MT * DM * 2;
constexpr size_t WS_SSQ = WS_XRES + (size_t)MT * DM * 4;
constexpr size_t WS_LFTP = al256(WS_SSQ + (size_t)5 * MT * 4);
constexpr size_t WS_LFTS = WS_LFTP + (size_t)NBATCH * NH * SEQ * 4;
constexpr size_t WS_KNRM = al256(WS_LFTS + (size_t)NDB * NH * DSEQ * 4);
constexpr size_t WS_QNRM = WS_KNRM + (size_t)MT * NH * 4 * 4;
constexpr size_t WS_WINUT = al256(WS_QNRM + (size_t)MT * NH * 4 * 4);
constexpr size_t WS_WINUS = WS_WINUT + (size_t)2 * EA * DM * 2;
constexpr size_t WS_PREVB = WS_WINUS + (size_t)2 * DM * EA * 2;
constexpr size_t WS_PREVT = WS_PREVB + (size_t)2 * 256 * EA * 2;
constexpr size_t WS_ACT = al256(WS_PREVT + (size_t)2 * 256 * EA * 2);
constexpr size_t SZ_A = (size_t)MT * EA * 2, SZ_B = (size_t)MT * DM * 2;
constexpr size_t WS_U = WS_ACT, WS_SG = WS_U + SZ_A, WS_D = WS_SG + SZ_A;
constexpr size_t WS_KB = WS_ACT, WS_VB = WS_KB + SZ_B, WS_QB = WS_VB + SZ_B, WS_SGB = WS_QB + SZ_B, WS_OG = WS_SGB + SZ_B;
constexpr size_t WS_END = (WS_D + SZ_A) > (WS_OG + SZ_B) ? (WS_D + SZ_A) : (WS_OG + SZ_B);

struct Params { const float* in[18]; float* out; unsigned char* ws; int ph_lo, ph_hi; };

__device__ __forceinline__ unsigned cvtpk(float lo, float hi) { unsigned r; asm volatile("v_cvt_pk_bf16_f32 %0, %1, %2" : "=v"(r) : "v"(lo), "v"(hi)); return r; }
__device__ __forceinline__ bf16x8 pack8(f32x4 a, f32x4 b) { u32x4 w = {cvtpk(a[0], a[1]), cvtpk(a[2], a[3]), cvtpk(b[0], b[1]), cvtpk(b[2], b[3])}; return *reinterpret_cast<bf16x8*>(&w); }
__device__ __forceinline__ float bflo(unsigned w) { return __uint_as_float(w << 16); }
__device__ __forceinline__ float bfhi(unsigned w) { return __uint_as_float(w & 0xffff0000u); }
__device__ __forceinline__ float silu_f(float x) { return x * __builtin_amdgcn_rcpf(1.0f + __builtin_amdgcn_exp2f(-x * LOG2E)); }
__device__ __forceinline__ float wave_sum(float v) {
#pragma unroll
    for (int o = 1; o < 64; o <<= 1) v += __shfl_xor(v, o);
    return v;
}
__device__ __forceinline__ int otid(int wv) { int t = wv * 64 + (int)__builtin_amdgcn_mbcnt_hi(~0u, __builtin_amdgcn_mbcnt_lo(~0u, 0u)); asm volatile("" : "+v"(t)); return t; }
__device__ __forceinline__ float xsum16(float v) { auto r = __builtin_amdgcn_permlane16_swap(__float_as_uint(v), __float_as_uint(v), false, false); return __uint_as_float(r[0]) + __uint_as_float(r[1]); }
__device__ __forceinline__ float xsum32(float v) { auto r = __builtin_amdgcn_permlane32_swap(__float_as_uint(v), __float_as_uint(v), false, false); return __uint_as_float(r[0]) + __uint_as_float(r[1]); }
__device__ __forceinline__ float xmax16(float v) { auto r = __builtin_amdgcn_permlane16_swap(__float_as_uint(v), __float_as_uint(v), false, false); return fmaxf(__uint_as_float(r[0]), __uint_as_float(r[1])); }
__device__ __forceinline__ float xmax32(float v) { auto r = __builtin_amdgcn_permlane32_swap(__float_as_uint(v), __float_as_uint(v), false, false); return fmaxf(__uint_as_float(r[0]), __uint_as_float(r[1])); }
__device__ __forceinline__ float bperm(float v, int srclane) { return __uint_as_float((unsigned)__builtin_amdgcn_ds_bpermute(srclane << 2, (int)__float_as_uint(v))); }
__device__ __forceinline__ float logsig(float x) { return fminf(x, 0.f) - log1pf(__expf(-fabsf(x))); }

namespace pg8 {
constexpr int BM = 256, BK = 64, HALF = 128, HTB = HALF * BK * 2, NXCD = 8, WGM = 8;
__device__ __forceinline__ int lds_byte(int r, int c) { const int st = (r >> 4) * 2 + (c >> 5), rr = r & 15, cc = c & 31, ob = rr * 64 + cc * 2; return st * 1024 + (ob ^ (((ob >> 9) & 1) << 5)); }
__device__ __forceinline__ void stage_rc(int b, int& R, int& C) { const int st = b / 1024, sb = b % 1024, swz = sb ^ (((sb >> 9) & 1) << 5); R = (st >> 1) * 16 + swz / 64; C = (st & 1) * 32 + (swz % 64) / 2; }
__device__ __forceinline__ int perm32(int rho) { const int n = rho >> 4, i = rho & 15; return 8 * (i >> 2) + 4 * n + (i & 3); }
struct Unit { int pm, pn; };
struct Gemm { const bf16_t* A; const bf16_t* Bt; int K, lda, ldb, mode; };
__device__ __forceinline__ void unit_off(const Gemm& g, const Unit& u, size_t& oa, size_t& ob) {
    if (g.mode == 2) { oa = (size_t)u.pm * 256 * g.lda; ob = (size_t)(u.pm >> 4) * DM * EA + (size_t)((u.pm >> 2) & 3) * 1024 + (size_t)u.pn * 256 * g.ldb; }
    else if (g.mode == 3) { oa = (size_t)u.pm * 256 * g.lda + (size_t)(u.pn >> 2) * 1024; ob = (size_t)(u.pm * 16 + u.pn) * 256 * g.ldb; }
    else { oa = (size_t)u.pm * 256 * g.lda; ob = (size_t)u.pn * 256 * g.ldb; }
    oa *= 2; ob *= 2;
}
struct StaticOrder {
    int nM, nN, nwg, G, c;
    __device__ void init(int nM_, int nN_, int G_, int c_) { nM = nM_; nN = nN_; nwg = nM * nN; G = G_; c = c_; }
    __device__ bool next(int i, Unit& u) const {
        const long L = (long)i * G + c; if (L >= nwg) return false;
        int wgid = (int)L; { const int q = nwg / NXCD, r = nwg % NXCD, xcd = wgid % NXCD, off = wgid / NXCD; wgid = (xcd < r ? xcd * (q + 1) : r * (q + 1) + (xcd - r) * q) + off; }
        const int nig = WGM * nN, gid = wgid / nig, fm = gid * WGM, gsz = (nM - fm) < WGM ? (nM - fm) : WGM;
        u.pm = fm + ((wgid % nig) % gsz); u.pn = (wgid % nig) / gsz; return true;
    }
};
struct StateOrder {
    int G, c;
    __device__ bool next(int i, Unit& u) const { const int idx = G - 1 - c; if (i != 0 || idx >= 80) return false; const int k = idx >> 4; u.pm = k < 4 ? 16 * k + 15 : 64; u.pn = idx & 15; return true; }
};
template <class Epi, class Ord>
__device__ __forceinline__ void gemm_phase(int wv, LAS unsigned char* lds, const Gemm g, const Ord& S, const Epi& E) {
    const int tid = otid(wv), wid = __builtin_amdgcn_readfirstlane(tid >> 6), lane = tid & 63, wr = wid >> 2, wc = wid & 3, fr = lane & 15, fq = lane >> 4;
    const int K = g.K, nt = K / BK;
    unsigned voffA[2], voffB[2];
#pragma unroll
    for (int i = 0; i < 2; ++i) { int R, C; stage_rc(tid * 16 + i * 8192, R, C); const int Rb = Epi::PERM ? ((R & ~31) + perm32(R & 31)) : R;
        voffA[i] = (unsigned)(R * g.lda + C) * 2u; voffB[i] = (unsigned)(Rb * g.ldb + C) * 2u; }
    const size_t kstep = (size_t)(BK * 2);
    const size_t hstepA = (size_t)HALF * g.lda * 2;
    const size_t hstepB = (size_t)HALF * g.ldb * 2;
    const unsigned ldsw = (unsigned)wid * 1024u;
    const int aoff = lds_byte(wr * 64 + fr, fq * 8), boff = lds_byte(wc * 32 + fr, fq * 8);
#define PG8_SA(b, h) (((b) * 2 + (h)) * HTB)
#define PG8_SB(b, h) ((4 + (b) * 2 + (h)) * HTB)
#define PG8_STAGE(bufoff, gbase, voff) do { _Pragma("unroll") for (int _i = 0; _i < 2; ++_i) \
        __builtin_amdgcn_global_load_lds((const unsigned*)((const char*)(gbase) + (voff)[_i]), (LAS unsigned*)(lds + (bufoff) + ldsw + _i * 8192), 16, 0, 0); } while (0)
#define PG8_LDA(dst, b, h) do { _Pragma("unroll") for (int m = 0; m < 4; ++m) _Pragma("unroll") for (int k = 0; k < 2; ++k) dst[m][k] = *(const LAS bf16x8*)(lds + PG8_SA(b, h) + aoff + m * 2048 + k * 1024); } while (0)
#define PG8_LDB(dst, b, h) do { _Pragma("unroll") for (int n = 0; n < 2; ++n) _Pragma("unroll") for (int k = 0; k < 2; ++k) dst[n][k] = *(const LAS bf16x8*)(lds + PG8_SB(b, h) + boff + n * 2048 + k * 1024); } while (0)
#define PG8_MMA(ai, bj, At, Bt) do { __builtin_amdgcn_s_setprio(1); _Pragma("unroll") for (int m = 0; m < 4; ++m) _Pragma("unroll") for (int n = 0; n < 2; ++n) _Pragma("unroll") for (int k = 0; k < 2; ++k) \
        acc[ai][bj][m][n] = __builtin_amdgcn_mfma_f32_16x16x32_bf16(Bt[n][k], At[m][k], acc[ai][bj][m][n], 0, 0, 0); __builtin_amdgcn_s_setprio(0); } while (0)
#define PG8_WAIT_V(n) asm volatile("s_waitcnt vmcnt(" #n ")" ::: "memory")
#define PG8_WAIT_L(n) asm volatile("s_waitcnt lgkmcnt(" #n ")" ::: "memory")
#define PG8_BAR __builtin_amdgcn_s_barrier()
#define PG8_SCHED __builtin_amdgcn_sched_barrier(0)
    Unit cur, nxt; int ui = 0;
    if (!S.next(0, cur)) return;
    f32x4 acc[2][2][4][2];
#pragma unroll
    for (int a = 0; a < 2; ++a)
#pragma unroll
        for (int b = 0; b < 2; ++b)
#pragma unroll
            for (int m = 0; m < 4; ++m)
#pragma unroll
                for (int n = 0; n < 2; ++n) acc[a][b][m][n] = (f32x4){0.f, 0.f, 0.f, 0.f};
    bf16x8 At[4][2], B0[2][2], B1[2][2];
    size_t oa_, ob_; unit_off(g, cur, oa_, ob_);
    const char* cA = (const char*)g.A + oa_; const char* cB = (const char*)g.Bt + ob_;
    PG8_STAGE(PG8_SB(0, 0), cB, voffB); PG8_STAGE(PG8_SA(0, 0), cA, voffA); PG8_STAGE(PG8_SB(0, 1), cB + hstepB, voffB); PG8_STAGE(PG8_SA(0, 1), cA + hstepA, voffA);
    if (wr == 1) PG8_BAR;
    PG8_WAIT_V(4); PG8_BAR;
    PG8_STAGE(PG8_SB(1, 0), cB + kstep, voffB); PG8_STAGE(PG8_SA(1, 0), cA + kstep, voffA); PG8_STAGE(PG8_SB(1, 1), cB + hstepB + kstep, voffB);
    PG8_WAIT_V(6); PG8_BAR;
    for (;;) {
        const bool has_next = S.next(ui + 1, nxt);
        const char* nA = cA; const char* nB = cB;
        if (has_next) { unit_off(g, nxt, oa_, ob_); nA = (const char*)g.A + oa_; nB = (const char*)g.Bt + ob_; }
        for (int t = 0; t < nt; t += 2) {
            const bool last = (t == nt - 2);
            const char* a1 = cA + (size_t)(t + 1) * kstep;
            const char* a2 = last ? nA : cA + (size_t)(t + 2) * kstep; const char* b2 = last ? nB : cB + (size_t)(t + 2) * kstep;
            const char* a3 = a2 + kstep; const char* b3 = b2 + kstep;
            PG8_LDB(B0, 0, 0); PG8_SCHED; PG8_LDA(At, 0, 0); PG8_STAGE(PG8_SA(1, 1), a1 + hstepA, voffA);
            PG8_WAIT_L(8); PG8_BAR; PG8_WAIT_L(0); PG8_MMA(0, 0, At, B0); PG8_BAR; PG8_SCHED;
            PG8_LDB(B1, 0, 1); PG8_STAGE(PG8_SB(0, 0), b2, voffB);
            PG8_BAR; PG8_WAIT_L(0); PG8_MMA(0, 1, At, B1); PG8_BAR;
            PG8_LDA(At, 0, 1); PG8_STAGE(PG8_SA(0, 0), a2, voffA);
            PG8_BAR; PG8_WAIT_L(0); PG8_MMA(1, 0, At, B0); PG8_BAR; PG8_SCHED;
            PG8_STAGE(PG8_SB(0, 1), b2 + hstepB, voffB);
            PG8_WAIT_V(6); PG8_BAR; PG8_MMA(1, 1, At, B1); PG8_BAR;
            PG8_LDB(B0, 1, 0); PG8_SCHED; PG8_LDA(At, 1, 0); PG8_STAGE(PG8_SA(0, 1), a2 + hstepA, voffA);
            PG8_WAIT_L(8); PG8_BAR; PG8_WAIT_L(0); PG8_MMA(0, 0, At, B0); PG8_BAR; PG8_SCHED;
            PG8_LDB(B1, 1, 1); PG8_STAGE(PG8_SB(1, 0), b3, voffB);
            PG8_BAR; PG8_WAIT_L(0); PG8_MMA(0, 1, At, B1); PG8_BAR;
            PG8_LDA(At, 1, 1); PG8_STAGE(PG8_SA(1, 0), a3, voffA);
            PG8_BAR; PG8_WAIT_L(0); PG8_MMA(1, 0, At, B0); PG8_BAR; PG8_SCHED;
            PG8_STAGE(PG8_SB(1, 1), b3 + hstepB, voffB);
            PG8_WAIT_V(6); PG8_BAR; PG8_MMA(1, 1, At, B1); PG8_BAR;
        }
        E(acc, cur, wr, wc, fr, fq);
        if (!has_next) break;
#pragma unroll
        for (int a = 0; a < 2; ++a)
#pragma unroll
            for (int b = 0; b < 2; ++b)
#pragma unroll
                for (int m = 0; m < 4; ++m)
#pragma unroll
                    for (int n = 0; n < 2; ++n) acc[a][b][m][n] = (f32x4){0.f, 0.f, 0.f, 0.f};
        cur = nxt; cA = nA; cB = nB; ++ui;
    }
    PG8_WAIT_V(0);
    if (wr == 0) PG8_BAR;
    PG8_BAR;
#undef PG8_SA
#undef PG8_SB
#undef PG8_STAGE
#undef PG8_LDA
#undef PG8_LDB
#undef PG8_MMA
#undef PG8_WAIT_V
#undef PG8_WAIT_L
#undef PG8_BAR
#undef PG8_SCHED
}

typedef const f32x4 (&AccRef)[2][2][4][2];

struct EpiInA {
    static constexpr bool PERM = true;
    const float* ssq; bf16_t* tt; bf16_t* sg;
    __device__ __forceinline__ void operator()(AccRef acc, const Unit& un, int wr, int wc, int fr, int fq) const {
        const int row0 = un.pm * BM + wr * 64 + fr, colt = un.pn * BM + wc * 32 + 8 * fq;
        const bool is_t = un.pn < 16;
        float rrs[2][4];
#pragma unroll
        for (int ai = 0; ai < 2; ++ai)
#pragma unroll
            for (int m = 0; m < 4; ++m) rrs[ai][m] = ssq[row0 + ai * HALF + m * 16];
#pragma unroll
        for (int ai = 0; ai < 2; ++ai)
#pragma unroll
            for (int m = 0; m < 4; ++m) { const int row = row0 + ai * HALF + m * 16; const float rr = rsqrtf(rrs[ai][m] * (1.0f / DM) + EPS);
#pragma unroll
                for (int bj = 0; bj < 2; ++bj) { f32x4 v0 = acc[ai][bj][m][0] * rr, v1 = acc[ai][bj][m][1] * rr; const int col = colt + bj * HALF;
                    if (is_t) *(bf16x8*)(tt + (size_t)row * EA + col) = pack8(v0, v1);
                    else {
#pragma unroll
                        for (int j = 0; j < 4; ++j) { v0[j] = silu_f(v0[j]); v1[j] = silu_f(v1[j]); }
                        *(bf16x8*)(sg + (size_t)row * EA + (col - EA)) = pack8(v0, v1); } } }
    }
};
struct EpiUState {
    static constexpr bool PERM = true;
    const float* ssq; float* pool_p; float* pool_s;
    __device__ __forceinline__ void operator()(AccRef acc, const Unit& un, int wr, int wc, int fr, int fq) const {
        const int row0 = un.pm * BM + wr * 64 + fr, colt = un.pn * BM + wc * 32 + 8 * fq;
#pragma unroll
        for (int ai = 0; ai < 2; ++ai)
#pragma unroll
            for (int m = 0; m < 4; ++m) { const int row = row0 + ai * HALF + m * 16;
                float* pp = nullptr;
                if (row < MP) { const int t = row & (SEQ - 1); if (t >= SEQ - PPAD) pp = pool_p + ((size_t)(row >> 12) * PPAD + (t - (SEQ - PPAD))) * EA; }
                else { const int rs = row - MP, t = rs & 15; if (t >= 1) pp = pool_s + ((size_t)(rs >> 4) * PPAD + (t - 1)) * EA; }
                if (pp) { const float rr = rsqrtf(ssq[row] * (1.0f / DM) + EPS);
#pragma unroll
                    for (int bj = 0; bj < 2; ++bj) { *(f32x4*)(pp + colt + bj * HALF) = acc[ai][bj][m][0] * rr; *(f32x4*)(pp + colt + bj * HALF + 4) = acc[ai][bj][m][1] * rr; } } }
    }
};
struct EpiStore {
    static constexpr bool PERM = true;
    bf16_t* O; int ldc, wmode;
    __device__ __forceinline__ void operator()(AccRef acc, const Unit& un, int wr, int wc, int fr, int fq) const {
        const int rbase = wmode ? (un.pm >> 4) * 2 * EA + (un.pm & 15) * BM : un.pm * BM;
        const int row0 = rbase + wr * 64 + fr, colt = un.pn * BM + wc * 32 + 8 * fq;
#pragma unroll
        for (int ai = 0; ai < 2; ++ai)
#pragma unroll
            for (int m = 0; m < 4; ++m)
#pragma unroll
                for (int bj = 0; bj < 2; ++bj) *(bf16x8*)(O + (size_t)(row0 + ai * HALF + m * 16) * ldc + colt + bj * HALF) = pack8(acc[ai][bj][m][0], acc[ai][bj][m][1]);
    }
};
struct EpiRes {
    static constexpr bool PERM = false;
    const float* base_p; const float* base_s; float* xres; bf16_t* xb; float* ssq_next;
    __device__ __forceinline__ void operator()(AccRef acc, const Unit& un, int wr, int wc, int fr, int fq) const {
        const int row0 = un.pm * BM + wr * 64 + fr, col0 = un.pn * BM + wc * 32 + 4 * fq;
#pragma unroll
        for (int ai = 0; ai < 2; ++ai) {
            f32x4 bx_[4][2][2];
#pragma unroll
            for (int m = 0; m < 4; ++m) { const int row = row0 + ai * HALF + m * 16;
                const float* bp = (row < MP ? base_p + (size_t)row * DM : base_s + (size_t)(row - MP) * DM) + col0;
#pragma unroll
                for (int bj = 0; bj < 2; ++bj)
#pragma unroll
                    for (int n = 0; n < 2; ++n) bx_[m][bj][n] = *(const f32x4*)(bp + bj * HALF + n * 16); }
#pragma unroll
            for (int m = 0; m < 4; ++m) { const int row = row0 + ai * HALF + m * 16;
                float* xo = xres + (size_t)row * DM + col0; bf16_t* bo = xb + (size_t)row * DM + col0; float s = 0.f;
#pragma unroll
                for (int bj = 0; bj < 2; ++bj)
#pragma unroll
                    for (int n = 0; n < 2; ++n) { const f32x4 x = bx_[m][bj][n] + acc[ai][bj][m][n];
                        *(f32x4*)(xo + bj * HALF + n * 16) = x; u32x2 w; w.x = cvtpk(x[0], x[1]); w.y = cvtpk(x[2], x[3]); *(u32x2*)(bo + bj * HALF + n * 16) = w;
                        s += (x[0] * x[0] + x[1] * x[1]) + (x[2] * x[2] + x[3] * x[3]); }
                s = xsum16(s); s = xsum32(s);
                if (fq == 0) atomicAdd(ssq_next + row, s); } }
    }
};
struct EpiKVQ {
    static constexpr bool PERM = true;
    int pn_off; const float* ssq; float* out; unsigned char* ws; const float* b_f;
    __device__ __forceinline__ void operator()(AccRef acc, const Unit& un, int wr, int wc, int fr, int fq) const {
        const int tt = un.pn + pn_off;
        const int row0 = un.pm * BM + wr * 64 + fr, cw = wc * 32 + 8 * fq;
        float rrs[2][4];
#pragma unroll
        for (int ai = 0; ai < 2; ++ai)
#pragma unroll
            for (int m = 0; m < 4; ++m) rrs[ai][m] = ssq[row0 + ai * HALF + m * 16];
        if (tt == 16) {
            if (wc == 0 && fq < 2) {
            const f32x4 bf0 = *(const f32x4*)(b_f + 8 * fq), bf1 = *(const f32x4*)(b_f + 8 * fq + 4);
            float* lft_p = (float*)(ws + WS_LFTP); float* lft_s = (float*)(ws + WS_LFTS);
#pragma unroll
            for (int ai = 0; ai < 2; ++ai)
#pragma unroll
                for (int m = 0; m < 4; ++m) { const int row = row0 + ai * HALF + m * 16; const float rr = rsqrtf(rrs[ai][m] * (1.0f / DM) + EPS);
                    f32x4 v0 = acc[ai][0][m][0] * rr + bf0, v1 = acc[ai][0][m][1] * rr + bf1;
#pragma unroll
                    for (int j = 0; j < 4; ++j) { v0[j] = logsig(v0[j]); v1[j] = logsig(v1[j]); }
                    if (row < MP) { float* o = out + O_LFP + (size_t)row * NH + 8 * fq; *(f32x4*)o = v0; *(f32x4*)(o + 4) = v1;
                        float* tp = lft_p + ((size_t)(row >> 12) * NH + 8 * fq) * SEQ + (row & (SEQ - 1));
#pragma unroll
                        for (int j = 0; j < 4; ++j) { tp[(size_t)j * SEQ] = v0[j]; tp[(size_t)(j + 4) * SEQ] = v1[j]; } }
                    else { const int rs = row - MP; float* o = out + O_LFS + (size_t)rs * NH + 8 * fq; *(f32x4*)o = v0; *(f32x4*)(o + 4) = v1;
                        float* tp = lft_s + ((size_t)(rs >> 4) * NH + 8 * fq) * DSEQ + (rs & 15);
#pragma unroll
                        for (int j = 0; j < 4; ++j) { tp[j * DSEQ] = v0[j]; tp[(j + 4) * DSEQ] = v1[j]; } } }
            }
        } else {
        const int kind = tt < 8 ? 0 : (tt < 16 ? 1 : (tt < 25 ? 2 : 3));
        const int colt = (tt - (kind == 0 ? 0 : kind == 1 ? 8 : kind == 2 ? 17 : 25)) * BM + cw;
        float* fo_p = out + (kind == 0 ? O_KP : O_VP); float* fo_s = out + (kind == 0 ? O_KS : O_VS);
        bf16_t* bo = (bf16_t*)(ws + (kind == 0 ? WS_KB : (kind == 1 ? WS_VB : (kind == 2 ? WS_QB : WS_SGB))));
#pragma unroll
        for (int ai = 0; ai < 2; ++ai)
#pragma unroll
            for (int m = 0; m < 4; ++m) { const int row = row0 + ai * HALF + m * 16; float rr = rsqrtf(rrs[ai][m] * (1.0f / DM) + EPS);
                if (kind == 2) rr *= QSCALE;
                float* fo = (row < MP ? fo_p + (size_t)row * DM : fo_s + (size_t)(row - MP) * DM) + colt;
#pragma unroll
                for (int bj = 0; bj < 2; ++bj) { f32x4 v0 = acc[ai][bj][m][0] * rr, v1 = acc[ai][bj][m][1] * rr;
                    if (kind < 2) { *(f32x4*)(fo + bj * HALF) = v0; *(f32x4*)(fo + bj * HALF + 4) = v1; }
                    if (kind == 3) {
#pragma unroll
                        for (int j = 0; j < 4; ++j) { v0[j] = silu_f(v0[j]); v1[j] = silu_f(v1[j]); } }
                    *(bf16x8*)(bo + (size_t)row * DM + colt + bj * HALF) = pack8(v0, v1);
                    if (kind == 0 || kind == 2) {
                        float ss = (v0[0] * v0[0] + v0[1] * v0[1]) + (v0[2] * v0[2] + v0[3] * v0[3]) + (v1[0] * v1[0] + v1[1] * v1[1]) + (v1[2] * v1[2] + v1[3] * v1[3]);
                        ss = xsum16(ss); ss = xsum32(ss);
                        float* nt = (float*)(ws + (kind == 0 ? WS_KNRM : WS_QNRM));
                        if (fq == 0) nt[((size_t)row * NH + 2 * (colt >> 8) + bj) * 4 + wc] = ss; } } }
        }
    }
};
}

namespace att {
constexpr int NW = 8, QBLK = 32, KVBLK = 64, QB = NW * QBLK, D = 128, LD = 2048;
constexpr int SHM_V = KVBLK * D * 2, SHM_K = KVBLK * D * 2;
constexpr int OFF_WS = 2 * SHM_V + 2 * SHM_K, OFF_F = OFF_WS + NW * 64 * 4, OFF_SC = OFF_F + SEQ * 4, OFF_KT = OFF_SC + 64, OFF_QM = OFF_KT + 256, OFF_JL = OFF_QM + 64;
constexpr float SKIP_T = 32.f;
constexpr float THR2 = 11.5f;
#define KSWZ(row, colB) ((row) * 256 + ((colB) ^ (((row) & 7) << 4)))
#define SBAR() __builtin_amdgcn_sched_barrier(0)
__device__ __forceinline__ int v_st(int k, int c) { const int kk = (k & ~0xC) | ((k & 4) << 1) | ((k & 8) >> 1); return ((kk >> 3) * 4 + (c >> 5)) * 512 + ((kk & 7) * 32 + (c & 31)) * 2; }
__device__ __forceinline__ int v_rd_base(int lane) { return ((lane & 3) << 3) | (((lane >> 2) & 3) << 6) | (((lane >> 4) & 1) << 5) | (((lane >> 5) & 1) << 8); }
constexpr int v_rd_off(int d0, int ks, int half) { return d0 * 512 + ks * 4096 + half * 2048; }
__device__ __forceinline__ int crow(int r, int hi) { return (r & 3) + 8 * (r >> 2) + 4 * hi; }
__device__ __forceinline__ void mask_tile(f32x16& p0, f32x16& p1, int dq) {
    const float NEG = -__builtin_inff();
#pragma unroll
    for (int r = 0; r < 16; ++r) { const int c = (r & 3) + 8 * (r >> 2);
        if (dq - c < 0) p0[r] = NEG;
        if (dq - c - 32 < 0) p1[r] = NEG; }
}
__device__ __forceinline__ void partialSM(f32x16& p0, f32x16& p1, float& m_reg, float& mn, float& alpha) {
    float pmax = p0[0];
#pragma unroll
    for (int r = 1; r < 16; ++r) pmax = fmaxf(pmax, p0[r]);
#pragma unroll
    for (int r = 0; r < 16; ++r) pmax = fmaxf(pmax, p1[r]);
    { auto rr = __builtin_amdgcn_permlane32_swap(__float_as_uint(pmax), __float_as_uint(pmax), false, false);
      pmax = fmaxf(__uint_as_float(rr[0]), __uint_as_float(rr[1])); }
    if (__builtin_expect(__all((pmax - m_reg) <= THR2), 1)) { mn = m_reg; alpha = 1.f; }
    else { mn = fmaxf(m_reg, pmax); alpha = __builtin_amdgcn_exp2f(m_reg - mn); m_reg = mn; }
#pragma unroll
    for (int r = 0; r < 16; ++r) p0[r] = p0[r] - mn;
#pragma unroll
    for (int r = 0; r < 16; ++r) p1[r] = p1[r] - mn;
#pragma unroll
    for (int r = 0; r < 16; ++r) p0[r] = __builtin_amdgcn_exp2f(p0[r]);
}
__device__ __forceinline__ void finishSM(f32x16& p0, f32x16& p1, float alpha, float& l_reg, bf16x8& pa0, bf16x8& pa1, bf16x8& pa2, bf16x8& pa3) {
#pragma unroll
    for (int r = 0; r < 16; ++r) p1[r] = __builtin_amdgcn_exp2f(p1[r]);
    float ps = 0;
#pragma unroll
    for (int r = 0; r < 16; ++r) ps += p0[r];
#pragma unroll
    for (int r = 0; r < 16; ++r) ps += p1[r];
    { auto rr = __builtin_amdgcn_permlane32_swap(__float_as_uint(ps), __float_as_uint(ps), false, false);
      ps = __uint_as_float(rr[0]) + __uint_as_float(rr[1]); }
    l_reg = l_reg * alpha + ps;
#define PK4(P, B_, OUT) do { unsigned a0 = cvtpk(P[B_+0], P[B_+1]), a1 = cvtpk(P[B_+2], P[B_+3]);                          \
        unsigned b0 = cvtpk(P[B_+4], P[B_+5]), b1 = cvtpk(P[B_+6], P[B_+7]);                                             \
        auto r0 = __builtin_amdgcn_permlane32_swap(a0, b0, false, false); auto r1 = __builtin_amdgcn_permlane32_swap(a1, b1, false, false); \
        u32x4 w = {r0[0], r1[0], r0[1], r1[1]}; OUT = *reinterpret_cast<bf16x8*>(&w); } while (0)
    PK4(p0, 0, pa0); PK4(p0, 8, pa1); PK4(p1, 0, pa2); PK4(p1, 8, pa3);
#undef PK4
}
template <int KB>
__device__ __forceinline__ void qkt(f32x16& p0, f32x16& p1, const char* K_lds, const float* fl, int r32, int hi, const bf16x8* qr) {
    { const f32x4 a0 = *(const f32x4*)(fl), a1 = *(const f32x4*)(fl + 8), a2 = *(const f32x4*)(fl + 16), a3 = *(const f32x4*)(fl + 24);
      const f32x4 b0 = *(const f32x4*)(fl + 32), b1 = *(const f32x4*)(fl + 40), b2 = *(const f32x4*)(fl + 48), b3 = *(const f32x4*)(fl + 56);
      p0 = (f32x16){a0[0], a0[1], a0[2], a0[3], a1[0], a1[1], a1[2], a1[3], a2[0], a2[1], a2[2], a2[3], a3[0], a3[1], a3[2], a3[3]};
      p1 = (f32x16){b0[0], b0[1], b0[2], b0[3], b1[0], b1[1], b1[2], b1[3], b2[0], b2[1], b2[2], b2[3], b3[0], b3[1], b3[2], b3[3]}; }
    const char* kb[4];
#pragma unroll
    for (int dd = 0; dd < 4; ++dd) kb[dd] = K_lds + KB * SHM_K + KSWZ(r32, (dd * 16 + hi * 8) * 2);
#pragma unroll
    for (int d0 = 0; d0 < 8; ++d0) { const char* a = kb[d0 & 3] + (d0 >> 2) * 128;
        bf16x8 b0 = *reinterpret_cast<const bf16x8*>(a);
        bf16x8 b1 = *reinterpret_cast<const bf16x8*>(a + 32 * 256);
        p0 = __builtin_amdgcn_mfma_f32_32x32x16_bf16(b0, qr[d0], p0, 0, 0, 0);
        p1 = __builtin_amdgcn_mfma_f32_32x32x16_bf16(b1, qr[d0], p1, 0, 0, 0); }
}
template <int VB>
__device__ __forceinline__ void pv_tile(f32x16* o, int vb0, bf16x8 pa0, bf16x8 pa1, bf16x8 pa2, bf16x8 pa3) {
#define TRRD(dst, off) asm volatile("ds_read_b64_tr_b16 %0, %1 offset:%2" : "=&v"(dst) : "v"(vb0), "i"(off) : "memory")
#define PV_D0(d0) do { s16x4 l0, l1, l2, l3, h0, h1, h2, h3; constexpr int b_ = VB * SHM_V + v_rd_off(d0, 0, 0);   \
        TRRD(l0, b_); TRRD(h0, b_ + 2048); TRRD(l1, b_ + 4096); TRRD(h1, b_ + 6144); TRRD(l2, b_ + 8192); TRRD(h2, b_ + 10240); TRRD(l3, b_ + 12288); TRRD(h3, b_ + 14336); \
        asm volatile("s_waitcnt lgkmcnt(0)" ::: "memory"); SBAR();   \
        o[d0] = __builtin_amdgcn_mfma_f32_32x32x16_bf16(pa0, (bf16x8){l0[0], l0[1], l0[2], l0[3], h0[0], h0[1], h0[2], h0[3]}, o[d0], 0, 0, 0);   \
        o[d0] = __builtin_amdgcn_mfma_f32_32x32x16_bf16(pa1, (bf16x8){l1[0], l1[1], l1[2], l1[3], h1[0], h1[1], h1[2], h1[3]}, o[d0], 0, 0, 0);   \
        o[d0] = __builtin_amdgcn_mfma_f32_32x32x16_bf16(pa2, (bf16x8){l2[0], l2[1], l2[2], l2[3], h2[0], h2[1], h2[2], h2[3]}, o[d0], 0, 0, 0);   \
        o[d0] = __builtin_amdgcn_mfma_f32_32x32x16_bf16(pa3, (bf16x8){l3[0], l3[1], l3[2], l3[3], h3[0], h3[1], h3[2], h3[3]}, o[d0], 0, 0, 0); } while (0)
    PV_D0(0); PV_D0(1); PV_D0(2); PV_D0(3);
#undef PV_D0
#undef TRRD
}
struct Tensors { const bf16_t* q; const bf16_t* k; const bf16_t* v; bf16_t* og; const bf16_t* sg; const float* lft; };
struct BlockRef { unsigned q0, s0; int P0, jlo; };
struct Seam { bf16x8 qr[8]; bf16x8 st_v0, st_v1, st_k0, st_k1; };
#define ROWP(p, k0) ((p) + (unsigned)(k0) * (unsigned)LD)
#define VMW() asm volatile("s_waitcnt vmcnt(0)" ::: "memory")
#define VMWN(n) asm volatile("s_waitcnt vmcnt(%0)" :: "i"(n) : "memory")
#define LD8(p) (*reinterpret_cast<const bf16x8*>(p))
#define SLOAD_H(Kp, Vp, k0) do { S.st_v0 = LD8(ROWP(Vp, k0) + voff); S.st_v1 = LD8(ROWP(Vp, (k0) + 32) + voff);              \
                         S.st_k0 = LD8(ROWP(Kp, k0) + voff); S.st_k1 = LD8(ROWP(Kp, (k0) + 32) + voff); } while (0)
#define SWRITE_HK(bf) do { *(bf16x8*)(K_lds + (bf) * SHM_K + kws) = S.st_k0; *(bf16x8*)(K_lds + (bf) * SHM_K + kws + 32 * 256) = S.st_k1; } while (0)
#define SWRITE_HV(bf) do { *(bf16x8*)(V_lds + (bf) * SHM_V + vst0) = S.st_v0; *(bf16x8*)(V_lds + (bf) * SHM_V + vst0 + VST1) = S.st_v1; } while (0)
#define SWRITE_H(bf) do { SWRITE_HV(bf); SWRITE_HK(bf); } while (0)
__device__ __forceinline__ void prime(int wv, const Tensors& T, const BlockRef& cur, char* lds, Seam& S) {
    const int tid = otid(wv), wid = __builtin_amdgcn_readfirstlane(tid >> 6), lane = tid & 63, r32 = lane & 31, hi = lane >> 5;
    const int sr = tid >> 4, sc = (tid & 15) * 8, kws = KSWZ(sr, sc * 2); char* K_lds = lds + 2 * SHM_V;
    const unsigned voff = (unsigned)sr * LD + sc, qoff = (unsigned)(wid * QBLK + r32) * LD + hi * 8;
    const bf16_t* Qp = T.q + cur.q0; const bf16_t* Kh = T.k + cur.s0; const bf16_t* Vh = T.v + cur.s0;
#pragma unroll
    for (int d0 = 0; d0 < 8; ++d0) S.qr[d0] = LD8(Qp + qoff + d0 * 16);
    SLOAD_H(Kh, Vh, cur.jlo * KVBLK); VMW(); SWRITE_HK(0);
    __syncthreads();
}
__device__ __forceinline__ void block(int wv, const Tensors& T, const BlockRef& cur, const BlockRef& nxt, char* lds, Seam& S) {
    const int tid = otid(wv), wid = __builtin_amdgcn_readfirstlane(tid >> 6), lane = tid & 63, r32 = lane & 31, hi = lane >> 5;
    const int j_lo = cur.jlo, NT = (cur.P0 + QB) / KVBLK - j_lo;
    const int qlo = cur.P0 - j_lo * KVBLK + wid * QBLK, qm = qlo + r32 - 4 * hi;
    char* V_lds = lds; char* K_lds = lds + 2 * SHM_V;
    float* wsl = (float*)(lds + OFF_WS) + wid * 64; float* li_l = wsl, * al_l = wsl + 32;
    float* Fl = (float*)(lds + OFF_F);
    float m_reg = -1e30f, l_reg = 0; f32x16 o[4] = {};
    const int sr = tid >> 4, sc = (tid & 15) * 8, vst0 = v_st(sr, sc), kws = KSWZ(sr, sc * 2); constexpr int VST1 = 8192;
    const int vb0 = (int)(uintptr_t)V_lds + v_rd_base(lane);
    const bf16_t* Kh = T.k + cur.s0 + (unsigned)(j_lo * KVBLK) * LD; const bf16_t* Vh = T.v + cur.s0 + (unsigned)(j_lo * KVBLK) * LD;
    const unsigned voff = (unsigned)sr * LD + sc, qoff = (unsigned)(wid * QBLK + r32) * LD + hi * 8;
    const float* flb = Fl + j_lo * KVBLK + 4 * hi;
#define RESC(a) do { if (__any((a) < 1.f)) { if (hi == 0) al_l[r32] = (a); asm volatile("s_waitcnt lgkmcnt(0)" ::: "memory");              \
                     for (int d_ = 0; d_ < 4; ++d_) for (int r = 0; r < 16; ++r) o[d_][r] *= al_l[crow(r, hi)]; } } while (0)
#define KBASE(t) ((t) * KVBLK)
#define MASKT(P0_, P1_, t) do { const int kb_ = KBASE(t); if (kb_ + KVBLK - 1 > qlo) mask_tile(P0_, P1_, qm - kb_); } while (0)
#define SEAM_K0() do { VMWN(8); SWRITE_HK(0); SBAR(); } while (0)
    f32x16 pA0, pA1, pB0, pB1; float mnA, mnB, alA, alB; bf16x8 pa0, pa1, pa2, pa3;
    SWRITE_HV(0); SBAR();
    if (NT > 1) { SLOAD_H(Kh, Vh, KBASE(1)); }
    SBAR(); qkt<0>(pA0, pA1, K_lds, flb + KBASE(0), r32, hi, S.qr);
    MASKT(pA0, pA1, 0); partialSM(pA0, pA1, m_reg, mnA, alA);
    if (NT > 1) { VMW(); SWRITE_H(1); }
    __syncthreads();
#define HALF_STEP(PX0, PX1, mnX, alX, PY0, PY1, alY, t, KB, VB, SB) do {                                                      \
        SBAR(); qkt<KB>(PX0, PX1, K_lds, flb + KBASE(t), r32, hi, S.qr);                                             \
        finishSM(PY0, PY1, alY, l_reg, pa0, pa1, pa2, pa3); SBAR();                                                           \
        if ((t) + 1 < NT) { SLOAD_H(Kh, Vh, KBASE((t) + 1)); SBAR(); }                                               \
        pv_tile<VB>(o, vb0, pa0, pa1, pa2, pa3); MASKT(PX0, PX1, (t)); partialSM(PX0, PX1, m_reg, mnX, alX);                                        \
        __syncthreads();                                                                                                      \
        if ((t) + 1 < NT) { VMW(); SWRITE_H(SB); }                                                                          \
        RESC(alX); __syncthreads(); } while (0)
    for (int t = 1; t + 1 < NT; t += 2) {
        HALF_STEP(pB0, pB1, mnB, alB, pA0, pA1, alA, t, 1, 0, 0);
        HALF_STEP(pA0, pA1, mnA, alA, pB0, pB1, alB, t + 1, 0, 1, 1);
    }
    const bool even = (NT & 1) == 0;
    if (even) { SBAR(); qkt<1>(pB0, pB1, K_lds, flb + KBASE(NT - 1), r32, hi, S.qr); SBAR(); }
    { const bf16_t* Kn = T.k + nxt.s0; const bf16_t* Vn = T.v + nxt.s0; SLOAD_H(Kn, Vn, nxt.jlo * KVBLK); } SBAR();
    { const bf16_t* Qn = T.q + nxt.q0;
#pragma unroll
      for (int d0 = 0; d0 < 8; ++d0) S.qr[d0] = LD8(Qn + qoff + d0 * 16); }
    SBAR();
    finishSM(pA0, pA1, alA, l_reg, pa0, pa1, pa2, pa3); SBAR();
    pv_tile<0>(o, vb0, pa0, pa1, pa2, pa3);
    if (even) { MASKT(pB0, pB1, NT - 1); partialSM(pB0, pB1, m_reg, mnB, alB); __syncthreads(); RESC(alB);
        finishSM(pB0, pB1, alB, l_reg, pa0, pa1, pa2, pa3); SBAR(); pv_tile<1>(o, vb0, pa0, pa1, pa2, pa3); }
    SBAR(); SEAM_K0();
    if (hi == 0) li_l[r32] = l_reg; asm volatile("s_waitcnt lgkmcnt(0)" ::: "memory");
    float rli[16];
#pragma unroll
    for (int r = 0; r < 16; ++r) rli[r] = __builtin_amdgcn_rcpf(li_l[crow(r, hi)]);
    { const unsigned eoff = (unsigned)(4 * hi) * LD + r32;
#pragma unroll
      for (int r = 0; r < 16; ++r) { const unsigned ro = cur.q0 + (unsigned)(wid * QBLK + (r & 3) + 8 * (r >> 2)) * LD;
        bf16_t* Orow = T.og + ro; const bf16_t* Grow = T.sg + ro;
#pragma unroll
        for (int d0 = 0; d0 < 4; ++d0) { const float v = o[d0][r] * rli[r];
            const float vn = __shfl_xor(v, 1);
            if ((r32 & 1) == 0) { const unsigned gg = *(const unsigned*)(Grow + eoff + d0 * 32);
                *(unsigned*)(Orow + eoff + d0 * 32) = cvtpk(v * bflo(gg), vn * bfhi(gg)); } } } }
    __syncthreads();
#undef RESC
#undef KBASE
#undef MASKT
#undef SEAM_K0
#undef HALF_STEP
}
#undef ROWP
#undef VMW
#undef VMWN
#undef SLOAD_H
#undef SWRITE_HK
#undef SWRITE_HV
#undef SWRITE_H
#undef LD8

__device__ __forceinline__ BlockRef mkref(int bh, int qb) {
    const int b = bh >> 4, h = bh & 15; BlockRef r; r.s0 = (unsigned)b * SEQ * LD + h * D; r.q0 = r.s0 + (unsigned)qb * QB * LD; r.jlo = 0; r.P0 = qb * QB; return r;
}
__device__ __forceinline__ void item_setup(int wv, const Tensors& T, const float* knrm, const float* qnrm, int bh, int xa, int xb, char* lds, int& jloA, int& jloB) {
    const int tid = otid(wv), wid = __builtin_amdgcn_readfirstlane(tid >> 6), lane = tid & 63;
    float* Fl = (float*)(lds + OFF_F); float* scn = (float*)(lds + OFF_SC); float* Kt = (float*)(lds + OFF_KT); float* Qm = (float*)(lds + OFF_QM); int* JL = (int*)(lds + OFF_JL);
    const int b = bh >> 4, h = bh & 15, nkeys = (xb + 1) * QB, t0 = tid * 8;
    const float* LF = T.lft + (size_t)bh * SEQ;
    f32x4 a = {0.f, 0.f, 0.f, 0.f}, c = {0.f, 0.f, 0.f, 0.f};
    float kmx = 0.f;
    if (t0 < nkeys) { a = *(const f32x4*)(LF + t0); c = *(const f32x4*)(LF + t0 + 4);
        const float* kn = knrm + ((size_t)(b * SEQ + t0) * NH + h) * 4;
#pragma unroll
        for (int i = 0; i < 8; ++i) { const f32x4 p = *(const f32x4*)(kn + (size_t)i * NH * 4); kmx = fmaxf(kmx, (p[0] + p[1]) + (p[2] + p[3])); } }
    kmx = fmaxf(kmx, bperm(kmx, lane ^ 1)); kmx = fmaxf(kmx, bperm(kmx, lane ^ 2)); kmx = fmaxf(kmx, bperm(kmx, lane ^ 4));
    if ((tid & 7) == 0 && t0 < nkeys) Kt[tid >> 3] = sqrtf(kmx) * 1.01f;
    { const int qrow = b * SEQ + (tid < 256 ? xa * QB + tid : xb * QB + (tid - 256));
      const f32x4 p = *(const f32x4*)(qnrm + ((size_t)qrow * NH + h) * 4); float qm = (p[0] + p[1]) + (p[2] + p[3]);
#pragma unroll
      for (int o = 1; o < 64; o <<= 1) qm = fmaxf(qm, bperm(qm, lane ^ o));
      if (lane == 0) Qm[wid] = qm; }
    a[1] += a[0]; a[2] += a[1]; a[3] += a[2]; c[0] += a[3]; c[1] += c[0]; c[2] += c[1]; c[3] += c[2];
    const float tot = c[3]; float inc = tot;
#pragma unroll
    for (int o = 1; o < 64; o <<= 1) { const float v = bperm(inc, (lane - o) & 63); if (lane >= o) inc += v; }
    if (lane == 63) scn[wid] = inc;
    if (tid == 0) { JL[0] = xa * 4; JL[1] = xb * 4; }
    __syncthreads();
    float base = inc - tot;
    for (int w = 0; w < wid; ++w) base += scn[w];
    a = (a + base) * (-LOG2E); c = (c + base) * (-LOG2E);
    if (t0 < nkeys) { *(f32x4*)(Fl + t0) = a; *(f32x4*)(Fl + t0 + 4) = c; }
    __syncthreads();
    if (tid < 128) { const int which = tid >> 6, j = tid & 63, x = which ? xb : xa, nd = x * 4;
        if (j < nd) { const float qmax = sqrtf(fmaxf(fmaxf(Qm[which * 4], Qm[which * 4 + 1]), fmaxf(Qm[which * 4 + 2], Qm[which * 4 + 3]))) * 1.01f;
            const float kdiag = fmaxf(fmaxf(Kt[nd], Kt[nd + 1]), fmaxf(Kt[nd + 2], Kt[nd + 3]));
            const bool skip = qmax * (Kt[j] + kdiag) + Fl[64 * j + 63] - Fl[x * QB] < -SKIP_T;
            if (!skip) atomicMin(JL + which, j); } }
    __syncthreads();
    jloA = __builtin_amdgcn_readfirstlane(JL[0]); jloB = __builtin_amdgcn_readfirstlane(JL[1]);
}
__device__ __forceinline__ void prompt_phase(int wv, char* lds, const Tensors& T, const float* knrm, const float* qnrm, int vw, int G) {
    constexpr int TOTAL = NBATCH * NH * 8;
    Seam S;
    for (int L = vw; L < TOTAL; L += G) {
        const int bh = L >> 3, x = (L >= TOTAL / 2) ? 7 - (L & 7) : (L & 7);
        int ja, jb;
        item_setup(wv, T, knrm, qnrm, bh, x, 15 - x, lds, ja, jb);
        BlockRef A = mkref(bh, x), Bk = mkref(bh, 15 - x); A.jlo = ja; Bk.jlo = jb;
        prime(wv, T, A, lds, S);
#pragma unroll 1
        for (int pass = 0; pass < 2; ++pass) { const BlockRef cur = pass ? Bk : A; block(wv, T, cur, Bk, lds, S); }
    }
}
}

namespace sat {
constexpr int OFF_F = 0, OFF_SC = 8448, OFF_P = 8704, OFF_A = OFF_P + 8 * 4096, OFF_ML = OFF_A + 512, OFF_O = OFF_ML + 1024;
struct Tensors { const bf16_t* q; const bf16_t* kb; const bf16_t* vb; bf16_t* og; const bf16_t* sg; const float* ck; const float* cv; const float* clf; const float* lfts; };
__device__ __forceinline__ void item(int wv, char* lds, const Tensors& T, int b, int h) {
    const int tid = otid(wv), wid = __builtin_amdgcn_readfirstlane(tid >> 6), lane = tid & 63, fr = lane & 15, fq = lane >> 4, half = lane >> 5, dl = (lane & 31) * 4;
    float* Fl = (float*)(lds + OFF_F); float* scn = (float*)(lds + OFF_SC);
    float* Pw = (float*)(lds + OFF_P) + wid * 1024; float* Aw = (float*)(lds + OFF_A) + wid * 16; float* ML = (float*)(lds + OFF_ML); float* Op = (float*)(lds + OFF_O);
    { const float* cl = T.clf + ((size_t)b * PAST + tid * 4) * NH + h;
      float a0 = cl[0], a1 = cl[NH], a2 = cl[2 * NH], a3 = cl[3 * NH];
      a1 += a0; a2 += a1; a3 += a2;
      const float tot = a3; float inc = tot;
#pragma unroll
      for (int o = 1; o < 64; o <<= 1) { const float v = bperm(inc, (lane - o) & 63); if (lane >= o) inc += v; }
      if (lane == 63) scn[wid] = inc;
      __syncthreads();
      float base = inc - tot, all = 0.f;
      for (int w = 0; w < 8; ++w) { const float sw = scn[w]; if (w < wid) base += sw; all += sw; }
      *(f32x4*)(Fl + tid * 4) = (f32x4){(a0 + base) * (-LOG2E), (a1 + base) * (-LOG2E), (a2 + base) * (-LOG2E), (a3 + base) * (-LOG2E)};
      if (tid < DSEQ) { const float* nl = T.lfts + ((size_t)b * NH + h) * DSEQ; float s = all; for (int i = 0; i <= tid; ++i) s += nl[i]; Fl[PAST + tid] = s * (-LOG2E); }
      __syncthreads(); }
    const size_t qrow = (size_t)(MP + b * DSEQ);
    bf16x8 qf[4];
#pragma unroll
    for (int dc = 0; dc < 4; ++dc) qf[dc] = *(const bf16x8*)(T.q + (qrow + fr) * DM + h * HD + dc * 32 + fq * 8);
    float m_run = -1e30f, l_run = 0.f;
    f32x4 oacc[16];
#pragma unroll
    for (int q = 0; q < 16; ++q) oacc[q] = (f32x4){0.f, 0.f, 0.f, 0.f};
    for (int ch = 0; ch < 4; ++ch) {
        const int key0 = (ch * 8 + wid) * 64;
        f32x4 s4[4];
#pragma unroll
        for (int tl = 0; tl < 4; ++tl) { const int kbase = key0 + tl * 16;
            const float* kp = T.ck + (((size_t)b * PAST + kbase + fr) * NH + h) * HD + fq * 8;
            f32x4 acc = *(const f32x4*)(Fl + kbase + fq * 4);
#pragma unroll
            for (int dc = 0; dc < 4; ++dc) { const f32x4 x0 = *(const f32x4*)(kp + dc * 32), x1 = *(const f32x4*)(kp + dc * 32 + 4);
                acc = __builtin_amdgcn_mfma_f32_16x16x32_bf16(pack8(x0, x1), qf[dc], acc, 0, 0, 0); }
            s4[tl] = acc; }
        float cm = s4[0][0];
#pragma unroll
        for (int tl = 0; tl < 4; ++tl)
#pragma unroll
            for (int j = 0; j < 4; ++j) cm = fmaxf(cm, s4[tl][j]);
        cm = xmax16(cm); cm = xmax32(cm);
        const float mn = fmaxf(m_run, cm), alpha = __builtin_amdgcn_exp2f(m_run - mn); m_run = mn;
        float ps = 0.f;
#pragma unroll
        for (int tl = 0; tl < 4; ++tl)
#pragma unroll
            for (int j = 0; j < 4; ++j) { const float p = __builtin_amdgcn_exp2f(s4[tl][j] - mn); ps += p; Pw[(tl * 16 + fq * 4 + j) * 16 + fr] = p; }
        ps = xsum16(ps); ps = xsum32(ps);
        l_run = l_run * alpha + ps;
        if (fq == 0) Aw[fr] = alpha;
        asm volatile("s_waitcnt lgkmcnt(0)" ::: "memory");
        { const f32x4 a0 = *(const f32x4*)(Aw), a1 = *(const f32x4*)(Aw + 4), a2 = *(const f32x4*)(Aw + 8), a3 = *(const f32x4*)(Aw + 12);
#pragma unroll
          for (int j = 0; j < 4; ++j) { oacc[j] *= a0[j]; oacc[4 + j] *= a1[j]; oacc[8 + j] *= a2[j]; oacc[12 + j] *= a3[j]; } }
        const float* vp = T.cv + (((size_t)b * PAST + key0 + half) * NH + h) * HD + dl;
#pragma unroll 8
        for (int kp2 = 0; kp2 < 32; ++kp2) { const f32x4 v = *(const f32x4*)(vp + (size_t)kp2 * 2 * NH * HD);
            const float* pr = Pw + (2 * kp2 + half) * 16;
            const f32x4 p0 = *(const f32x4*)(pr), p1 = *(const f32x4*)(pr + 4), p2 = *(const f32x4*)(pr + 8), p3 = *(const f32x4*)(pr + 12);
#pragma unroll
            for (int j = 0; j < 4; ++j) { oacc[j] += v * p0[j]; oacc[4 + j] += v * p1[j]; oacc[8 + j] += v * p2[j]; oacc[12 + j] += v * p3[j]; } }
        asm volatile("s_waitcnt lgkmcnt(0)" ::: "memory");
    }
    if (wid == 0) {
        f32x4 acc = *(const f32x4*)(Fl + PAST + fq * 4);
        const bf16_t* kp = T.kb + (qrow + fr) * DM + h * HD + fq * 8;
#pragma unroll
        for (int dc = 0; dc < 4; ++dc) acc = __builtin_amdgcn_mfma_f32_16x16x32_bf16(*(const bf16x8*)(kp + dc * 32), qf[dc], acc, 0, 0, 0);
#pragma unroll
        for (int j = 0; j < 4; ++j) if (fq * 4 + j > fr) acc[j] = -__builtin_inff();
        float cm = fmaxf(fmaxf(acc[0], acc[1]), fmaxf(acc[2], acc[3]));
        cm = xmax16(cm); cm = xmax32(cm);
        const float mn = fmaxf(m_run, cm), alpha = __builtin_amdgcn_exp2f(m_run - mn); m_run = mn;
        float ps = 0.f;
#pragma unroll
        for (int j = 0; j < 4; ++j) { const float p = __builtin_amdgcn_exp2f(acc[j] - mn); ps += p; Pw[(fq * 4 + j) * 16 + fr] = p; }
        ps = xsum16(ps); ps = xsum32(ps);
        l_run = l_run * alpha + ps;
        if (fq == 0) Aw[fr] = alpha;
        asm volatile("s_waitcnt lgkmcnt(0)" ::: "memory");
        { const f32x4 a0 = *(const f32x4*)(Aw), a1 = *(const f32x4*)(Aw + 4), a2 = *(const f32x4*)(Aw + 8), a3 = *(const f32x4*)(Aw + 12);
#pragma unroll
          for (int j = 0; j < 4; ++j) { oacc[j] *= a0[j]; oacc[4 + j] *= a1[j]; oacc[8 + j] *= a2[j]; oacc[12 + j] *= a3[j]; } }
        const bf16_t* vp = T.vb + (qrow + half) * DM + h * HD + dl;
#pragma unroll
        for (int kp2 = 0; kp2 < 8; ++kp2) { const u32x2 vw = *(const u32x2*)(vp + (size_t)kp2 * 2 * DM);
            const f32x4 v = {bflo(vw.x), bfhi(vw.x), bflo(vw.y), bfhi(vw.y)};
            const float* pr = Pw + (2 * kp2 + half) * 16;
            const f32x4 p0 = *(const f32x4*)(pr), p1 = *(const f32x4*)(pr + 4), p2 = *(const f32x4*)(pr + 8), p3 = *(const f32x4*)(pr + 12);
#pragma unroll
            for (int j = 0; j < 4; ++j) { oacc[j] += v * p0[j]; oacc[4 + j] += v * p1[j]; oacc[8 + j] += v * p2[j]; oacc[12 + j] += v * p3[j]; } }
        asm volatile("s_waitcnt lgkmcnt(0)" ::: "memory");
    }
#pragma unroll
    for (int q = 0; q < 16; ++q)
#pragma unroll
        for (int c = 0; c < 4; ++c) oacc[q][c] = xsum32(oacc[q][c]);
    if (lane < 32) {
#pragma unroll
        for (int q = 0; q < 16; ++q) *(f32x4*)(Op + (wid * 16 + q) * HD + dl) = oacc[q]; }
    if (fq == 0) { ML[(wid * 16 + fr) * 2] = m_run; ML[(wid * 16 + fr) * 2 + 1] = l_run; }
    __syncthreads();
    { const int q = tid >> 5, d4 = (tid & 31) * 4;
      float mx = ML[q * 2];
#pragma unroll
      for (int w = 1; w < 8; ++w) mx = fmaxf(mx, ML[(w * 16 + q) * 2]);
      float L = 0.f; f32x4 O = {0.f, 0.f, 0.f, 0.f};
#pragma unroll
      for (int w = 0; w < 8; ++w) { const float s = __builtin_amdgcn_exp2f(ML[(w * 16 + q) * 2] - mx); L += s * ML[(w * 16 + q) * 2 + 1]; O += *(const f32x4*)(Op + (w * 16 + q) * HD + d4) * s; }
      const float il = 1.0f / L; const size_t off = (qrow + q) * DM + h * HD + d4;
      const u32x2 gw = *(const u32x2*)(T.sg + off);
      u32x2 w; w.x = cvtpk(O[0] * il * bflo(gw.x), O[1] * il * bfhi(gw.x)); w.y = cvtpk(O[2] * il * bflo(gw.y), O[3] * il * bfhi(gw.y));
      *(u32x2*)(T.og + off) = w; }
    __syncthreads();
}
}

__device__ __forceinline__ void transpose_item(const float* W, int ldw, int N, bf16_t* WT, int K, const float* g, float* scr, int item, int lane) {
    const int nblk = (N + 31) / 32, kb = item / nblk, nb = item % nblk, k0 = 64 * kb, n0 = 32 * nb;
    const int c4 = (lane & 7) * 4, kr = lane >> 3; const bool nok = n0 + c4 < N;
    f32x4 v[8];
#pragma unroll
    for (int i = 0; i < 8; ++i) v[i] = nok ? *(const f32x4*)(W + (size_t)(k0 + 8 * i + kr) * ldw + n0 + c4) : (f32x4){0.f, 0.f, 0.f, 0.f};
    if (g) {
#pragma unroll
        for (int i = 0; i < 8; ++i) v[i] *= g[k0 + 8 * i + kr]; }
#pragma unroll
    for (int i = 0; i < 8; ++i) { float* s = scr + (8 * i + kr) * 33 + c4; s[0] = v[i][0]; s[1] = v[i][1]; s[2] = v[i][2]; s[3] = v[i][3]; }
    asm volatile("s_waitcnt lgkmcnt(0)" ::: "memory");
    const int c = lane & 7;
#pragma unroll
    for (int j = 0; j < 4; ++j) { const int nn = (lane >> 3) + 8 * j; const float* s = scr + (8 * c) * 33 + nn;
        u32x4 o; o.x = cvtpk(s[0 * 33], s[1 * 33]); o.y = cvtpk(s[2 * 33], s[3 * 33]); o.z = cvtpk(s[4 * 33], s[5 * 33]); o.w = cvtpk(s[6 * 33], s[7 * 33]);
        if (n0 + nn < N) *(u32x4*)(WT + (size_t)(n0 + nn) * K + k0 + 8 * c) = o; }
    asm volatile("s_waitcnt lgkmcnt(0)" ::: "memory");
}
struct TJob { const float* W; bf16_t* WT; const float* g; int K, N, ldw; };
__device__ __forceinline__ TJob get_job(const Params& p, int j) {
    unsigned char* ws = p.ws; TJob t; t.g = nullptr; t.ldw = 0;
    if (j < 2) { t.W = p.in[7] + (size_t)j * DM * 2 * EA + EA; t.WT = (bf16_t*)(ws + WS_WINA) + (size_t)j * 2 * EA * DM + (size_t)EA * DM; t.g = p.in[6] + j * DM; t.K = DM; t.N = EA; t.ldw = 2 * EA; }
    else if (j >= 17) { const int l = j - 17; t.W = p.in[7] + (size_t)l * DM * 2 * EA; t.WT = (bf16_t*)(ws + WS_WINUT) + (size_t)l * EA * DM; t.g = p.in[6] + l * DM; t.K = DM; t.N = EA; t.ldw = 2 * EA; }
    else if (j < 10) { const int i = j - 2; t.W = p.in[8] + (size_t)i * 1024 * 1024; t.WT = (bf16_t*)(ws + WS_WGRP) + (size_t)i * 1024 * 1024; t.K = 1024; t.N = 1024; }
    else if (j < 12) { const int l = j - 10; t.W = p.in[10] + (size_t)l * EA * DM; t.WT = (bf16_t*)(ws + WS_WOUTA) + (size_t)l * DM * EA; t.K = EA; t.N = DM; }
    else if (j == 12) { t.W = p.in[12]; t.WT = (bf16_t*)(ws + WS_W4); t.g = p.in[11]; t.K = DM; t.N = 2 * DM + NH; }
    else if (j == 13) { t.W = p.in[15]; t.WT = (bf16_t*)(ws + WS_W4) + (size_t)4352 * DM; t.g = p.in[14]; t.K = DM; t.N = 2 * DM; }
    else if (j == 14) { t.W = p.in[15] + (size_t)DM * 2 * DM; t.WT = (bf16_t*)(ws + WS_WINB1); t.g = p.in[14] + DM; t.K = DM; t.N = 2 * DM; }
    else { const int l = j - 15; t.W = p.in[16] + (size_t)l * DM * DM; t.WT = (bf16_t*)(ws + WS_WOUTB) + (size_t)l * DM * DM; t.K = DM; t.N = DM; }
    if (t.ldw == 0) t.ldw = t.N;
    return t;
}
__device__ __forceinline__ void prologue_phase(int wv, const Params& p, char* lds) {
    const int tid = otid(wv), lane = tid & 63, wid = tid >> 6, G = gridDim.x;
    const int gw = blockIdx.x * NWAVES + wid, NGW = G * NWAVES;
    float* scr = (float*)(lds + wid * 8704);
    int rot = 0;
    for (int j = 0; j < 19; ++j) { const TJob t = get_job(p, j); const int nitems = (t.K / 64) * ((t.N + 31) / 32);
        int start = gw - rot; if (start < 0) start += NGW;
        for (int it = start; it < nitems; it += NGW) transpose_item(t.W, t.ldw, t.N, t.WT, t.K, t.g, scr, it, lane);
        rot = (rot + nitems) % NGW; }
    float* ssq = (float*)(p.ws + WS_SSQ); bf16_t* xb = (bf16_t*)(p.ws + WS_XB);
    for (int m = gw; m < MT; m += NGW) { const float* xr = m < MP ? p.in[0] + (size_t)m * DM : p.in[1] + (size_t)(m - MP) * DM;
        float s = 0.f; unsigned long long* o8 = (unsigned long long*)(xb + (size_t)m * DM) + lane;
#pragma unroll
        for (int j = 0; j < 8; ++j) { const f32x4 v = *((const f32x4*)xr + lane + 64 * j); s += (v[0] * v[0] + v[1] * v[1]) + (v[2] * v[2] + v[3] * v[3]);
            o8[64 * j] = (unsigned long long)cvtpk(v[0], v[1]) | ((unsigned long long)cvtpk(v[2], v[3]) << 32); }
        s = wave_sum(s); if (lane == 0) ssq[m] = s; }
    for (int i = blockIdx.x * NTHREADS + tid; i < 4 * MT; i += G * NTHREADS) ssq[MT + i] = 0.f;
    { bf16_t* wus = (bf16_t*)(p.ws + WS_WINUS);
      for (int i = blockIdx.x * NTHREADS + tid; i < 2 * DM * (EA / 8); i += G * NTHREADS) { const int r = i >> 9, c = (i & 511) * 8, l = r >> 11, k = r & (DM - 1);
          const float* s = p.in[7] + ((size_t)l * DM + k) * 2 * EA + c; const float gk = p.in[6][l * DM + k];
          *(bf16x8*)(wus + (size_t)r * EA + c) = pack8(*(const f32x4*)s * gk, *(const f32x4*)(s + 4) * gk); }
      bf16_t* pb = (bf16_t*)(p.ws + WS_PREVB);
      for (int i = blockIdx.x * NTHREADS + tid; i < 2 * 256 * (EA / 8); i += G * NTHREADS) { const int r = i >> 9, c = (i & 511) * 8, l = r >> 8, rr = r & 255;
          f32x4 a = {0.f, 0.f, 0.f, 0.f}, b = a;
          if (rr < NDB * PPAD) { const float* s = p.in[5] + ((size_t)l * NDB * PPAD + rr) * EA + c; a = *(const f32x4*)s; b = *(const f32x4*)(s + 4); }
          *(bf16x8*)(pb + (size_t)r * EA + c) = pack8(a, b); } }
}
template <int W>
__device__ __forceinline__ void poolmix_item(const bf16_t* tt, const bf16_t* sg, const float* scale, const bf16_t* prevt, bf16_t* yg, int row0, int ch) {
    constexpr int NR = 16 + W - 1;
    u32x4 rows[NR];
    const bool samp = row0 >= MP; const int t0 = samp ? 0 : (row0 & (SEQ - 1));
    const bf16_t* up = tt + (size_t)row0 * EA + ch;
    if (t0 != 0) {
#pragma unroll
        for (int i = 0; i < NR; ++i) rows[i] = *(const u32x4*)(up + (ptrdiff_t)(i - (W - 1)) * EA);
    } else {
#pragma unroll
        for (int i = W - 1; i < NR; ++i) rows[i] = *(const u32x4*)(up + (ptrdiff_t)(i - (W - 1)) * EA);
        if (samp) { const bf16_t* pp = prevt + ((size_t)((row0 - MP) >> 4) * PPAD + (PPAD - (W - 1))) * EA + ch;
#pragma unroll
            for (int i = 0; i < W - 1; ++i) rows[i] = *(const u32x4*)(pp + (size_t)i * EA); }
        else {
#pragma unroll
            for (int i = 0; i < W - 1; ++i) rows[i] = (u32x4){0u, 0u, 0u, 0u}; }
    }
    const f32x4 sc0 = *(const f32x4*)(scale + ch), sc1 = *(const f32x4*)(scale + ch + 4);
    float s[8] = {0.f, 0.f, 0.f, 0.f, 0.f, 0.f, 0.f, 0.f};
#define ROWF(v, f) const float f[8] = {bflo(v.x), bfhi(v.x), bflo(v.y), bfhi(v.y), bflo(v.z), bfhi(v.z), bflo(v.w), bfhi(v.w)}
#pragma unroll
    for (int i = 0; i < W - 1; ++i) { ROWF(rows[i], f);
#pragma unroll
        for (int c = 0; c < 8; ++c) s[c] += f[c]; }
#pragma unroll
    for (int j = 0; j < 16; ++j) { ROWF(rows[j + W - 1], f);
        const u32x4 gv = *(const u32x4*)(sg + (size_t)(row0 + j) * EA + ch); ROWF(gv, gt);
#pragma unroll
        for (int c = 0; c < 8; ++c) s[c] += f[c];
        const int nv = (!samp && t0 + j + 1 < W) ? t0 + j + 1 : W; const float ic = 1.0f / (float)nv;
        u32x4 o; o.x = cvtpk((s[0] * ic - f[0]) * sc0[0] * gt[0], (s[1] * ic - f[1]) * sc0[1] * gt[1]); o.y = cvtpk((s[2] * ic - f[2]) * sc0[2] * gt[2], (s[3] * ic - f[3]) * sc0[3] * gt[3]);
        o.z = cvtpk((s[4] * ic - f[4]) * sc1[0] * gt[4], (s[5] * ic - f[5]) * sc1[1] * gt[5]); o.w = cvtpk((s[6] * ic - f[6]) * sc1[2] * gt[6], (s[7] * ic - f[7]) * sc1[3] * gt[7]);
        *(u32x4*)(yg + (size_t)(row0 + j) * EA + ch) = o;
        ROWF(rows[j], g);
#pragma unroll
        for (int c = 0; c < 8; ++c) s[c] -= g[c]; }
#undef ROWF
}
__device__ __forceinline__ void poolmix_phase(int wv, const Params& p, int l) {
    const bf16_t* tt = (const bf16_t*)(p.ws + WS_U); const bf16_t* sg = (const bf16_t*)(p.ws + WS_SG); bf16_t* yg = (bf16_t*)(p.ws + WS_D);
    const bf16_t* prevt = (const bf16_t*)(p.ws + WS_PREVT) + (size_t)l * 256 * EA; const float* scale = p.in[9] + (size_t)l * EA;
    const int nth = gridDim.x * NTHREADS;
    for (int idx = blockIdx.x * NTHREADS + otid(wv); idx < (MT / 16) * (EA / 8); idx += nth) {
        const int row0 = (idx >> 9) * 16, ch = (idx & 511) * 8, grp = __builtin_amdgcn_readfirstlane(ch >> 10);
        if (grp == 0) poolmix_item<2>(tt, sg, scale, prevt, yg, row0, ch);
        else if (grp == 1) poolmix_item<4>(tt, sg, scale, prevt, yg, row0, ch);
        else if (grp == 2) poolmix_item<8>(tt, sg, scale, prevt, yg, row0, ch);
        else poolmix_item<16>(tt, sg, scale, prevt, yg, row0, ch);
    }
}
__device__ __forceinline__ void final_phase(int wv, const Params& p) {
    const int tid = otid(wv), lane = tid & 63, gw = blockIdx.x * NWAVES + (tid >> 6), NGW = gridDim.x * NWAVES;
    const float* xres = (const float*)(p.ws + WS_XRES); const float* ssq = (const float*)(p.ws + WS_SSQ) + (size_t)4 * MT; const float* g = p.in[17];
    for (int m = gw; m < MT; m += NGW) { const float rr = rsqrtf(ssq[m] * (1.0f / DM) + EPS);
        const f32x4* xr = (const f32x4*)(xres + (size_t)m * DM) + lane; f32x4* o = (f32x4*)(p.out + (m < MP ? O_YP + (size_t)m * DM : O_YS + (size_t)(m - MP) * DM)) + lane;
#pragma unroll
        for (int j = 0; j < 8; ++j) o[64 * j] = xr[64 * j] * rr * ((const f32x4*)g)[lane + 64 * j]; }
}

constexpr int NPHASES = 15;
typedef const __attribute__((address_space(4))) Params* KArgPtr;
#if defined(__HIP_DEVICE_COMPILE__)
#define LOADP_() KArgPtr kp_ = (KArgPtr)__builtin_amdgcn_kernarg_segment_ptr(); asm volatile("" : "+s"(kp_)); Params lp; _Pragma("unroll") for (int i_ = 0; i_ < 18; ++i_) lp.in[i_] = kp_->in[i_]; lp.out = kp_->out; lp.ws = kp_->ws; lp.ph_lo = 0; lp.ph_hi = 0
#else
#define LOADP_() const Params lp = p
#endif
#define LOADP() LOADP_(); unsigned char* const ws = lp.ws; \
    float* const ssq = (float*)(ws + WS_SSQ); bf16_t* const xb = (bf16_t*)(ws + WS_XB); float* const xres = (float*)(ws + WS_XRES); (void)ssq; (void)xb; (void)xres
__global__ void __launch_bounds__(NTHREADS, 2) yoco_fwd(Params p) {
    extern __shared__ __attribute__((aligned(16))) unsigned char lds_raw[];
    char* lds = (char*)lds_raw; LAS unsigned char* ldsl = (LAS unsigned char*)lds_raw;
    const int G = gridDim.x, bx = blockIdx.x, wv = __builtin_amdgcn_readfirstlane(threadIdx.x >> 6);
#ifndef ONLY_PHASE
#define ONLY_PHASE -1
#endif
#define IN(k) ((ONLY_PHASE < 0 || ONLY_PHASE == (k)) && p.ph_lo <= (k) && (k) < p.ph_hi)
#ifndef SAT_REP
#define SAT_REP 1
#endif
#ifndef REPEAT_MASK
#define REPEAT_MASK 0
#endif
#define NREP(k) (1 + (int)(((unsigned)(REPEAT_MASK) >> (k)) & 1u))
#define SEAM(k) do { if (rep_ + 1 < NREP(k) || (k) + 1 < p.ph_hi) cg::this_grid().sync(); } while (0)
    if (IN(0)) for (int rep_ = 0; rep_ < NREP(0); ++rep_) { { LOADP(); prologue_phase(wv, lp, lds); } SEAM(0); }
    if (IN(1)) for (int rep_ = 0; rep_ < NREP(1); ++rep_) {
        { LOADP(); pg8::Gemm g{(const bf16_t*)(ws + WS_WGRP), (const bf16_t*)(ws + WS_WINUS), 1024, 1024, EA, 2}; pg8::StaticOrder S; S.init(32, 8, G, bx);
          pg8::EpiStore E{(bf16_t*)(ws + WS_WINA), DM, 1};
          pg8::gemm_phase<pg8::EpiStore, pg8::StaticOrder>(wv, ldsl, g, S, E); }
        { LOADP(); pg8::Gemm g{(const bf16_t*)(ws + WS_PREVB), (const bf16_t*)(ws + WS_WGRP), 1024, EA, 1024, 3}; pg8::StaticOrder S; S.init(2, 16, G, bx);
          pg8::EpiStore E{(bf16_t*)(ws + WS_PREVT), EA, 0};
          pg8::gemm_phase<pg8::EpiStore, pg8::StaticOrder>(wv, ldsl, g, S, E); }
        SEAM(1); }
#pragma unroll 1
    for (int l = 0; l < 2; ++l) {
        int wv_o = wv, bx_o = bx, G_o = G; asm volatile("" : "+s"(wv_o), "+s"(bx_o), "+s"(G_o));
        const int wv = wv_o, bx = bx_o, G = G_o;
        if (IN(2 + 3 * l)) for (int rep_ = 0; rep_ < NREP(2 + 3 * l); ++rep_) {
            { LOADP(); bf16_t* u = (bf16_t*)(ws + WS_U); bf16_t* sg = (bf16_t*)(ws + WS_SG);
              pg8::Gemm g{xb, (const bf16_t*)(ws + WS_WINA) + (size_t)l * 2 * EA * DM, DM, DM, DM, 0}; pg8::StaticOrder S; S.init(65, 32, G, bx);
              pg8::EpiInA E{ssq + (size_t)l * MT, u, sg};
              pg8::gemm_phase<pg8::EpiInA, pg8::StaticOrder>(wv, ldsl, g, S, E); }
            { LOADP(); pg8::Gemm g{xb, (const bf16_t*)(ws + WS_WINUT) + (size_t)l * EA * DM, DM, DM, DM, 0}; pg8::StateOrder S{G, bx};
              pg8::EpiUState E{ssq + (size_t)l * MT, lp.out + O_PP + (size_t)l * NBATCH * PPAD * EA, lp.out + O_PS + (size_t)l * NDB * PPAD * EA};
              pg8::gemm_phase<pg8::EpiUState, pg8::StateOrder>(wv, ldsl, g, S, E); }
            SEAM(2 + 3 * l); }
        if (IN(3 + 3 * l)) for (int rep_ = 0; rep_ < NREP(3 + 3 * l); ++rep_) { { LOADP(); poolmix_phase(wv, lp, l); } SEAM(3 + 3 * l); }
        if (IN(4 + 3 * l)) for (int rep_ = 0; rep_ < NREP(4 + 3 * l); ++rep_) { { LOADP(); bf16_t* yg = (bf16_t*)(ws + WS_D);
            pg8::Gemm g{yg, (const bf16_t*)(ws + WS_WOUTA) + (size_t)l * DM * EA, EA, EA, EA, 0}; pg8::StaticOrder S; S.init(65, 8, G, bx);
            pg8::EpiRes E{l == 0 ? lp.in[0] : xres, l == 0 ? lp.in[1] : xres + (size_t)MP * DM, xres, xb, ssq + (size_t)(l + 1) * MT};
            pg8::gemm_phase<pg8::EpiRes, pg8::StaticOrder>(wv, ldsl, g, S, E); } SEAM(4 + 3 * l); }
    }
#pragma unroll 1
    for (int lb = 0; lb < 2; ++lb) {
        int wv_o = wv, bx_o = bx, G_o = G; asm volatile("" : "+s"(wv_o), "+s"(bx_o), "+s"(G_o));
        const int wv = wv_o, bx = bx_o, G = G_o;
        if (IN(8 + 3 * lb)) for (int rep_ = 0; rep_ < NREP(8 + 3 * lb); ++rep_) { { LOADP();
            pg8::Gemm g{xb, lb == 0 ? (const bf16_t*)(ws + WS_W4) : (const bf16_t*)(ws + WS_WINB1), DM, DM, DM, 0};
            pg8::StaticOrder S; S.init(65, lb == 0 ? 33 : 16, G, bx);
            pg8::EpiKVQ E{lb == 0 ? 0 : 17, ssq + (size_t)(2 + lb) * MT, lp.out, ws, lp.in[13]};
            pg8::gemm_phase<pg8::EpiKVQ, pg8::StaticOrder>(wv, ldsl, g, S, E); } SEAM(8 + 3 * lb); }
        if (IN(9 + 3 * lb)) for (int rep_ = 0; rep_ < NREP(9 + 3 * lb); ++rep_) {
            for (int half_ = 0; half_ < 2; ++half_) {
                if (((bx & 1) == 0) == (half_ == 0)) { LOADP();
                    sat::Tensors ST{(const bf16_t*)(ws + WS_QB), (const bf16_t*)(ws + WS_KB), (const bf16_t*)(ws + WS_VB), (bf16_t*)(ws + WS_OG), (const bf16_t*)(ws + WS_SGB),
                                    lp.in[2], lp.in[3], lp.in[4], (const float*)(ws + WS_LFTS)};
                    for (int it = bx; it < NDB * NH; it += G) sat::item(wv, lds, ST, it >> 4, it & 15); }
                if (half_ == 0) { LOADP(); const int vw = (G % 8 == 0) ? (bx % 8) * (G / 8) + bx / 8 : bx;
                    att::Tensors AT{(const bf16_t*)(ws + WS_QB), (const bf16_t*)(ws + WS_KB), (const bf16_t*)(ws + WS_VB), (bf16_t*)(ws + WS_OG), (const bf16_t*)(ws + WS_SGB), (const float*)(ws + WS_LFTP)};
                    att::prompt_phase(wv, lds, AT, (const float*)(ws + WS_KNRM), (const float*)(ws + WS_QNRM), vw, G); } }
            SEAM(9 + 3 * lb); }
        if (IN(10 + 3 * lb)) for (int rep_ = 0; rep_ < NREP(10 + 3 * lb); ++rep_) { { LOADP();
            pg8::Gemm g{(const bf16_t*)(ws + WS_OG), (const bf16_t*)(ws + WS_WOUTB) + (size_t)lb * DM * DM, DM, DM, DM, 0}; pg8::StaticOrder S; S.init(65, 8, G, bx);
            pg8::EpiRes E{xres, xres + (size_t)MP * DM, xres, xb, ssq + (size_t)(3 + lb) * MT};
            pg8::gemm_phase<pg8::EpiRes, pg8::StaticOrder>(wv, ldsl, g, S, E); } SEAM(10 + 3 * lb); }
    }
    if (IN(14)) { LOADP(); final_phase(wv, lp); }
#undef IN
#undef SEAM
}

extern "C" void kernel_launch(void* const* d_in, const int* in_sizes, int n_in, void* d_out, int out_size, void* d_ws, size_t ws_size, hipStream_t stream) {
    static int grid = 0;
    if (grid == 0) {
        if (n_in != 18 || (size_t)out_size != O_END || ws_size < WS_END) { fprintf(stderr, "kernel_launch: unexpected shapes: n_in %d out %d (want %zu) ws %zu (need %zu)\n", n_in, out_size, (size_t)O_END, ws_size, (size_t)WS_END); grid = -1; return; }
        int dev = 0, cus = 0, per_cu = 0;
        (void)hipGetDevice(&dev); (void)hipDeviceGetAttribute(&cus, hipDeviceAttributeMultiprocessorCount, dev);
        if (hipFuncSetAttribute((const void*)yoco_fwd, hipFuncAttributeMaxDynamicSharedMemorySize, LDS_BYTES) != hipSuccess) { fprintf(stderr, "kernel_launch: hipFuncSetAttribute failed\n"); grid = -1; return; }
        if (hipOccupancyMaxActiveBlocksPerMultiprocessor(&per_cu, (const void*)yoco_fwd, NTHREADS, LDS_BYTES) != hipSuccess || per_cu < 1) { fprintf(stderr, "kernel_launch: occupancy query gave %d\n", per_cu); per_cu = 1; }
        (void)hipGetLastError();
        grid = cus > 0 ? cus : 256;
    }
    if (grid < 0) return;
    Params p{};
    for (int i = 0; i < 18; ++i) p.in[i] = (const float*)d_in[i];
    p.out = (float*)d_out; p.ws = (unsigned char*)d_ws;
#if MULTI_LAUNCH
    for (int ph = 0; ph < NPHASES; ++ph) { p.ph_lo = ph; p.ph_hi = ph + 1; hipLaunchKernelGGL(yoco_fwd, dim3(grid), dim3(NTHREADS), LDS_BYTES, stream, p); }
#else
    p.ph_lo = 0; p.ph_hi = NPHASES;
    void* args[] = {&p};
    hipError_t e = hipLaunchCooperativeKernel((const void*)yoco_fwd, dim3(grid), dim3(NTHREADS), args, LDS_BYTES, stream);
    if (e != hipSuccess) fprintf(stderr, "kernel_launch: cooperative launch failed: %s (grid %d)\n", hipGetErrorString(e), grid);
#endif
}
```

```cpp
#include <hip/hip_runtime.h>
#include <hip/hip_cooperative_groups.h>
#include <cstdio>
#include <cstdint>
namespace cg = cooperative_groups;

#ifndef MULTI_LAUNCH
#define MULTI_LAUNCH 0
#endif

#define LAS __attribute__((address_space(3)))
typedef unsigned short bf16_t;
typedef short bf16x8 __attribute__((ext_vector_type(8)));
typedef short s16x4 __attribute__((ext_vector_type(4)));
typedef float f32x4 __attribute__((ext_vector_type(4)));
typedef float f32x16 __attribute__((ext_vector_type(16)));
typedef unsigned u32x4 __attribute__((ext_vector_type(4)));
typedef unsigned u32x2 __attribute__((ext_vector_type(2)));

constexpr int DM = 2048, NBATCH = 4, SEQ = 4096, NDB = 16, DSEQ = 16, PAST = 2048, EA = 4096, NH = 16, HD = 128, PPAD = 15;
constexpr int MP = NBATCH * SEQ, MS = NDB * DSEQ, MT = MP + MS;
constexpr float EPS = 1e-6f;
constexpr float LOG2E = 1.4426950408889634f;
constexpr float QSCALE = 0.08838834764831845f * 1.4426950408889634f;
constexpr int NTHREADS = 512, NWAVES = 8;
constexpr int LDS_BYTES = 131072;

constexpr size_t O_YP = 0, O_YS = O_YP + (size_t)MP * DM, O_KP = O_YS + (size_t)MS * DM, O_VP = O_KP + (size_t)MP * DM,
                 O_LFP = O_VP + (size_t)MP * DM, O_PP = O_LFP + (size_t)MP * NH, O_KS = O_PP + (size_t)2 * NBATCH * PPAD * EA,
                 O_VS = O_KS + (size_t)MS * DM, O_LFS = O_VS + (size_t)MS * DM, O_PS = O_LFS + (size_t)MS * NH, O_END = O_PS + (size_t)2 * NDB * PPAD * EA;

constexpr size_t al256(size_t x) { return (x + 255) & ~(size_t)255; }
constexpr size_t WS_WINA = 0;
constexpr size_t WS_WGRP = WS_WINA + (size_t)2 * 8192 * 2048 * 2;
constexpr size_t WS_WOUTA = WS_WGRP + (size_t)2 * 4096 * 1024 * 2;
constexpr size_t WS_W4 = WS_WOUTA + (size_t)2 * 2048 * 4096 * 2;
constexpr size_t WS_WINB1 = WS_W4 + (size_t)8448 * 2048 * 2;
constexpr size_t WS_WOUTB = WS_WINB1 + (size_t)4096 * 2048 * 2;
constexpr size_t WS_XB = WS_WOUTB + (size_t)2 * 2048 * 2048 * 2;
constexpr size_t WS_XRES = WS_XB + (size_t)MT * DM * 2;
constexpr size_t WS_SSQ = WS_XRES + (size_t)MT * DM * 4;
constexpr size_t WS_LFTP = al256(WS_SSQ + (size_t)5 * MT * 4);
constexpr size_t WS_LFTS = WS_LFTP + (size_t)NBATCH * NH * SEQ * 4;
constexpr size_t WS_KNRM = al256(WS_LFTS + (size_t)NDB * NH * DSEQ * 4);
constexpr size_t WS_QNRM = WS_KNRM + (size_t)MT * NH * 4 * 4;
constexpr size_t WS_WINUT = al256(WS_QNRM + (size_t)MT * NH * 4 * 4);
constexpr size_t WS_WINUS = WS_WINUT + (size_t)2 * EA * DM * 2;
constexpr size_t WS_PREVB = WS_WINUS + (size_t)2 * DM * EA * 2;
constexpr size_t WS_PREVT = WS_PREVB + (size_t)2 * 256 * EA * 2;
constexpr size_t WS_SPLIT = al256(WS_PREVT + (size_t)2 * 256 * EA * 2);
constexpr size_t SPLIT_TILE = 65536 * 4, SPLIT_TILES = 8 * 4 + 16;
constexpr size_t WS_SPCNT = WS_SPLIT + SPLIT_TILES * SPLIT_TILE;
constexpr size_t WS_ACT = al256(WS_SPCNT + SPLIT_TILES * 8 * 4);
constexpr size_t SZ_A = (size_t)MT * EA * 2, SZ_B = (size_t)MT * DM * 2;
constexpr size_t WS_U = WS_ACT, WS_SG = WS_U + SZ_A, WS_D = WS_SG + SZ_A;
constexpr size_t WS_KB = WS_ACT, WS_VB = WS_KB + SZ_B, WS_QB = WS_VB + SZ_B, WS_SGB = WS_QB + SZ_B, WS_OG = WS_SGB + SZ_B;
constexpr size_t WS_END = (WS_D + SZ_A) > (WS_OG + SZ_B) ? (WS_D + SZ_A) : (WS_OG + SZ_B);

struct Params { const float* in[18]; float* out; unsigned char* ws; int ph_lo, ph_hi; };

__device__ __forceinline__ unsigned cvtpk(float lo, float hi) { unsigned r; asm volatile("v_cvt_pk_bf16_f32 %0, %1, %2" : "=v"(r) : "v"(lo), "v"(hi)); return r; }
__device__ __forceinline__ bf16x8 pack8(f32x4 a, f32x4 b) { u32x4 w = {cvtpk(a[0], a[1]), cvtpk(a[2], a[3]), cvtpk(b[0], b[1]), cvtpk(b[2], b[3])}; return *reinterpret_cast<bf16x8*>(&w); }
__device__ __forceinline__ float bflo(unsigned w) { return __uint_as_float(w << 16); }
__device__ __forceinline__ float bfhi(unsigned w) { return __uint_as_float(w & 0xffff0000u); }
__device__ __forceinline__ float silu_f(float x) { return x * __builtin_amdgcn_rcpf(1.0f + __builtin_amdgcn_exp2f(-x * LOG2E)); }
__device__ __forceinline__ float wave_sum(float v) {
#pragma unroll
    for (int o = 1; o < 64; o <<= 1) v += __shfl_xor(v, o);
    return v;
}
__device__ __forceinline__ int otid(int wv) { int t = wv * 64 + (int)__builtin_amdgcn_mbcnt_hi(~0u, __builtin_amdgcn_mbcnt_lo(~0u, 0u)); asm volatile("" : "+v"(t)); return t; }
__device__ __forceinline__ float xsum16(float v) { auto r = __builtin_amdgcn_permlane16_swap(__float_as_uint(v), __float_as_uint(v), false, false); return __uint_as_float(r[0]) + __uint_as_float(r[1]); }
__device__ __forceinline__ float xsum32(float v) { auto r = __builtin_amdgcn_permlane32_swap(__float_as_uint(v), __float_as_uint(v), false, false); return __uint_as_float(r[0]) + __uint_as_float(r[1]); }
__device__ __forceinline__ float xmax16(float v) { auto r = __builtin_amdgcn_permlane16_swap(__float_as_uint(v), __float_as_uint(v), false, false); return fmaxf(__uint_as_float(r[0]), __uint_as_float(r[1])); }
__device__ __forceinline__ float xmax32(float v) { auto r = __builtin_amdgcn_permlane32_swap(__float_as_uint(v), __float_as_uint(v), false, false); return fmaxf(__uint_as_float(r[0]), __uint_as_float(r[1])); }
__device__ __forceinline__ float bperm(float v, int srclane) { return __uint_as_float((unsigned)__builtin_amdgcn_ds_bpermute(srclane << 2, (int)__float_as_uint(v))); }
__device__ __forceinline__ float logsig(float x) { return fminf(x, 0.f) - log1pf(__expf(-fabsf(x))); }

namespace pg8 {
constexpr int BM = 256, BK = 64, HALF = 128, HTB = HALF * BK * 2, NXCD = 8, WGM = 8;
__device__ __forceinline__ int lds_byte(int r, int c) { const int st = (r >> 4) * 2 + (c >> 5), rr = r & 15, cc = c & 31, ob = rr * 64 + cc * 2; return st * 1024 + (ob ^ (((ob >> 9) & 1) << 5)); }
__device__ __forceinline__ void stage_rc(int b, int& R, int& C) { const int st = b / 1024, sb = b % 1024, swz = sb ^ (((sb >> 9) & 1) << 5); R = (st >> 1) * 16 + swz / 64; C = (st & 1) * 32 + (swz % 64) / 2; }
__device__ __forceinline__ int perm32(int rho) { const int n = rho >> 4, i = rho & 15; return 8 * (i >> 2) + 4 * n + (i & 3); }
struct Unit { int pm, pn, ks, nks; };
struct Gemm { const bf16_t* A; const bf16_t* Bt; int K, lda, ldb, mode; float* sp_acc; unsigned* sp_cnt; };
__device__ __forceinline__ void unit_off(const Gemm& g, const Unit& u, size_t& oa, size_t& ob) {
    if (g.mode == 2) { oa = (size_t)u.pm * 256 * g.lda; ob = (size_t)(u.pm >> 4) * DM * EA + (size_t)((u.pm >> 2) & 3) * 1024 + (size_t)u.pn * 256 * g.ldb; }
    else if (g.mode == 3) { oa = (size_t)u.pm * 256 * g.lda + (size_t)(u.pn >> 2) * 1024; ob = (size_t)(u.pm * 16 + u.pn) * 256 * g.ldb; }
    else { oa = (size_t)u.pm * 256 * g.lda; ob = (size_t)u.pn * 256 * g.ldb; }
    const size_t ko = (size_t)u.ks * (size_t)(g.K / u.nks); oa = (oa + ko) * 2; ob = (ob + ko) * 2;
}
struct StaticOrder {
    int nM, nN, nwg, G, c;
    __device__ void init(int nM_, int nN_, int G_, int c_) { nM = nM_; nN = nN_; nwg = nM * nN; G = G_; c = c_; }
    __device__ bool next(int i, Unit& u) const {
        const long L = (long)i * G + c; if (L >= nwg) return false;
        int wgid = (int)L; { const int q = nwg / NXCD, r = nwg % NXCD, xcd = wgid % NXCD, off = wgid / NXCD; wgid = (xcd < r ? xcd * (q + 1) : r * (q + 1) + (xcd - r) * q) + off; }
        const int nig = WGM * nN, gid = wgid / nig, fm = gid * WGM, gsz = (nM - fm) < WGM ? (nM - fm) : WGM;
        u.pm = fm + ((wgid % nig) % gsz); u.pn = (wgid % nig) / gsz; u.ks = 0; u.nks = 1; return true;
    }
};
struct SplitOrder {
    StaticOrder S0; int nN, nks, i0;
    __device__ void init(int nN_, int nks_, int G_, int c_) { S0.init(64, nN_, G_, c_); nN = nN_; nks = nks_; i0 = c_ < S0.nwg ? (S0.nwg - c_ + G_ - 1) / G_ : 0; }
    __device__ bool next(int i, Unit& u) const {
        if (i < i0) return S0.next(i, u);
        const int idx = (i - i0) * S0.G + S0.c; if (idx >= nN * nks) return false;
        u.pm = 64; u.pn = idx / nks; u.ks = idx % nks; u.nks = nks; return true;
    }
};
struct StateOrder {
    int G, c;
    __device__ bool next(int i, Unit& u) const { const int idx = G - 1 - c; if (i != 0 || idx >= 80) return false; const int k = idx >> 4; u.pm = k < 4 ? 16 * k + 15 : 64; u.pn = idx & 15; u.ks = 0; u.nks = 1; return true; }
};
template <class Epi, class Ord>
__device__ __forceinline__ void gemm_phase(int wv, LAS unsigned char* lds, const Gemm g, const Ord& S, const Epi& E) {
    const int tid = otid(wv), wid = __builtin_amdgcn_readfirstlane(tid >> 6), lane = tid & 63, wr = wid >> 2, wc = wid & 3, fr = lane & 15, fq = lane >> 4;
    const int K = g.K, nt = K / BK;
    unsigned voffA[2], voffB[2];
#pragma unroll
    for (int i = 0; i < 2; ++i) { int R, C; stage_rc(tid * 16 + i * 8192, R, C); const int Rb = Epi::PERM ? ((R & ~31) + perm32(R & 31)) : R;
        voffA[i] = (unsigned)(R * g.lda + C) * 2u; voffB[i] = (unsigned)(Rb * g.ldb + C) * 2u; }
    const size_t kstep = (size_t)(BK * 2);
    const size_t hstepA = (size_t)HALF * g.lda * 2;
    const size_t hstepB = (size_t)HALF * g.ldb * 2;
    const unsigned ldsw = (unsigned)wid * 1024u;
    const int aoff = lds_byte(wr * 64 + fr, fq * 8), boff = lds_byte(wc * 32 + fr, fq * 8);
#define PG8_SA(b, h) (((b) * 2 + (h)) * HTB)
#define PG8_SB(b, h) ((4 + (b) * 2 + (h)) * HTB)
#define PG8_STAGE(bufoff, gbase, voff) do { _Pragma("unroll") for (int _i = 0; _i < 2; ++_i) \
        __builtin_amdgcn_global_load_lds((const unsigned*)((const char*)(gbase) + (voff)[_i]), (LAS unsigned*)(lds + (bufoff) + ldsw + _i * 8192), 16, 0, 0); } while (0)
#define PG8_LDA(dst, b, h) do { _Pragma("unroll") for (int m = 0; m < 4; ++m) _Pragma("unroll") for (int k = 0; k < 2; ++k) dst[m][k] = *(const LAS bf16x8*)(lds + PG8_SA(b, h) + aoff + m * 2048 + k * 1024); } while (0)
#define PG8_LDB(dst, b, h) do { _Pragma("unroll") for (int n = 0; n < 2; ++n) _Pragma("unroll") for (int k = 0; k < 2; ++k) dst[n][k] = *(const LAS bf16x8*)(lds + PG8_SB(b, h) + boff + n * 2048 + k * 1024); } while (0)
#define PG8_MMA(ai, bj, At, Bt) do { __builtin_amdgcn_s_setprio(1); _Pragma("unroll") for (int m = 0; m < 4; ++m) _Pragma("unroll") for (int n = 0; n < 2; ++n) _Pragma("unroll") for (int k = 0; k < 2; ++k) \
        acc[ai][bj][m][n] = __builtin_amdgcn_mfma_f32_16x16x32_bf16(Bt[n][k], At[m][k], acc[ai][bj][m][n], 0, 0, 0); __builtin_amdgcn_s_setprio(0); } while (0)
#define PG8_WAIT_V(n) asm volatile("s_waitcnt vmcnt(" #n ")" ::: "memory")
#define PG8_WAIT_L(n) asm volatile("s_waitcnt lgkmcnt(" #n ")" ::: "memory")
#define PG8_BAR __builtin_amdgcn_s_barrier()
#define PG8_SCHED __builtin_amdgcn_sched_barrier(0)
    Unit cur, nxt; int ui = 0;
    if (!S.next(0, cur)) return;
    f32x4 acc[2][2][4][2];
#pragma unroll
    for (int a = 0; a < 2; ++a)
#pragma unroll
        for (int b = 0; b < 2; ++b)
#pragma unroll
            for (int m = 0; m < 4; ++m)
#pragma unroll
                for (int n = 0; n < 2; ++n) acc[a][b][m][n] = (f32x4){0.f, 0.f, 0.f, 0.f};
    bf16x8 At[4][2], B0[2][2], B1[2][2];
    size_t oa_, ob_; unit_off(g, cur, oa_, ob_);
    const char* cA = (const char*)g.A + oa_; const char* cB = (const char*)g.Bt + ob_;
    PG8_STAGE(PG8_SB(0, 0), cB, voffB); PG8_STAGE(PG8_SA(0, 0), cA, voffA); PG8_STAGE(PG8_SB(0, 1), cB + hstepB, voffB); PG8_STAGE(PG8_SA(0, 1), cA + hstepA, voffA);
    if (wr == 1) PG8_BAR;
    PG8_WAIT_V(4); PG8_BAR;
    PG8_STAGE(PG8_SB(1, 0), cB + kstep, voffB); PG8_STAGE(PG8_SA(1, 0), cA + kstep, voffA); PG8_STAGE(PG8_SB(1, 1), cB + hstepB + kstep, voffB);
    PG8_WAIT_V(6); PG8_BAR;
    for (;;) {
        const bool has_next = S.next(ui + 1, nxt);
        const char* nA = cA; const char* nB = cB;
        if (has_next) { unit_off(g, nxt, oa_, ob_); nA = (const char*)g.A + oa_; nB = (const char*)g.Bt + ob_; }
        const int ntc = nt / cur.nks;
        for (int t = 0; t < ntc; t += 2) {
            const bool last = (t == ntc - 2);
            const char* a1 = cA + (size_t)(t + 1) * kstep;
            const char* a2 = last ? nA : cA + (size_t)(t + 2) * kstep; const char* b2 = last ? nB : cB + (size_t)(t + 2) * kstep;
            const char* a3 = a2 + kstep; const char* b3 = b2 + kstep;
            PG8_LDB(B0, 0, 0); PG8_SCHED; PG8_LDA(At, 0, 0); PG8_STAGE(PG8_SA(1, 1), a1 + hstepA, voffA);
            PG8_WAIT_L(8); PG8_BAR; PG8_WAIT_L(0); PG8_MMA(0, 0, At, B0); PG8_BAR; PG8_SCHED;
            PG8_LDB(B1, 0, 1); PG8_STAGE(PG8_SB(0, 0), b2, voffB);
            PG8_BAR; PG8_WAIT_L(0); PG8_MMA(0, 1, At, B1); PG8_BAR;
            PG8_LDA(At, 0, 1); PG8_STAGE(PG8_SA(0, 0), a2, voffA);
            PG8_BAR; PG8_WAIT_L(0); PG8_MMA(1, 0, At, B0); PG8_BAR; PG8_SCHED;
            PG8_STAGE(PG8_SB(0, 1), b2 + hstepB, voffB);
            PG8_WAIT_V(6); PG8_BAR; PG8_MMA(1, 1, At, B1); PG8_BAR;
            PG8_LDB(B0, 1, 0); PG8_SCHED; PG8_LDA(At, 1, 0); PG8_STAGE(PG8_SA(0, 1), a2 + hstepA, voffA);
            PG8_WAIT_L(8); PG8_BAR; PG8_WAIT_L(0); PG8_MMA(0, 0, At, B0); PG8_BAR; PG8_SCHED;
            PG8_LDB(B1, 1, 1); PG8_STAGE(PG8_SB(1, 0), b3, voffB);
            PG8_BAR; PG8_WAIT_L(0); PG8_MMA(0, 1, At, B1); PG8_BAR;
            PG8_LDA(At, 1, 1); PG8_STAGE(PG8_SA(1, 0), a3, voffA);
            PG8_BAR; PG8_WAIT_L(0); PG8_MMA(1, 0, At, B0); PG8_BAR; PG8_SCHED;
            PG8_STAGE(PG8_SB(1, 1), b3 + hstepB, voffB);
            PG8_WAIT_V(6); PG8_BAR; PG8_MMA(1, 1, At, B1); PG8_BAR;
        }
        bool do_epi = true;
        if (cur.nks > 1) {
            float* sc0 = g.sp_acc + (size_t)cur.pn * 65536 + (wid * 64 + lane); float* sc = sc0;
#pragma unroll
            for (int a = 0; a < 2; ++a)
#pragma unroll
                for (int b = 0; b < 2; ++b)
#pragma unroll
                    for (int m = 0; m < 4; ++m)
#pragma unroll
                        for (int n = 0; n < 2; ++n) {
#pragma unroll
                            for (int j = 0; j < 4; ++j) unsafeAtomicAdd(sc + j * 512, acc[a][b][m][n][j]);
                            sc += 2048; asm volatile("" : "+v"(sc)); }
            asm volatile("s_waitcnt vmcnt(0)" ::: "memory");
            __builtin_amdgcn_fence(__ATOMIC_RELEASE, "agent");
            unsigned old = 0u; if (lane == 0) old = __hip_atomic_fetch_add(g.sp_cnt + cur.pn * 8 + wid, 1u, __ATOMIC_RELAXED, __HIP_MEMORY_SCOPE_AGENT);
            old = (unsigned)__builtin_amdgcn_readfirstlane((int)old);
            do_epi = (old == (unsigned)cur.nks - 1u);
            if (do_epi) {
                __builtin_amdgcn_fence(__ATOMIC_ACQUIRE, "agent");
                sc = sc0;
#pragma unroll
                for (int a = 0; a < 2; ++a)
#pragma unroll
                    for (int b = 0; b < 2; ++b)
#pragma unroll
                        for (int m = 0; m < 4; ++m)
#pragma unroll
                            for (int n = 0; n < 2; ++n) {
#pragma unroll
                                for (int j = 0; j < 4; ++j) acc[a][b][m][n][j] = __hip_atomic_load(sc + j * 512, __ATOMIC_RELAXED, __HIP_MEMORY_SCOPE_AGENT);
                                sc += 2048; asm volatile("" : "+v"(sc)); } }
        }
        if (do_epi) E(acc, cur, wr, wc, fr, fq);
        if (!has_next) break;
#pragma unroll
        for (int a = 0; a < 2; ++a)
#pragma unroll
            for (int b = 0; b < 2; ++b)
#pragma unroll
                for (int m = 0; m < 4; ++m)
#pragma unroll
                    for (int n = 0; n < 2; ++n) acc[a][b][m][n] = (f32x4){0.f, 0.f, 0.f, 0.f};
        cur = nxt; cA = nA; cB = nB; ++ui;
    }
    PG8_WAIT_V(0);
    if (wr == 0) PG8_BAR;
    PG8_BAR;
#undef PG8_SA
#undef PG8_SB
#undef PG8_STAGE
#undef PG8_LDA
#undef PG8_LDB
#undef PG8_MMA
#undef PG8_WAIT_V
#undef PG8_WAIT_L
#undef PG8_BAR
#undef PG8_SCHED
}

typedef const f32x4 (&AccRef)[2][2][4][2];

struct EpiInA {
    static constexpr bool PERM = true;
    const float* ssq; bf16_t* tt; bf16_t* sg;
    __device__ __forceinline__ void operator()(AccRef acc, const Unit& un, int wr, int wc, int fr, int fq) const {
        const int row0 = un.pm * BM + wr * 64 + fr, colt = un.pn * BM + wc * 32 + 8 * fq;
        const bool is_t = un.pn < 16;
        float rrs[2][4];
#pragma unroll
        for (int ai = 0; ai < 2; ++ai)
#pragma unroll
            for (int m = 0; m < 4; ++m) rrs[ai][m] = ssq[row0 + ai * HALF + m * 16];
#pragma unroll
        for (int ai = 0; ai < 2; ++ai)
#pragma unroll
            for (int m = 0; m < 4; ++m) { const int row = row0 + ai * HALF + m * 16; const float rr = rsqrtf(rrs[ai][m] * (1.0f / DM) + EPS);
#pragma unroll
                for (int bj = 0; bj < 2; ++bj) { f32x4 v0 = acc[ai][bj][m][0] * rr, v1 = acc[ai][bj][m][1] * rr; const int col = colt + bj * HALF;
                    if (is_t) *(bf16x8*)(tt + (size_t)row * EA + col) = pack8(v0, v1);
                    else {
#pragma unroll
                        for (int j = 0; j < 4; ++j) { v0[j] = silu_f(v0[j]); v1[j] = silu_f(v1[j]); }
                        *(bf16x8*)(sg + (size_t)row * EA + (col - EA)) = pack8(v0, v1); } } }
    }
};
struct EpiUState {
    static constexpr bool PERM = true;
    const float* ssq; float* pool_p; float* pool_s;
    __device__ __forceinline__ void operator()(AccRef acc, const Unit& un, int wr, int wc, int fr, int fq) const {
        const int row0 = un.pm * BM + wr * 64 + fr, colt = un.pn * BM + wc * 32 + 8 * fq;
#pragma unroll
        for (int ai = 0; ai < 2; ++ai)
#pragma unroll
            for (int m = 0; m < 4; ++m) { const int row = row0 + ai * HALF + m * 16;
                float* pp = nullptr;
                if (row < MP) { const int t = row & (SEQ - 1); if (t >= SEQ - PPAD) pp = pool_p + ((size_t)(row >> 12) * PPAD + (t - (SEQ - PPAD))) * EA; }
                else { const int rs = row - MP, t = rs & 15; if (t >= 1) pp = pool_s + ((size_t)(rs >> 4) * PPAD + (t - 1)) * EA; }
                if (pp) { const float rr = rsqrtf(ssq[row] * (1.0f / DM) + EPS);
#pragma unroll
                    for (int bj = 0; bj < 2; ++bj) { *(f32x4*)(pp + colt + bj * HALF) = acc[ai][bj][m][0] * rr; *(f32x4*)(pp + colt + bj * HALF + 4) = acc[ai][bj][m][1] * rr; } } }
    }
};
struct EpiStore {
    static constexpr bool PERM = true;
    bf16_t* O; int ldc, wmode;
    __device__ __forceinline__ void operator()(AccRef acc, const Unit& un, int wr, int wc, int fr, int fq) const {
        const int rbase = wmode ? (un.pm >> 4) * 2 * EA + (un.pm & 15) * BM : un.pm * BM;
        const int row0 = rbase + wr * 64 + fr, colt = un.pn * BM + wc * 32 + 8 * fq;
#pragma unroll
        for (int ai = 0; ai < 2; ++ai)
#pragma unroll
            for (int m = 0; m < 4; ++m)
#pragma unroll
                for (int bj = 0; bj < 2; ++bj) *(bf16x8*)(O + (size_t)(row0 + ai * HALF + m * 16) * ldc + colt + bj * HALF) = pack8(acc[ai][bj][m][0], acc[ai][bj][m][1]);
    }
};
struct EpiRes {
    static constexpr bool PERM = false;
    const float* base_p; const float* base_s; float* xres; bf16_t* xb; float* ssq_next;
    __device__ __forceinline__ void operator()(AccRef acc, const Unit& un, int wr, int wc, int fr, int fq) const {
        const int row0 = un.pm * BM + wr * 64 + fr, col0 = un.pn * BM + wc * 32 + 4 * fq;
#pragma unroll
        for (int ai = 0; ai < 2; ++ai) {
            f32x4 bx_[4][2][2];
#pragma unroll
            for (int m = 0; m < 4; ++m) { const int row = row0 + ai * HALF + m * 16;
                const float* bp = (row < MP ? base_p + (size_t)row * DM : base_s + (size_t)(row - MP) * DM) + col0;
#pragma unroll
                for (int bj = 0; bj < 2; ++bj)
#pragma unroll
                    for (int n = 0; n < 2; ++n) bx_[m][bj][n] = *(const f32x4*)(bp + bj * HALF + n * 16); }
#pragma unroll
            for (int m = 0; m < 4; ++m) { const int row = row0 + ai * HALF + m * 16;
                float* xo = xres + (size_t)row * DM + col0; bf16_t* bo = xb + (size_t)row * DM + col0; float s = 0.f;
#pragma unroll
                for (int bj = 0; bj < 2; ++bj)
#pragma unroll
                    for (int n = 0; n < 2; ++n) { const f32x4 x = bx_[m][bj][n] + acc[ai][bj][m][n];
                        *(f32x4*)(xo + bj * HALF + n * 16) = x; u32x2 w; w.x = cvtpk(x[0], x[1]); w.y = cvtpk(x[2], x[3]); *(u32x2*)(bo + bj * HALF + n * 16) = w;
                        s += (x[0] * x[0] + x[1] * x[1]) + (x[2] * x[2] + x[3] * x[3]); }
                s = xsum16(s); s = xsum32(s);
                if (fq == 0) unsafeAtomicAdd(ssq_next + row, s); } }
    }
};
struct EpiKVQ {
    static constexpr bool PERM = true;
    int pn_off; const float* ssq; float* out; unsigned char* ws; const float* b_f;
    __device__ __forceinline__ void operator()(AccRef acc, const Unit& un, int wr, int wc, int fr, int fq) const {
        const int tt = un.pn + pn_off;
        const int row0 = un.pm * BM + wr * 64 + fr, cw = wc * 32 + 8 * fq;
        float rrs[2][4];
#pragma unroll
        for (int ai = 0; ai < 2; ++ai)
#pragma unroll
            for (int m = 0; m < 4; ++m) rrs[ai][m] = ssq[row0 + ai * HALF + m * 16];
        if (tt == 16) {
            if (wc == 0 && fq < 2) {
            const f32x4 bf0 = *(const f32x4*)(b_f + 8 * fq), bf1 = *(const f32x4*)(b_f + 8 * fq + 4);
            float* lft_p = (float*)(ws + WS_LFTP); float* lft_s = (float*)(ws + WS_LFTS);
#pragma unroll
            for (int ai = 0; ai < 2; ++ai)
#pragma unroll
                for (int m = 0; m < 4; ++m) { const int row = row0 + ai * HALF + m * 16; const float rr = rsqrtf(rrs[ai][m] * (1.0f / DM) + EPS);
                    f32x4 v0 = acc[ai][0][m][0] * rr + bf0, v1 = acc[ai][0][m][1] * rr + bf1;
#pragma unroll
                    for (int j = 0; j < 4; ++j) { v0[j] = logsig(v0[j]); v1[j] = logsig(v1[j]); }
                    if (row < MP) { float* o = out + O_LFP + (size_t)row * NH + 8 * fq; *(f32x4*)o = v0; *(f32x4*)(o + 4) = v1;
                        float* tp = lft_p + ((size_t)(row >> 12) * NH + 8 * fq) * SEQ + (row & (SEQ - 1));
#pragma unroll
                        for (int j = 0; j < 4; ++j) { tp[(size_t)j * SEQ] = v0[j]; tp[(size_t)(j + 4) * SEQ] = v1[j]; } }
                    else { const int rs = row - MP; float* o = out + O_LFS + (size_t)rs * NH + 8 * fq; *(f32x4*)o = v0; *(f32x4*)(o + 4) = v1;
                        float* tp = lft_s + ((size_t)(rs >> 4) * NH + 8 * fq) * DSEQ + (rs & 15);
#pragma unroll
                        for (int j = 0; j < 4; ++j) { tp[j * DSEQ] = v0[j]; tp[(j + 4) * DSEQ] = v1[j]; } } }
            }
        } else {
        const int kind = tt < 8 ? 0 : (tt < 16 ? 1 : (tt < 25 ? 2 : 3));
        const int colt = (tt - (kind == 0 ? 0 : kind == 1 ? 8 : kind == 2 ? 17 : 25)) * BM + cw;
        float* fo_p = out + (kind == 0 ? O_KP : O_VP); float* fo_s = out + (kind == 0 ? O_KS : O_VS);
        bf16_t* bo = (bf16_t*)(ws + (kind == 0 ? WS_KB : (kind == 1 ? WS_VB : (kind == 2 ? WS_QB : WS_SGB))));
#pragma unroll
        for (int ai = 0; ai < 2; ++ai)
#pragma unroll
            for (int m = 0; m < 4; ++m) { const int row = row0 + ai * HALF + m * 16; float rr = rsqrtf(rrs[ai][m] * (1.0f / DM) + EPS);
                if (kind == 2) rr *= QSCALE;
                float* fo = (row < MP ? fo_p + (size_t)row * DM : fo_s + (size_t)(row - MP) * DM) + colt;
#pragma unroll
                for (int bj = 0; bj < 2; ++bj) { f32x4 v0 = acc[ai][bj][m][0] * rr, v1 = acc[ai][bj][m][1] * rr;
                    if (kind < 2) { *(f32x4*)(fo + bj * HALF) = v0; *(f32x4*)(fo + bj * HALF + 4) = v1; }
                    if (kind == 3) {
#pragma unroll
                        for (int j = 0; j < 4; ++j) { v0[j] = silu_f(v0[j]); v1[j] = silu_f(v1[j]); } }
                    *(bf16x8*)(bo + (size_t)row * DM + colt + bj * HALF) = pack8(v0, v1);
                    if (kind == 0 || kind == 2) {
                        float ss = (v0[0] * v0[0] + v0[1] * v0[1]) + (v0[2] * v0[2] + v0[3] * v0[3]) + (v1[0] * v1[0] + v1[1] * v1[1]) + (v1[2] * v1[2] + v1[3] * v1[3]);
                        ss = xsum16(ss); ss = xsum32(ss);
                        float* nt = (float*)(ws + (kind == 0 ? WS_KNRM : WS_QNRM));
                        if (fq == 0) nt[((size_t)row * NH + 2 * (colt >> 8) + bj) * 4 + wc] = ss; } } }
        }
    }
};
}

namespace att {
constexpr int NW = 8, QBLK = 32, KVBLK = 64, QB = NW * QBLK, D = 128, LD = 2048;
constexpr int SHM_V = KVBLK * D * 2, SHM_K = KVBLK * D * 2;
constexpr int OFF_WS = 2 * SHM_V + 2 * SHM_K, OFF_F = OFF_WS + NW * 64 * 4, OFF_SC = OFF_F + SEQ * 4, OFF_KT = OFF_SC + 64, OFF_QM = OFF_KT + 256, OFF_JL = OFF_QM + 64;
constexpr float SKIP_T = 32.f;
constexpr float THR2 = 11.5f;
#define KSWZ(row, colB) ((row) * 256 + ((colB) ^ (((row) & 7) << 4)))
#define SBAR() __builtin_amdgcn_sched_barrier(0)
__device__ __forceinline__ int v_st(int k, int c) { const int kk = (k & ~0xC) | ((k & 4) << 1) | ((k & 8) >> 1); return ((kk >> 3) * 4 + (c >> 5)) * 512 + ((kk & 7) * 32 + (c & 31)) * 2; }
__device__ __forceinline__ int v_rd_base(int lane) { return ((lane & 3) << 3) | (((lane >> 2) & 3) << 6) | (((lane >> 4) & 1) << 5) | (((lane >> 5) & 1) << 8); }
constexpr int v_rd_off(int d0, int ks, int half) { return d0 * 512 + ks * 4096 + half * 2048; }
__device__ __forceinline__ int crow(int r, int hi) { return (r & 3) + 8 * (r >> 2) + 4 * hi; }
__device__ __forceinline__ void mask_tile(f32x16& p0, f32x16& p1, int dq) {
    const float NEG = -__builtin_inff();
#pragma unroll
    for (int r = 0; r < 16; ++r) { const int c = (r & 3) + 8 * (r >> 2);
        if (dq - c < 0) p0[r] = NEG;
        if (dq - c - 32 < 0) p1[r] = NEG; }
}
__device__ __forceinline__ void partialSM(f32x16& p0, f32x16& p1, float& m_reg, float& mn, float& alpha) {
    float pmax = p0[0];
#pragma unroll
    for (int r = 1; r < 16; ++r) pmax = fmaxf(pmax, p0[r]);
#pragma unroll
    for (int r = 0; r < 16; ++r) pmax = fmaxf(pmax, p1[r]);
    { auto rr = __builtin_amdgcn_permlane32_swap(__float_as_uint(pmax), __float_as_uint(pmax), false, false);
      pmax = fmaxf(__uint_as_float(rr[0]), __uint_as_float(rr[1])); }
    if (__builtin_expect(__all((pmax - m_reg) <= THR2), 1)) { mn = m_reg; alpha = 1.f; }
    else { mn = fmaxf(m_reg, pmax); alpha = __builtin_amdgcn_exp2f(m_reg - mn); m_reg = mn; }
#pragma unroll
    for (int r = 0; r < 16; ++r) p0[r] = p0[r] - mn;
#pragma unroll
    for (int r = 0; r < 16; ++r) p1[r] = p1[r] - mn;
#pragma unroll
    for (int r = 0; r < 16; ++r) p0[r] = __builtin_amdgcn_exp2f(p0[r]);
}
__device__ __forceinline__ void finishSM(f32x16& p0, f32x16& p1, float alpha, float& l_reg, bf16x8& pa0, bf16x8& pa1, bf16x8& pa2, bf16x8& pa3) {
#pragma unroll
    for (int r = 0; r < 16; ++r) p1[r] = __builtin_amdgcn_exp2f(p1[r]);
    float ps = 0;
#pragma unroll
    for (int r = 0; r < 16; ++r) ps += p0[r];
#pragma unroll
    for (int r = 0; r < 16; ++r) ps += p1[r];
    { auto rr = __builtin_amdgcn_permlane32_swap(__float_as_uint(ps), __float_as_uint(ps), false, false);
      ps = __uint_as_float(rr[0]) + __uint_as_float(rr[1]); }
    l_reg = l_reg * alpha + ps;
#define PK4(P, B_, OUT) do { unsigned a0 = cvtpk(P[B_+0], P[B_+1]), a1 = cvtpk(P[B_+2], P[B_+3]);                          \
        unsigned b0 = cvtpk(P[B_+4], P[B_+5]), b1 = cvtpk(P[B_+6], P[B_+7]);                                             \
        auto r0 = __builtin_amdgcn_permlane32_swap(a0, b0, false, false); auto r1 = __builtin_amdgcn_permlane32_swap(a1, b1, false, false); \
        u32x4 w = {r0[0], r1[0], r0[1], r1[1]}; OUT = *reinterpret_cast<bf16x8*>(&w); } while (0)
    PK4(p0, 0, pa0); PK4(p0, 8, pa1); PK4(p1, 0, pa2); PK4(p1, 8, pa3);
#undef PK4
}
template <int KB>
__device__ __forceinline__ void qkt(f32x16& p0, f32x16& p1, const char* K_lds, const float* fl, int r32, int hi, const bf16x8* qr) {
    { const f32x4 a0 = *(const f32x4*)(fl), a1 = *(const f32x4*)(fl + 8), a2 = *(const f32x4*)(fl + 16), a3 = *(const f32x4*)(fl + 24);
      const f32x4 b0 = *(const f32x4*)(fl + 32), b1 = *(const f32x4*)(fl + 40), b2 = *(const f32x4*)(fl + 48), b3 = *(const f32x4*)(fl + 56);
      p0 = (f32x16){a0[0], a0[1], a0[2], a0[3], a1[0], a1[1], a1[2], a1[3], a2[0], a2[1], a2[2], a2[3], a3[0], a3[1], a3[2], a3[3]};
      p1 = (f32x16){b0[0], b0[1], b0[2], b0[3], b1[0], b1[1], b1[2], b1[3], b2[0], b2[1], b2[2], b2[3], b3[0], b3[1], b3[2], b3[3]}; }
    const char* kb[4];
#pragma unroll
    for (int dd = 0; dd < 4; ++dd) kb[dd] = K_lds + KB * SHM_K + KSWZ(r32, (dd * 16 + hi * 8) * 2);
#pragma unroll
    for (int d0 = 0; d0 < 8; ++d0) { const char* a = kb[d0 & 3] + (d0 >> 2) * 128;
        bf16x8 b0 = *reinterpret_cast<const bf16x8*>(a);
        bf16x8 b1 = *reinterpret_cast<const bf16x8*>(a + 32 * 256);
        p0 = __builtin_amdgcn_mfma_f32_32x32x16_bf16(b0, qr[d0], p0, 0, 0, 0);
        p1 = __builtin_amdgcn_mfma_f32_32x32x16_bf16(b1, qr[d0], p1, 0, 0, 0); }
}
template <int VB>
__device__ __forceinline__ void pv_tile(f32x16* o, int vb0, bf16x8 pa0, bf16x8 pa1, bf16x8 pa2, bf16x8 pa3) {
#define TRRD(dst, off) asm volatile("ds_read_b64_tr_b16 %0, %1 offset:%2" : "=&v"(dst) : "v"(vb0), "i"(off) : "memory")
#define PV_D0(d0) do { s16x4 l0, l1, l2, l3, h0, h1, h2, h3; constexpr int b_ = VB * SHM_V + v_rd_off(d0, 0, 0);   \
        TRRD(l0, b_); TRRD(h0, b_ + 2048); TRRD(l1, b_ + 4096); TRRD(h1, b_ + 6144); TRRD(l2, b_ + 8192); TRRD(h2, b_ + 10240); TRRD(l3, b_ + 12288); TRRD(h3, b_ + 14336); \
        asm volatile("s_waitcnt lgkmcnt(0)" ::: "memory"); SBAR();   \
        o[d0] = __builtin_amdgcn_mfma_f32_32x32x16_bf16(pa0, (bf16x8){l0[0], l0[1], l0[2], l0[3], h0[0], h0[1], h0[2], h0[3]}, o[d0], 0, 0, 0);   \
        o[d0] = __builtin_amdgcn_mfma_f32_32x32x16_bf16(pa1, (bf16x8){l1[0], l1[1], l1[2], l1[3], h1[0], h1[1], h1[2], h1[3]}, o[d0], 0, 0, 0);   \
        o[d0] = __builtin_amdgcn_mfma_f32_32x32x16_bf16(pa2, (bf16x8){l2[0], l2[1], l2[2], l2[3], h2[0], h2[1], h2[2], h2[3]}, o[d0], 0, 0, 0);   \
        o[d0] = __builtin_amdgcn_mfma_f32_32x32x16_bf16(pa3, (bf16x8){l3[0], l3[1], l3[2], l3[3], h3[0], h3[1], h3[2], h3[3]}, o[d0], 0, 0, 0); } while (0)
    PV_D0(0); PV_D0(1); PV_D0(2); PV_D0(3);
#undef PV_D0
#undef TRRD
}
struct Tensors { const bf16_t* q; const bf16_t* k; const bf16_t* v; bf16_t* og; const bf16_t* sg; const float* lft; };
struct BlockRef { unsigned q0, s0; int P0, jlo; };
struct Seam { bf16x8 qr[8]; bf16x8 st_v0, st_v1, st_k0, st_k1; };
#define ROWP(p, k0) ((p) + (unsigned)(k0) * (unsigned)LD)
#define VMW() asm volatile("s_waitcnt vmcnt(0)" ::: "memory")
#define VMWN(n) asm volatile("s_waitcnt vmcnt(%0)" :: "i"(n) : "memory")
#define LD8(p) (*reinterpret_cast<const bf16x8*>(p))
#define SLOAD_H(Kp, Vp, k0) do { S.st_v0 = LD8(ROWP(Vp, k0) + voff); S.st_v1 = LD8(ROWP(Vp, (k0) + 32) + voff);              \
                         S.st_k0 = LD8(ROWP(Kp, k0) + voff); S.st_k1 = LD8(ROWP(Kp, (k0) + 32) + voff); } while (0)
#define SWRITE_HK(bf) do { *(bf16x8*)(K_lds + (bf) * SHM_K + kws) = S.st_k0; *(bf16x8*)(K_lds + (bf) * SHM_K + kws + 32 * 256) = S.st_k1; } while (0)
#define SWRITE_HV(bf) do { *(bf16x8*)(V_lds + (bf) * SHM_V + vst0) = S.st_v0; *(bf16x8*)(V_lds + (bf) * SHM_V + vst0 + VST1) = S.st_v1; } while (0)
#define SWRITE_H(bf) do { SWRITE_HV(bf); SWRITE_HK(bf); } while (0)
__device__ __forceinline__ void prime(int wv, const Tensors& T, const BlockRef& cur, char* lds, Seam& S) {
    const int tid = otid(wv), wid = __builtin_amdgcn_readfirstlane(tid >> 6), lane = tid & 63, r32 = lane & 31, hi = lane >> 5;
    const int sr = tid >> 4, sc = (tid & 15) * 8, kws = KSWZ(sr, sc * 2); char* K_lds = lds + 2 * SHM_V;
    const unsigned voff = (unsigned)sr * LD + sc, qoff = (unsigned)(wid * QBLK + r32) * LD + hi * 8;
    const bf16_t* Qp = T.q + cur.q0; const bf16_t* Kh = T.k + cur.s0; const bf16_t* Vh = T.v + cur.s0;
#pragma unroll
    for (int d0 = 0; d0 < 8; ++d0) S.qr[d0] = LD8(Qp + qoff + d0 * 16);
    SLOAD_H(Kh, Vh, cur.jlo * KVBLK); VMW(); SWRITE_HK(0);
    __syncthreads();
}
__device__ __forceinline__ void block(int wv, const Tensors& T, const BlockRef& cur, const BlockRef& nxt, char* lds, Seam& S) {
    const int tid = otid(wv), wid = __builtin_amdgcn_readfirstlane(tid >> 6), lane = tid & 63, r32 = lane & 31, hi = lane >> 5;
    const int j_lo = cur.jlo, NT = (cur.P0 + QB) / KVBLK - j_lo;
    const int qlo = cur.P0 - j_lo * KVBLK + wid * QBLK, qm = qlo + r32 - 4 * hi;
    char* V_lds = lds; char* K_lds = lds + 2 * SHM_V;
    float* wsl = (float*)(lds + OFF_WS) + wid * 64; float* li_l = wsl, * al_l = wsl + 32;
    float* Fl = (float*)(lds + OFF_F);
    float m_reg = -1e30f, l_reg = 0; f32x16 o[4] = {};
    const int sr = tid >> 4, sc = (tid & 15) * 8, vst0 = v_st(sr, sc), kws = KSWZ(sr, sc * 2); constexpr int VST1 = 8192;
    const int vb0 = (int)(uintptr_t)V_lds + v_rd_base(lane);
    const bf16_t* Kh = T.k + cur.s0 + (unsigned)(j_lo * KVBLK) * LD; const bf16_t* Vh = T.v + cur.s0 + (unsigned)(j_lo * KVBLK) * LD;
    const unsigned voff = (unsigned)sr * LD + sc, qoff = (unsigned)(wid * QBLK + r32) * LD + hi * 8;
    const float* flb = Fl + j_lo * KVBLK + 4 * hi;
#define RESC(a) do { if (__any((a) < 1.f)) { if (hi == 0) al_l[r32] = (a); asm volatile("s_waitcnt lgkmcnt(0)" ::: "memory");              \
                     for (int d_ = 0; d_ < 4; ++d_) for (int r = 0; r < 16; ++r) o[d_][r] *= al_l[crow(r, hi)]; } } while (0)
#define KBASE(t) ((t) * KVBLK)
#define MASKT(P0_, P1_, t) do { const int kb_ = KBASE(t); if (kb_ + KVBLK - 1 > qlo) mask_tile(P0_, P1_, qm - kb_); } while (0)
#define SEAM_K0() do { VMWN(8); SWRITE_HK(0); SBAR(); } while (0)
    f32x16 pA0, pA1, pB0, pB1; float mnA, mnB, alA, alB; bf16x8 pa0, pa1, pa2, pa3;
    SWRITE_HV(0); SBAR();
    if (NT > 1) { SLOAD_H(Kh, Vh, KBASE(1)); }
    SBAR(); qkt<0>(pA0, pA1, K_lds, flb + KBASE(0), r32, hi, S.qr);
    MASKT(pA0, pA1, 0); partialSM(pA0, pA1, m_reg, mnA, alA);
    if (NT > 1) { VMW(); SWRITE_H(1); }
    __syncthreads();
#define HALF_STEP(PX0, PX1, mnX, alX, PY0, PY1, alY, t, KB, VB, SB) do {                                                      \
        SBAR(); qkt<KB>(PX0, PX1, K_lds, flb + KBASE(t), r32, hi, S.qr);                                             \
        finishSM(PY0, PY1, alY, l_reg, pa0, pa1, pa2, pa3); SBAR();                                                           \
        if ((t) + 1 < NT) { SLOAD_H(Kh, Vh, KBASE((t) + 1)); SBAR(); }                                               \
        pv_tile<VB>(o, vb0, pa0, pa1, pa2, pa3); MASKT(PX0, PX1, (t)); partialSM(PX0, PX1, m_reg, mnX, alX);                                        \
        __syncthreads();                                                                                                      \
        if ((t) + 1 < NT) { VMW(); SWRITE_H(SB); }                                                                          \
        RESC(alX); __syncthreads(); } while (0)
    for (int t = 1; t + 1 < NT; t += 2) {
        HALF_STEP(pB0, pB1, mnB, alB, pA0, pA1, alA, t, 1, 0, 0);
        HALF_STEP(pA0, pA1, mnA, alA, pB0, pB1, alB, t + 1, 0, 1, 1);
    }
    const bool even = (NT & 1) == 0;
    if (even) { SBAR(); qkt<1>(pB0, pB1, K_lds, flb + KBASE(NT - 1), r32, hi, S.qr); SBAR(); }
    { const bf16_t* Kn = T.k + nxt.s0; const bf16_t* Vn = T.v + nxt.s0; SLOAD_H(Kn, Vn, nxt.jlo * KVBLK); } SBAR();
    { const bf16_t* Qn = T.q + nxt.q0;
#pragma unroll
      for (int d0 = 0; d0 < 8; ++d0) S.qr[d0] = LD8(Qn + qoff + d0 * 16); }
    SBAR();
    finishSM(pA0, pA1, alA, l_reg, pa0, pa1, pa2, pa3); SBAR();
    pv_tile<0>(o, vb0, pa0, pa1, pa2, pa3);
    if (even) { MASKT(pB0, pB1, NT - 1); partialSM(pB0, pB1, m_reg, mnB, alB); __syncthreads(); RESC(alB);
        finishSM(pB0, pB1, alB, l_reg, pa0, pa1, pa2, pa3); SBAR(); pv_tile<1>(o, vb0, pa0, pa1, pa2, pa3); }
    SBAR(); SEAM_K0();
    if (hi == 0) li_l[r32] = l_reg; asm volatile("s_waitcnt lgkmcnt(0)" ::: "memory");
    float rli[16];
#pragma unroll
    for (int r = 0; r < 16; ++r) rli[r] = __builtin_amdgcn_rcpf(li_l[crow(r, hi)]);
    { const unsigned eoff = (unsigned)(4 * hi) * LD + r32;
#pragma unroll
      for (int r = 0; r < 16; ++r) { const unsigned ro = cur.q0 + (unsigned)(wid * QBLK + (r & 3) + 8 * (r >> 2)) * LD;
        bf16_t* Orow = T.og + ro; const bf16_t* Grow = T.sg + ro;
#pragma unroll
        for (int d0 = 0; d0 < 4; ++d0) { const float v = o[d0][r] * rli[r];
            const float vn = __shfl_xor(v, 1);
            if ((r32 & 1) == 0) { const unsigned gg = *(const unsigned*)(Grow + eoff + d0 * 32);
                *(unsigned*)(Orow + eoff + d0 * 32) = cvtpk(v * bflo(gg), vn * bfhi(gg)); } } } }
    __syncthreads();
#undef RESC
#undef KBASE
#undef MASKT
#undef SEAM_K0
#undef HALF_STEP
}
#undef ROWP
#undef VMW
#undef VMWN
#undef SLOAD_H
#undef SWRITE_HK
#undef SWRITE_HV
#undef SWRITE_H
#undef LD8

__device__ __forceinline__ BlockRef mkref(int bh, int qb) {
    const int b = bh >> 4, h = bh & 15; BlockRef r; r.s0 = (unsigned)b * SEQ * LD + h * D; r.q0 = r.s0 + (unsigned)qb * QB * LD; r.jlo = 0; r.P0 = qb * QB; return r;
}
__device__ __forceinline__ void item_setup(int wv, const Tensors& T, const float* knrm, const float* qnrm, int bh, int xa, int xb, char* lds, int& jloA, int& jloB) {
    const int tid = otid(wv), wid = __builtin_amdgcn_readfirstlane(tid >> 6), lane = tid & 63;
    float* Fl = (float*)(lds + OFF_F); float* scn = (float*)(lds + OFF_SC); float* Kt = (float*)(lds + OFF_KT); float* Qm = (float*)(lds + OFF_QM); int* JL = (int*)(lds + OFF_JL);
    const int b = bh >> 4, h = bh & 15, nkeys = (xb + 1) * QB, t0 = tid * 8;
    const float* LF = T.lft + (size_t)bh * SEQ;
    f32x4 a = {0.f, 0.f, 0.f, 0.f}, c = {0.f, 0.f, 0.f, 0.f};
    float kmx = 0.f;
    if (t0 < nkeys) { a = *(const f32x4*)(LF + t0); c = *(const f32x4*)(LF + t0 + 4);
        const float* kn = knrm + ((size_t)(b * SEQ + t0) * NH + h) * 4;
#pragma unroll
        for (int i = 0; i < 8; ++i) { const f32x4 p = *(const f32x4*)(kn + (size_t)i * NH * 4); kmx = fmaxf(kmx, (p[0] + p[1]) + (p[2] + p[3])); } }
    kmx = fmaxf(kmx, bperm(kmx, lane ^ 1)); kmx = fmaxf(kmx, bperm(kmx, lane ^ 2)); kmx = fmaxf(kmx, bperm(kmx, lane ^ 4));
    if ((tid & 7) == 0 && t0 < nkeys) Kt[tid >> 3] = sqrtf(kmx) * 1.01f;
    { const int qrow = b * SEQ + (tid < 256 ? xa * QB + tid : xb * QB + (tid - 256));
      const f32x4 p = *(const f32x4*)(qnrm + ((size_t)qrow * NH + h) * 4); float qm = (p[0] + p[1]) + (p[2] + p[3]);
#pragma unroll
      for (int o = 1; o < 64; o <<= 1) qm = fmaxf(qm, bperm(qm, lane ^ o));
      if (lane == 0) Qm[wid] = qm; }
    a[1] += a[0]; a[2] += a[1]; a[3] += a[2]; c[0] += a[3]; c[1] += c[0]; c[2] += c[1]; c[3] += c[2];
    const float tot = c[3]; float inc = tot;
#pragma unroll
    for (int o = 1; o < 64; o <<= 1) { const float v = bperm(inc, (lane - o) & 63); if (lane >= o) inc += v; }
    if (lane == 63) scn[wid] = inc;
    if (tid == 0) { JL[0] = xa * 4; JL[1] = xb * 4; }
    __syncthreads();
    float base = inc - tot;
    for (int w = 0; w < wid; ++w) base += scn[w];
    a = (a + base) * (-LOG2E); c = (c + base) * (-LOG2E);
    if (t0 < nkeys) { *(f32x4*)(Fl + t0) = a; *(f32x4*)(Fl + t0 + 4) = c; }
    __syncthreads();
    if (tid < 128) { const int which = tid >> 6, j = tid & 63, x = which ? xb : xa, nd = x * 4;
        if (j < nd) { const float qmax = sqrtf(fmaxf(fmaxf(Qm[which * 4], Qm[which * 4 + 1]), fmaxf(Qm[which * 4 + 2], Qm[which * 4 + 3]))) * 1.01f;
            const float kdiag = fmaxf(fmaxf(Kt[nd], Kt[nd + 1]), fmaxf(Kt[nd + 2], Kt[nd + 3]));
            const bool skip = qmax * (Kt[j] + kdiag) + Fl[64 * j + 63] - Fl[x * QB] < -SKIP_T;
            if (!skip) atomicMin(JL + which, j); } }
    __syncthreads();
    jloA = __builtin_amdgcn_readfirstlane(JL[0]); jloB = __builtin_amdgcn_readfirstlane(JL[1]);
}
__device__ __forceinline__ void prompt_phase(int wv, char* lds, const Tensors& T, const float* knrm, const float* qnrm, int vw, int G) {
    constexpr int TOTAL = NBATCH * NH * 8;
    Seam S;
    for (int L = vw; L < TOTAL; L += G) {
        const int bh = L >> 3, x = (L >= TOTAL / 2) ? 7 - (L & 7) : (L & 7);
        int ja, jb;
        item_setup(wv, T, knrm, qnrm, bh, x, 15 - x, lds, ja, jb);
        BlockRef A = mkref(bh, x), Bk = mkref(bh, 15 - x); A.jlo = ja; Bk.jlo = jb;
        prime(wv, T, A, lds, S);
#pragma unroll 1
        for (int pass = 0; pass < 2; ++pass) { const BlockRef cur = pass ? Bk : A; block(wv, T, cur, Bk, lds, S); }
    }
}
}

namespace sat {
constexpr int OFF_F = 0, OFF_SC = 8448, OFF_P = 8704, OFF_A = OFF_P + 8 * 4096, OFF_ML = OFF_A + 512, OFF_O = OFF_ML + 1024;
struct Tensors { const bf16_t* q; const bf16_t* kb; const bf16_t* vb; bf16_t* og; const bf16_t* sg; const float* ck; const float* cv; const float* clf; const float* lfts; };
__device__ __forceinline__ void item(int wv, char* lds, const Tensors& T, int b, int h) {
    const int tid = otid(wv), wid = __builtin_amdgcn_readfirstlane(tid >> 6), lane = tid & 63, fr = lane & 15, fq = lane >> 4, half = lane >> 5, dl = (lane & 31) * 4;
    float* Fl = (float*)(lds + OFF_F); float* scn = (float*)(lds + OFF_SC);
    float* Pw = (float*)(lds + OFF_P) + wid * 1024; float* Aw = (float*)(lds + OFF_A) + wid * 16; float* ML = (float*)(lds + OFF_ML); float* Op = (float*)(lds + OFF_O);
    { const float* cl = T.clf + ((size_t)b * PAST + tid * 4) * NH + h;
      float a0 = cl[0], a1 = cl[NH], a2 = cl[2 * NH], a3 = cl[3 * NH];
      a1 += a0; a2 += a1; a3 += a2;
      const float tot = a3; float inc = tot;
#pragma unroll
      for (int o = 1; o < 64; o <<= 1) { const float v = bperm(inc, (lane - o) & 63); if (lane >= o) inc += v; }
      if (lane == 63) scn[wid] = inc;
      __syncthreads();
      float base = inc - tot, all = 0.f;
      for (int w = 0; w < 8; ++w) { const float sw = scn[w]; if (w < wid) base += sw; all += sw; }
      *(f32x4*)(Fl + tid * 4) = (f32x4){(a0 + base) * (-LOG2E), (a1 + base) * (-LOG2E), (a2 + base) * (-LOG2E), (a3 + base) * (-LOG2E)};
      if (tid < DSEQ) { const float* nl = T.lfts + ((size_t)b * NH + h) * DSEQ; float s = all; for (int i = 0; i <= tid; ++i) s += nl[i]; Fl[PAST + tid] = s * (-LOG2E); }
      __syncthreads(); }
    const size_t qrow = (size_t)(MP + b * DSEQ);
    bf16x8 qf[4];
#pragma unroll
    for (int dc = 0; dc < 4; ++dc) qf[dc] = *(const bf16x8*)(T.q + (qrow + fr) * DM + h * HD + dc * 32 + fq * 8);
    float m_run = -1e30f, l_run = 0.f;
    f32x4 oacc[16];
#pragma unroll
    for (int q = 0; q < 16; ++q) oacc[q] = (f32x4){0.f, 0.f, 0.f, 0.f};
    for (int ch = 0; ch < 4; ++ch) {
        const int key0 = (ch * 8 + wid) * 64;
        f32x4 s4[4];
#pragma unroll
        for (int tl = 0; tl < 4; ++tl) { const int kbase = key0 + tl * 16;
            const float* kp = T.ck + (((size_t)b * PAST + kbase + fr) * NH + h) * HD + fq * 8;
            f32x4 acc = *(const f32x4*)(Fl + kbase + fq * 4);
#pragma unroll
            for (int dc = 0; dc < 4; ++dc) { const f32x4 x0 = *(const f32x4*)(kp + dc * 32), x1 = *(const f32x4*)(kp + dc * 32 + 4);
                acc = __builtin_amdgcn_mfma_f32_16x16x32_bf16(pack8(x0, x1), qf[dc], acc, 0, 0, 0); }
            s4[tl] = acc; }
        float cm = s4[0][0];
#pragma unroll
        for (int tl = 0; tl < 4; ++tl)
#pragma unroll
            for (int j = 0; j < 4; ++j) cm = fmaxf(cm, s4[tl][j]);
        cm = xmax16(cm); cm = xmax32(cm);
        const float mn = fmaxf(m_run, cm), alpha = __builtin_amdgcn_exp2f(m_run - mn); m_run = mn;
        float ps = 0.f;
#pragma unroll
        for (int tl = 0; tl < 4; ++tl)
#pragma unroll
            for (int j = 0; j < 4; ++j) { const float p = __builtin_amdgcn_exp2f(s4[tl][j] - mn); ps += p; Pw[(tl * 16 + fq * 4 + j) * 16 + fr] = p; }
        ps = xsum16(ps); ps = xsum32(ps);
        l_run = l_run * alpha + ps;
        if (fq == 0) Aw[fr] = alpha;
        asm volatile("s_waitcnt lgkmcnt(0)" ::: "memory");
        { const f32x4 a0 = *(const f32x4*)(Aw), a1 = *(const f32x4*)(Aw + 4), a2 = *(const f32x4*)(Aw + 8), a3 = *(const f32x4*)(Aw + 12);
#pragma unroll
          for (int j = 0; j < 4; ++j) { oacc[j] *= a0[j]; oacc[4 + j] *= a1[j]; oacc[8 + j] *= a2[j]; oacc[12 + j] *= a3[j]; } }
        const float* vp = T.cv + (((size_t)b * PAST + key0 + half) * NH + h) * HD + dl;
#pragma unroll 8
        for (int kp2 = 0; kp2 < 32; ++kp2) { const f32x4 v = *(const f32x4*)(vp + (size_t)kp2 * 2 * NH * HD);
            const float* pr = Pw + (2 * kp2 + half) * 16;
            const f32x4 p0 = *(const f32x4*)(pr), p1 = *(const f32x4*)(pr + 4), p2 = *(const f32x4*)(pr + 8), p3 = *(const f32x4*)(pr + 12);
#pragma unroll
            for (int j = 0; j < 4; ++j) { oacc[j] += v * p0[j]; oacc[4 + j] += v * p1[j]; oacc[8 + j] += v * p2[j]; oacc[12 + j] += v * p3[j]; } }
        asm volatile("s_waitcnt lgkmcnt(0)" ::: "memory");
    }
    if (wid == 0) {
        f32x4 acc = *(const f32x4*)(Fl + PAST + fq * 4);
        const bf16_t* kp = T.kb + (qrow + fr) * DM + h * HD + fq * 8;
#pragma unroll
        for (int dc = 0; dc < 4; ++dc) acc = __builtin_amdgcn_mfma_f32_16x16x32_bf16(*(const bf16x8*)(kp + dc * 32), qf[dc], acc, 0, 0, 0);
#pragma unroll
        for (int j = 0; j < 4; ++j) if (fq * 4 + j > fr) acc[j] = -__builtin_inff();
        float cm = fmaxf(fmaxf(acc[0], acc[1]), fmaxf(acc[2], acc[3]));
        cm = xmax16(cm); cm = xmax32(cm);
        const float mn = fmaxf(m_run, cm), alpha = __builtin_amdgcn_exp2f(m_run - mn); m_run = mn;
        float ps = 0.f;
#pragma unroll
        for (int j = 0; j < 4; ++j) { const float p = __builtin_amdgcn_exp2f(acc[j] - mn); ps += p; Pw[(fq * 4 + j) * 16 + fr] = p; }
        ps = xsum16(ps); ps = xsum32(ps);
        l_run = l_run * alpha + ps;
        if (fq == 0) Aw[fr] = alpha;
        asm volatile("s_waitcnt lgkmcnt(0)" ::: "memory");
        { const f32x4 a0 = *(const f32x4*)(Aw), a1 = *(const f32x4*)(Aw + 4), a2 = *(const f32x4*)(Aw + 8), a3 = *(const f32x4*)(Aw + 12);
#pragma unroll
          for (int j = 0; j < 4; ++j) { oacc[j] *= a0[j]; oacc[4 + j] *= a1[j]; oacc[8 + j] *= a2[j]; oacc[12 + j] *= a3[j]; } }
        const bf16_t* vp = T.vb + (qrow + half) * DM + h * HD + dl;
#pragma unroll
        for (int kp2 = 0; kp2 < 8; ++kp2) { const u32x2 vw = *(const u32x2*)(vp + (size_t)kp2 * 2 * DM);
            const f32x4 v = {bflo(vw.x), bfhi(vw.x), bflo(vw.y), bfhi(vw.y)};
            const float* pr = Pw + (2 * kp2 + half) * 16;
            const f32x4 p0 = *(const f32x4*)(pr), p1 = *(const f32x4*)(pr + 4), p2 = *(const f32x4*)(pr + 8), p3 = *(const f32x4*)(pr + 12);
#pragma unroll
            for (int j = 0; j < 4; ++j) { oacc[j] += v * p0[j]; oacc[4 + j] += v * p1[j]; oacc[8 + j] += v * p2[j]; oacc[12 + j] += v * p3[j]; } }
        asm volatile("s_waitcnt lgkmcnt(0)" ::: "memory");
    }
#pragma unroll
    for (int q = 0; q < 16; ++q)
#pragma unroll
        for (int c = 0; c < 4; ++c) oacc[q][c] = xsum32(oacc[q][c]);
    if (lane < 32) {
#pragma unroll
        for (int q = 0; q < 16; ++q) *(f32x4*)(Op + (wid * 16 + q) * HD + dl) = oacc[q]; }
    if (fq == 0) { ML[(wid * 16 + fr) * 2] = m_run; ML[(wid * 16 + fr) * 2 + 1] = l_run; }
    __syncthreads();
    { const int q = tid >> 5, d4 = (tid & 31) * 4;
      float mx = ML[q * 2];
#pragma unroll
      for (int w = 1; w < 8; ++w) mx = fmaxf(mx, ML[(w * 16 + q) * 2]);
      float L = 0.f; f32x4 O = {0.f, 0.f, 0.f, 0.f};
#pragma unroll
      for (int w = 0; w < 8; ++w) { const float s = __builtin_amdgcn_exp2f(ML[(w * 16 + q) * 2] - mx); L += s * ML[(w * 16 + q) * 2 + 1]; O += *(const f32x4*)(Op + (w * 16 + q) * HD + d4) * s; }
      const float il = 1.0f / L; const size_t off = (qrow + q) * DM + h * HD + d4;
      const u32x2 gw = *(const u32x2*)(T.sg + off);
      u32x2 w; w.x = cvtpk(O[0] * il * bflo(gw.x), O[1] * il * bfhi(gw.x)); w.y = cvtpk(O[2] * il * bflo(gw.y), O[3] * il * bfhi(gw.y));
      *(u32x2*)(T.og + off) = w; }
    __syncthreads();
}
}

__device__ __forceinline__ void transpose_item(const float* W, int ldw, int N, bf16_t* WT, int K, const float* g, float* scr, int item, int lane) {
    const int nblk = (N + 31) / 32, kb = item / nblk, nb = item % nblk, k0 = 64 * kb, n0 = 32 * nb;
    const int c4 = (lane & 7) * 4, kr = lane >> 3; const bool nok = n0 + c4 < N;
    f32x4 v[8];
#pragma unroll
    for (int i = 0; i < 8; ++i) v[i] = nok ? *(const f32x4*)(W + (size_t)(k0 + 8 * i + kr) * ldw + n0 + c4) : (f32x4){0.f, 0.f, 0.f, 0.f};
    if (g) {
#pragma unroll
        for (int i = 0; i < 8; ++i) v[i] *= g[k0 + 8 * i + kr]; }
#pragma unroll
    for (int i = 0; i < 8; ++i) { float* s = scr + (8 * i + kr) * 33 + c4; s[0] = v[i][0]; s[1] = v[i][1]; s[2] = v[i][2]; s[3] = v[i][3]; }
    asm volatile("s_waitcnt lgkmcnt(0)" ::: "memory");
    const int c = lane & 7;
#pragma unroll
    for (int j = 0; j < 4; ++j) { const int nn = (lane >> 3) + 8 * j; const float* s = scr + (8 * c) * 33 + nn;
        u32x4 o; o.x = cvtpk(s[0 * 33], s[1 * 33]); o.y = cvtpk(s[2 * 33], s[3 * 33]); o.z = cvtpk(s[4 * 33], s[5 * 33]); o.w = cvtpk(s[6 * 33], s[7 * 33]);
        if (n0 + nn < N) *(u32x4*)(WT + (size_t)(n0 + nn) * K + k0 + 8 * c) = o; }
    asm volatile("s_waitcnt lgkmcnt(0)" ::: "memory");
}
struct TJob { const float* W; bf16_t* WT; const float* g; int K, N, ldw; };
__device__ __forceinline__ TJob get_job(const Params& p, int j) {
    unsigned char* ws = p.ws; TJob t; t.g = nullptr; t.ldw = 0;
    if (j < 2) { t.W = p.in[7] + (size_t)j * DM * 2 * EA + EA; t.WT = (bf16_t*)(ws + WS_WINA) + (size_t)j * 2 * EA * DM + (size_t)EA * DM; t.g = p.in[6] + j * DM; t.K = DM; t.N = EA; t.ldw = 2 * EA; }
    else if (j >= 17) { const int l = j - 17; t.W = p.in[7] + (size_t)l * DM * 2 * EA; t.WT = (bf16_t*)(ws + WS_WINUT) + (size_t)l * EA * DM; t.g = p.in[6] + l * DM; t.K = DM; t.N = EA; t.ldw = 2 * EA; }
    else if (j < 10) { const int i = j - 2; t.W = p.in[8] + (size_t)i * 1024 * 1024; t.WT = (bf16_t*)(ws + WS_WGRP) + (size_t)i * 1024 * 1024; t.K = 1024; t.N = 1024; }
    else if (j < 12) { const int l = j - 10; t.W = p.in[10] + (size_t)l * EA * DM; t.WT = (bf16_t*)(ws + WS_WOUTA) + (size_t)l * DM * EA; t.K = EA; t.N = DM; }
    else if (j == 12) { t.W = p.in[12]; t.WT = (bf16_t*)(ws + WS_W4); t.g = p.in[11]; t.K = DM; t.N = 2 * DM + NH; }
    else if (j == 13) { t.W = p.in[15]; t.WT = (bf16_t*)(ws + WS_W4) + (size_t)4352 * DM; t.g = p.in[14]; t.K = DM; t.N = 2 * DM; }
    else if (j == 14) { t.W = p.in[15] + (size_t)DM * 2 * DM; t.WT = (bf16_t*)(ws + WS_WINB1); t.g = p.in[14] + DM; t.K = DM; t.N = 2 * DM; }
    else { const int l = j - 15; t.W = p.in[16] + (size_t)l * DM * DM; t.WT = (bf16_t*)(ws + WS_WOUTB) + (size_t)l * DM * DM; t.K = DM; t.N = DM; }
    if (t.ldw == 0) t.ldw = t.N;
    return t;
}
__device__ __forceinline__ void prologue_phase(int wv, const Params& p, char* lds) {
    const int tid = otid(wv), lane = tid & 63, wid = tid >> 6, G = gridDim.x;
    const int gw = blockIdx.x * NWAVES + wid, NGW = G * NWAVES;
    float* scr = (float*)(lds + wid * 8704);
    int rot = 0;
    for (int j = 0; j < 19; ++j) { const TJob t = get_job(p, j); const int nitems = (t.K / 64) * ((t.N + 31) / 32);
        int start = gw - rot; if (start < 0) start += NGW;
        for (int it = start; it < nitems; it += NGW) transpose_item(t.W, t.ldw, t.N, t.WT, t.K, t.g, scr, it, lane);
        rot = (rot + nitems) % NGW; }
    float* ssq = (float*)(p.ws + WS_SSQ); bf16_t* xb = (bf16_t*)(p.ws + WS_XB);
    for (int m = gw; m < MT; m += NGW) { const float* xr = m < MP ? p.in[0] + (size_t)m * DM : p.in[1] + (size_t)(m - MP) * DM;
        float s = 0.f; unsigned long long* o8 = (unsigned long long*)(xb + (size_t)m * DM) + lane;
#pragma unroll
        for (int j = 0; j < 8; ++j) { const f32x4 v = *((const f32x4*)xr + lane + 64 * j); s += (v[0] * v[0] + v[1] * v[1]) + (v[2] * v[2] + v[3] * v[3]);
            o8[64 * j] = (unsigned long long)cvtpk(v[0], v[1]) | ((unsigned long long)cvtpk(v[2], v[3]) << 32); }
        s = wave_sum(s); if (lane == 0) ssq[m] = s; }
    for (int i = blockIdx.x * NTHREADS + tid; i < 4 * MT; i += G * NTHREADS) ssq[MT + i] = 0.f;
    { f32x4* z = (f32x4*)(p.ws + WS_SPLIT); const size_t nz = (SPLIT_TILES * SPLIT_TILE + SPLIT_TILES * 8 * 4) / 16;
      for (size_t i = (size_t)blockIdx.x * NTHREADS + tid; i < nz; i += (size_t)G * NTHREADS) z[i] = (f32x4){0.f, 0.f, 0.f, 0.f}; }
    { bf16_t* wus = (bf16_t*)(p.ws + WS_WINUS);
      for (int i = blockIdx.x * NTHREADS + tid; i < 2 * DM * (EA / 8); i += G * NTHREADS) { const int r = i >> 9, c = (i & 511) * 8, l = r >> 11, k = r & (DM - 1);
          const float* s = p.in[7] + ((size_t)l * DM + k) * 2 * EA + c; const float gk = p.in[6][l * DM + k];
          *(bf16x8*)(wus + (size_t)r * EA + c) = pack8(*(const f32x4*)s * gk, *(const f32x4*)(s + 4) * gk); }
      bf16_t* pb = (bf16_t*)(p.ws + WS_PREVB);
      for (int i = blockIdx.x * NTHREADS + tid; i < 2 * 256 * (EA / 8); i += G * NTHREADS) { const int r = i >> 9, c = (i & 511) * 8, l = r >> 8, rr = r & 255;
          f32x4 a = {0.f, 0.f, 0.f, 0.f}, b = a;
          if (rr < NDB * PPAD) { const float* s = p.in[5] + ((size_t)l * NDB * PPAD + rr) * EA + c; a = *(const f32x4*)s; b = *(const f32x4*)(s + 4); }
          *(bf16x8*)(pb + (size_t)r * EA + c) = pack8(a, b); } }
}
template <int W>
__device__ __forceinline__ void poolmix_item(const bf16_t* tt, const bf16_t* sg, const float* scale, const bf16_t* prevt, bf16_t* yg, int row0, int ch) {
    constexpr int NR = 16 + W - 1;
    u32x4 rows[NR];
    const bool samp = row0 >= MP; const int t0 = samp ? 0 : (row0 & (SEQ - 1));
    const bf16_t* up = tt + (size_t)row0 * EA + ch;
    if (t0 != 0) {
#pragma unroll
        for (int i = 0; i < NR; ++i) rows[i] = *(const u32x4*)(up + (ptrdiff_t)(i - (W - 1)) * EA);
    } else {
#pragma unroll
        for (int i = W - 1; i < NR; ++i) rows[i] = *(const u32x4*)(up + (ptrdiff_t)(i - (W - 1)) * EA);
        if (samp) { const bf16_t* pp = prevt + ((size_t)((row0 - MP) >> 4) * PPAD + (PPAD - (W - 1))) * EA + ch;
#pragma unroll
            for (int i = 0; i < W - 1; ++i) rows[i] = *(const u32x4*)(pp + (size_t)i * EA); }
        else {
#pragma unroll
            for (int i = 0; i < W - 1; ++i) rows[i] = (u32x4){0u, 0u, 0u, 0u}; }
    }
    const f32x4 sc0 = *(const f32x4*)(scale + ch), sc1 = *(const f32x4*)(scale + ch + 4);
    float s[8] = {0.f, 0.f, 0.f, 0.f, 0.f, 0.f, 0.f, 0.f};
#define ROWF(v, f) const float f[8] = {bflo(v.x), bfhi(v.x), bflo(v.y), bfhi(v.y), bflo(v.z), bfhi(v.z), bflo(v.w), bfhi(v.w)}
#pragma unroll
    for (int i = 0; i < W - 1; ++i) { ROWF(rows[i], f);
#pragma unroll
        for (int c = 0; c < 8; ++c) s[c] += f[c]; }
#pragma unroll
    for (int j = 0; j < 16; ++j) { ROWF(rows[j + W - 1], f);
        const u32x4 gv = *(const u32x4*)(sg + (size_t)(row0 + j) * EA + ch); ROWF(gv, gt);
#pragma unroll
        for (int c = 0; c < 8; ++c) s[c] += f[c];
        const int nv = (!samp && t0 + j + 1 < W) ? t0 + j + 1 : W; const float ic = 1.0f / (float)nv;
        u32x4 o; o.x = cvtpk((s[0] * ic - f[0]) * sc0[0] * gt[0], (s[1] * ic - f[1]) * sc0[1] * gt[1]); o.y = cvtpk((s[2] * ic - f[2]) * sc0[2] * gt[2], (s[3] * ic - f[3]) * sc0[3] * gt[3]);
        o.z = cvtpk((s[4] * ic - f[4]) * sc1[0] * gt[4], (s[5] * ic - f[5]) * sc1[1] * gt[5]); o.w = cvtpk((s[6] * ic - f[6]) * sc1[2] * gt[6], (s[7] * ic - f[7]) * sc1[3] * gt[7]);
        *(u32x4*)(yg + (size_t)(row0 + j) * EA + ch) = o;
        ROWF(rows[j], g);
#pragma unroll
        for (int c = 0; c < 8; ++c) s[c] -= g[c]; }
#undef ROWF
}
__device__ __forceinline__ void poolmix_phase(int wv, const Params& p, int l) {
    const bf16_t* tt = (const bf16_t*)(p.ws + WS_U); const bf16_t* sg = (const bf16_t*)(p.ws + WS_SG); bf16_t* yg = (bf16_t*)(p.ws + WS_D);
    const bf16_t* prevt = (const bf16_t*)(p.ws + WS_PREVT) + (size_t)l * 256 * EA; const float* scale = p.in[9] + (size_t)l * EA;
    const int nth = gridDim.x * NTHREADS;
    for (int idx = blockIdx.x * NTHREADS + otid(wv); idx < (MT / 16) * (EA / 8); idx += nth) {
        const int row0 = (idx >> 9) * 16, ch = (idx & 511) * 8, grp = __builtin_amdgcn_readfirstlane(ch >> 10);
        if (grp == 0) poolmix_item<2>(tt, sg, scale, prevt, yg, row0, ch);
        else if (grp == 1) poolmix_item<4>(tt, sg, scale, prevt, yg, row0, ch);
        else if (grp == 2) poolmix_item<8>(tt, sg, scale, prevt, yg, row0, ch);
        else poolmix_item<16>(tt, sg, scale, prevt, yg, row0, ch);
    }
}
__device__ __forceinline__ void final_phase(int wv, const Params& p) {
    const int tid = otid(wv), lane = tid & 63, gw = blockIdx.x * NWAVES + (tid >> 6), NGW = gridDim.x * NWAVES;
    const float* xres = (const float*)(p.ws + WS_XRES); const float* ssq = (const float*)(p.ws + WS_SSQ) + (size_t)4 * MT; const float* g = p.in[17];
    for (int m = gw; m < MT; m += NGW) { const float rr = rsqrtf(ssq[m] * (1.0f / DM) + EPS);
        const f32x4* xr = (const f32x4*)(xres + (size_t)m * DM) + lane; f32x4* o = (f32x4*)(p.out + (m < MP ? O_YP + (size_t)m * DM : O_YS + (size_t)(m - MP) * DM)) + lane;
#pragma unroll
        for (int j = 0; j < 8; ++j) o[64 * j] = xr[64 * j] * rr * ((const f32x4*)g)[lane + 64 * j]; }
}

constexpr int NPHASES = 15;
typedef const __attribute__((address_space(4))) Params* KArgPtr;
#if defined(__HIP_DEVICE_COMPILE__)
#define LOADP_() KArgPtr kp_ = (KArgPtr)__builtin_amdgcn_kernarg_segment_ptr(); asm volatile("" : "+s"(kp_)); Params lp; _Pragma("unroll") for (int i_ = 0; i_ < 18; ++i_) lp.in[i_] = kp_->in[i_]; lp.out = kp_->out; lp.ws = kp_->ws; lp.ph_lo = 0; lp.ph_hi = 0
#else
#define LOADP_() const Params lp = p
#endif
#define LOADP() LOADP_(); unsigned char* const ws = lp.ws; \
    float* const ssq = (float*)(ws + WS_SSQ); bf16_t* const xb = (bf16_t*)(ws + WS_XB); float* const xres = (float*)(ws + WS_XRES); (void)ssq; (void)xb; (void)xres
__global__ void __launch_bounds__(NTHREADS, 2) yoco_fwd(Params p) {
    extern __shared__ __attribute__((aligned(16))) unsigned char lds_raw[];
    char* lds = (char*)lds_raw; LAS unsigned char* ldsl = (LAS unsigned char*)lds_raw;
    const int G = gridDim.x, bx = blockIdx.x, wv = __builtin_amdgcn_readfirstlane(threadIdx.x >> 6);
#ifndef ONLY_PHASE
#define ONLY_PHASE -1
#endif
#define IN(k) ((ONLY_PHASE < 0 || ONLY_PHASE == (k)) && p.ph_lo <= (k) && (k) < p.ph_hi)
#ifndef SAT_REP
#define SAT_REP 1
#endif
#ifndef REPEAT_MASK
#define REPEAT_MASK 0
#endif
#define NREP(k) (1 + (int)(((unsigned)(REPEAT_MASK) >> (k)) & 1u))
#define SEAM(k) do { if (rep_ + 1 < NREP(k) || (k) + 1 < p.ph_hi) cg::this_grid().sync(); } while (0)
    if (IN(0)) for (int rep_ = 0; rep_ < NREP(0); ++rep_) { { LOADP(); prologue_phase(wv, lp, lds); } SEAM(0); }
    if (IN(1)) for (int rep_ = 0; rep_ < NREP(1); ++rep_) {
        { LOADP(); pg8::Gemm g{(const bf16_t*)(ws + WS_WGRP), (const bf16_t*)(ws + WS_WINUS), 1024, 1024, EA, 2, nullptr, nullptr}; pg8::StaticOrder S; S.init(32, 8, G, bx);
          pg8::EpiStore E{(bf16_t*)(ws + WS_WINA), DM, 1};
          pg8::gemm_phase<pg8::EpiStore, pg8::StaticOrder>(wv, ldsl, g, S, E); }
        { LOADP(); pg8::Gemm g{(const bf16_t*)(ws + WS_PREVB), (const bf16_t*)(ws + WS_WGRP), 1024, EA, 1024, 3, nullptr, nullptr}; pg8::StaticOrder S; S.init(2, 16, G, bx);
          pg8::EpiStore E{(bf16_t*)(ws + WS_PREVT), EA, 0};
          pg8::gemm_phase<pg8::EpiStore, pg8::StaticOrder>(wv, ldsl, g, S, E); }
        SEAM(1); }
#pragma unroll 1
    for (int l = 0; l < 2; ++l) {
        int wv_o = wv, bx_o = bx, G_o = G; asm volatile("" : "+s"(wv_o), "+s"(bx_o), "+s"(G_o));
        const int wv = wv_o, bx = bx_o, G = G_o;
        if (IN(2 + 3 * l)) for (int rep_ = 0; rep_ < NREP(2 + 3 * l); ++rep_) {
            { LOADP(); bf16_t* u = (bf16_t*)(ws + WS_U); bf16_t* sg = (bf16_t*)(ws + WS_SG);
              pg8::Gemm g{xb, (const bf16_t*)(ws + WS_WINA) + (size_t)l * 2 * EA * DM, DM, DM, DM, 0, nullptr, nullptr}; pg8::StaticOrder S; S.init(65, 32, G, bx);
              pg8::EpiInA E{ssq + (size_t)l * MT, u, sg};
              pg8::gemm_phase<pg8::EpiInA, pg8::StaticOrder>(wv, ldsl, g, S, E); }
            { LOADP(); pg8::Gemm g{xb, (const bf16_t*)(ws + WS_WINUT) + (size_t)l * EA * DM, DM, DM, DM, 0, nullptr, nullptr}; pg8::StateOrder S{G, bx};
              pg8::EpiUState E{ssq + (size_t)l * MT, lp.out + O_PP + (size_t)l * NBATCH * PPAD * EA, lp.out + O_PS + (size_t)l * NDB * PPAD * EA};
              pg8::gemm_phase<pg8::EpiUState, pg8::StateOrder>(wv, ldsl, g, S, E); }
            SEAM(2 + 3 * l); }
        if (IN(3 + 3 * l)) for (int rep_ = 0; rep_ < NREP(3 + 3 * l); ++rep_) { { LOADP(); poolmix_phase(wv, lp, l); } SEAM(3 + 3 * l); }
        if (IN(4 + 3 * l)) for (int rep_ = 0; rep_ < NREP(4 + 3 * l); ++rep_) { { LOADP(); bf16_t* yg = (bf16_t*)(ws + WS_D);
            pg8::Gemm g{yg, (const bf16_t*)(ws + WS_WOUTA) + (size_t)l * DM * EA, EA, EA, EA, 0, (float*)(ws + WS_SPLIT) + (size_t)l * 8 * 65536, (unsigned*)(ws + WS_SPCNT) + l * 64}; pg8::SplitOrder S; S.init(8, 8, G, bx);
            pg8::EpiRes E{l == 0 ? lp.in[0] : xres, l == 0 ? lp.in[1] : xres + (size_t)MP * DM, xres, xb, ssq + (size_t)(l + 1) * MT};
            pg8::gemm_phase<pg8::EpiRes, pg8::SplitOrder>(wv, ldsl, g, S, E); } SEAM(4 + 3 * l); }
    }
#pragma unroll 1
    for (int lb = 0; lb < 2; ++lb) {
        int wv_o = wv, bx_o = bx, G_o = G; asm volatile("" : "+s"(wv_o), "+s"(bx_o), "+s"(G_o));
        const int wv = wv_o, bx = bx_o, G = G_o;
        if (IN(8 + 3 * lb)) for (int rep_ = 0; rep_ < NREP(8 + 3 * lb); ++rep_) { { LOADP();
            pg8::EpiKVQ E{lb == 0 ? 0 : 17, ssq + (size_t)(2 + lb) * MT, lp.out, ws, lp.in[13]};
            if (lb == 0) { pg8::Gemm g{xb, (const bf16_t*)(ws + WS_W4), DM, DM, DM, 0, nullptr, nullptr}; pg8::StaticOrder S; S.init(65, 33, G, bx);
                pg8::gemm_phase<pg8::EpiKVQ, pg8::StaticOrder>(wv, ldsl, g, S, E); }
            else { pg8::Gemm g{xb, (const bf16_t*)(ws + WS_WINB1), DM, DM, DM, 0, (float*)(ws + WS_SPLIT) + (size_t)32 * 65536, (unsigned*)(ws + WS_SPCNT) + 256}; pg8::SplitOrder S; S.init(16, 4, G, bx);
                pg8::gemm_phase<pg8::EpiKVQ, pg8::SplitOrder>(wv, ldsl, g, S, E); } } SEAM(8 + 3 * lb); }
        if (IN(9 + 3 * lb)) for (int rep_ = 0; rep_ < NREP(9 + 3 * lb); ++rep_) {
            for (int half_ = 0; half_ < 2; ++half_) {
                if (((bx & 1) == 0) == (half_ == 0)) { LOADP();
                    sat::Tensors ST{(const bf16_t*)(ws + WS_QB), (const bf16_t*)(ws + WS_KB), (const bf16_t*)(ws + WS_VB), (bf16_t*)(ws + WS_OG), (const bf16_t*)(ws + WS_SGB),
                                    lp.in[2], lp.in[3], lp.in[4], (const float*)(ws + WS_LFTS)};
                    for (int it = bx; it < NDB * NH; it += G) sat::item(wv, lds, ST, it >> 4, it & 15); }
                if (half_ == 0) { LOADP(); const int vw = (G % 8 == 0) ? (bx % 8) * (G / 8) + bx / 8 : bx;
                    att::Tensors AT{(const bf16_t*)(ws + WS_QB), (const bf16_t*)(ws + WS_KB), (const bf16_t*)(ws + WS_VB), (bf16_t*)(ws + WS_OG), (const bf16_t*)(ws + WS_SGB), (const float*)(ws + WS_LFTP)};
                    att::prompt_phase(wv, lds, AT, (const float*)(ws + WS_KNRM), (const float*)(ws + WS_QNRM), vw, G); } }
            SEAM(9 + 3 * lb); }
        if (IN(10 + 3 * lb)) for (int rep_ = 0; rep_ < NREP(10 + 3 * lb); ++rep_) { { LOADP();
            pg8::Gemm g{(const bf16_t*)(ws + WS_OG), (const bf16_t*)(ws + WS_WOUTB) + (size_t)lb * DM * DM, DM, DM, DM, 0, (float*)(ws + WS_SPLIT) + (size_t)(2 + lb) * 8 * 65536, (unsigned*)(ws + WS_SPCNT) + (2 + lb) * 64}; pg8::SplitOrder S; S.init(8, 4, G, bx);
            pg8::EpiRes E{xres, xres + (size_t)MP * DM, xres, xb, ssq + (size_t)(3 + lb) * MT};
            pg8::gemm_phase<pg8::EpiRes, pg8::SplitOrder>(wv, ldsl, g, S, E); } SEAM(10 + 3 * lb); }
    }
    if (IN(14)) { LOADP(); final_phase(wv, lp); }
#undef IN
#undef SEAM
}

extern "C" void kernel_launch(void* const* d_in, const int* in_sizes, int n_in, void* d_out, int out_size, void* d_ws, size_t ws_size, hipStream_t stream) {
    static int grid = 0;
    if (grid == 0) {
        if (n_in != 18 || (size_t)out_size != O_END || ws_size < WS_END) { fprintf(stderr, "kernel_launch: unexpected shapes: n_in %d out %d (want %zu) ws %zu (need %zu)\n", n_in, out_size, (size_t)O_END, ws_size, (size_t)WS_END); grid = -1; return; }
        int dev = 0, cus = 0, per_cu = 0;
        (void)hipGetDevice(&dev); (void)hipDeviceGetAttribute(&cus, hipDeviceAttributeMultiprocessorCount, dev);
        if (hipFuncSetAttribute((const void*)yoco_fwd, hipFuncAttributeMaxDynamicSharedMemorySize, LDS_BYTES) != hipSuccess) { fprintf(stderr, "kernel_launch: hipFuncSetAttribute failed\n"); grid = -1; return; }
        if (hipOccupancyMaxActiveBlocksPerMultiprocessor(&per_cu, (const void*)yoco_fwd, NTHREADS, LDS_BYTES) != hipSuccess || per_cu < 1) { fprintf(stderr, "kernel_launch: occupancy query gave %d\n", per_cu); per_cu = 1; }
        (void)hipGetLastError();
        grid = cus > 0 ? cus : 256;
    }
    if (grid < 0) return;
    Params p{};
    for (int i = 0; i < 18; ++i) p.in[i] = (const float*)d_in[i];
    p.out = (float*)d_out; p.ws = (unsigned char*)d_ws;
#if MULTI_LAUNCH
    for (int ph = 0; ph < NPHASES; ++ph) { p.ph_lo = ph; p.ph_hi = ph + 1; hipLaunchKernelGGL(yoco_fwd, dim3(grid), dim3(NTHREADS), LDS_BYTES, stream, p); }
#else
    p.ph_lo = 0; p.ph_hi = NPHASES;
    void* args[] = {&p};
    hipError_t e = hipLaunchCooperativeKernel((const void*)yoco_fwd, dim3(grid), dim3(NTHREADS), args, LDS_BYTES, stream);
    if (e != hipSuccess) fprintf(stderr, "kernel_launch: cooperative launch failed: %s (grid %d)\n", hipGetErrorString(e), grid);
#endif
}
```

```cpp
#include <hip/hip_runtime.h>
#include <hip/hip_cooperative_groups.h>
#include <cstdio>
#include <cstdint>
namespace cg = cooperative_groups;

#ifndef MULTI_LAUNCH
#define MULTI_LAUNCH 0
#endif

#define LAS __attribute__((address_space(3)))
typedef unsigned short bf16_t;
typedef short bf16x8 __attribute__((ext_vector_type(8)));
typedef short s16x4 __attribute__((ext_vector_type(4)));
typedef float f32x4 __attribute__((ext_vector_type(4)));
typedef float f32x16 __attribute__((ext_vector_type(16)));
typedef unsigned u32x4 __attribute__((ext_vector_type(4)));
typedef unsigned u32x2 __attribute__((ext_vector_type(2)));

constexpr int DM = 2048, NBATCH = 4, SEQ = 4096, NDB = 16, DSEQ = 16, PAST = 2048, EA = 4096, NH = 16, HD = 128, PPAD = 15;
constexpr int MP = NBATCH * SEQ, MS = NDB * DSEQ, MT = MP + MS;
constexpr float EPS = 1e-6f;
constexpr float LOG2E = 1.4426950408889634f;
constexpr float QSCALE = 0.08838834764831845f * 1.4426950408889634f;
constexpr int NTHREADS = 512, NWAVES = 8;
constexpr int LDS_BYTES = 131072;

constexpr size_t O_YP = 0, O_YS = O_YP + (size_t)MP * DM, O_KP = O_YS + (size_t)MS * DM, O_VP = O_KP + (size_t)MP * DM,
                 O_LFP = O_VP + (size_t)MP * DM, O_PP = O_LFP + (size_t)MP * NH, O_KS = O_PP + (size_t)2 * NBATCH * PPAD * EA,
                 O_VS = O_KS + (size_t)MS * DM, O_LFS = O_VS + (size_t)MS * DM, O_PS = O_LFS + (size_t)MS * NH, O_END = O_PS + (size_t)2 * NDB * PPAD * EA;

constexpr size_t al256(size_t x) { return (x + 255) & ~(size_t)255; }
constexpr size_t WS_WINA = 0;
constexpr size_t WS_WGRP = WS_WINA + (size_t)2 * 8192 * 2048 * 2;
constexpr size_t WS_WOUTA = WS_WGRP + (size_t)2 * 4096 * 1024 * 2;
constexpr size_t WS_W4 = WS_WOUTA + (size_t)2 * 2048 * 4096 * 2;
constexpr size_t WS_WINB1 = WS_W4 + (size_t)8448 * 2048 * 2;
constexpr size_t WS_WOUTB = WS_WINB1 + (size_t)4096 * 2048 * 2;
constexpr size_t WS_XB = WS_WOUTB + (size_t)2 * 2048 * 2048 * 2;
constexpr size_t WS_XRES = WS_XB + (size_t)MT * DM * 2;
constexpr size_t WS_SSQ = WS_XRES + (size_t)MT * DM * 4;
constexpr size_t WS_LFTP = al256(WS_SSQ + (size_t)5 * MT * 4);
constexpr size_t WS_LFTS = WS_LFTP + (size_t)NBATCH * NH * SEQ * 4;
constexpr size_t WS_KNRM = al256(WS_LFTS + (size_t)NDB * NH * DSEQ * 4);
constexpr size_t WS_QNRM = WS_KNRM + (size_t)MT * NH * 4 * 4;
constexpr size_t WS_WINUT = al256(WS_QNRM + (size_t)MT * NH * 4 * 4);
constexpr size_t WS_WINUS = WS_WINUT + (size_t)2 * EA * DM * 2;
constexpr size_t WS_PREVB = WS_WINUS + (size_t)2 * DM * EA * 2;
constexpr size_t WS_PREVT = WS_PREVB + (size_t)2 * 256 * EA * 2;
constexpr size_t WS_SPLIT = al256(WS_PREVT + (size_t)2 * 256 * EA * 2);
constexpr size_t SPLIT_TILE = 65536 * 4, SPLIT_TILES = 8 * 4 + 16;
constexpr size_t WS_SPCNT = WS_SPLIT + SPLIT_TILES * SPLIT_TILE;
constexpr size_t WS_ACT = al256(WS_SPCNT + SPLIT_TILES * 8 * 4);
constexpr size_t SZ_A = (size_t)MT * EA * 2, SZ_B = (size_t)MT * DM * 2;
constexpr size_t WS_U = WS_ACT, WS_SG = WS_U + SZ_A, WS_D = WS_SG + SZ_A;
constexpr size_t WS_KB = WS_ACT, WS_VB = WS_KB + SZ_B, WS_QB = WS_VB + SZ_B, WS_SGB = WS_QB + SZ_B, WS_OG = WS_SGB + SZ_B;
constexpr size_t WS_END = (WS_D + SZ_A) > (WS_OG + SZ_B) ? (WS_D + SZ_A) : (WS_OG + SZ_B);

struct Params { const float* in[18]; float* out; unsigned char* ws; int ph_lo, ph_hi; };

__device__ __forceinline__ unsigned cvtpk(float lo, float hi) { unsigned r; asm volatile("v_cvt_pk_bf16_f32 %0, %1, %2" : "=v"(r) : "v"(lo), "v"(hi)); return r; }
__device__ __forceinline__ bf16x8 pack8(f32x4 a, f32x4 b) { u32x4 w = {cvtpk(a[0], a[1]), cvtpk(a[2], a[3]), cvtpk(b[0], b[1]), cvtpk(b[2], b[3])}; return *reinterpret_cast<bf16x8*>(&w); }
__device__ __forceinline__ float bflo(unsigned w) { return __uint_as_float(w << 16); }
__device__ __forceinline__ float bfhi(unsigned w) { return __uint_as_float(w & 0xffff0000u); }
__device__ __forceinline__ float silu_f(float x) { return x * __builtin_amdgcn_rcpf(1.0f + __builtin_amdgcn_exp2f(-x * LOG2E)); }
__device__ __forceinline__ float wave_sum(float v) {
#pragma unroll
    for (int o = 1; o < 64; o <<= 1) v += __shfl_xor(v, o);
    return v;
}
__device__ __forceinline__ int otid(int wv) { int l; asm volatile("v_mbcnt_lo_u32_b32 %0, -1, 0\n\tv_mbcnt_hi_u32_b32 %0, -1, %0" : "=v"(l)); return wv * 64 + l; }
__device__ __forceinline__ float xsum16(float v) { auto r = __builtin_amdgcn_permlane16_swap(__float_as_uint(v), __float_as_uint(v), false, false); return __uint_as_float(r[0]) + __uint_as_float(r[1]); }
__device__ __forceinline__ float xsum32(float v) { auto r = __builtin_amdgcn_permlane32_swap(__float_as_uint(v), __float_as_uint(v), false, false); return __uint_as_float(r[0]) + __uint_as_float(r[1]); }
__device__ __forceinline__ float xmax16(float v) { auto r = __builtin_amdgcn_permlane16_swap(__float_as_uint(v), __float_as_uint(v), false, false); return fmaxf(__uint_as_float(r[0]), __uint_as_float(r[1])); }
__device__ __forceinline__ float xmax32(float v) { auto r = __builtin_amdgcn_permlane32_swap(__float_as_uint(v), __float_as_uint(v), false, false); return fmaxf(__uint_as_float(r[0]), __uint_as_float(r[1])); }
__device__ __forceinline__ float bperm(float v, int srclane) { return __uint_as_float((unsigned)__builtin_amdgcn_ds_bpermute(srclane << 2, (int)__float_as_uint(v))); }
__device__ __forceinline__ float logsig(float x) { return fminf(x, 0.f) - log1pf(__expf(-fabsf(x))); }

namespace pg8 {
constexpr int BM = 256, BK = 64, HALF = 128, HTB = HALF * BK * 2, NXCD = 8, WGM = 8;
__device__ __forceinline__ int lds_byte(int r, int c) { const int st = (r >> 4) * 2 + (c >> 5), rr = r & 15, cc = c & 31, ob = rr * 64 + cc * 2; return st * 1024 + (ob ^ (((ob >> 9) & 1) << 5)); }
__device__ __forceinline__ void stage_rc(int b, int& R, int& C) { const int st = b / 1024, sb = b % 1024, swz = sb ^ (((sb >> 9) & 1) << 5); R = (st >> 1) * 16 + swz / 64; C = (st & 1) * 32 + (swz % 64) / 2; }
__device__ __forceinline__ int perm32(int rho) { const int n = rho >> 4, i = rho & 15; return 8 * (i >> 2) + 4 * n + (i & 3); }
struct Unit { int pm, pn, ks, nks; };
struct Gemm { const bf16_t* A; const bf16_t* Bt; int K, lda, ldb, mode; float* sp_acc; unsigned* sp_cnt; };
__device__ __forceinline__ void unit_off(const Gemm& g, const Unit& u, size_t& oa, size_t& ob) {
    if (g.mode == 2) { oa = (size_t)u.pm * 256 * g.lda; ob = (size_t)(u.pm >> 4) * DM * EA + (size_t)((u.pm >> 2) & 3) * 1024 + (size_t)u.pn * 256 * g.ldb; }
    else if (g.mode == 3) { oa = (size_t)u.pm * 256 * g.lda + (size_t)(u.pn >> 2) * 1024; ob = (size_t)(u.pm * 16 + u.pn) * 256 * g.ldb; }
    else { oa = (size_t)u.pm * 256 * g.lda; ob = (size_t)u.pn * 256 * g.ldb; }
    const size_t ko = (size_t)u.ks * (size_t)(g.K / u.nks); oa = (oa + ko) * 2; ob = (ob + ko) * 2;
}
struct StaticOrder {
    int nM, nN, nwg, G, c;
    __device__ void init(int nM_, int nN_, int G_, int c_) { nM = nM_; nN = nN_; nwg = nM * nN; G = G_; c = c_; }
    __device__ bool next(int i, Unit& u) const {
        const long L = (long)i * G + c; if (L >= nwg) return false;
        int wgid = (int)L; { const int q = nwg / NXCD, r = nwg % NXCD, xcd = wgid % NXCD, off = wgid / NXCD; wgid = (xcd < r ? xcd * (q + 1) : r * (q + 1) + (xcd - r) * q) + off; }
        const int nig = WGM * nN, gid = wgid / nig, fm = gid * WGM, gsz = (nM - fm) < WGM ? (nM - fm) : WGM;
        u.pm = fm + ((wgid % nig) % gsz); u.pn = (wgid % nig) / gsz; u.ks = 0; u.nks = 1; return true;
    }
};
struct SplitOrder {
    StaticOrder S0; int nN, nks, i0;
    __device__ void init(int nN_, int nks_, int G_, int c_) { S0.init(64, nN_, G_, c_); nN = nN_; nks = nks_; i0 = c_ < S0.nwg ? (S0.nwg - c_ + G_ - 1) / G_ : 0; }
    __device__ bool next(int i, Unit& u) const {
        if (i < i0) return S0.next(i, u);
        const int idx = (i - i0) * S0.G + S0.c; if (idx >= nN * nks) return false;
        u.pm = 64; u.pn = idx / nks; u.ks = idx % nks; u.nks = nks; return true;
    }
};
struct StateOrder {
    int G, c;
    __device__ bool next(int i, Unit& u) const { const int idx = G - 1 - c; if (i != 0 || idx >= 80) return false; const int k = idx >> 4; u.pm = k < 4 ? 16 * k + 15 : 64; u.pn = idx & 15; u.ks = 0; u.nks = 1; return true; }
};
template <class Epi, class Ord>
__device__ __forceinline__ void gemm_phase(int wv, LAS unsigned char* lds, const Gemm g, const Ord& S, const Epi& E) {
    const int tid = otid(wv), wid = __builtin_amdgcn_readfirstlane(tid >> 6), lane = tid & 63, wr = wid >> 2, wc = wid & 3, fr = lane & 15, fq = lane >> 4;
    const int K = g.K, nt = K / BK;
    unsigned voffA[2], voffB[2];
#pragma unroll
    for (int i = 0; i < 2; ++i) { int R, C; stage_rc(tid * 16 + i * 8192, R, C); const int Rb = Epi::PERM ? ((R & ~31) + perm32(R & 31)) : R;
        voffA[i] = (unsigned)(R * g.lda + C) * 2u; voffB[i] = (unsigned)(Rb * g.ldb + C) * 2u; }
    const size_t kstep = (size_t)(BK * 2);
    const size_t hstepA = (size_t)HALF * g.lda * 2;
    const size_t hstepB = (size_t)HALF * g.ldb * 2;
    const unsigned ldsw = (unsigned)wid * 1024u;
    const int aoff = lds_byte(wr * 64 + fr, fq * 8), boff = lds_byte(wc * 32 + fr, fq * 8);
#define PG8_SA(b, h) (((b) * 2 + (h)) * HTB)
#define PG8_SB(b, h) ((4 + (b) * 2 + (h)) * HTB)
#define PG8_STAGE(bufoff, gbase, voff) do { _Pragma("unroll") for (int _i = 0; _i < 2; ++_i) \
        __builtin_amdgcn_global_load_lds((const unsigned*)((const char*)(gbase) + (voff)[_i]), (LAS unsigned*)(lds + (bufoff) + ldsw + _i * 8192), 16, 0, 0); } while (0)
#define PG8_LDA(dst, b, h) do { _Pragma("unroll") for (int m = 0; m < 4; ++m) _Pragma("unroll") for (int k = 0; k < 2; ++k) dst[m][k] = *(const LAS bf16x8*)(lds + PG8_SA(b, h) + aoff + m * 2048 + k * 1024); } while (0)
#define PG8_LDB(dst, b, h) do { _Pragma("unroll") for (int n = 0; n < 2; ++n) _Pragma("unroll") for (int k = 0; k < 2; ++k) dst[n][k] = *(const LAS bf16x8*)(lds + PG8_SB(b, h) + boff + n * 2048 + k * 1024); } while (0)
#define PG8_MMA(ai, bj, At, Bt) do { __builtin_amdgcn_s_setprio(1); _Pragma("unroll") for (int m = 0; m < 4; ++m) _Pragma("unroll") for (int n = 0; n < 2; ++n) _Pragma("unroll") for (int k = 0; k < 2; ++k) \
        acc[ai][bj][m][n] = __builtin_amdgcn_mfma_f32_16x16x32_bf16(Bt[n][k], At[m][k], acc[ai][bj][m][n], 0, 0, 0); __builtin_amdgcn_s_setprio(0); } while (0)
#define PG8_WAIT_V(n) asm volatile("s_waitcnt vmcnt(" #n ")" ::: "memory")
#define PG8_WAIT_L(n) asm volatile("s_waitcnt lgkmcnt(" #n ")" ::: "memory")
#define PG8_BAR __builtin_amdgcn_s_barrier()
#define PG8_SCHED __builtin_amdgcn_sched_barrier(0)
    Unit cur, nxt; int ui = 0;
    if (!S.next(0, cur)) return;
    f32x4 acc[2][2][4][2];
#pragma unroll
    for (int a = 0; a < 2; ++a)
#pragma unroll
        for (int b = 0; b < 2; ++b)
#pragma unroll
            for (int m = 0; m < 4; ++m)
#pragma unroll
                for (int n = 0; n < 2; ++n) acc[a][b][m][n] = (f32x4){0.f, 0.f, 0.f, 0.f};
    bf16x8 At[4][2], B0[2][2], B1[2][2];
    size_t oa_, ob_; unit_off(g, cur, oa_, ob_);
    const char* cA = (const char*)g.A + oa_; const char* cB = (const char*)g.Bt + ob_;
    PG8_STAGE(PG8_SB(0, 0), cB, voffB); PG8_STAGE(PG8_SA(0, 0), cA, voffA); PG8_STAGE(PG8_SB(0, 1), cB + hstepB, voffB); PG8_STAGE(PG8_SA(0, 1), cA + hstepA, voffA);
    if (wr == 1) PG8_BAR;
    PG8_WAIT_V(4); PG8_BAR;
    PG8_STAGE(PG8_SB(1, 0), cB + kstep, voffB); PG8_STAGE(PG8_SA(1, 0), cA + kstep, voffA); PG8_STAGE(PG8_SB(1, 1), cB + hstepB + kstep, voffB);
    PG8_WAIT_V(6); PG8_BAR;
    for (;;) {
        const bool has_next = S.next(ui + 1, nxt);
        const char* nA = cA; const char* nB = cB;
        if (has_next) { unit_off(g, nxt, oa_, ob_); nA = (const char*)g.A + oa_; nB = (const char*)g.Bt + ob_; }
        const int ntc = nt / cur.nks;
        for (int t = 0; t < ntc; t += 2) {
            const bool last = (t == ntc - 2);
            const char* a1 = cA + (size_t)(t + 1) * kstep;
            const char* a2 = last ? nA : cA + (size_t)(t + 2) * kstep; const char* b2 = last ? nB : cB + (size_t)(t + 2) * kstep;
            const char* a3 = a2 + kstep; const char* b3 = b2 + kstep;
            PG8_LDB(B0, 0, 0); PG8_SCHED; PG8_LDA(At, 0, 0); PG8_STAGE(PG8_SA(1, 1), a1 + hstepA, voffA);
            PG8_WAIT_L(8); PG8_BAR; PG8_WAIT_L(0); PG8_MMA(0, 0, At, B0); PG8_BAR; PG8_SCHED;
            PG8_LDB(B1, 0, 1); PG8_STAGE(PG8_SB(0, 0), b2, voffB);
            PG8_BAR; PG8_WAIT_L(0); PG8_MMA(0, 1, At, B1); PG8_BAR;
            PG8_LDA(At, 0, 1); PG8_STAGE(PG8_SA(0, 0), a2, voffA);
            PG8_BAR; PG8_WAIT_L(0); PG8_MMA(1, 0, At, B0); PG8_BAR; PG8_SCHED;
            PG8_STAGE(PG8_SB(0, 1), b2 + hstepB, voffB);
            PG8_WAIT_V(6); PG8_BAR; PG8_MMA(1, 1, At, B1); PG8_BAR;
            PG8_LDB(B0, 1, 0); PG8_SCHED; PG8_LDA(At, 1, 0); PG8_STAGE(PG8_SA(0, 1), a2 + hstepA, voffA);
            PG8_WAIT_L(8); PG8_BAR; PG8_WAIT_L(0); PG8_MMA(0, 0, At, B0); PG8_BAR; PG8_SCHED;
            PG8_LDB(B1, 1, 1); PG8_STAGE(PG8_SB(1, 0), b3, voffB);
            PG8_BAR; PG8_WAIT_L(0); PG8_MMA(0, 1, At, B1); PG8_BAR;
            PG8_LDA(At, 1, 1); PG8_STAGE(PG8_SA(1, 0), a3, voffA);
            PG8_BAR; PG8_WAIT_L(0); PG8_MMA(1, 0, At, B0); PG8_BAR; PG8_SCHED;
            PG8_STAGE(PG8_SB(1, 1), b3 + hstepB, voffB);
            PG8_WAIT_V(6); PG8_BAR; PG8_MMA(1, 1, At, B1); PG8_BAR;
        }
        bool do_epi = true;
        if (cur.nks > 1) {
            float* sc0 = g.sp_acc + (size_t)cur.pn * 65536 + (wid * 64 + lane); float* sc = sc0;
#pragma unroll
            for (int a = 0; a < 2; ++a)
#pragma unroll
                for (int b = 0; b < 2; ++b)
#pragma unroll
                    for (int m = 0; m < 4; ++m)
#pragma unroll
                        for (int n = 0; n < 2; ++n) {
#pragma unroll
                            for (int j = 0; j < 4; ++j) unsafeAtomicAdd(sc + j * 512, acc[a][b][m][n][j]);
                            sc += 2048; asm volatile("" : "+v"(sc)); }
            asm volatile("s_waitcnt vmcnt(0)" ::: "memory");
            __builtin_amdgcn_fence(__ATOMIC_RELEASE, "agent");
            unsigned old = 0u; if (lane == 0) old = __hip_atomic_fetch_add(g.sp_cnt + cur.pn * 8 + wid, 1u, __ATOMIC_RELAXED, __HIP_MEMORY_SCOPE_AGENT);
            old = (unsigned)__builtin_amdgcn_readfirstlane((int)old);
            do_epi = (old == (unsigned)cur.nks - 1u);
            if (do_epi) {
                __builtin_amdgcn_fence(__ATOMIC_ACQUIRE, "agent");
                sc = sc0;
#pragma unroll
                for (int a = 0; a < 2; ++a)
#pragma unroll
                    for (int b = 0; b < 2; ++b)
#pragma unroll
                        for (int m = 0; m < 4; ++m)
#pragma unroll
                            for (int n = 0; n < 2; ++n) {
#pragma unroll
                                for (int j = 0; j < 4; ++j) acc[a][b][m][n][j] = __hip_atomic_load(sc + j * 512, __ATOMIC_RELAXED, __HIP_MEMORY_SCOPE_AGENT);
                                sc += 2048; asm volatile("" : "+v"(sc)); } }
        }
        if (do_epi) E(acc, cur, wr, wc, fr, fq);
        if (!has_next) break;
#pragma unroll
        for (int a = 0; a < 2; ++a)
#pragma unroll
            for (int b = 0; b < 2; ++b)
#pragma unroll
                for (int m = 0; m < 4; ++m)
#pragma unroll
                    for (int n = 0; n < 2; ++n) acc[a][b][m][n] = (f32x4){0.f, 0.f, 0.f, 0.f};
        cur = nxt; cA = nA; cB = nB; ++ui;
    }
    PG8_WAIT_V(0);
    if (wr == 0) PG8_BAR;
    PG8_BAR;
#undef PG8_SA
#undef PG8_SB
#undef PG8_STAGE
#undef PG8_LDA
#undef PG8_LDB
#undef PG8_MMA
#undef PG8_WAIT_V
#undef PG8_WAIT_L
#undef PG8_BAR
#undef PG8_SCHED
}

typedef const f32x4 (&AccRef)[2][2][4][2];

struct EpiInA {
    static constexpr bool PERM = true;
    const float* ssq; bf16_t* tt; bf16_t* sg;
    __device__ __forceinline__ void operator()(AccRef acc, const Unit& un, int wr, int wc, int fr, int fq) const {
        const int row0 = un.pm * BM + wr * 64 + fr, colt = un.pn * BM + wc * 32 + 8 * fq;
        const bool is_t = un.pn < 16;
        float rrs[2][4];
#pragma unroll
        for (int ai = 0; ai < 2; ++ai)
#pragma unroll
            for (int m = 0; m < 4; ++m) rrs[ai][m] = ssq[row0 + ai * HALF + m * 16];
#pragma unroll
        for (int ai = 0; ai < 2; ++ai)
#pragma unroll
            for (int m = 0; m < 4; ++m) { const int row = row0 + ai * HALF + m * 16; const float rr = rsqrtf(rrs[ai][m] * (1.0f / DM) + EPS);
#pragma unroll
                for (int bj = 0; bj < 2; ++bj) { f32x4 v0 = acc[ai][bj][m][0] * rr, v1 = acc[ai][bj][m][1] * rr; const int col = colt + bj * HALF;
                    if (is_t) *(bf16x8*)(tt + (size_t)row * EA + col) = pack8(v0, v1);
                    else {
#pragma unroll
                        for (int j = 0; j < 4; ++j) { v0[j] = silu_f(v0[j]); v1[j] = silu_f(v1[j]); }
                        *(bf16x8*)(sg + (size_t)row * EA + (col - EA)) = pack8(v0, v1); } } }
    }
};
struct EpiUState {
    static constexpr bool PERM = true;
    const float* ssq; float* pool_p; float* pool_s;
    __device__ __forceinline__ void operator()(AccRef acc, const Unit& un, int wr, int wc, int fr, int fq) const {
        const int row0 = un.pm * BM + wr * 64 + fr, colt = un.pn * BM + wc * 32 + 8 * fq;
#pragma unroll
        for (int ai = 0; ai < 2; ++ai)
#pragma unroll
            for (int m = 0; m < 4; ++m) { const int row = row0 + ai * HALF + m * 16;
                float* pp = nullptr;
                if (row < MP) { const int t = row & (SEQ - 1); if (t >= SEQ - PPAD) pp = pool_p + ((size_t)(row >> 12) * PPAD + (t - (SEQ - PPAD))) * EA; }
                else { const int rs = row - MP, t = rs & 15; if (t >= 1) pp = pool_s + ((size_t)(rs >> 4) * PPAD + (t - 1)) * EA; }
                if (pp) { const float rr = rsqrtf(ssq[row] * (1.0f / DM) + EPS);
#pragma unroll
                    for (int bj = 0; bj < 2; ++bj) { *(f32x4*)(pp + colt + bj * HALF) = acc[ai][bj][m][0] * rr; *(f32x4*)(pp + colt + bj * HALF + 4) = acc[ai][bj][m][1] * rr; } } }
    }
};
struct EpiStore {
    static constexpr bool PERM = true;
    bf16_t* O; int ldc, wmode;
    __device__ __forceinline__ void operator()(AccRef acc, const Unit& un, int wr, int wc, int fr, int fq) const {
        const int rbase = wmode ? (un.pm >> 4) * 2 * EA + (un.pm & 15) * BM : un.pm * BM;
        const int row0 = rbase + wr * 64 + fr, colt = un.pn * BM + wc * 32 + 8 * fq;
#pragma unroll
        for (int ai = 0; ai < 2; ++ai)
#pragma unroll
            for (int m = 0; m < 4; ++m)
#pragma unroll
                for (int bj = 0; bj < 2; ++bj) *(bf16x8*)(O + (size_t)(row0 + ai * HALF + m * 16) * ldc + colt + bj * HALF) = pack8(acc[ai][bj][m][0], acc[ai][bj][m][1]);
    }
};
struct EpiRes {
    static constexpr bool PERM = false;
    const float* base_p; const float* base_s; float* xres; bf16_t* xb; float* ssq_next;
    __device__ __forceinline__ void operator()(AccRef acc, const Unit& un, int wr, int wc, int fr, int fq) const {
        const int row0 = un.pm * BM + wr * 64 + fr, col0 = un.pn * BM + wc * 32 + 4 * fq;
#pragma unroll
        for (int ai = 0; ai < 2; ++ai) {
            f32x4 bx_[4][2][2];
#pragma unroll
            for (int m = 0; m < 4; ++m) { const int row = row0 + ai * HALF + m * 16;
                const float* bp = (row < MP ? base_p + (size_t)row * DM : base_s + (size_t)(row - MP) * DM) + col0;
#pragma unroll
                for (int bj = 0; bj < 2; ++bj)
#pragma unroll
                    for (int n = 0; n < 2; ++n) bx_[m][bj][n] = *(const f32x4*)(bp + bj * HALF + n * 16); }
#pragma unroll
            for (int m = 0; m < 4; ++m) { const int row = row0 + ai * HALF + m * 16;
                float* xo = xres + (size_t)row * DM + col0; bf16_t* bo = xb + (size_t)row * DM + col0; float s = 0.f;
#pragma unroll
                for (int bj = 0; bj < 2; ++bj)
#pragma unroll
                    for (int n = 0; n < 2; ++n) { const f32x4 x = bx_[m][bj][n] + acc[ai][bj][m][n];
                        *(f32x4*)(xo + bj * HALF + n * 16) = x; u32x2 w; w.x = cvtpk(x[0], x[1]); w.y = cvtpk(x[2], x[3]); *(u32x2*)(bo + bj * HALF + n * 16) = w;
                        s += (x[0] * x[0] + x[1] * x[1]) + (x[2] * x[2] + x[3] * x[3]); }
                s = xsum16(s); s = xsum32(s);
                if (fq == 0) unsafeAtomicAdd(ssq_next + row, s); } }
    }
};
struct EpiKVQ {
    static constexpr bool PERM = true;
    int pn_off; const float* ssq; float* out; unsigned char* ws; const float* b_f;
    __device__ __forceinline__ void operator()(AccRef acc, const Unit& un, int wr, int wc, int fr, int fq) const {
        const int tt = un.pn + pn_off;
        const int row0 = un.pm * BM + wr * 64 + fr, cw = wc * 32 + 8 * fq;
        float rrs[2][4];
#pragma unroll
        for (int ai = 0; ai < 2; ++ai)
#pragma unroll
            for (int m = 0; m < 4; ++m) rrs[ai][m] = ssq[row0 + ai * HALF + m * 16];
        if (tt == 16) {
            if (wc == 0 && fq < 2) {
            const f32x4 bf0 = *(const f32x4*)(b_f + 8 * fq), bf1 = *(const f32x4*)(b_f + 8 * fq + 4);
            float* lft_p = (float*)(ws + WS_LFTP); float* lft_s = (float*)(ws + WS_LFTS);
#pragma unroll
            for (int ai = 0; ai < 2; ++ai)
#pragma unroll
                for (int m = 0; m < 4; ++m) { const int row = row0 + ai * HALF + m * 16; const float rr = rsqrtf(rrs[ai][m] * (1.0f / DM) + EPS);
                    f32x4 v0 = acc[ai][0][m][0] * rr + bf0, v1 = acc[ai][0][m][1] * rr + bf1;
#pragma unroll
                    for (int j = 0; j < 4; ++j) { v0[j] = logsig(v0[j]); v1[j] = logsig(v1[j]); }
                    if (row < MP) { float* o = out + O_LFP + (size_t)row * NH + 8 * fq; *(f32x4*)o = v0; *(f32x4*)(o + 4) = v1;
                        float* tp = lft_p + ((size_t)(row >> 12) * NH + 8 * fq) * SEQ + (row & (SEQ - 1));
#pragma unroll
                        for (int j = 0; j < 4; ++j) { tp[(size_t)j * SEQ] = v0[j]; tp[(size_t)(j + 4) * SEQ] = v1[j]; } }
                    else { const int rs = row - MP; float* o = out + O_LFS + (size_t)rs * NH + 8 * fq; *(f32x4*)o = v0; *(f32x4*)(o + 4) = v1;
                        float* tp = lft_s + ((size_t)(rs >> 4) * NH + 8 * fq) * DSEQ + (rs & 15);
#pragma unroll
                        for (int j = 0; j < 4; ++j) { tp[j * DSEQ] = v0[j]; tp[(j + 4) * DSEQ] = v1[j]; } } }
            }
        } else {
        const int kind = tt < 8 ? 0 : (tt < 16 ? 1 : (tt < 25 ? 2 : 3));
        const int colt = (tt - (kind == 0 ? 0 : kind == 1 ? 8 : kind == 2 ? 17 : 25)) * BM + cw;
        float* fo_p = out + (kind == 0 ? O_KP : O_VP); float* fo_s = out + (kind == 0 ? O_KS : O_VS);
        bf16_t* bo = (bf16_t*)(ws + (kind == 0 ? WS_KB : (kind == 1 ? WS_VB : (kind == 2 ? WS_QB : WS_SGB))));
#pragma unroll
        for (int ai = 0; ai < 2; ++ai)
#pragma unroll
            for (int m = 0; m < 4; ++m) { const int row = row0 + ai * HALF + m * 16; float rr = rsqrtf(rrs[ai][m] * (1.0f / DM) + EPS);
                if (kind == 2) rr *= QSCALE;
                float* fo = (row < MP ? fo_p + (size_t)row * DM : fo_s + (size_t)(row - MP) * DM) + colt;
#pragma unroll
                for (int bj = 0; bj < 2; ++bj) { f32x4 v0 = acc[ai][bj][m][0] * rr, v1 = acc[ai][bj][m][1] * rr;
                    if (kind < 2) { *(f32x4*)(fo + bj * HALF) = v0; *(f32x4*)(fo + bj * HALF + 4) = v1; }
                    if (kind == 3) {
#pragma unroll
                        for (int j = 0; j < 4; ++j) { v0[j] = silu_f(v0[j]); v1[j] = silu_f(v1[j]); } }
                    *(bf16x8*)(bo + (size_t)row * DM + colt + bj * HALF) = pack8(v0, v1);
                    if (kind == 0 || kind == 2) {
                        float ss = (v0[0] * v0[0] + v0[1] * v0[1]) + (v0[2] * v0[2] + v0[3] * v0[3]) + (v1[0] * v1[0] + v1[1] * v1[1]) + (v1[2] * v1[2] + v1[3] * v1[3]);
                        ss = xsum16(ss); ss = xsum32(ss);
                        float* nt = (float*)(ws + (kind == 0 ? WS_KNRM : WS_QNRM));
                        if (fq == 0) nt[((size_t)row * NH + 2 * (colt >> 8) + bj) * 4 + wc] = ss; } } }
        }
    }
};
}

namespace att {
constexpr int NW = 8, QBLK = 32, KVBLK = 64, QB = NW * QBLK, D = 128, LD = 2048;
constexpr int SHM_V = KVBLK * D * 2, SHM_K = KVBLK * D * 2;
constexpr int OFF_WS = 2 * SHM_V + 2 * SHM_K, OFF_F = OFF_WS + NW * 64 * 4, OFF_SC = OFF_F + SEQ * 4, OFF_KT = OFF_SC + 64, OFF_QM = OFF_KT + 256, OFF_JL = OFF_QM + 128;
constexpr float SKIP_T = 32.f;
constexpr float THR2 = 11.5f;
#define KSWZ(row, colB) ((row) * 256 + ((colB) ^ (((row) & 7) << 4)))
#define SBAR() __builtin_amdgcn_sched_barrier(0)
__device__ __forceinline__ int v_st(int k, int c) { const int kk = (k & ~0xC) | ((k & 4) << 1) | ((k & 8) >> 1); return ((kk >> 3) * 4 + (c >> 5)) * 512 + ((kk & 7) * 32 + (c & 31)) * 2; }
__device__ __forceinline__ int v_rd_base(int lane) { return ((lane & 3) << 3) | (((lane >> 2) & 3) << 6) | (((lane >> 4) & 1) << 5) | (((lane >> 5) & 1) << 8); }
constexpr int v_rd_off(int d0, int ks, int half) { return d0 * 512 + ks * 4096 + half * 2048; }
__device__ __forceinline__ int crow(int r, int hi) { return (r & 3) + 8 * (r >> 2) + 4 * hi; }
__device__ __forceinline__ void mask_tile(f32x16& p0, f32x16& p1, int dq) {
    const float NEG = -__builtin_inff();
#pragma unroll
    for (int r = 0; r < 16; ++r) { const int c = (r & 3) + 8 * (r >> 2);
        if (dq - c < 0) p0[r] = NEG;
        if (dq - c - 32 < 0) p1[r] = NEG; }
}
__device__ __forceinline__ void partialSM(f32x16& p0, f32x16& p1, float& m_reg, float& mn, float& alpha) {
    float pmax = p0[0];
#pragma unroll
    for (int r = 1; r < 16; ++r) pmax = fmaxf(pmax, p0[r]);
#pragma unroll
    for (int r = 0; r < 16; ++r) pmax = fmaxf(pmax, p1[r]);
    { auto rr = __builtin_amdgcn_permlane32_swap(__float_as_uint(pmax), __float_as_uint(pmax), false, false);
      pmax = fmaxf(__uint_as_float(rr[0]), __uint_as_float(rr[1])); }
    if (__builtin_expect(__all((pmax - m_reg) <= THR2), 1)) { mn = m_reg; alpha = 1.f; }
    else { mn = fmaxf(m_reg, pmax); alpha = __builtin_amdgcn_exp2f(m_reg - mn); m_reg = mn; }
#pragma unroll
    for (int r = 0; r < 16; ++r) p0[r] = p0[r] - mn;
#pragma unroll
    for (int r = 0; r < 16; ++r) p1[r] = p1[r] - mn;
#pragma unroll
    for (int r = 0; r < 16; ++r) p0[r] = __builtin_amdgcn_exp2f(p0[r]);
}
__device__ __forceinline__ void finishSM(f32x16& p0, f32x16& p1, float alpha, float& l_reg, bf16x8& pa0, bf16x8& pa1, bf16x8& pa2, bf16x8& pa3) {
#pragma unroll
    for (int r = 0; r < 16; ++r) p1[r] = __builtin_amdgcn_exp2f(p1[r]);
    float ps = 0;
#pragma unroll
    for (int r = 0; r < 16; ++r) ps += p0[r];
#pragma unroll
    for (int r = 0; r < 16; ++r) ps += p1[r];
    { auto rr = __builtin_amdgcn_permlane32_swap(__float_as_uint(ps), __float_as_uint(ps), false, false);
      ps = __uint_as_float(rr[0]) + __uint_as_float(rr[1]); }
    l_reg = l_reg * alpha + ps;
#define PK4(P, B_, OUT) do { unsigned a0 = cvtpk(P[B_+0], P[B_+1]), a1 = cvtpk(P[B_+2], P[B_+3]);                          \
        unsigned b0 = cvtpk(P[B_+4], P[B_+5]), b1 = cvtpk(P[B_+6], P[B_+7]);                                             \
        auto r0 = __builtin_amdgcn_permlane32_swap(a0, b0, false, false); auto r1 = __builtin_amdgcn_permlane32_swap(a1, b1, false, false); \
        u32x4 w = {r0[0], r1[0], r0[1], r1[1]}; OUT = *reinterpret_cast<bf16x8*>(&w); } while (0)
    PK4(p0, 0, pa0); PK4(p0, 8, pa1); PK4(p1, 0, pa2); PK4(p1, 8, pa3);
#undef PK4
}
template <int KB>
__device__ __forceinline__ void qkt(f32x16& p0, f32x16& p1, const char* K_lds, const float* fl, int r32, int hi, const bf16x8* qr) {
    { const f32x4 a0 = *(const f32x4*)(fl), a1 = *(const f32x4*)(fl + 8), a2 = *(const f32x4*)(fl + 16), a3 = *(const f32x4*)(fl + 24);
      const f32x4 b0 = *(const f32x4*)(fl + 32), b1 = *(const f32x4*)(fl + 40), b2 = *(const f32x4*)(fl + 48), b3 = *(const f32x4*)(fl + 56);
      p0 = (f32x16){a0[0], a0[1], a0[2], a0[3], a1[0], a1[1], a1[2], a1[3], a2[0], a2[1], a2[2], a2[3], a3[0], a3[1], a3[2], a3[3]};
      p1 = (f32x16){b0[0], b0[1], b0[2], b0[3], b1[0], b1[1], b1[2], b1[3], b2[0], b2[1], b2[2], b2[3], b3[0], b3[1], b3[2], b3[3]}; }
    const char* kb[4];
#pragma unroll
    for (int dd = 0; dd < 4; ++dd) kb[dd] = K_lds + KB * SHM_K + KSWZ(r32, (dd * 16 + hi * 8) * 2);
#pragma unroll
    for (int d0 = 0; d0 < 8; ++d0) { const char* a = kb[d0 & 3] + (d0 >> 2) * 128;
        bf16x8 b0 = *reinterpret_cast<const bf16x8*>(a);
        bf16x8 b1 = *reinterpret_cast<const bf16x8*>(a + 32 * 256);
        p0 = __builtin_amdgcn_mfma_f32_32x32x16_bf16(b0, qr[d0], p0, 0, 0, 0);
        p1 = __builtin_amdgcn_mfma_f32_32x32x16_bf16(b1, qr[d0], p1, 0, 0, 0); }
}
template <int VB>
__device__ __forceinline__ void pv_tile(f32x16* o, int vb0, bf16x8 pa0, bf16x8 pa1, bf16x8 pa2, bf16x8 pa3) {
#define TRRD(dst, off) asm volatile("ds_read_b64_tr_b16 %0, %1 offset:%2" : "=&v"(dst) : "v"(vb0), "i"(off) : "memory")
#define PV_D0(d0) do { s16x4 l0, l1, l2, l3, h0, h1, h2, h3; constexpr int b_ = VB * SHM_V + v_rd_off(d0, 0, 0);   \
        TRRD(l0, b_); TRRD(h0, b_ + 2048); TRRD(l1, b_ + 4096); TRRD(h1, b_ + 6144); TRRD(l2, b_ + 8192); TRRD(h2, b_ + 10240); TRRD(l3, b_ + 12288); TRRD(h3, b_ + 14336); \
        asm volatile("s_waitcnt lgkmcnt(0)" ::: "memory"); SBAR();   \
        o[d0] = __builtin_amdgcn_mfma_f32_32x32x16_bf16(pa0, (bf16x8){l0[0], l0[1], l0[2], l0[3], h0[0], h0[1], h0[2], h0[3]}, o[d0], 0, 0, 0);   \
        o[d0] = __builtin_amdgcn_mfma_f32_32x32x16_bf16(pa1, (bf16x8){l1[0], l1[1], l1[2], l1[3], h1[0], h1[1], h1[2], h1[3]}, o[d0], 0, 0, 0);   \
        o[d0] = __builtin_amdgcn_mfma_f32_32x32x16_bf16(pa2, (bf16x8){l2[0], l2[1], l2[2], l2[3], h2[0], h2[1], h2[2], h2[3]}, o[d0], 0, 0, 0);   \
        o[d0] = __builtin_amdgcn_mfma_f32_32x32x16_bf16(pa3, (bf16x8){l3[0], l3[1], l3[2], l3[3], h3[0], h3[1], h3[2], h3[3]}, o[d0], 0, 0, 0); } while (0)
    PV_D0(0); PV_D0(1); PV_D0(2); PV_D0(3);
#undef PV_D0
#undef TRRD
}
struct Tensors { const bf16_t* q; const bf16_t* k; const bf16_t* v; bf16_t* og; const bf16_t* sg; const float* lft; };
struct BlockRef { unsigned q0, s0; int P0, jlo; };
struct Seam { bf16x8 qr[8]; bf16x8 st_v0, st_v1, st_k0, st_k1; };
#define ROWP(p, k0) ((p) + (unsigned)(k0) * (unsigned)LD)
#define VMW() asm volatile("s_waitcnt vmcnt(0)" ::: "memory")
#define VMWN(n) asm volatile("s_waitcnt vmcnt(%0)" :: "i"(n) : "memory")
#define LD8(p) (*reinterpret_cast<const bf16x8*>(p))
#define SLOAD_H(Kp, Vp, k0) do { S.st_v0 = LD8(ROWP(Vp, k0) + voff); S.st_v1 = LD8(ROWP(Vp, (k0) + 32) + voff);              \
                         S.st_k0 = LD8(ROWP(Kp, k0) + voff); S.st_k1 = LD8(ROWP(Kp, (k0) + 32) + voff); } while (0)
#define SWRITE_HK(bf) do { *(bf16x8*)(K_lds + (bf) * SHM_K + kws) = S.st_k0; *(bf16x8*)(K_lds + (bf) * SHM_K + kws + 32 * 256) = S.st_k1; } while (0)
#define SWRITE_HV(bf) do { *(bf16x8*)(V_lds + (bf) * SHM_V + vst0) = S.st_v0; *(bf16x8*)(V_lds + (bf) * SHM_V + vst0 + VST1) = S.st_v1; } while (0)
#define SWRITE_H(bf) do { SWRITE_HV(bf); SWRITE_HK(bf); } while (0)
__device__ __forceinline__ void prime(int wv, const Tensors& T, const BlockRef& cur, char* lds, Seam& S) {
    const int tid = otid(wv), wid = __builtin_amdgcn_readfirstlane(tid >> 6), lane = tid & 63, r32 = lane & 31, hi = lane >> 5;
    const int sr = tid >> 4, sc = (tid & 15) * 8, kws = KSWZ(sr, sc * 2); char* K_lds = lds + 2 * SHM_V;
    const unsigned voff = (unsigned)sr * LD + sc, qoff = (unsigned)(wid * QBLK + r32) * LD + hi * 8;
    const bf16_t* Qp = T.q + cur.q0; const bf16_t* Kh = T.k + cur.s0; const bf16_t* Vh = T.v + cur.s0;
#pragma unroll
    for (int d0 = 0; d0 < 8; ++d0) S.qr[d0] = LD8(Qp + qoff + d0 * 16);
    SLOAD_H(Kh, Vh, cur.jlo * KVBLK); VMW(); SWRITE_HK(0);
    __syncthreads();
}
__device__ __forceinline__ void block(int wv, const Tensors& T, const BlockRef& cur, const BlockRef& nxt, char* lds, Seam& S) {
    const int tid = otid(wv), wid = __builtin_amdgcn_readfirstlane(tid >> 6), lane = tid & 63, r32 = lane & 31, hi = lane >> 5;
    const int j_lo = cur.jlo, NT = (cur.P0 + QB) / KVBLK - j_lo;
    const int qlo = cur.P0 - j_lo * KVBLK + wid * QBLK, qm = qlo + r32 - 4 * hi;
    char* V_lds = lds; char* K_lds = lds + 2 * SHM_V;
    float* wsl = (float*)(lds + OFF_WS) + wid * 64; float* li_l = wsl, * al_l = wsl + 32;
    float* Fl = (float*)(lds + OFF_F);
    float m_reg = -1e30f, l_reg = 0; f32x16 o[4] = {};
    const int sr = tid >> 4, sc = (tid & 15) * 8, vst0 = v_st(sr, sc), kws = KSWZ(sr, sc * 2); constexpr int VST1 = 8192;
    const int vb0 = (int)(uintptr_t)V_lds + v_rd_base(lane);
    const bf16_t* Kh = T.k + cur.s0 + (unsigned)(j_lo * KVBLK) * LD; const bf16_t* Vh = T.v + cur.s0 + (unsigned)(j_lo * KVBLK) * LD;
    const unsigned voff = (unsigned)sr * LD + sc, qoff = (unsigned)(wid * QBLK + r32) * LD + hi * 8;
    const float* flb = Fl + j_lo * KVBLK + 4 * hi;
#define RESC(a) do { if (__any((a) < 1.f)) { if (hi == 0) al_l[r32] = (a); asm volatile("s_waitcnt lgkmcnt(0)" ::: "memory");              \
                     for (int d_ = 0; d_ < 4; ++d_) for (int r = 0; r < 16; ++r) o[d_][r] *= al_l[crow(r, hi)]; } } while (0)
#define KBASE(t) ((t) * KVBLK)
#define MASKT(P0_, P1_, t) do { const int kb_ = KBASE(t); if (kb_ + KVBLK - 1 > qlo) mask_tile(P0_, P1_, qm - kb_); } while (0)
#define SEAM_K0() do { VMWN(8); SWRITE_HK(0); SBAR(); } while (0)
    f32x16 pA0, pA1, pB0, pB1; float mnA, mnB, alA, alB; bf16x8 pa0, pa1, pa2, pa3;
    SWRITE_HV(0); SBAR();
    if (NT > 1) { SLOAD_H(Kh, Vh, KBASE(1)); }
    SBAR(); qkt<0>(pA0, pA1, K_lds, flb + KBASE(0), r32, hi, S.qr);
    MASKT(pA0, pA1, 0); partialSM(pA0, pA1, m_reg, mnA, alA);
    if (NT > 1) { VMW(); SWRITE_H(1); }
    __syncthreads();
#define HALF_STEP(PX0, PX1, mnX, alX, PY0, PY1, alY, t, KB, VB, SB) do {                                                      \
        SBAR(); qkt<KB>(PX0, PX1, K_lds, flb + KBASE(t), r32, hi, S.qr);                                             \
        finishSM(PY0, PY1, alY, l_reg, pa0, pa1, pa2, pa3); SBAR();                                                           \
        if ((t) + 1 < NT) { SLOAD_H(Kh, Vh, KBASE((t) + 1)); SBAR(); }                                               \
        pv_tile<VB>(o, vb0, pa0, pa1, pa2, pa3); MASKT(PX0, PX1, (t)); partialSM(PX0, PX1, m_reg, mnX, alX);                                        \
        __syncthreads();                                                                                                      \
        if ((t) + 1 < NT) { VMW(); SWRITE_H(SB); }                                                                          \
        RESC(alX); __syncthreads(); } while (0)
    for (int t = 1; t + 1 < NT; t += 2) {
        HALF_STEP(pB0, pB1, mnB, alB, pA0, pA1, alA, t, 1, 0, 0);
        HALF_STEP(pA0, pA1, mnA, alA, pB0, pB1, alB, t + 1, 0, 1, 1);
    }
    const bool even = (NT & 1) == 0;
    if (even) { SBAR(); qkt<1>(pB0, pB1, K_lds, flb + KBASE(NT - 1), r32, hi, S.qr); SBAR(); }
    { const bf16_t* Kn = T.k + nxt.s0; const bf16_t* Vn = T.v + nxt.s0; SLOAD_H(Kn, Vn, nxt.jlo * KVBLK); } SBAR();
    { const bf16_t* Qn = T.q + nxt.q0;
#pragma unroll
      for (int d0 = 0; d0 < 8; ++d0) S.qr[d0] = LD8(Qn + qoff + d0 * 16); }
    SBAR();
    finishSM(pA0, pA1, alA, l_reg, pa0, pa1, pa2, pa3); SBAR();
    pv_tile<0>(o, vb0, pa0, pa1, pa2, pa3);
    if (even) { MASKT(pB0, pB1, NT - 1); partialSM(pB0, pB1, m_reg, mnB, alB); __syncthreads(); RESC(alB);
        finishSM(pB0, pB1, alB, l_reg, pa0, pa1, pa2, pa3); SBAR(); pv_tile<1>(o, vb0, pa0, pa1, pa2, pa3); }
    SBAR(); SEAM_K0();
    if (hi == 0) li_l[r32] = l_reg; asm volatile("s_waitcnt lgkmcnt(0)" ::: "memory");
    float rli[16];
#pragma unroll
    for (int r = 0; r < 16; ++r) rli[r] = __builtin_amdgcn_rcpf(li_l[crow(r, hi)]);
    { const unsigned eoff = (unsigned)(4 * hi) * LD + r32;
#pragma unroll
      for (int r = 0; r < 16; ++r) { const unsigned ro = cur.q0 + (unsigned)(wid * QBLK + (r & 3) + 8 * (r >> 2)) * LD;
        bf16_t* Orow = T.og + ro; const bf16_t* Grow = T.sg + ro;
#pragma unroll
        for (int d0 = 0; d0 < 4; ++d0) { const float v = o[d0][r] * rli[r];
            const float vn = __shfl_xor(v, 1);
            if ((r32 & 1) == 0) { const unsigned gg = *(const unsigned*)(Grow + eoff + d0 * 32);
                *(unsigned*)(Orow + eoff + d0 * 32) = cvtpk(v * bflo(gg), vn * bfhi(gg)); } } } }
    __syncthreads();
#undef RESC
#undef KBASE
#undef MASKT
#undef SEAM_K0
#undef HALF_STEP
}
#undef ROWP
#undef VMW
#undef VMWN
#undef SLOAD_H
#undef SWRITE_HK
#undef SWRITE_HV
#undef SWRITE_H
#undef LD8

__device__ __forceinline__ BlockRef mkref(int bh, int qb) {
    const int b = bh >> 4, h = bh & 15; BlockRef r; r.s0 = (unsigned)b * SEQ * LD + h * D; r.q0 = r.s0 + (unsigned)qb * QB * LD; r.jlo = 0; r.P0 = qb * QB; return r;
}
__device__ __forceinline__ void item_setup(int wv, const Tensors& T, const float* knrm, const float* qnrm, int bh, unsigned blks, int nb, char* lds) {
    const int tid = otid(wv), wid = __builtin_amdgcn_readfirstlane(tid >> 6), lane = tid & 63;
    float* Fl = (float*)(lds + OFF_F); float* scn = (float*)(lds + OFF_SC); float* Kt = (float*)(lds + OFF_KT); float* Qm = (float*)(lds + OFF_QM); int* JL = (int*)(lds + OFF_JL);
    const int b = bh >> 4, h = bh & 15, xmax = (int)((blks >> (4 * (nb - 1))) & 15u), nkeys = (xmax + 1) * QB, t0 = tid * 8;
    const float* LF = T.lft + (size_t)bh * SEQ;
    f32x4 a = {0.f, 0.f, 0.f, 0.f}, c = {0.f, 0.f, 0.f, 0.f};
    float kmx = 0.f;
    if (t0 < nkeys) { a = *(const f32x4*)(LF + t0); c = *(const f32x4*)(LF + t0 + 4);
        const float* kn = knrm + ((size_t)(b * SEQ + t0) * NH + h) * 4;
#pragma unroll
        for (int i = 0; i < 8; ++i) { const f32x4 p = *(const f32x4*)(kn + (size_t)i * NH * 4); kmx = fmaxf(kmx, (p[0] + p[1]) + (p[2] + p[3])); } }
    kmx = fmaxf(kmx, bperm(kmx, lane ^ 1)); kmx = fmaxf(kmx, bperm(kmx, lane ^ 2)); kmx = fmaxf(kmx, bperm(kmx, lane ^ 4));
    if ((tid & 7) == 0 && t0 < nkeys) Kt[tid >> 3] = sqrtf(kmx) * 1.01f;
#pragma unroll 1
    for (int bi = 0; bi < nb; bi += 2) { const int bsel = bi + (tid >> 8);
        if (bsel < nb) { const int x = (int)((blks >> (4 * bsel)) & 15u), qrow = b * SEQ + x * QB + (tid & 255);
            const f32x4 p = *(const f32x4*)(qnrm + ((size_t)qrow * NH + h) * 4); float qm = (p[0] + p[1]) + (p[2] + p[3]);
#pragma unroll
            for (int o = 1; o < 64; o <<= 1) qm = fmaxf(qm, bperm(qm, lane ^ o));
            if (lane == 0) Qm[bsel * 4 + (wid & 3)] = qm; } }
    a[1] += a[0]; a[2] += a[1]; a[3] += a[2]; c[0] += a[3]; c[1] += c[0]; c[2] += c[1]; c[3] += c[2];
    const float tot = c[3]; float inc = tot;
#pragma unroll
    for (int o = 1; o < 64; o <<= 1) { const float v = bperm(inc, (lane - o) & 63); if (lane >= o) inc += v; }
    if (lane == 63) scn[wid] = inc;
    if (tid < nb) JL[tid] = (int)((blks >> (4 * tid)) & 15u) * 4;
    __syncthreads();
    float base = inc - tot;
    for (int w = 0; w < wid; ++w) base += scn[w];
    a = (a + base) * (-LOG2E); c = (c + base) * (-LOG2E);
    if (t0 < nkeys) { *(f32x4*)(Fl + t0) = a; *(f32x4*)(Fl + t0 + 4) = c; }
    __syncthreads();
    { const int which = tid >> 6, j = tid & 63;
      if (which < nb) { const int x = (int)((blks >> (4 * which)) & 15u), nd = x * 4;
        if (j < nd) { const float qmax = sqrtf(fmaxf(fmaxf(Qm[which * 4], Qm[which * 4 + 1]), fmaxf(Qm[which * 4 + 2], Qm[which * 4 + 3]))) * 1.01f;
            const float kdiag = fmaxf(fmaxf(Kt[nd], Kt[nd + 1]), fmaxf(Kt[nd + 2], Kt[nd + 3]));
            const bool skip = qmax * (Kt[j] + kdiag) + Fl[64 * j + 63] - Fl[x * QB] < -SKIP_T;
            if (!skip) atomicMin(JL + which, j); } } }
    __syncthreads();
}
__device__ __forceinline__ void prompt_phase(int wv, char* lds, const Tensors& T, const float* knrm, const float* qnrm, int pw) {
    const int bh = pw / 3, gsel = pw - bh * 3;
    const unsigned blks = gsel == 0 ? 0xDA742u : (gsel == 1 ? 0xEB8510u : 0xFC963u); const int nb = gsel == 1 ? 6 : 5;
    item_setup(wv, T, knrm, qnrm, bh, blks, nb, lds);
    const int* JL = (const int*)(lds + OFF_JL);
    Seam S;
    BlockRef cur = mkref(bh, (int)(blks & 15u)); cur.jlo = __builtin_amdgcn_readfirstlane(JL[0]);
    prime(wv, T, cur, lds, S);
#pragma unroll 1
    for (int i = 0; i < nb; ++i) { const int in = i + 1 < nb ? i + 1 : i;
        BlockRef nxt = mkref(bh, (int)((blks >> (4 * in)) & 15u)); nxt.jlo = __builtin_amdgcn_readfirstlane(JL[in]);
        block(wv, T, cur, nxt, lds, S);
        cur = nxt; }
}
}

namespace sat {
constexpr int OFF_F = 0, OFF_SC = 8448, OFF_P = 8704, OFF_A = OFF_P + 8 * 4096, OFF_ML = OFF_A + 512, OFF_O = OFF_ML + 1024;
struct Tensors { const bf16_t* q; const bf16_t* kb; const bf16_t* vb; bf16_t* og; const bf16_t* sg; const float* ck; const float* cv; const float* clf; const float* lfts; };
__device__ __forceinline__ void item(int wv, char* lds, const Tensors& T, int b, int h) {
    const int tid = otid(wv), wid = __builtin_amdgcn_readfirstlane(tid >> 6), lane = tid & 63, fr = lane & 15, fq = lane >> 4;
    float* Fl = (float*)(lds + OFF_F); float* scn = (float*)(lds + OFF_SC);
    float* ML = (float*)(lds + OFF_ML); float* Op = (float*)(lds + OFF_O);
    { const float* cl = T.clf + ((size_t)b * PAST + tid * 4) * NH + h;
      float a0 = cl[0], a1 = cl[NH], a2 = cl[2 * NH], a3 = cl[3 * NH];
      a1 += a0; a2 += a1; a3 += a2;
      const float tot = a3; float inc = tot;
#pragma unroll
      for (int o = 1; o < 64; o <<= 1) { const float v = bperm(inc, (lane - o) & 63); if (lane >= o) inc += v; }
      if (lane == 63) scn[wid] = inc;
      __syncthreads();
      float base = inc - tot, all = 0.f;
      for (int w = 0; w < 8; ++w) { const float sw = scn[w]; if (w < wid) base += sw; all += sw; }
      *(f32x4*)(Fl + tid * 4) = (f32x4){(a0 + base) * (-LOG2E), (a1 + base) * (-LOG2E), (a2 + base) * (-LOG2E), (a3 + base) * (-LOG2E)};
      if (tid < DSEQ) { const float* nl = T.lfts + ((size_t)b * NH + h) * DSEQ; float s = all; for (int i = 0; i <= tid; ++i) s += nl[i]; Fl[PAST + tid] = s * (-LOG2E); }
      __syncthreads(); }
    const size_t qrow = (size_t)(MP + b * DSEQ);
    bf16x8 qf[4];
#pragma unroll
    for (int dc = 0; dc < 4; ++dc) qf[dc] = *(const bf16x8*)(T.q + (qrow + fr) * DM + h * HD + dc * 32 + fq * 8);
    float m_run = -1e30f, l_run = 0.f;
    f32x4 ot[8];
#pragma unroll
    for (int dt = 0; dt < 8; ++dt) ot[dt] = (f32x4){0.f, 0.f, 0.f, 0.f};
    const unsigned vlo = (unsigned)(fq * 4) * (NH * HD) + fr;
    for (int ch = 0; ch < 4; ++ch) {
        const int key0 = (ch * 8 + wid) * 64;
        f32x4 s4[4];
#pragma unroll
        for (int tl = 0; tl < 4; ++tl) { const int kbase = key0 + tl * 16;
            const float* kp = T.ck + (((size_t)b * PAST + kbase + fr) * NH + h) * HD + fq * 8;
            f32x4 acc = *(const f32x4*)(Fl + kbase + fq * 4);
#pragma unroll
            for (int dc = 0; dc < 4; ++dc) { const f32x4 x0 = *(const f32x4*)(kp + dc * 32), x1 = *(const f32x4*)(kp + dc * 32 + 4);
                acc = __builtin_amdgcn_mfma_f32_16x16x32_bf16(pack8(x0, x1), qf[dc], acc, 0, 0, 0); }
            s4[tl] = acc; }
        float cm = s4[0][0];
#pragma unroll
        for (int tl = 0; tl < 4; ++tl)
#pragma unroll
            for (int j = 0; j < 4; ++j) cm = fmaxf(cm, s4[tl][j]);
        cm = xmax16(cm); cm = xmax32(cm);
        const float mn = fmaxf(m_run, cm), alpha = __builtin_amdgcn_exp2f(m_run - mn); m_run = mn;
        float ps = 0.f;
#pragma unroll
        for (int tl = 0; tl < 4; ++tl)
#pragma unroll
            for (int j = 0; j < 4; ++j) { s4[tl][j] = __builtin_amdgcn_exp2f(s4[tl][j] - mn); ps += s4[tl][j]; }
        ps = xsum16(ps); ps = xsum32(ps);
        l_run = l_run * alpha + ps;
#pragma unroll
        for (int dt = 0; dt < 8; ++dt) ot[dt] *= alpha;
#pragma unroll
        for (int hf = 0; hf < 2; ++hf) {
            const bf16x8 pb = pack8(s4[2 * hf], s4[2 * hf + 1]);
            const float* vb_u = T.cv + (((size_t)b * PAST + key0 + hf * 32) * NH + h) * HD;
#pragma unroll
            for (int dt = 0; dt < 8; ++dt) { f32x4 v0, v1;
#pragma unroll
                for (int i = 0; i < 4; ++i) { v0[i] = (vb_u + (size_t)i * (NH * HD) + dt * 16)[vlo]; v1[i] = (vb_u + (size_t)(16 + i) * (NH * HD) + dt * 16)[vlo]; }
                ot[dt] = __builtin_amdgcn_mfma_f32_16x16x32_bf16(pack8(v0, v1), pb, ot[dt], 0, 0, 0); } }
    }
    if (wid == 0) {
        f32x4 acc = *(const f32x4*)(Fl + PAST + fq * 4);
        const bf16_t* kp = T.kb + (qrow + fr) * DM + h * HD + fq * 8;
#pragma unroll
        for (int dc = 0; dc < 4; ++dc) acc = __builtin_amdgcn_mfma_f32_16x16x32_bf16(*(const bf16x8*)(kp + dc * 32), qf[dc], acc, 0, 0, 0);
#pragma unroll
        for (int j = 0; j < 4; ++j) if (fq * 4 + j > fr) acc[j] = -__builtin_inff();
        float cm = fmaxf(fmaxf(acc[0], acc[1]), fmaxf(acc[2], acc[3]));
        cm = xmax16(cm); cm = xmax32(cm);
        const float mn = fmaxf(m_run, cm), alpha = __builtin_amdgcn_exp2f(m_run - mn); m_run = mn;
        float ps = 0.f;
#pragma unroll
        for (int j = 0; j < 4; ++j) { acc[j] = __builtin_amdgcn_exp2f(acc[j] - mn); ps += acc[j]; }
        ps = xsum16(ps); ps = xsum32(ps);
        l_run = l_run * alpha + ps;
        const bf16x8 pb = pack8(acc, (f32x4){0.f, 0.f, 0.f, 0.f});
        const bf16_t* vb_u = T.vb + qrow * DM + h * HD; const unsigned vlo2 = (unsigned)(fq * 4) * DM + fr;
#pragma unroll
        for (int dt = 0; dt < 8; ++dt) { ot[dt] *= alpha;
            unsigned w0 = (unsigned)(vb_u + dt * 16)[vlo2] | ((unsigned)(vb_u + DM + dt * 16)[vlo2] << 16), w1 = (unsigned)(vb_u + 2 * DM + dt * 16)[vlo2] | ((unsigned)(vb_u + 3 * DM + dt * 16)[vlo2] << 16);
            u32x4 w = {w0, w1, 0u, 0u};
            ot[dt] = __builtin_amdgcn_mfma_f32_16x16x32_bf16(*reinterpret_cast<bf16x8*>(&w), pb, ot[dt], 0, 0, 0); }
    }
#pragma unroll
    for (int dt = 0; dt < 8; ++dt) *(f32x4*)(Op + (wid * 16 + fr) * HD + dt * 16 + fq * 4) = ot[dt];
    if (fq == 0) { ML[(wid * 16 + fr) * 2] = m_run; ML[(wid * 16 + fr) * 2 + 1] = l_run; }
    __syncthreads();
    { const int q = tid >> 5, d4 = (tid & 31) * 4;
      float mx = ML[q * 2];
#pragma unroll
      for (int w = 1; w < 8; ++w) mx = fmaxf(mx, ML[(w * 16 + q) * 2]);
      float L = 0.f; f32x4 O = {0.f, 0.f, 0.f, 0.f};
#pragma unroll
      for (int w = 0; w < 8; ++w) { const float s = __builtin_amdgcn_exp2f(ML[(w * 16 + q) * 2] - mx); L += s * ML[(w * 16 + q) * 2 + 1]; O += *(const f32x4*)(Op + (w * 16 + q) * HD + d4) * s; }
      const float il = 1.0f / L; const size_t off = (qrow + q) * DM + h * HD + d4;
      const u32x2 gw = *(const u32x2*)(T.sg + off);
      u32x2 w; w.x = cvtpk(O[0] * il * bflo(gw.x), O[1] * il * bfhi(gw.x)); w.y = cvtpk(O[2] * il * bflo(gw.y), O[3] * il * bfhi(gw.y));
      *(u32x2*)(T.og + off) = w; }
    __syncthreads();
}
}

__device__ __forceinline__ void transpose_item(const float* W, int ldw, int N, bf16_t* WT, int K, const float* g, float* scr, int item, int lane) {
    const int nblk = (N + 31) / 32, kb = item / nblk, nb = item % nblk, k0 = 64 * kb, n0 = 32 * nb;
    const int c4 = (lane & 7) * 4, kr = lane >> 3; const bool nok = n0 + c4 < N;
    f32x4 v[8];
#pragma unroll
    for (int i = 0; i < 8; ++i) v[i] = nok ? *(const f32x4*)(W + (size_t)(k0 + 8 * i + kr) * ldw + n0 + c4) : (f32x4){0.f, 0.f, 0.f, 0.f};
    if (g) {
#pragma unroll
        for (int i = 0; i < 8; ++i) v[i] *= g[k0 + 8 * i + kr]; }
#pragma unroll
    for (int i = 0; i < 8; ++i) { float* s = scr + (8 * i + kr) * 33 + c4; s[0] = v[i][0]; s[1] = v[i][1]; s[2] = v[i][2]; s[3] = v[i][3]; }
    asm volatile("s_waitcnt lgkmcnt(0)" ::: "memory");
    const int c = lane & 7;
#pragma unroll
    for (int j = 0; j < 4; ++j) { const int nn = (lane >> 3) + 8 * j; const float* s = scr + (8 * c) * 33 + nn;
        u32x4 o; o.x = cvtpk(s[0 * 33], s[1 * 33]); o.y = cvtpk(s[2 * 33], s[3 * 33]); o.z = cvtpk(s[4 * 33], s[5 * 33]); o.w = cvtpk(s[6 * 33], s[7 * 33]);
        if (n0 + nn < N) *(u32x4*)(WT + (size_t)(n0 + nn) * K + k0 + 8 * c) = o; }
    asm volatile("s_waitcnt lgkmcnt(0)" ::: "memory");
}
struct TJob { const float* W; bf16_t* WT; const float* g; int K, N, ldw; };
__device__ __forceinline__ TJob get_job(const Params& p, int j) {
    unsigned char* ws = p.ws; TJob t; t.g = nullptr; t.ldw = 0;
    if (j < 2) { t.W = p.in[7] + (size_t)j * DM * 2 * EA + EA; t.WT = (bf16_t*)(ws + WS_WINA) + (size_t)j * 2 * EA * DM + (size_t)EA * DM; t.g = p.in[6] + j * DM; t.K = DM; t.N = EA; t.ldw = 2 * EA; }
    else if (j >= 17) { const int l = j - 17; t.W = p.in[7] + (size_t)l * DM * 2 * EA; t.WT = (bf16_t*)(ws + WS_WINUT) + (size_t)l * EA * DM; t.g = p.in[6] + l * DM; t.K = DM; t.N = EA; t.ldw = 2 * EA; }
    else if (j < 10) { const int i = j - 2; t.W = p.in[8] + (size_t)i * 1024 * 1024; t.WT = (bf16_t*)(ws + WS_WGRP) + (size_t)i * 1024 * 1024; t.K = 1024; t.N = 1024; }
    else if (j < 12) { const int l = j - 10; t.W = p.in[10] + (size_t)l * EA * DM; t.WT = (bf16_t*)(ws + WS_WOUTA) + (size_t)l * DM * EA; t.K = EA; t.N = DM; }
    else if (j == 12) { t.W = p.in[12]; t.WT = (bf16_t*)(ws + WS_W4); t.g = p.in[11]; t.K = DM; t.N = 2 * DM + NH; }
    else if (j == 13) { t.W = p.in[15]; t.WT = (bf16_t*)(ws + WS_W4) + (size_t)4352 * DM; t.g = p.in[14]; t.K = DM; t.N = 2 * DM; }
    else if (j == 14) { t.W = p.in[15] + (size_t)DM * 2 * DM; t.WT = (bf16_t*)(ws + WS_WINB1); t.g = p.in[14] + DM; t.K = DM; t.N = 2 * DM; }
    else { const int l = j - 15; t.W = p.in[16] + (size_t)l * DM * DM; t.WT = (bf16_t*)(ws + WS_WOUTB) + (size_t)l * DM * DM; t.K = DM; t.N = DM; }
    if (t.ldw == 0) t.ldw = t.N;
    return t;
}
__device__ __forceinline__ void prologue_phase(int wv, const Params& p, char* lds) {
    const int tid = otid(wv), lane = tid & 63, wid = tid >> 6, G = gridDim.x;
    const int gw = blockIdx.x * NWAVES + wid, NGW = G * NWAVES;
    float* scr = (float*)(lds + wid * 8704);
    int rot = 0;
    for (int j = 0; j < 19; ++j) { const TJob t = get_job(p, j); const int nitems = (t.K / 64) * ((t.N + 31) / 32);
        int start = gw - rot; if (start < 0) start += NGW;
        for (int it = start; it < nitems; it += NGW) transpose_item(t.W, t.ldw, t.N, t.WT, t.K, t.g, scr, it, lane);
        rot = (rot + nitems) % NGW; }
    float* ssq = (float*)(p.ws + WS_SSQ); bf16_t* xb = (bf16_t*)(p.ws + WS_XB);
    for (int m = gw; m < MT; m += NGW) { const float* xr = m < MP ? p.in[0] + (size_t)m * DM : p.in[1] + (size_t)(m - MP) * DM;
        float s = 0.f; unsigned long long* o8 = (unsigned long long*)(xb + (size_t)m * DM) + lane;
#pragma unroll
        for (int j = 0; j < 8; ++j) { const f32x4 v = *((const f32x4*)xr + lane + 64 * j); s += (v[0] * v[0] + v[1] * v[1]) + (v[2] * v[2] + v[3] * v[3]);
            o8[64 * j] = (unsigned long long)cvtpk(v[0], v[1]) | ((unsigned long long)cvtpk(v[2], v[3]) << 32); }
        s = wave_sum(s); if (lane == 0) ssq[m] = s; }
    for (int i = blockIdx.x * NTHREADS + tid; i < 4 * MT; i += G * NTHREADS) ssq[MT + i] = 0.f;
    { f32x4* z = (f32x4*)(p.ws + WS_SPLIT); const size_t nz = (SPLIT_TILES * SPLIT_TILE + SPLIT_TILES * 8 * 4) / 16;
      for (size_t i = (size_t)blockIdx.x * NTHREADS + tid; i < nz; i += (size_t)G * NTHREADS) z[i] = (f32x4){0.f, 0.f, 0.f, 0.f}; }
    { bf16_t* wus = (bf16_t*)(p.ws + WS_WINUS);
      for (int i = blockIdx.x * NTHREADS + tid; i < 2 * DM * (EA / 8); i += G * NTHREADS) { const int r = i >> 9, c = (i & 511) * 8, l = r >> 11, k = r & (DM - 1);
          const float* s = p.in[7] + ((size_t)l * DM + k) * 2 * EA + c; const float gk = p.in[6][l * DM + k];
          *(bf16x8*)(wus + (size_t)r * EA + c) = pack8(*(const f32x4*)s * gk, *(const f32x4*)(s + 4) * gk); }
      bf16_t* pb = (bf16_t*)(p.ws + WS_PREVB);
      for (int i = blockIdx.x * NTHREADS + tid; i < 2 * 256 * (EA / 8); i += G * NTHREADS) { const int r = i >> 9, c = (i & 511) * 8, l = r >> 8, rr = r & 255;
          f32x4 a = {0.f, 0.f, 0.f, 0.f}, b = a;
          if (rr < NDB * PPAD) { const float* s = p.in[5] + ((size_t)l * NDB * PPAD + rr) * EA + c; a = *(const f32x4*)s; b = *(const f32x4*)(s + 4); }
          *(bf16x8*)(pb + (size_t)r * EA + c) = pack8(a, b); } }
}
template <int W>
__device__ __forceinline__ void poolmix_item(const bf16_t* tt, const bf16_t* sg, const float* scale, const bf16_t* prevt, bf16_t* yg, int row0, int ch) {
    constexpr int NR = 16 + W - 1;
    u32x4 rows[NR];
    const bool samp = row0 >= MP; const int t0 = samp ? 0 : (row0 & (SEQ - 1));
    const bf16_t* up = tt + (size_t)row0 * EA + ch;
    if (t0 != 0) {
#pragma unroll
        for (int i = 0; i < NR; ++i) rows[i] = *(const u32x4*)(up + (ptrdiff_t)(i - (W - 1)) * EA);
    } else {
#pragma unroll
        for (int i = W - 1; i < NR; ++i) rows[i] = *(const u32x4*)(up + (ptrdiff_t)(i - (W - 1)) * EA);
        if (samp) { const bf16_t* pp = prevt + ((size_t)((row0 - MP) >> 4) * PPAD + (PPAD - (W - 1))) * EA + ch;
#pragma unroll
            for (int i = 0; i < W - 1; ++i) rows[i] = *(const u32x4*)(pp + (size_t)i * EA); }
        else {
#pragma unroll
            for (int i = 0; i < W - 1; ++i) rows[i] = (u32x4){0u, 0u, 0u, 0u}; }
    }
    const f32x4 sc0 = *(const f32x4*)(scale + ch), sc1 = *(const f32x4*)(scale + ch + 4);
    float s[8] = {0.f, 0.f, 0.f, 0.f, 0.f, 0.f, 0.f, 0.f};
#define ROWF(v, f) const float f[8] = {bflo(v.x), bfhi(v.x), bflo(v.y), bfhi(v.y), bflo(v.z), bfhi(v.z), bflo(v.w), bfhi(v.w)}
#pragma unroll
    for (int i = 0; i < W - 1; ++i) { ROWF(rows[i], f);
#pragma unroll
        for (int c = 0; c < 8; ++c) s[c] += f[c]; }
#pragma unroll
    for (int j = 0; j < 16; ++j) { ROWF(rows[j + W - 1], f);
        const u32x4 gv = *(const u32x4*)(sg + (size_t)(row0 + j) * EA + ch); ROWF(gv, gt);
#pragma unroll
        for (int c = 0; c < 8; ++c) s[c] += f[c];
        const int nv = (!samp && t0 + j + 1 < W) ? t0 + j + 1 : W; const float ic = 1.0f / (float)nv;
        u32x4 o; o.x = cvtpk((s[0] * ic - f[0]) * sc0[0] * gt[0], (s[1] * ic - f[1]) * sc0[1] * gt[1]); o.y = cvtpk((s[2] * ic - f[2]) * sc0[2] * gt[2], (s[3] * ic - f[3]) * sc0[3] * gt[3]);
        o.z = cvtpk((s[4] * ic - f[4]) * sc1[0] * gt[4], (s[5] * ic - f[5]) * sc1[1] * gt[5]); o.w = cvtpk((s[6] * ic - f[6]) * sc1[2] * gt[6], (s[7] * ic - f[7]) * sc1[3] * gt[7]);
        *(u32x4*)(yg + (size_t)(row0 + j) * EA + ch) = o;
        ROWF(rows[j], g);
#pragma unroll
        for (int c = 0; c < 8; ++c) s[c] -= g[c]; }
#undef ROWF
}
__device__ __forceinline__ void poolmix_phase(int wv, const Params& p, int l) {
    const bf16_t* tt = (const bf16_t*)(p.ws + WS_U); const bf16_t* sg = (const bf16_t*)(p.ws + WS_SG); bf16_t* yg = (bf16_t*)(p.ws + WS_D);
    const bf16_t* prevt = (const bf16_t*)(p.ws + WS_PREVT) + (size_t)l * 256 * EA; const float* scale = p.in[9] + (size_t)l * EA;
    const int nth = gridDim.x * NTHREADS;
    for (int idx = blockIdx.x * NTHREADS + otid(wv); idx < (MT / 16) * (EA / 8); idx += nth) {
        const int row0 = (idx >> 9) * 16, ch = (idx & 511) * 8, grp = __builtin_amdgcn_readfirstlane(ch >> 10);
        if (grp == 0) poolmix_item<2>(tt, sg, scale, prevt, yg, row0, ch);
        else if (grp == 1) poolmix_item<4>(tt, sg, scale, prevt, yg, row0, ch);
        else if (grp == 2) poolmix_item<8>(tt, sg, scale, prevt, yg, row0, ch);
        else poolmix_item<16>(tt, sg, scale, prevt, yg, row0, ch);
    }
}
__device__ __forceinline__ void final_phase(int wv, const Params& p) {
    const int tid = otid(wv), lane = tid & 63, gw = blockIdx.x * NWAVES + (tid >> 6), NGW = gridDim.x * NWAVES;
    const float* xres = (const float*)(p.ws + WS_XRES); const float* ssq = (const float*)(p.ws + WS_SSQ) + (size_t)4 * MT; const float* g = p.in[17];
    for (int m = gw; m < MT; m += NGW) { const float rr = rsqrtf(ssq[m] * (1.0f / DM) + EPS);
        const f32x4* xr = (const f32x4*)(xres + (size_t)m * DM) + lane; f32x4* o = (f32x4*)(p.out + (m < MP ? O_YP + (size_t)m * DM : O_YS + (size_t)(m - MP) * DM)) + lane;
#pragma unroll
        for (int j = 0; j < 8; ++j) o[64 * j] = xr[64 * j] * rr * ((const f32x4*)g)[lane + 64 * j]; }
}

constexpr int NPHASES = 15;
typedef const __attribute__((address_space(4))) Params* KArgPtr;
#if defined(__HIP_DEVICE_COMPILE__)
#define LOADP_() KArgPtr kp_ = (KArgPtr)__builtin_amdgcn_kernarg_segment_ptr(); asm volatile("" : "+s"(kp_)); Params lp; _Pragma("unroll") for (int i_ = 0; i_ < 18; ++i_) lp.in[i_] = kp_->in[i_]; lp.out = kp_->out; lp.ws = kp_->ws; lp.ph_lo = 0; lp.ph_hi = 0
#else
#define LOADP_() const Params lp = p
#endif
#define LOADP() LOADP_(); unsigned char* const ws = lp.ws; \
    float* const ssq = (float*)(ws + WS_SSQ); bf16_t* const xb = (bf16_t*)(ws + WS_XB); float* const xres = (float*)(ws + WS_XRES); (void)ssq; (void)xb; (void)xres
__global__ void __launch_bounds__(NTHREADS, 2) yoco_fwd(Params p) {
    extern __shared__ __attribute__((aligned(16))) unsigned char lds_raw[];
    char* lds = (char*)lds_raw; LAS unsigned char* ldsl = (LAS unsigned char*)lds_raw;
    const int G = gridDim.x, bx = blockIdx.x, wv = __builtin_amdgcn_readfirstlane(threadIdx.x >> 6);
#ifndef ONLY_PHASE
#define ONLY_PHASE -1
#endif
#define IN(k) ((ONLY_PHASE < 0 || ONLY_PHASE == (k)) && p.ph_lo <= (k) && (k) < p.ph_hi)
#ifndef SAT_REP
#define SAT_REP 1
#endif
#ifndef REPEAT_MASK
#define REPEAT_MASK 0
#endif
#define NREP(k) (1 + (int)(((unsigned)(REPEAT_MASK) >> (k)) & 1u))
#define SEAM(k) do { if (rep_ + 1 < NREP(k) || (k) + 1 < p.ph_hi) cg::this_grid().sync(); } while (0)
    if (IN(0)) for (int rep_ = 0; rep_ < NREP(0); ++rep_) { { LOADP(); prologue_phase(wv, lp, lds); } SEAM(0); }
    if (IN(1)) for (int rep_ = 0; rep_ < NREP(1); ++rep_) {
        { LOADP(); pg8::Gemm g{(const bf16_t*)(ws + WS_WGRP), (const bf16_t*)(ws + WS_WINUS), 1024, 1024, EA, 2, nullptr, nullptr}; pg8::StaticOrder S; S.init(32, 8, G, bx);
          pg8::EpiStore E{(bf16_t*)(ws + WS_WINA), DM, 1};
          pg8::gemm_phase<pg8::EpiStore, pg8::StaticOrder>(wv, ldsl, g, S, E); }
        { LOADP(); pg8::Gemm g{(const bf16_t*)(ws + WS_PREVB), (const bf16_t*)(ws + WS_WGRP), 1024, EA, 1024, 3, nullptr, nullptr}; pg8::StaticOrder S; S.init(2, 16, G, bx);
          pg8::EpiStore E{(bf16_t*)(ws + WS_PREVT), EA, 0};
          pg8::gemm_phase<pg8::EpiStore, pg8::StaticOrder>(wv, ldsl, g, S, E); }
        SEAM(1); }
#pragma unroll 1
    for (int l = 0; l < 2; ++l) {
        int wv_o = wv, bx_o = bx, G_o = G; asm volatile("" : "+s"(wv_o), "+s"(bx_o), "+s"(G_o));
        const int wv = wv_o, bx = bx_o, G = G_o;
        if (IN(2 + 3 * l)) for (int rep_ = 0; rep_ < NREP(2 + 3 * l); ++rep_) {
            { LOADP(); bf16_t* u = (bf16_t*)(ws + WS_U); bf16_t* sg = (bf16_t*)(ws + WS_SG);
              pg8::Gemm g{xb, (const bf16_t*)(ws + WS_WINA) + (size_t)l * 2 * EA * DM, DM, DM, DM, 0, nullptr, nullptr}; pg8::StaticOrder S; S.init(65, 32, G, bx);
              pg8::EpiInA E{ssq + (size_t)l * MT, u, sg};
              pg8::gemm_phase<pg8::EpiInA, pg8::StaticOrder>(wv, ldsl, g, S, E); }
            { LOADP(); pg8::Gemm g{xb, (const bf16_t*)(ws + WS_WINUT) + (size_t)l * EA * DM, DM, DM, DM, 0, nullptr, nullptr}; pg8::StateOrder S{G, bx};
              pg8::EpiUState E{ssq + (size_t)l * MT, lp.out + O_PP + (size_t)l * NBATCH * PPAD * EA, lp.out + O_PS + (size_t)l * NDB * PPAD * EA};
              pg8::gemm_phase<pg8::EpiUState, pg8::StateOrder>(wv, ldsl, g, S, E); }
            SEAM(2 + 3 * l); }
        if (IN(3 + 3 * l)) for (int rep_ = 0; rep_ < NREP(3 + 3 * l); ++rep_) { { LOADP(); poolmix_phase(wv, lp, l); } SEAM(3 + 3 * l); }
        if (IN(4 + 3 * l)) for (int rep_ = 0; rep_ < NREP(4 + 3 * l); ++rep_) { { LOADP(); bf16_t* yg = (bf16_t*)(ws + WS_D);
            pg8::Gemm g{yg, (const bf16_t*)(ws + WS_WOUTA) + (size_t)l * DM * EA, EA, EA, EA, 0, (float*)(ws + WS_SPLIT) + (size_t)l * 8 * 65536, (unsigned*)(ws + WS_SPCNT) + l * 64}; pg8::SplitOrder S; S.init(8, 8, G, bx);
            pg8::EpiRes E{l == 0 ? lp.in[0] : xres, l == 0 ? lp.in[1] : xres + (size_t)MP * DM, xres, xb, ssq + (size_t)(l + 1) * MT};
            pg8::gemm_phase<pg8::EpiRes, pg8::SplitOrder>(wv, ldsl, g, S, E); } SEAM(4 + 3 * l); }
    }
#pragma unroll 1
    for (int lb = 0; lb < 2; ++lb) {
        int wv_o = wv, bx_o = bx, G_o = G; asm volatile("" : "+s"(wv_o), "+s"(bx_o), "+s"(G_o));
        const int wv = wv_o, bx = bx_o, G = G_o;
        if (IN(8 + 3 * lb)) for (int rep_ = 0; rep_ < NREP(8 + 3 * lb); ++rep_) { { LOADP();
            pg8::EpiKVQ E{lb == 0 ? 0 : 17, ssq + (size_t)(2 + lb) * MT, lp.out, ws, lp.in[13]};
            if (lb == 0) { pg8::Gemm g{xb, (const bf16_t*)(ws + WS_W4), DM, DM, DM, 0, nullptr, nullptr}; pg8::StaticOrder S; S.init(65, 33, G, bx);
                pg8::gemm_phase<pg8::EpiKVQ, pg8::StaticOrder>(wv, ldsl, g, S, E); }
            else { pg8::Gemm g{xb, (const bf16_t*)(ws + WS_WINB1), DM, DM, DM, 0, (float*)(ws + WS_SPLIT) + (size_t)32 * 65536, (unsigned*)(ws + WS_SPCNT) + 256}; pg8::SplitOrder S; S.init(16, 4, G, bx);
                pg8::gemm_phase<pg8::EpiKVQ, pg8::SplitOrder>(wv, ldsl, g, S, E); } } SEAM(8 + 3 * lb); }
        if (IN(9 + 3 * lb)) for (int rep_ = 0; rep_ < NREP(9 + 3 * lb); ++rep_) {
            { const int xcd = bx & 7, j = bx >> 3;
              if (G != 256 || j >= 24) { LOADP();
                  sat::Tensors ST{(const bf16_t*)(ws + WS_QB), (const bf16_t*)(ws + WS_KB), (const bf16_t*)(ws + WS_VB), (bf16_t*)(ws + WS_OG), (const bf16_t*)(ws + WS_SGB),
                                  lp.in[2], lp.in[3], lp.in[4], (const float*)(ws + WS_LFTS)};
                  const int s0 = G == 256 ? xcd * 8 + (j - 24) : bx, sstep = G == 256 ? 64 : G;
                  for (int it = s0; it < NDB * NH; it += sstep) sat::item(wv, lds, ST, it >> 4, it & 15); }
              if (G != 256 || j < 24) { LOADP();
                  att::Tensors AT{(const bf16_t*)(ws + WS_QB), (const bf16_t*)(ws + WS_KB), (const bf16_t*)(ws + WS_VB), (bf16_t*)(ws + WS_OG), (const bf16_t*)(ws + WS_SGB), (const float*)(ws + WS_LFTP)};
                  const int p0 = G == 256 ? xcd * 24 + j : bx, pstep = G == 256 ? 192 : G;
                  for (int pw = p0; pw < 192; pw += pstep) att::prompt_phase(wv, lds, AT, (const float*)(ws + WS_KNRM), (const float*)(ws + WS_QNRM), pw); } }
            SEAM(9 + 3 * lb); }
        if (IN(10 + 3 * lb)) for (int rep_ = 0; rep_ < NREP(10 + 3 * lb); ++rep_) { { LOADP();
            pg8::Gemm g{(const bf16_t*)(ws + WS_OG), (const bf16_t*)(ws + WS_WOUTB) + (size_t)lb * DM * DM, DM, DM, DM, 0, (float*)(ws + WS_SPLIT) + (size_t)(2 + lb) * 8 * 65536, (unsigned*)(ws + WS_SPCNT) + (2 + lb) * 64}; pg8::SplitOrder S; S.init(8, 4, G, bx);
            pg8::EpiRes E{xres, xres + (size_t)MP * DM, xres, xb, ssq + (size_t)(3 + lb) * MT};
            pg8::gemm_phase<pg8::EpiRes, pg8::SplitOrder>(wv, ldsl, g, S, E); } SEAM(10 + 3 * lb); }
    }
    if (IN(14)) { LOADP(); final_phase(wv, lp); }
#undef IN
#undef SEAM
}

extern "C" void kernel_launch(void* const* d_in, const int* in_sizes, int n_in, void* d_out, int out_size, void* d_ws, size_t ws_size, hipStream_t stream) {
    static int grid = 0;
    if (grid == 0) {
        if (n_in != 18 || (size_t)out_size != O_END || ws_size < WS_END) { fprintf(stderr, "kernel_launch: unexpected shapes: n_in %d out %d (want %zu) ws %zu (need %zu)\n", n_in, out_size, (size_t)O_END, ws_size, (size_t)WS_END); grid = -1; return; }
        int dev = 0, cus = 0, per_cu = 0;
        (void)hipGetDevice(&dev); (void)hipDeviceGetAttribute(&cus, hipDeviceAttributeMultiprocessorCount, dev);
        if (hipFuncSetAttribute((const void*)yoco_fwd, hipFuncAttributeMaxDynamicSharedMemorySize, LDS_BYTES) != hipSuccess) { fprintf(stderr, "kernel_launch: hipFuncSetAttribute failed\n"); grid = -1; return; }
        if (hipOccupancyMaxActiveBlocksPerMultiprocessor(&per_cu, (const void*)yoco_fwd, NTHREADS, LDS_BYTES) != hipSuccess || per_cu < 1) { fprintf(stderr, "kernel_launch: occupancy query gave %d\n", per_cu); per_cu = 1; }
        (void)hipGetLastError();
        grid = cus > 0 ? cus : 256;
    }
    if (grid < 0) return;
    Params p{};
    for (int i = 0; i < 18; ++i) p.in[i] = (const float*)d_in[i];
    p.out = (float*)d_out; p.ws = (unsigned char*)d_ws;
#if MULTI_LAUNCH
    for (int ph = 0; ph < NPHASES; ++ph) { p.ph_lo = ph; p.ph_hi = ph + 1; hipLaunchKernelGGL(yoco_fwd, dim3(grid), dim3(NTHREADS), LDS_BYTES, stream, p); }
#else
    p.ph_lo = 0; p.ph_hi = NPHASES;
    void* args[] = {&p};
    hipError_t e = hipLaunchCooperativeKernel((const void*)yoco_fwd, dim3(grid), dim3(NTHREADS), args, LDS_BYTES, stream);
    if (e != hipSuccess) fprintf(stderr, "kernel_launch: cooperative launch failed: %s (grid %d)\n", hipGetErrorString(e), grid);
#endif
}
```

```cpp
#include <hip/hip_runtime.h>
#include <hip/hip_cooperative_groups.h>
#include <cstdio>
#include <cstdint>
namespace cg = cooperative_groups;

#ifndef MULTI_LAUNCH
#define MULTI_LAUNCH 0
#endif

#define LAS __attribute__((address_space(3)))
typedef unsigned short bf16_t;
typedef short bf16x8 __attribute__((ext_vector_type(8)));
typedef short s16x4 __attribute__((ext_vector_type(4)));
typedef float f32x4 __attribute__((ext_vector_type(4)));
typedef float f32x16 __attribute__((ext_vector_type(16)));
typedef unsigned u32x4 __attribute__((ext_vector_type(4)));
typedef unsigned u32x2 __attribute__((ext_vector_type(2)));

constexpr int DM = 2048, NBATCH = 4, SEQ = 4096, NDB = 16, DSEQ = 16, PAST = 2048, EA = 4096, NH = 16, HD = 128, PPAD = 15;
constexpr int MP = NBATCH * SEQ, MS = NDB * DSEQ, MT = MP + MS;
constexpr float EPS = 1e-6f;
constexpr float LOG2E = 1.4426950408889634f;
constexpr float QSCALE = 0.08838834764831845f * 1.4426950408889634f;
constexpr int NTHREADS = 512, NWAVES = 8;
constexpr int LDS_BYTES = 131072;

constexpr size_t O_YP = 0, O_YS = O_YP + (size_t)MP * DM, O_KP = O_YS + (size_t)MS * DM, O_VP = O_KP + (size_t)MP * DM,
                 O_LFP = O_VP + (size_t)MP * DM, O_PP = O_LFP + (size_t)MP * NH, O_KS = O_PP + (size_t)2 * NBATCH * PPAD * EA,
                 O_VS = O_KS + (size_t)MS * DM, O_LFS = O_VS + (size_t)MS * DM, O_PS = O_LFS + (size_t)MS * NH, O_END = O_PS + (size_t)2 * NDB * PPAD * EA;

constexpr size_t al256(size_t x) { return (x + 255) & ~(size_t)255; }
constexpr size_t WS_WINA = 0;
constexpr size_t WS_WGRP = WS_WINA + (size_t)2 * 8192 * 2048 * 2;
constexpr size_t WS_WOUTA = WS_WGRP + (size_t)2 * 4096 * 1024 * 2;
constexpr size_t WS_W4 = WS_WOUTA + (size_t)2 * 2048 * 4096 * 2;
constexpr size_t WS_WINB1 = WS_W4 + (size_t)8448 * 2048 * 2;
constexpr size_t WS_WOUTB = WS_WINB1 + (size_t)4096 * 2048 * 2;
constexpr size_t WS_XB = WS_WOUTB + (size_t)2 * 2048 * 2048 * 2;
constexpr size_t WS_XRES = WS_XB + (size_t)MT * DM * 2;
constexpr size_t WS_SSQ = WS_XRES + (size_t)MT * DM * 4;
constexpr size_t WS_LFTP = al256(WS_SSQ + (size_t)5 * MT * 4);
constexpr size_t WS_LFTS = WS_LFTP + (size_t)NBATCH * NH * SEQ * 4;
constexpr size_t WS_KNRM = al256(WS_LFTS + (size_t)NDB * NH * DSEQ * 4);
constexpr size_t WS_QNRM = WS_KNRM + (size_t)MT * NH * 4 * 4;
constexpr size_t WS_WINUT = al256(WS_QNRM + (size_t)MT * NH * 4 * 4);
constexpr size_t WS_WINUS = WS_WINUT + (size_t)2 * EA * DM * 2;
constexpr size_t WS_PREVB = WS_WINUS + (size_t)2 * DM * EA * 2;
constexpr size_t WS_PREVT = WS_PREVB + (size_t)2 * 256 * EA * 2;
constexpr size_t WS_SPLIT = al256(WS_PREVT + (size_t)2 * 256 * EA * 2);
constexpr size_t SPLIT_TILE = 65536 * 4, SPLIT_TILES = 8 * 4 + 16;
constexpr size_t WS_SPCNT = WS_SPLIT + SPLIT_TILES * SPLIT_TILE;
constexpr size_t WS_ACT = al256(WS_SPCNT + SPLIT_TILES * 8 * 4);
constexpr size_t SZ_A = (size_t)MT * EA * 2, SZ_B = (size_t)MT * DM * 2;
constexpr size_t WS_U = WS_ACT, WS_SG = WS_U + SZ_A, WS_D = WS_SG + SZ_A;
constexpr size_t WS_KB = WS_ACT, WS_VB = WS_KB + SZ_B, WS_QB = WS_VB + SZ_B, WS_SGB = WS_QB + SZ_B, WS_OG = WS_SGB + SZ_B;
constexpr size_t WS_END = (WS_D + SZ_A) > (WS_OG + SZ_B) ? (WS_D + SZ_A) : (WS_OG + SZ_B);

struct Params { const float* in[18]; float* out; unsigned char* ws; int ph_lo, ph_hi; };

__device__ __forceinline__ unsigned cvtpk(float lo, float hi) { unsigned r; asm volatile("v_cvt_pk_bf16_f32 %0, %1, %2" : "=v"(r) : "v"(lo), "v"(hi)); return r; }
__device__ __forceinline__ bf16x8 pack8(f32x4 a, f32x4 b) { u32x4 w = {cvtpk(a[0], a[1]), cvtpk(a[2], a[3]), cvtpk(b[0], b[1]), cvtpk(b[2], b[3])}; return *reinterpret_cast<bf16x8*>(&w); }
__device__ __forceinline__ float bflo(unsigned w) { return __uint_as_float(w << 16); }
__device__ __forceinline__ float bfhi(unsigned w) { return __uint_as_float(w & 0xffff0000u); }
__device__ __forceinline__ float silu_f(float x) { return x * __builtin_amdgcn_rcpf(1.0f + __builtin_amdgcn_exp2f(-x * LOG2E)); }
__device__ __forceinline__ float wave_sum(float v) {
#pragma unroll
    for (int o = 1; o < 64; o <<= 1) v += __shfl_xor(v, o);
    return v;
}
__device__ __forceinline__ int otid(int wv) { int l; asm volatile("v_mbcnt_lo_u32_b32 %0, -1, 0\n\tv_mbcnt_hi_u32_b32 %0, -1, %0" : "=v"(l)); return wv * 64 + l; }
__device__ __forceinline__ float xsum16(float v) { auto r = __builtin_amdgcn_permlane16_swap(__float_as_uint(v), __float_as_uint(v), false, false); return __uint_as_float(r[0]) + __uint_as_float(r[1]); }
__device__ __forceinline__ float xsum32(float v) { auto r = __builtin_amdgcn_permlane32_swap(__float_as_uint(v), __float_as_uint(v), false, false); return __uint_as_float(r[0]) + __uint_as_float(r[1]); }
__device__ __forceinline__ float xmax16(float v) { auto r = __builtin_amdgcn_permlane16_swap(__float_as_uint(v), __float_as_uint(v), false, false); return fmaxf(__uint_as_float(r[0]), __uint_as_float(r[1])); }
__device__ __forceinline__ float xmax32(float v) { auto r = __builtin_amdgcn_permlane32_swap(__float_as_uint(v), __float_as_uint(v), false, false); return fmaxf(__uint_as_float(r[0]), __uint_as_float(r[1])); }
__device__ __forceinline__ float bperm(float v, int srclane) { return __uint_as_float((unsigned)__builtin_amdgcn_ds_bpermute(srclane << 2, (int)__float_as_uint(v))); }
__device__ __forceinline__ float logsig(float x) { return fminf(x, 0.f) - log1pf(__expf(-fabsf(x))); }

namespace pg8 {
constexpr int BM = 256, BK = 64, HALF = 128, HTB = HALF * BK * 2, NXCD = 8, WGM = 8;
__device__ __forceinline__ int lds_byte(int r, int c) { const int st = (r >> 4) * 2 + (c >> 5), rr = r & 15, cc = c & 31, ob = rr * 64 + cc * 2; return st * 1024 + (ob ^ (((ob >> 9) & 1) << 5)); }
__device__ __forceinline__ void stage_rc(int b, int& R, int& C) { const int st = b / 1024, sb = b % 1024, swz = sb ^ (((sb >> 9) & 1) << 5); R = (st >> 1) * 16 + swz / 64; C = (st & 1) * 32 + (swz % 64) / 2; }
__device__ __forceinline__ int perm32(int rho) { const int n = rho >> 4, i = rho & 15; return 8 * (i >> 2) + 4 * n + (i & 3); }
struct Unit { int pm, pn, ks, nks; };
struct Gemm { const bf16_t* A; const bf16_t* Bt; int K, lda, ldb, mode; float* sp_acc; unsigned* sp_cnt; };
__device__ __forceinline__ void unit_off(const Gemm& g, const Unit& u, size_t& oa, size_t& ob) {
    if (g.mode == 2) { oa = (size_t)u.pm * 256 * g.lda; ob = (size_t)(u.pm >> 4) * DM * EA + (size_t)((u.pm >> 2) & 3) * 1024 + (size_t)u.pn * 256 * g.ldb; }
    else if (g.mode == 3) { oa = (size_t)u.pm * 256 * g.lda + (size_t)(u.pn >> 2) * 1024; ob = (size_t)(u.pm * 16 + u.pn) * 256 * g.ldb; }
    else { oa = (size_t)u.pm * 256 * g.lda; ob = (size_t)u.pn * 256 * g.ldb; }
    const size_t ko = (size_t)u.ks * (size_t)(g.K / u.nks); oa = (oa + ko) * 2; ob = (ob + ko) * 2;
}
struct StaticOrder {
    int nM, nN, nwg, G, c;
    __device__ void init(int nM_, int nN_, int G_, int c_) { nM = nM_; nN = nN_; nwg = nM * nN; G = G_; c = c_; }
    __device__ bool next(int i, Unit& u) const {
        const long L = (long)i * G + c; if (L >= nwg) return false;
        int wgid = (int)L; { const int q = nwg / NXCD, r = nwg % NXCD, xcd = wgid % NXCD, off = wgid / NXCD; wgid = (xcd < r ? xcd * (q + 1) : r * (q + 1) + (xcd - r) * q) + off; }
        const int nig = WGM * nN, gid = wgid / nig, fm = gid * WGM, gsz = (nM - fm) < WGM ? (nM - fm) : WGM;
        u.pm = fm + ((wgid % nig) % gsz); u.pn = (wgid % nig) / gsz; u.ks = 0; u.nks = 1; return true;
    }
};
struct SplitOrder {
    StaticOrder S0; int nN, nks, i0;
    __device__ void init(int nN_, int nks_, int G_, int c_) { S0.init(64, nN_, G_, c_); nN = nN_; nks = nks_; i0 = c_ < S0.nwg ? (S0.nwg - c_ + G_ - 1) / G_ : 0; }
    __device__ bool next(int i, Unit& u) const {
        if (i < i0) return S0.next(i, u);
        const int idx = (i - i0) * S0.G + S0.c; if (idx >= nN * nks) return false;
        u.pm = 64; u.pn = idx / nks; u.ks = idx % nks; u.nks = nks; return true;
    }
};
struct StateOrder {
    int G, c;
    __device__ bool next(int i, Unit& u) const { const int idx = G - 1 - c; if (i != 0 || idx >= 80) return false; const int k = idx >> 4; u.pm = k < 4 ? 16 * k + 15 : 64; u.pn = idx & 15; u.ks = 0; u.nks = 1; return true; }
};
template <class Epi, class Ord>
__device__ __forceinline__ void gemm_phase(int wv, LAS unsigned char* lds, const Gemm g, const Ord& S, const Epi& E) {
    const int tid = otid(wv), wid = __builtin_amdgcn_readfirstlane(tid >> 6), lane = tid & 63, wr = wid >> 2, wc = wid & 3, fr = lane & 15, fq = lane >> 4;
    const int K = g.K, nt = K / BK;
    unsigned voffA[2], voffB[2];
#pragma unroll
    for (int i = 0; i < 2; ++i) { int R, C; stage_rc(tid * 16 + i * 8192, R, C); const int Rb = Epi::PERM ? ((R & ~31) + perm32(R & 31)) : R;
        voffA[i] = (unsigned)(R * g.lda + C) * 2u; voffB[i] = (unsigned)(Rb * g.ldb + C) * 2u; }
    const size_t kstep = (size_t)(BK * 2);
    const size_t hstepA = (size_t)HALF * g.lda * 2;
    const size_t hstepB = (size_t)HALF * g.ldb * 2;
    const unsigned ldsw = (unsigned)wid * 1024u;
    const int aoff = lds_byte(wr * 64 + fr, fq * 8), boff = lds_byte(wc * 32 + fr, fq * 8);
#define PG8_SA(b, h) (((b) * 2 + (h)) * HTB)
#define PG8_SB(b, h) ((4 + (b) * 2 + (h)) * HTB)
#define PG8_STAGE(bufoff, gbase, voff) do { _Pragma("unroll") for (int _i = 0; _i < 2; ++_i) \
        __builtin_amdgcn_global_load_lds((const unsigned*)((const char*)(gbase) + (voff)[_i]), (LAS unsigned*)(lds + (bufoff) + ldsw + _i * 8192), 16, 0, 0); } while (0)
#define PG8_LDA(dst, b, h) do { _Pragma("unroll") for (int m = 0; m < 4; ++m) _Pragma("unroll") for (int k = 0; k < 2; ++k) dst[m][k] = *(const LAS bf16x8*)(lds + PG8_SA(b, h) + aoff + m * 2048 + k * 1024); } while (0)
#define PG8_LDB(dst, b, h) do { _Pragma("unroll") for (int n = 0; n < 2; ++n) _Pragma("unroll") for (int k = 0; k < 2; ++k) dst[n][k] = *(const LAS bf16x8*)(lds + PG8_SB(b, h) + boff + n * 2048 + k * 1024); } while (0)
#define PG8_MMA(ai, bj, At, Bt) do { __builtin_amdgcn_s_setprio(1); _Pragma("unroll") for (int m = 0; m < 4; ++m) _Pragma("unroll") for (int n = 0; n < 2; ++n) _Pragma("unroll") for (int k = 0; k < 2; ++k) \
        acc[ai][bj][m][n] = __builtin_amdgcn_mfma_f32_16x16x32_bf16(Bt[n][k], At[m][k], acc[ai][bj][m][n], 0, 0, 0); __builtin_amdgcn_s_setprio(0); } while (0)
#define PG8_WAIT_V(n) asm volatile("s_waitcnt vmcnt(" #n ")" ::: "memory")
#define PG8_WAIT_L(n) asm volatile("s_waitcnt lgkmcnt(" #n ")" ::: "memory")
#define PG8_BAR __builtin_amdgcn_s_barrier()
#define PG8_SCHED __builtin_amdgcn_sched_barrier(0)
    Unit cur, nxt; int ui = 0;
    if (!S.next(0, cur)) return;
    f32x4 acc[2][2][4][2];
#pragma unroll
    for (int a = 0; a < 2; ++a)
#pragma unroll
        for (int b = 0; b < 2; ++b)
#pragma unroll
            for (int m = 0; m < 4; ++m)
#pragma unroll
                for (int n = 0; n < 2; ++n) acc[a][b][m][n] = (f32x4){0.f, 0.f, 0.f, 0.f};
    bf16x8 At[4][2], B0[2][2], B1[2][2];
    size_t oa_, ob_; unit_off(g, cur, oa_, ob_);
    const char* cA = (const char*)g.A + oa_; const char* cB = (const char*)g.Bt + ob_;
    PG8_STAGE(PG8_SB(0, 0), cB, voffB); PG8_STAGE(PG8_SA(0, 0), cA, voffA); PG8_STAGE(PG8_SB(0, 1), cB + hstepB, voffB); PG8_STAGE(PG8_SA(0, 1), cA + hstepA, voffA);
    if (wr == 1) PG8_BAR;
    PG8_WAIT_V(4); PG8_BAR;
    PG8_STAGE(PG8_SB(1, 0), cB + kstep, voffB); PG8_STAGE(PG8_SA(1, 0), cA + kstep, voffA); PG8_STAGE(PG8_SB(1, 1), cB + hstepB + kstep, voffB);
    PG8_WAIT_V(6); PG8_BAR;
    for (;;) {
        const bool has_next = S.next(ui + 1, nxt);
        const char* nA = cA; const char* nB = cB;
        if (has_next) { unit_off(g, nxt, oa_, ob_); nA = (const char*)g.A + oa_; nB = (const char*)g.Bt + ob_; }
        const int ntc = nt / cur.nks;
        for (int t = 0; t < ntc; t += 2) {
            const bool last = (t == ntc - 2);
            const char* a1 = cA + (size_t)(t + 1) * kstep;
            const char* a2 = last ? nA : cA + (size_t)(t + 2) * kstep; const char* b2 = last ? nB : cB + (size_t)(t + 2) * kstep;
            const char* a3 = a2 + kstep; const char* b3 = b2 + kstep;
            PG8_LDB(B0, 0, 0); PG8_SCHED; PG8_LDA(At, 0, 0); PG8_STAGE(PG8_SA(1, 1), a1 + hstepA, voffA);
            PG8_WAIT_L(8); PG8_BAR; PG8_WAIT_L(0); PG8_MMA(0, 0, At, B0); PG8_BAR; PG8_SCHED;
            PG8_LDB(B1, 0, 1); PG8_STAGE(PG8_SB(0, 0), b2, voffB);
            PG8_BAR; PG8_WAIT_L(0); PG8_MMA(0, 1, At, B1); PG8_BAR;
            PG8_LDA(At, 0, 1); PG8_STAGE(PG8_SA(0, 0), a2, voffA);
            PG8_BAR; PG8_WAIT_L(0); PG8_MMA(1, 0, At, B0); PG8_BAR; PG8_SCHED;
            PG8_STAGE(PG8_SB(0, 1), b2 + hstepB, voffB);
            PG8_WAIT_V(6); PG8_BAR; PG8_MMA(1, 1, At, B1); PG8_BAR;
            PG8_LDB(B0, 1, 0); PG8_SCHED; PG8_LDA(At, 1, 0); PG8_STAGE(PG8_SA(0, 1), a2 + hstepA, voffA);
            PG8_WAIT_L(8); PG8_BAR; PG8_WAIT_L(0); PG8_MMA(0, 0, At, B0); PG8_BAR; PG8_SCHED;
            PG8_LDB(B1, 1, 1); PG8_STAGE(PG8_SB(1, 0), b3, voffB);
            PG8_BAR; PG8_WAIT_L(0); PG8_MMA(0, 1, At, B1); PG8_BAR;
            PG8_LDA(At, 1, 1); PG8_STAGE(PG8_SA(1, 0), a3, voffA);
            PG8_BAR; PG8_WAIT_L(0); PG8_MMA(1, 0, At, B0); PG8_BAR; PG8_SCHED;
            PG8_STAGE(PG8_SB(1, 1), b3 + hstepB, voffB);
            PG8_WAIT_V(6); PG8_BAR; PG8_MMA(1, 1, At, B1); PG8_BAR;
        }
        bool do_epi = true;
        if (cur.nks > 1) {
            float* sc0 = g.sp_acc + (size_t)cur.pn * 65536 + (wid * 64 + lane); float* sc = sc0;
#pragma unroll
            for (int a = 0; a < 2; ++a)
#pragma unroll
                for (int b = 0; b < 2; ++b)
#pragma unroll
                    for (int m = 0; m < 4; ++m)
#pragma unroll
                        for (int n = 0; n < 2; ++n) {
#pragma unroll
                            for (int j = 0; j < 4; ++j) unsafeAtomicAdd(sc + j * 512, acc[a][b][m][n][j]);
                            sc += 2048; asm volatile("" : "+v"(sc)); }
            asm volatile("s_waitcnt vmcnt(0)" ::: "memory");
            __builtin_amdgcn_fence(__ATOMIC_RELEASE, "agent");
            unsigned old = 0u; if (lane == 0) old = __hip_atomic_fetch_add(g.sp_cnt + cur.pn * 8 + wid, 1u, __ATOMIC_RELAXED, __HIP_MEMORY_SCOPE_AGENT);
            old = (unsigned)__builtin_amdgcn_readfirstlane((int)old);
            do_epi = (old == (unsigned)cur.nks - 1u);
            if (do_epi) {
                __builtin_amdgcn_fence(__ATOMIC_ACQUIRE, "agent");
                sc = sc0;
#pragma unroll
                for (int a = 0; a < 2; ++a)
#pragma unroll
                    for (int b = 0; b < 2; ++b)
#pragma unroll
                        for (int m = 0; m < 4; ++m)
#pragma unroll
                            for (int n = 0; n < 2; ++n) {
#pragma unroll
                                for (int j = 0; j < 4; ++j) acc[a][b][m][n][j] = __hip_atomic_load(sc + j * 512, __ATOMIC_RELAXED, __HIP_MEMORY_SCOPE_AGENT);
                                sc += 2048; asm volatile("" : "+v"(sc)); } }
        }
        if (do_epi) E(acc, cur, wr, wc, fr, fq);
        if (!has_next) break;
#pragma unroll
        for (int a = 0; a < 2; ++a)
#pragma unroll
            for (int b = 0; b < 2; ++b)
#pragma unroll
                for (int m = 0; m < 4; ++m)
#pragma unroll
                    for (int n = 0; n < 2; ++n) acc[a][b][m][n] = (f32x4){0.f, 0.f, 0.f, 0.f};
        cur = nxt; cA = nA; cB = nB; ++ui;
    }
    PG8_WAIT_V(0);
    if (wr == 0) PG8_BAR;
    PG8_BAR;
#undef PG8_SA
#undef PG8_SB
#undef PG8_STAGE
#undef PG8_LDA
#undef PG8_LDB
#undef PG8_MMA
#undef PG8_WAIT_V
#undef PG8_WAIT_L
#undef PG8_BAR
#undef PG8_SCHED
}

typedef const f32x4 (&AccRef)[2][2][4][2];

struct EpiInA {
    static constexpr bool PERM = true;
    const float* ssq; bf16_t* tt; bf16_t* sg;
    __device__ __forceinline__ void operator()(AccRef acc, const Unit& un, int wr, int wc, int fr, int fq) const {
        const int row0 = un.pm * BM + wr * 64 + fr, colt = un.pn * BM + wc * 32 + 8 * fq;
        const bool is_t = un.pn < 16;
        float rrs[2][4];
#pragma unroll
        for (int ai = 0; ai < 2; ++ai)
#pragma unroll
            for (int m = 0; m < 4; ++m) rrs[ai][m] = ssq[row0 + ai * HALF + m * 16];
#pragma unroll
        for (int ai = 0; ai < 2; ++ai)
#pragma unroll
            for (int m = 0; m < 4; ++m) { const int row = row0 + ai * HALF + m * 16; const float rr = rsqrtf(rrs[ai][m] * (1.0f / DM) + EPS);
#pragma unroll
                for (int bj = 0; bj < 2; ++bj) { f32x4 v0 = acc[ai][bj][m][0] * rr, v1 = acc[ai][bj][m][1] * rr; const int col = colt + bj * HALF;
                    if (is_t) *(bf16x8*)(tt + (size_t)row * EA + col) = pack8(v0, v1);
                    else {
#pragma unroll
                        for (int j = 0; j < 4; ++j) { v0[j] = silu_f(v0[j]); v1[j] = silu_f(v1[j]); }
                        *(bf16x8*)(sg + (size_t)row * EA + (col - EA)) = pack8(v0, v1); } } }
    }
};
struct EpiUState {
    static constexpr bool PERM = true;
    const float* ssq; float* pool_p; float* pool_s;
    __device__ __forceinline__ void operator()(AccRef acc, const Unit& un, int wr, int wc, int fr, int fq) const {
        const int row0 = un.pm * BM + wr * 64 + fr, colt = un.pn * BM + wc * 32 + 8 * fq;
#pragma unroll
        for (int ai = 0; ai < 2; ++ai)
#pragma unroll
            for (int m = 0; m < 4; ++m) { const int row = row0 + ai * HALF + m * 16;
                float* pp = nullptr;
                if (row < MP) { const int t = row & (SEQ - 1); if (t >= SEQ - PPAD) pp = pool_p + ((size_t)(row >> 12) * PPAD + (t - (SEQ - PPAD))) * EA; }
                else { const int rs = row - MP, t = rs & 15; if (t >= 1) pp = pool_s + ((size_t)(rs >> 4) * PPAD + (t - 1)) * EA; }
                if (pp) { const float rr = rsqrtf(ssq[row] * (1.0f / DM) + EPS);
#pragma unroll
                    for (int bj = 0; bj < 2; ++bj) { *(f32x4*)(pp + colt + bj * HALF) = acc[ai][bj][m][0] * rr; *(f32x4*)(pp + colt + bj * HALF + 4) = acc[ai][bj][m][1] * rr; } } }
    }
};
struct EpiStore {
    static constexpr bool PERM = true;
    bf16_t* O; int ldc, wmode;
    __device__ __forceinline__ void operator()(AccRef acc, const Unit& un, int wr, int wc, int fr, int fq) const {
        const int rbase = wmode ? (un.pm >> 4) * 2 * EA + (un.pm & 15) * BM : un.pm * BM;
        const int row0 = rbase + wr * 64 + fr, colt = un.pn * BM + wc * 32 + 8 * fq;
#pragma unroll
        for (int ai = 0; ai < 2; ++ai)
#pragma unroll
            for (int m = 0; m < 4; ++m)
#pragma unroll
                for (int bj = 0; bj < 2; ++bj) *(bf16x8*)(O + (size_t)(row0 + ai * HALF + m * 16) * ldc + colt + bj * HALF) = pack8(acc[ai][bj][m][0], acc[ai][bj][m][1]);
    }
};
struct EpiRes {
    static constexpr bool PERM = false;
    const float* base_p; const float* base_s; float* xres; bf16_t* xb; float* ssq_next;
    __device__ __forceinline__ void operator()(AccRef acc, const Unit& un, int wr, int wc, int fr, int fq) const {
        const int row0 = un.pm * BM + wr * 64 + fr, col0 = un.pn * BM + wc * 32 + 4 * fq;
#pragma unroll
        for (int ai = 0; ai < 2; ++ai) {
            f32x4 bx_[4][2][2];
#pragma unroll
            for (int m = 0; m < 4; ++m) { const int row = row0 + ai * HALF + m * 16;
                const float* bp = (row < MP ? base_p + (size_t)row * DM : base_s + (size_t)(row - MP) * DM) + col0;
#pragma unroll
                for (int bj = 0; bj < 2; ++bj)
#pragma unroll
                    for (int n = 0; n < 2; ++n) bx_[m][bj][n] = *(const f32x4*)(bp + bj * HALF + n * 16); }
#pragma unroll
            for (int m = 0; m < 4; ++m) { const int row = row0 + ai * HALF + m * 16;
                float* xo = xres + (size_t)row * DM + col0; bf16_t* bo = xb + (size_t)row * DM + col0; float s = 0.f;
#pragma unroll
                for (int bj = 0; bj < 2; ++bj)
#pragma unroll
                    for (int n = 0; n < 2; ++n) { const f32x4 x = bx_[m][bj][n] + acc[ai][bj][m][n];
                        *(f32x4*)(xo + bj * HALF + n * 16) = x; u32x2 w; w.x = cvtpk(x[0], x[1]); w.y = cvtpk(x[2], x[3]); *(u32x2*)(bo + bj * HALF + n * 16) = w;
                        s += (x[0] * x[0] + x[1] * x[1]) + (x[2] * x[2] + x[3] * x[3]); }
                s = xsum16(s); s = xsum32(s);
                if (fq == 0) unsafeAtomicAdd(ssq_next + row, s); } }
    }
};
struct EpiKVQ {
    static constexpr bool PERM = true;
    int pn_off; const float* ssq; float* out; unsigned char* ws; const float* b_f;
    __device__ __forceinline__ void operator()(AccRef acc, const Unit& un, int wr, int wc, int fr, int fq) const {
        const int tt = un.pn + pn_off;
        const int row0 = un.pm * BM + wr * 64 + fr, cw = wc * 32 + 8 * fq;
        float rrs[2][4];
#pragma unroll
        for (int ai = 0; ai < 2; ++ai)
#pragma unroll
            for (int m = 0; m < 4; ++m) rrs[ai][m] = ssq[row0 + ai * HALF + m * 16];
        if (tt == 16) {
            if (wc == 0 && fq < 2) {
            const f32x4 bf0 = *(const f32x4*)(b_f + 8 * fq), bf1 = *(const f32x4*)(b_f + 8 * fq + 4);
            float* lft_p = (float*)(ws + WS_LFTP); float* lft_s = (float*)(ws + WS_LFTS);
#pragma unroll
            for (int ai = 0; ai < 2; ++ai)
#pragma unroll
                for (int m = 0; m < 4; ++m) { const int row = row0 + ai * HALF + m * 16; const float rr = rsqrtf(rrs[ai][m] * (1.0f / DM) + EPS);
                    f32x4 v0 = acc[ai][0][m][0] * rr + bf0, v1 = acc[ai][0][m][1] * rr + bf1;
#pragma unroll
                    for (int j = 0; j < 4; ++j) { v0[j] = logsig(v0[j]); v1[j] = logsig(v1[j]); }
                    if (row < MP) { float* o = out + O_LFP + (size_t)row * NH + 8 * fq; *(f32x4*)o = v0; *(f32x4*)(o + 4) = v1;
                        float* tp = lft_p + ((size_t)(row >> 12) * NH + 8 * fq) * SEQ + (row & (SEQ - 1));
#pragma unroll
                        for (int j = 0; j < 4; ++j) { tp[(size_t)j * SEQ] = v0[j]; tp[(size_t)(j + 4) * SEQ] = v1[j]; } }
                    else { const int rs = row - MP; float* o = out + O_LFS + (size_t)rs * NH + 8 * fq; *(f32x4*)o = v0; *(f32x4*)(o + 4) = v1;
                        float* tp = lft_s + ((size_t)(rs >> 4) * NH + 8 * fq) * DSEQ + (rs & 15);
#pragma unroll
                        for (int j = 0; j < 4; ++j) { tp[j * DSEQ] = v0[j]; tp[(j + 4) * DSEQ] = v1[j]; } } }
            }
        } else {
        const int kind = tt < 8 ? 0 : (tt < 16 ? 1 : (tt < 25 ? 2 : 3));
        const int colt = (tt - (kind == 0 ? 0 : kind == 1 ? 8 : kind == 2 ? 17 : 25)) * BM + cw;
        float* fo_p = out + (kind == 0 ? O_KP : O_VP); float* fo_s = out + (kind == 0 ? O_KS : O_VS);
        bf16_t* bo = (bf16_t*)(ws + (kind == 0 ? WS_KB : (kind == 1 ? WS_VB : (kind == 2 ? WS_QB : WS_SGB))));
#pragma unroll
        for (int ai = 0; ai < 2; ++ai)
#pragma unroll
            for (int m = 0; m < 4; ++m) { const int row = row0 + ai * HALF + m * 16; float rr = rsqrtf(rrs[ai][m] * (1.0f / DM) + EPS);
                if (kind == 2) rr *= QSCALE;
                float* fo = (row < MP ? fo_p + (size_t)row * DM : fo_s + (size_t)(row - MP) * DM) + colt;
#pragma unroll
                for (int bj = 0; bj < 2; ++bj) { f32x4 v0 = acc[ai][bj][m][0] * rr, v1 = acc[ai][bj][m][1] * rr;
                    if (kind < 2) { *(f32x4*)(fo + bj * HALF) = v0; *(f32x4*)(fo + bj * HALF + 4) = v1; }
                    if (kind == 3) {
#pragma unroll
                        for (int j = 0; j < 4; ++j) { v0[j] = silu_f(v0[j]); v1[j] = silu_f(v1[j]); } }
                    *(bf16x8*)(bo + (size_t)row * DM + colt + bj * HALF) = pack8(v0, v1);
                    if (kind == 0 || kind == 2) {
                        float ss = (v0[0] * v0[0] + v0[1] * v0[1]) + (v0[2] * v0[2] + v0[3] * v0[3]) + (v1[0] * v1[0] + v1[1] * v1[1]) + (v1[2] * v1[2] + v1[3] * v1[3]);
                        ss = xsum16(ss); ss = xsum32(ss);
                        float* nt = (float*)(ws + (kind == 0 ? WS_KNRM : WS_QNRM));
                        if (fq == 0) nt[((size_t)row * NH + 2 * (colt >> 8) + bj) * 4 + wc] = ss; } } }
        }
    }
};
}

namespace att {
constexpr int NW = 8, QBLK = 32, KVBLK = 64, QB = NW * QBLK, D = 128, LD = 2048;
constexpr int SHM_V = KVBLK * D * 2, SHM_K = KVBLK * D * 2;
constexpr int OFF_WS = 2 * SHM_V + 2 * SHM_K, OFF_F = OFF_WS + NW * 64 * 4, OFF_SC = OFF_F + SEQ * 4, OFF_KT = OFF_SC + 64, OFF_QM = OFF_KT + 256, OFF_JL = OFF_QM + 128;
constexpr float SKIP_T = 32.f;
constexpr float THR2 = 11.5f;
#define KSWZ(row, colB) ((row) * 256 + ((colB) ^ (((row) & 7) << 4)))
#define SBAR() __builtin_amdgcn_sched_barrier(0)
__device__ __forceinline__ int v_st(int k, int c) { const int kk = (k & ~0xC) | ((k & 4) << 1) | ((k & 8) >> 1); return ((kk >> 3) * 4 + (c >> 5)) * 512 + ((kk & 7) * 32 + (c & 31)) * 2; }
__device__ __forceinline__ int v_rd_base(int lane) { return ((lane & 3) << 3) | (((lane >> 2) & 3) << 6) | (((lane >> 4) & 1) << 5) | (((lane >> 5) & 1) << 8); }
constexpr int v_rd_off(int d0, int ks, int half) { return d0 * 512 + ks * 4096 + half * 2048; }
__device__ __forceinline__ int crow(int r, int hi) { return (r & 3) + 8 * (r >> 2) + 4 * hi; }
__device__ __forceinline__ void mask_tile(f32x16& p0, f32x16& p1, int dq) {
    const float NEG = -__builtin_inff();
#pragma unroll
    for (int r = 0; r < 16; ++r) { const int c = (r & 3) + 8 * (r >> 2);
        if (dq - c < 0) p0[r] = NEG;
        if (dq - c - 32 < 0) p1[r] = NEG; }
}
__device__ __forceinline__ void partialSM(f32x16& p0, f32x16& p1, float& m_reg, float& mn, float& alpha) {
    float pmax = p0[0];
#pragma unroll
    for (int r = 1; r < 16; ++r) pmax = fmaxf(pmax, p0[r]);
#pragma unroll
    for (int r = 0; r < 16; ++r) pmax = fmaxf(pmax, p1[r]);
    { auto rr = __builtin_amdgcn_permlane32_swap(__float_as_uint(pmax), __float_as_uint(pmax), false, false);
      pmax = fmaxf(__uint_as_float(rr[0]), __uint_as_float(rr[1])); }
    if (__builtin_expect(__all((pmax - m_reg) <= THR2), 1)) { mn = m_reg; alpha = 1.f; }
    else { mn = fmaxf(m_reg, pmax); alpha = __builtin_amdgcn_exp2f(m_reg - mn); m_reg = mn; }
#pragma unroll
    for (int r = 0; r < 16; ++r) p0[r] = p0[r] - mn;
#pragma unroll
    for (int r = 0; r < 16; ++r) p1[r] = p1[r] - mn;
#pragma unroll
    for (int r = 0; r < 16; ++r) p0[r] = __builtin_amdgcn_exp2f(p0[r]);
}
__device__ __forceinline__ void finishSM(f32x16& p0, f32x16& p1, float alpha, float& l_reg, bf16x8& pa0, bf16x8& pa1, bf16x8& pa2, bf16x8& pa3) {
#pragma unroll
    for (int r = 0; r < 16; ++r) p1[r] = __builtin_amdgcn_exp2f(p1[r]);
    float ps = 0;
#pragma unroll
    for (int r = 0; r < 16; ++r) ps += p0[r];
#pragma unroll
    for (int r = 0; r < 16; ++r) ps += p1[r];
    { auto rr = __builtin_amdgcn_permlane32_swap(__float_as_uint(ps), __float_as_uint(ps), false, false);
      ps = __uint_as_float(rr[0]) + __uint_as_float(rr[1]); }
    l_reg = l_reg * alpha + ps;
#define PK4(P, B_, OUT) do { unsigned a0 = cvtpk(P[B_+0], P[B_+1]), a1 = cvtpk(P[B_+2], P[B_+3]);                          \
        unsigned b0 = cvtpk(P[B_+4], P[B_+5]), b1 = cvtpk(P[B_+6], P[B_+7]);                                             \
        auto r0 = __builtin_amdgcn_permlane32_swap(a0, b0, false, false); auto r1 = __builtin_amdgcn_permlane32_swap(a1, b1, false, false); \
        u32x4 w = {r0[0], r1[0], r0[1], r1[1]}; OUT = *reinterpret_cast<bf16x8*>(&w); } while (0)
    PK4(p0, 0, pa0); PK4(p0, 8, pa1); PK4(p1, 0, pa2); PK4(p1, 8, pa3);
#undef PK4
}
template <int KB>
__device__ __forceinline__ void qkt(f32x16& p0, f32x16& p1, const char* K_lds, const float* fl, int r32, int hi, const bf16x8* qr) {
    { const f32x4 a0 = *(const f32x4*)(fl), a1 = *(const f32x4*)(fl + 8), a2 = *(const f32x4*)(fl + 16), a3 = *(const f32x4*)(fl + 24);
      const f32x4 b0 = *(const f32x4*)(fl + 32), b1 = *(const f32x4*)(fl + 40), b2 = *(const f32x4*)(fl + 48), b3 = *(const f32x4*)(fl + 56);
      p0 = (f32x16){a0[0], a0[1], a0[2], a0[3], a1[0], a1[1], a1[2], a1[3], a2[0], a2[1], a2[2], a2[3], a3[0], a3[1], a3[2], a3[3]};
      p1 = (f32x16){b0[0], b0[1], b0[2], b0[3], b1[0], b1[1], b1[2], b1[3], b2[0], b2[1], b2[2], b2[3], b3[0], b3[1], b3[2], b3[3]}; }
    const char* kb[4];
#pragma unroll
    for (int dd = 0; dd < 4; ++dd) kb[dd] = K_lds + KB * SHM_K + KSWZ(r32, (dd * 16 + hi * 8) * 2);
#pragma unroll
    for (int d0 = 0; d0 < 8; ++d0) { const char* a = kb[d0 & 3] + (d0 >> 2) * 128;
        bf16x8 b0 = *reinterpret_cast<const bf16x8*>(a);
        bf16x8 b1 = *reinterpret_cast<const bf16x8*>(a + 32 * 256);
        p0 = __builtin_amdgcn_mfma_f32_32x32x16_bf16(b0, qr[d0], p0, 0, 0, 0);
        p1 = __builtin_amdgcn_mfma_f32_32x32x16_bf16(b1, qr[d0], p1, 0, 0, 0); }
}
template <int VB>
__device__ __forceinline__ void pv_tile(f32x16* o, int vb0, bf16x8 pa0, bf16x8 pa1, bf16x8 pa2, bf16x8 pa3) {
#define TRRD(dst, off) asm volatile("ds_read_b64_tr_b16 %0, %1 offset:%2" : "=&v"(dst) : "v"(vb0), "i"(off) : "memory")
#define PV_D0(d0) do { s16x4 l0, l1, l2, l3, h0, h1, h2, h3; constexpr int b_ = VB * SHM_V + v_rd_off(d0, 0, 0);   \
        TRRD(l0, b_); TRRD(h0, b_ + 2048); TRRD(l1, b_ + 4096); TRRD(h1, b_ + 6144); TRRD(l2, b_ + 8192); TRRD(h2, b_ + 10240); TRRD(l3, b_ + 12288); TRRD(h3, b_ + 14336); \
        asm volatile("s_waitcnt lgkmcnt(0)" ::: "memory"); SBAR();   \
        o[d0] = __builtin_amdgcn_mfma_f32_32x32x16_bf16(pa0, (bf16x8){l0[0], l0[1], l0[2], l0[3], h0[0], h0[1], h0[2], h0[3]}, o[d0], 0, 0, 0);   \
        o[d0] = __builtin_amdgcn_mfma_f32_32x32x16_bf16(pa1, (bf16x8){l1[0], l1[1], l1[2], l1[3], h1[0], h1[1], h1[2], h1[3]}, o[d0], 0, 0, 0);   \
        o[d0] = __builtin_amdgcn_mfma_f32_32x32x16_bf16(pa2, (bf16x8){l2[0], l2[1], l2[2], l2[3], h2[0], h2[1], h2[2], h2[3]}, o[d0], 0, 0, 0);   \
        o[d0] = __builtin_amdgcn_mfma_f32_32x32x16_bf16(pa3, (bf16x8){l3[0], l3[1], l3[2], l3[3], h3[0], h3[1], h3[2], h3[3]}, o[d0], 0, 0, 0); } while (0)
    PV_D0(0); PV_D0(1); PV_D0(2); PV_D0(3);
#undef PV_D0
#undef TRRD
}
struct Tensors { const bf16_t* q; const bf16_t* k; const bf16_t* v; bf16_t* og; const bf16_t* sg; const float* lft; };
struct BlockRef { unsigned q0, s0; int P0, jlo; };
struct Seam { bf16x8 qr[8]; bf16x8 st_v0, st_v1, st_k0, st_k1; };
#define ROWP(p, k0) ((p) + (unsigned)(k0) * (unsigned)LD)
#define VMW() asm volatile("s_waitcnt vmcnt(0)" ::: "memory")
#define VMWN(n) asm volatile("s_waitcnt vmcnt(%0)" :: "i"(n) : "memory")
#define LD8(p) (*reinterpret_cast<const bf16x8*>(p))
#define SLOAD_H(Kp, Vp, k0) do { S.st_v0 = LD8(ROWP(Vp, k0) + voff); S.st_v1 = LD8(ROWP(Vp, (k0) + 32) + voff);              \
                         S.st_k0 = LD8(ROWP(Kp, k0) + voff); S.st_k1 = LD8(ROWP(Kp, (k0) + 32) + voff); } while (0)
#define SWRITE_HK(bf) do { *(bf16x8*)(K_lds + (bf) * SHM_K + kws) = S.st_k0; *(bf16x8*)(K_lds + (bf) * SHM_K + kws + 32 * 256) = S.st_k1; } while (0)
#define SWRITE_HV(bf) do { *(bf16x8*)(V_lds + (bf) * SHM_V + vst0) = S.st_v0; *(bf16x8*)(V_lds + (bf) * SHM_V + vst0 + VST1) = S.st_v1; } while (0)
#define SWRITE_H(bf) do { SWRITE_HV(bf); SWRITE_HK(bf); } while (0)
__device__ __forceinline__ void prime(int wv, const Tensors& T, const BlockRef& cur, char* lds, Seam& S) {
    const int tid = otid(wv), wid = __builtin_amdgcn_readfirstlane(tid >> 6), lane = tid & 63, r32 = lane & 31, hi = lane >> 5;
    const int sr = tid >> 4, sc = (tid & 15) * 8, kws = KSWZ(sr, sc * 2); char* K_lds = lds + 2 * SHM_V;
    const unsigned voff = (unsigned)sr * LD + sc, qoff = (unsigned)(wid * QBLK + r32) * LD + hi * 8;
    const bf16_t* Qp = T.q + cur.q0; const bf16_t* Kh = T.k + cur.s0; const bf16_t* Vh = T.v + cur.s0;
#pragma unroll
    for (int d0 = 0; d0 < 8; ++d0) S.qr[d0] = LD8(Qp + qoff + d0 * 16);
    SLOAD_H(Kh, Vh, cur.jlo * KVBLK); VMW(); SWRITE_HK(0);
    __syncthreads();
}
__device__ __forceinline__ void block(int wv, const Tensors& T, const BlockRef& cur, const BlockRef& nxt, char* lds, Seam& S) {
    const int tid = otid(wv), wid = __builtin_amdgcn_readfirstlane(tid >> 6), lane = tid & 63, r32 = lane & 31, hi = lane >> 5;
    const int j_lo = cur.jlo, NT = (cur.P0 + QB) / KVBLK - j_lo;
    const int qlo = cur.P0 - j_lo * KVBLK + wid * QBLK, qm = qlo + r32 - 4 * hi;
    char* V_lds = lds; char* K_lds = lds + 2 * SHM_V;
    float* wsl = (float*)(lds + OFF_WS) + wid * 64; float* li_l = wsl, * al_l = wsl + 32;
    float* Fl = (float*)(lds + OFF_F);
    float m_reg = -1e30f, l_reg = 0; f32x16 o[4] = {};
    const int sr = tid >> 4, sc = (tid & 15) * 8, vst0 = v_st(sr, sc), kws = KSWZ(sr, sc * 2); constexpr int VST1 = 8192;
    const int vb0 = (int)(uintptr_t)V_lds + v_rd_base(lane);
    const bf16_t* Kh = T.k + cur.s0 + (unsigned)(j_lo * KVBLK) * LD; const bf16_t* Vh = T.v + cur.s0 + (unsigned)(j_lo * KVBLK) * LD;
    const unsigned voff = (unsigned)sr * LD + sc, qoff = (unsigned)(wid * QBLK + r32) * LD + hi * 8;
    const float* flb = Fl + j_lo * KVBLK + 4 * hi;
#define RESC(a) do { if (__any((a) < 1.f)) { if (hi == 0) al_l[r32] = (a); asm volatile("s_waitcnt lgkmcnt(0)" ::: "memory");              \
                     for (int d_ = 0; d_ < 4; ++d_) for (int r = 0; r < 16; ++r) o[d_][r] *= al_l[crow(r, hi)]; } } while (0)
#define KBASE(t) ((t) * KVBLK)
#define MASKT(P0_, P1_, t) do { const int kb_ = KBASE(t); if (kb_ + KVBLK - 1 > qlo) mask_tile(P0_, P1_, qm - kb_); } while (0)
#define SEAM_K0() do { VMWN(8); SWRITE_HK(0); SBAR(); } while (0)
    f32x16 pA0, pA1, pB0, pB1; float mnA, mnB, alA, alB; bf16x8 pa0, pa1, pa2, pa3;
    SWRITE_HV(0); SBAR();
    if (NT > 1) { SLOAD_H(Kh, Vh, KBASE(1)); }
    SBAR(); qkt<0>(pA0, pA1, K_lds, flb + KBASE(0), r32, hi, S.qr);
    MASKT(pA0, pA1, 0); partialSM(pA0, pA1, m_reg, mnA, alA);
    if (NT > 1) { VMW(); SWRITE_H(1); }
    __syncthreads();
#define HALF_STEP(PX0, PX1, mnX, alX, PY0, PY1, alY, t, KB, VB, SB) do {                                                      \
        SBAR(); qkt<KB>(PX0, PX1, K_lds, flb + KBASE(t), r32, hi, S.qr);                                             \
        finishSM(PY0, PY1, alY, l_reg, pa0, pa1, pa2, pa3); SBAR();                                                           \
        if ((t) + 1 < NT) { SLOAD_H(Kh, Vh, KBASE((t) + 1)); SBAR(); }                                               \
        pv_tile<VB>(o, vb0, pa0, pa1, pa2, pa3); MASKT(PX0, PX1, (t)); partialSM(PX0, PX1, m_reg, mnX, alX);                                        \
        __syncthreads();                                                                                                      \
        if ((t) + 1 < NT) { VMW(); SWRITE_H(SB); }                                                                          \
        RESC(alX); __syncthreads(); } while (0)
    for (int t = 1; t + 1 < NT; t += 2) {
        HALF_STEP(pB0, pB1, mnB, alB, pA0, pA1, alA, t, 1, 0, 0);
        HALF_STEP(pA0, pA1, mnA, alA, pB0, pB1, alB, t + 1, 0, 1, 1);
    }
    const bool even = (NT & 1) == 0;
    if (even) { SBAR(); qkt<1>(pB0, pB1, K_lds, flb + KBASE(NT - 1), r32, hi, S.qr); SBAR(); }
    { const bf16_t* Kn = T.k + nxt.s0; const bf16_t* Vn = T.v + nxt.s0; SLOAD_H(Kn, Vn, nxt.jlo * KVBLK); } SBAR();
    { const bf16_t* Qn = T.q + nxt.q0;
#pragma unroll
      for (int d0 = 0; d0 < 8; ++d0) S.qr[d0] = LD8(Qn + qoff + d0 * 16); }
    SBAR();
    finishSM(pA0, pA1, alA, l_reg, pa0, pa1, pa2, pa3); SBAR();
    pv_tile<0>(o, vb0, pa0, pa1, pa2, pa3);
    if (even) { MASKT(pB0, pB1, NT - 1); partialSM(pB0, pB1, m_reg, mnB, alB); __syncthreads(); RESC(alB);
        finishSM(pB0, pB1, alB, l_reg, pa0, pa1, pa2, pa3); SBAR(); pv_tile<1>(o, vb0, pa0, pa1, pa2, pa3); }
    SBAR(); SEAM_K0();
    if (hi == 0) li_l[r32] = l_reg; asm volatile("s_waitcnt lgkmcnt(0)" ::: "memory");
    float rli[16];
#pragma unroll
    for (int r = 0; r < 16; ++r) rli[r] = __builtin_amdgcn_rcpf(li_l[crow(r, hi)]);
    { const unsigned eoff = (unsigned)(4 * hi) * LD + r32;
      unsigned gg[16][4];
#pragma unroll
      for (int r = 0; r < 16; ++r) { const bf16_t* Grow = T.sg + cur.q0 + (unsigned)(wid * QBLK + (r & 3) + 8 * (r >> 2)) * LD;
#pragma unroll
        for (int d0 = 0; d0 < 4; ++d0) gg[r][d0] = *(const unsigned*)(Grow + (eoff & ~1u) + d0 * 32); }
#pragma unroll
      for (int r = 0; r < 16; ++r) { bf16_t* Orow = T.og + cur.q0 + (unsigned)(wid * QBLK + (r & 3) + 8 * (r >> 2)) * LD;
#pragma unroll
        for (int d0 = 0; d0 < 4; ++d0) { const float v = o[d0][r] * rli[r];
            const float vn = __shfl_xor(v, 1);
            if ((r32 & 1) == 0) *(unsigned*)(Orow + eoff + d0 * 32) = cvtpk(v * bflo(gg[r][d0]), vn * bfhi(gg[r][d0])); } } }
    __syncthreads();
#undef RESC
#undef KBASE
#undef MASKT
#undef SEAM_K0
#undef HALF_STEP
}
#undef ROWP
#undef VMW
#undef VMWN
#undef SLOAD_H
#undef SWRITE_HK
#undef SWRITE_HV
#undef SWRITE_H
#undef LD8

__device__ __forceinline__ BlockRef mkref(int bh, int qb) {
    const int b = bh >> 4, h = bh & 15; BlockRef r; r.s0 = (unsigned)b * SEQ * LD + h * D; r.q0 = r.s0 + (unsigned)qb * QB * LD; r.jlo = 0; r.P0 = qb * QB; return r;
}
__device__ __forceinline__ void item_setup(int wv, const Tensors& T, const float* knrm, const float* qnrm, int bh, unsigned blks, int nb, char* lds) {
    const int tid = otid(wv), wid = __builtin_amdgcn_readfirstlane(tid >> 6), lane = tid & 63;
    float* Fl = (float*)(lds + OFF_F); float* scn = (float*)(lds + OFF_SC); float* Kt = (float*)(lds + OFF_KT); float* Qm = (float*)(lds + OFF_QM); int* JL = (int*)(lds + OFF_JL);
    const int b = bh >> 4, h = bh & 15, xmax = (int)((blks >> (4 * (nb - 1))) & 15u), nkeys = (xmax + 1) * QB, t0 = tid * 8;
    const float* LF = T.lft + (size_t)bh * SEQ;
    f32x4 a = {0.f, 0.f, 0.f, 0.f}, c = {0.f, 0.f, 0.f, 0.f};
    float kmx = 0.f;
    if (t0 < nkeys) { a = *(const f32x4*)(LF + t0); c = *(const f32x4*)(LF + t0 + 4);
        const float* kn = knrm + ((size_t)(b * SEQ + t0) * NH + h) * 4;
#pragma unroll
        for (int i = 0; i < 8; ++i) { const f32x4 p = *(const f32x4*)(kn + (size_t)i * NH * 4); kmx = fmaxf(kmx, (p[0] + p[1]) + (p[2] + p[3])); } }
    kmx = fmaxf(kmx, bperm(kmx, lane ^ 1)); kmx = fmaxf(kmx, bperm(kmx, lane ^ 2)); kmx = fmaxf(kmx, bperm(kmx, lane ^ 4));
    if ((tid & 7) == 0 && t0 < nkeys) Kt[tid >> 3] = sqrtf(kmx) * 1.01f;
#pragma unroll 1
    for (int bi = 0; bi < nb; bi += 2) { const int bsel = bi + (tid >> 8);
        if (bsel < nb) { const int x = (int)((blks >> (4 * bsel)) & 15u), qrow = b * SEQ + x * QB + (tid & 255);
            const f32x4 p = *(const f32x4*)(qnrm + ((size_t)qrow * NH + h) * 4); float qm = (p[0] + p[1]) + (p[2] + p[3]);
#pragma unroll
            for (int o = 1; o < 64; o <<= 1) qm = fmaxf(qm, bperm(qm, lane ^ o));
            if (lane == 0) Qm[bsel * 4 + (wid & 3)] = qm; } }
    a[1] += a[0]; a[2] += a[1]; a[3] += a[2]; c[0] += a[3]; c[1] += c[0]; c[2] += c[1]; c[3] += c[2];
    const float tot = c[3]; float inc = tot;
#pragma unroll
    for (int o = 1; o < 64; o <<= 1) { const float v = bperm(inc, (lane - o) & 63); if (lane >= o) inc += v; }
    if (lane == 63) scn[wid] = inc;
    if (tid < nb) JL[tid] = (int)((blks >> (4 * tid)) & 15u) * 4;
    __syncthreads();
    float base = inc - tot;
    for (int w = 0; w < wid; ++w) base += scn[w];
    a = (a + base) * (-LOG2E); c = (c + base) * (-LOG2E);
    if (t0 < nkeys) { *(f32x4*)(Fl + t0) = a; *(f32x4*)(Fl + t0 + 4) = c; }
    __syncthreads();
    { const int which = tid >> 6, j = tid & 63;
      if (which < nb) { const int x = (int)((blks >> (4 * which)) & 15u), nd = x * 4;
        if (j < nd) { const float qmax = sqrtf(fmaxf(fmaxf(Qm[which * 4], Qm[which * 4 + 1]), fmaxf(Qm[which * 4 + 2], Qm[which * 4 + 3]))) * 1.01f;
            const float kdiag = fmaxf(fmaxf(Kt[nd], Kt[nd + 1]), fmaxf(Kt[nd + 2], Kt[nd + 3]));
            const bool skip = qmax * (Kt[j] + kdiag) + Fl[64 * j + 63] - Fl[x * QB] < -SKIP_T;
            if (!skip) atomicMin(JL + which, j); } } }
    __syncthreads();
}
__device__ __forceinline__ void prompt_phase(int wv, char* lds, const Tensors& T, const float* knrm, const float* qnrm, int pw) {
    const int bh = pw / 3, gsel = pw - bh * 3;
    const unsigned blks = gsel == 0 ? 0xDA742u : (gsel == 1 ? 0xEB8510u : 0xFC963u); const int nb = gsel == 1 ? 6 : 5;
    item_setup(wv, T, knrm, qnrm, bh, blks, nb, lds);
    const int* JL = (const int*)(lds + OFF_JL);
    Seam S;
    BlockRef cur = mkref(bh, (int)(blks & 15u)); cur.jlo = __builtin_amdgcn_readfirstlane(JL[0]);
    prime(wv, T, cur, lds, S);
#pragma unroll 1
    for (int i = 0; i < nb; ++i) { const int in = i + 1 < nb ? i + 1 : i;
        BlockRef nxt = mkref(bh, (int)((blks >> (4 * in)) & 15u)); nxt.jlo = __builtin_amdgcn_readfirstlane(JL[in]);
        block(wv, T, cur, nxt, lds, S);
        cur = nxt; }
}
}

namespace sat {
constexpr int OFF_F = 0, OFF_SC = 8448, OFF_P = 8704, OFF_A = OFF_P + 8 * 4096, OFF_ML = OFF_A + 512, OFF_O = OFF_ML + 1024;
struct Tensors { const bf16_t* q; const bf16_t* kb; const bf16_t* vb; bf16_t* og; const bf16_t* sg; const float* ck; const float* cv; const float* clf; const float* lfts; };
__device__ __forceinline__ void item(int wv, char* lds, const Tensors& T, int b, int h) {
    const int tid = otid(wv), wid = __builtin_amdgcn_readfirstlane(tid >> 6), lane = tid & 63, fr = lane & 15, fq = lane >> 4;
    float* Fl = (float*)(lds + OFF_F); float* scn = (float*)(lds + OFF_SC);
    float* ML = (float*)(lds + OFF_ML); float* Op = (float*)(lds + OFF_O);
    { const float* cl = T.clf + ((size_t)b * PAST + tid * 4) * NH + h;
      float a0 = cl[0], a1 = cl[NH], a2 = cl[2 * NH], a3 = cl[3 * NH];
      a1 += a0; a2 += a1; a3 += a2;
      const float tot = a3; float inc = tot;
#pragma unroll
      for (int o = 1; o < 64; o <<= 1) { const float v = bperm(inc, (lane - o) & 63); if (lane >= o) inc += v; }
      if (lane == 63) scn[wid] = inc;
      __syncthreads();
      float base = inc - tot, all = 0.f;
      for (int w = 0; w < 8; ++w) { const float sw = scn[w]; if (w < wid) base += sw; all += sw; }
      *(f32x4*)(Fl + tid * 4) = (f32x4){(a0 + base) * (-LOG2E), (a1 + base) * (-LOG2E), (a2 + base) * (-LOG2E), (a3 + base) * (-LOG2E)};
      if (tid < DSEQ) { const float* nl = T.lfts + ((size_t)b * NH + h) * DSEQ; float s = all; for (int i = 0; i <= tid; ++i) s += nl[i]; Fl[PAST + tid] = s * (-LOG2E); }
      __syncthreads(); }
    const size_t qrow = (size_t)(MP + b * DSEQ);
    bf16x8 qf[4];
#pragma unroll
    for (int dc = 0; dc < 4; ++dc) qf[dc] = *(const bf16x8*)(T.q + (qrow + fr) * DM + h * HD + dc * 32 + fq * 8);
    float m_run = -1e30f, l_run = 0.f;
    f32x4 ot[8];
#pragma unroll
    for (int dt = 0; dt < 8; ++dt) ot[dt] = (f32x4){0.f, 0.f, 0.f, 0.f};
    const unsigned vlo = (unsigned)(fq * 4) * (NH * HD) + fr;
    for (int ch = 0; ch < 4; ++ch) {
        const int key0 = (ch * 8 + wid) * 64;
        f32x4 s4[4];
        { f32x4 kk[4][4][2];
#pragma unroll
          for (int tl = 0; tl < 4; ++tl) { const float* kp = T.ck + (((size_t)b * PAST + key0 + tl * 16 + fr) * NH + h) * HD + fq * 8;
#pragma unroll
            for (int dc = 0; dc < 4; ++dc) { kk[tl][dc][0] = *(const f32x4*)(kp + dc * 32); kk[tl][dc][1] = *(const f32x4*)(kp + dc * 32 + 4); } }
          __builtin_amdgcn_sched_barrier(0);
#pragma unroll
          for (int tl = 0; tl < 4; ++tl) { f32x4 acc = *(const f32x4*)(Fl + key0 + tl * 16 + fq * 4);
#pragma unroll
            for (int dc = 0; dc < 4; ++dc) acc = __builtin_amdgcn_mfma_f32_16x16x32_bf16(pack8(kk[tl][dc][0], kk[tl][dc][1]), qf[dc], acc, 0, 0, 0);
            s4[tl] = acc; } }
        __builtin_amdgcn_sched_barrier(0);
        float vv[2][8][8];
        { const float* vb_c = T.cv + (((size_t)b * PAST + key0) * NH + h) * HD;
#pragma unroll
          for (int hf = 0; hf < 2; ++hf)
#pragma unroll
            for (int dt = 0; dt < 8; ++dt)
#pragma unroll
                for (int i = 0; i < 4; ++i) { vv[hf][dt][i] = (vb_c + (size_t)(hf * 32 + i) * (NH * HD) + dt * 16)[vlo]; vv[hf][dt][4 + i] = (vb_c + (size_t)(hf * 32 + 16 + i) * (NH * HD) + dt * 16)[vlo]; } }
        float cm = s4[0][0];
#pragma unroll
        for (int tl = 0; tl < 4; ++tl)
#pragma unroll
            for (int j = 0; j < 4; ++j) cm = fmaxf(cm, s4[tl][j]);
        cm = xmax16(cm); cm = xmax32(cm);
        const float mn = fmaxf(m_run, cm), alpha = __builtin_amdgcn_exp2f(m_run - mn); m_run = mn;
        float ps = 0.f;
#pragma unroll
        for (int tl = 0; tl < 4; ++tl)
#pragma unroll
            for (int j = 0; j < 4; ++j) { s4[tl][j] = __builtin_amdgcn_exp2f(s4[tl][j] - mn); ps += s4[tl][j]; }
        ps = xsum16(ps); ps = xsum32(ps);
        l_run = l_run * alpha + ps;
#pragma unroll
        for (int dt = 0; dt < 8; ++dt) ot[dt] *= alpha;
#pragma unroll
        for (int hf = 0; hf < 2; ++hf) {
            const bf16x8 pb = pack8(s4[2 * hf], s4[2 * hf + 1]);
#pragma unroll
            for (int dt = 0; dt < 8; ++dt) { const f32x4 v0 = {vv[hf][dt][0], vv[hf][dt][1], vv[hf][dt][2], vv[hf][dt][3]}, v1 = {vv[hf][dt][4], vv[hf][dt][5], vv[hf][dt][6], vv[hf][dt][7]};
                ot[dt] = __builtin_amdgcn_mfma_f32_16x16x32_bf16(pack8(v0, v1), pb, ot[dt], 0, 0, 0); } }
    }
    if (wid == 0) {
        f32x4 acc = *(const f32x4*)(Fl + PAST + fq * 4);
        const bf16_t* kp = T.kb + (qrow + fr) * DM + h * HD + fq * 8;
#pragma unroll
        for (int dc = 0; dc < 4; ++dc) acc = __builtin_amdgcn_mfma_f32_16x16x32_bf16(*(const bf16x8*)(kp + dc * 32), qf[dc], acc, 0, 0, 0);
#pragma unroll
        for (int j = 0; j < 4; ++j) if (fq * 4 + j > fr) acc[j] = -__builtin_inff();
        float cm = fmaxf(fmaxf(acc[0], acc[1]), fmaxf(acc[2], acc[3]));
        cm = xmax16(cm); cm = xmax32(cm);
        const float mn = fmaxf(m_run, cm), alpha = __builtin_amdgcn_exp2f(m_run - mn); m_run = mn;
        float ps = 0.f;
#pragma unroll
        for (int j = 0; j < 4; ++j) { acc[j] = __builtin_amdgcn_exp2f(acc[j] - mn); ps += acc[j]; }
        ps = xsum16(ps); ps = xsum32(ps);
        l_run = l_run * alpha + ps;
        const bf16x8 pb = pack8(acc, (f32x4){0.f, 0.f, 0.f, 0.f});
        const bf16_t* vb_u = T.vb + qrow * DM + h * HD; const unsigned vlo2 = (unsigned)(fq * 4) * DM + fr;
#pragma unroll
        for (int dt = 0; dt < 8; ++dt) { ot[dt] *= alpha;
            unsigned w0 = (unsigned)(vb_u + dt * 16)[vlo2] | ((unsigned)(vb_u + DM + dt * 16)[vlo2] << 16), w1 = (unsigned)(vb_u + 2 * DM + dt * 16)[vlo2] | ((unsigned)(vb_u + 3 * DM + dt * 16)[vlo2] << 16);
            u32x4 w = {w0, w1, 0u, 0u};
            ot[dt] = __builtin_amdgcn_mfma_f32_16x16x32_bf16(*reinterpret_cast<bf16x8*>(&w), pb, ot[dt], 0, 0, 0); }
    }
#pragma unroll
    for (int dt = 0; dt < 8; ++dt) *(f32x4*)(Op + (wid * 16 + fr) * HD + dt * 16 + fq * 4) = ot[dt];
    if (fq == 0) { ML[(wid * 16 + fr) * 2] = m_run; ML[(wid * 16 + fr) * 2 + 1] = l_run; }
    __syncthreads();
    { const int q = tid >> 5, d4 = (tid & 31) * 4;
      float mx = ML[q * 2];
#pragma unroll
      for (int w = 1; w < 8; ++w) mx = fmaxf(mx, ML[(w * 16 + q) * 2]);
      float L = 0.f; f32x4 O = {0.f, 0.f, 0.f, 0.f};
#pragma unroll
      for (int w = 0; w < 8; ++w) { const float s = __builtin_amdgcn_exp2f(ML[(w * 16 + q) * 2] - mx); L += s * ML[(w * 16 + q) * 2 + 1]; O += *(const f32x4*)(Op + (w * 16 + q) * HD + d4) * s; }
      const float il = 1.0f / L; const size_t off = (qrow + q) * DM + h * HD + d4;
      const u32x2 gw = *(const u32x2*)(T.sg + off);
      u32x2 w; w.x = cvtpk(O[0] * il * bflo(gw.x), O[1] * il * bfhi(gw.x)); w.y = cvtpk(O[2] * il * bflo(gw.y), O[3] * il * bfhi(gw.y));
      *(u32x2*)(T.og + off) = w; }
    __syncthreads();
}
}

__device__ __forceinline__ void transpose_item(const float* W, int ldw, int N, bf16_t* WT, int K, const float* g, float* scr, int item, int lane) {
    const int nblk = (N + 31) / 32, kb = item / nblk, nb = item % nblk, k0 = 64 * kb, n0 = 32 * nb;
    const int c4 = (lane & 7) * 4, kr = lane >> 3; const bool nok = n0 + c4 < N;
    f32x4 v[8];
#pragma unroll
    for (int i = 0; i < 8; ++i) v[i] = nok ? *(const f32x4*)(W + (size_t)(k0 + 8 * i + kr) * ldw + n0 + c4) : (f32x4){0.f, 0.f, 0.f, 0.f};
    if (g) {
#pragma unroll
        for (int i = 0; i < 8; ++i) v[i] *= g[k0 + 8 * i + kr]; }
#pragma unroll
    for (int i = 0; i < 8; ++i) { float* s = scr + (8 * i + kr) * 33 + c4; s[0] = v[i][0]; s[1] = v[i][1]; s[2] = v[i][2]; s[3] = v[i][3]; }
    asm volatile("s_waitcnt lgkmcnt(0)" ::: "memory");
    const int c = lane & 7;
#pragma unroll
    for (int j = 0; j < 4; ++j) { const int nn = (lane >> 3) + 8 * j; const float* s = scr + (8 * c) * 33 + nn;
        u32x4 o; o.x = cvtpk(s[0 * 33], s[1 * 33]); o.y = cvtpk(s[2 * 33], s[3 * 33]); o.z = cvtpk(s[4 * 33], s[5 * 33]); o.w = cvtpk(s[6 * 33], s[7 * 33]);
        if (n0 + nn < N) *(u32x4*)(WT + (size_t)(n0 + nn) * K + k0 + 8 * c) = o; }
    asm volatile("s_waitcnt lgkmcnt(0)" ::: "memory");
}
struct TJob { const float* W; bf16_t* WT; const float* g; int K, N, ldw; };
__device__ __forceinline__ TJob get_job(const Params& p, int j) {
    unsigned char* ws = p.ws; TJob t; t.g = nullptr; t.ldw = 0;
    if (j < 2) { t.W = p.in[7] + (size_t)j * DM * 2 * EA + EA; t.WT = (bf16_t*)(ws + WS_WINA) + (size_t)j * 2 * EA * DM + (size_t)EA * DM; t.g = p.in[6] + j * DM; t.K = DM; t.N = EA; t.ldw = 2 * EA; }
    else if (j >= 17) { const int l = j - 17; t.W = p.in[7] + (size_t)l * DM * 2 * EA; t.WT = (bf16_t*)(ws + WS_WINUT) + (size_t)l * EA * DM; t.g = p.in[6] + l * DM; t.K = DM; t.N = EA; t.ldw = 2 * EA; }
    else if (j < 10) { const int i = j - 2; t.W = p.in[8] + (size_t)i * 1024 * 1024; t.WT = (bf16_t*)(ws + WS_WGRP) + (size_t)i * 1024 * 1024; t.K = 1024; t.N = 1024; }
    else if (j < 12) { const int l = j - 10; t.W = p.in[10] + (size_t)l * EA * DM; t.WT = (bf16_t*)(ws + WS_WOUTA) + (size_t)l * DM * EA; t.K = EA; t.N = DM; }
    else if (j == 12) { t.W = p.in[12]; t.WT = (bf16_t*)(ws + WS_W4); t.g = p.in[11]; t.K = DM; t.N = 2 * DM + NH; }
    else if (j == 13) { t.W = p.in[15]; t.WT = (bf16_t*)(ws + WS_W4) + (size_t)4352 * DM; t.g = p.in[14]; t.K = DM; t.N = 2 * DM; }
    else if (j == 14) { t.W = p.in[15] + (size_t)DM * 2 * DM; t.WT = (bf16_t*)(ws + WS_WINB1); t.g = p.in[14] + DM; t.K = DM; t.N = 2 * DM; }
    else { const int l = j - 15; t.W = p.in[16] + (size_t)l * DM * DM; t.WT = (bf16_t*)(ws + WS_WOUTB) + (size_t)l * DM * DM; t.K = DM; t.N = DM; }
    if (t.ldw == 0) t.ldw = t.N;
    return t;
}
__device__ __forceinline__ void prologue_phase(int wv, const Params& p, char* lds) {
    const int tid = otid(wv), lane = tid & 63, wid = tid >> 6, G = gridDim.x;
    const int gw = blockIdx.x * NWAVES + wid, NGW = G * NWAVES;
    float* scr = (float*)(lds + wid * 8704);
    int rot = 0;
    for (int j = 0; j < 19; ++j) { const TJob t = get_job(p, j); const int nitems = (t.K / 64) * ((t.N + 31) / 32);
        int start = gw - rot; if (start < 0) start += NGW;
        for (int it = start; it < nitems; it += NGW) transpose_item(t.W, t.ldw, t.N, t.WT, t.K, t.g, scr, it, lane);
        rot = (rot + nitems) % NGW; }
    float* ssq = (float*)(p.ws + WS_SSQ); bf16_t* xb = (bf16_t*)(p.ws + WS_XB);
    for (int m = gw; m < MT; m += NGW) { const float* xr = m < MP ? p.in[0] + (size_t)m * DM : p.in[1] + (size_t)(m - MP) * DM;
        float s = 0.f; unsigned long long* o8 = (unsigned long long*)(xb + (size_t)m * DM) + lane;
        f32x4 xv[8];
#pragma unroll
        for (int j = 0; j < 8; ++j) xv[j] = *((const f32x4*)xr + lane + 64 * j);
#pragma unroll
        for (int j = 0; j < 8; ++j) { const f32x4 v = xv[j]; s += (v[0] * v[0] + v[1] * v[1]) + (v[2] * v[2] + v[3] * v[3]);
            o8[64 * j] = (unsigned long long)cvtpk(v[0], v[1]) | ((unsigned long long)cvtpk(v[2], v[3]) << 32); }
        s = wave_sum(s); if (lane == 0) ssq[m] = s; }
    for (int i = blockIdx.x * NTHREADS + tid; i < 4 * MT; i += G * NTHREADS) ssq[MT + i] = 0.f;
    { f32x4* z = (f32x4*)(p.ws + WS_SPLIT); const size_t nz = (SPLIT_TILES * SPLIT_TILE + SPLIT_TILES * 8 * 4) / 16;
      for (size_t i = (size_t)blockIdx.x * NTHREADS + tid; i < nz; i += (size_t)G * NTHREADS) z[i] = (f32x4){0.f, 0.f, 0.f, 0.f}; }
    { bf16_t* wus = (bf16_t*)(p.ws + WS_WINUS);
      for (int i = blockIdx.x * NTHREADS + tid; i < 2 * DM * (EA / 8); i += G * NTHREADS) { const int r = i >> 9, c = (i & 511) * 8, l = r >> 11, k = r & (DM - 1);
          const float* s = p.in[7] + ((size_t)l * DM + k) * 2 * EA + c; const float gk = p.in[6][l * DM + k];
          *(bf16x8*)(wus + (size_t)r * EA + c) = pack8(*(const f32x4*)s * gk, *(const f32x4*)(s + 4) * gk); }
      bf16_t* pb = (bf16_t*)(p.ws + WS_PREVB);
      for (int i = blockIdx.x * NTHREADS + tid; i < 2 * 256 * (EA / 8); i += G * NTHREADS) { const int r = i >> 9, c = (i & 511) * 8, l = r >> 8, rr = r & 255;
          f32x4 a = {0.f, 0.f, 0.f, 0.f}, b = a;
          if (rr < NDB * PPAD) { const float* s = p.in[5] + ((size_t)l * NDB * PPAD + rr) * EA + c; a = *(const f32x4*)s; b = *(const f32x4*)(s + 4); }
          *(bf16x8*)(pb + (size_t)r * EA + c) = pack8(a, b); } }
}
template <int W>
__device__ __forceinline__ void poolmix_item(const bf16_t* tt, const bf16_t* sg, const float* scale, const bf16_t* prevt, bf16_t* yg, int row0, int ch) {
    constexpr int NR = 16 + W - 1;
    u32x4 rows[NR];
    const bool samp = row0 >= MP; const int t0 = samp ? 0 : (row0 & (SEQ - 1));
    const bf16_t* up = tt + (size_t)row0 * EA + ch;
    if (t0 != 0) {
#pragma unroll
        for (int i = 0; i < NR; ++i) rows[i] = *(const u32x4*)(up + (ptrdiff_t)(i - (W - 1)) * EA);
    } else {
#pragma unroll
        for (int i = W - 1; i < NR; ++i) rows[i] = *(const u32x4*)(up + (ptrdiff_t)(i - (W - 1)) * EA);
        if (samp) { const bf16_t* pp = prevt + ((size_t)((row0 - MP) >> 4) * PPAD + (PPAD - (W - 1))) * EA + ch;
#pragma unroll
            for (int i = 0; i < W - 1; ++i) rows[i] = *(const u32x4*)(pp + (size_t)i * EA); }
        else {
#pragma unroll
            for (int i = 0; i < W - 1; ++i) rows[i] = (u32x4){0u, 0u, 0u, 0u}; }
    }
    const f32x4 sc0 = *(const f32x4*)(scale + ch), sc1 = *(const f32x4*)(scale + ch + 4);
    float s[8] = {0.f, 0.f, 0.f, 0.f, 0.f, 0.f, 0.f, 0.f};
#define ROWF(v, f) const float f[8] = {bflo(v.x), bfhi(v.x), bflo(v.y), bfhi(v.y), bflo(v.z), bfhi(v.z), bflo(v.w), bfhi(v.w)}
#pragma unroll
    for (int i = 0; i < W - 1; ++i) { ROWF(rows[i], f);
#pragma unroll
        for (int c = 0; c < 8; ++c) s[c] += f[c]; }
    u32x4 gvs[2];
#pragma unroll
    for (int j = 0; j < 16; ++j) { ROWF(rows[j + W - 1], f);
        if ((j & 1) == 0) {
#pragma unroll
            for (int jj = 0; jj < 2; ++jj) gvs[jj] = *(const u32x4*)(sg + (size_t)(row0 + j + jj) * EA + ch); }
        const u32x4 gv = gvs[j & 1]; ROWF(gv, gt);
#pragma unroll
        for (int c = 0; c < 8; ++c) s[c] += f[c];
        const int nv = (!samp && t0 + j + 1 < W) ? t0 + j + 1 : W; const float ic = 1.0f / (float)nv;
        u32x4 o; o.x = cvtpk((s[0] * ic - f[0]) * sc0[0] * gt[0], (s[1] * ic - f[1]) * sc0[1] * gt[1]); o.y = cvtpk((s[2] * ic - f[2]) * sc0[2] * gt[2], (s[3] * ic - f[3]) * sc0[3] * gt[3]);
        o.z = cvtpk((s[4] * ic - f[4]) * sc1[0] * gt[4], (s[5] * ic - f[5]) * sc1[1] * gt[5]); o.w = cvtpk((s[6] * ic - f[6]) * sc1[2] * gt[6], (s[7] * ic - f[7]) * sc1[3] * gt[7]);
        *(u32x4*)(yg + (size_t)(row0 + j) * EA + ch) = o;
        ROWF(rows[j], g);
#pragma unroll
        for (int c = 0; c < 8; ++c) s[c] -= g[c]; }
#undef ROWF
}
__device__ __forceinline__ void poolmix_phase(int wv, const Params& p, int l) {
    const bf16_t* tt = (const bf16_t*)(p.ws + WS_U); const bf16_t* sg = (const bf16_t*)(p.ws + WS_SG); bf16_t* yg = (bf16_t*)(p.ws + WS_D);
    const bf16_t* prevt = (const bf16_t*)(p.ws + WS_PREVT) + (size_t)l * 256 * EA; const float* scale = p.in[9] + (size_t)l * EA;
    const int nth = gridDim.x * NTHREADS;
    for (int idx = blockIdx.x * NTHREADS + otid(wv); idx < (MT / 16) * (EA / 8); idx += nth) {
        const int row0 = (idx >> 9) * 16, ch = (idx & 511) * 8, grp = __builtin_amdgcn_readfirstlane(ch >> 10);
        if (grp == 0) poolmix_item<2>(tt, sg, scale, prevt, yg, row0, ch);
        else if (grp == 1) poolmix_item<4>(tt, sg, scale, prevt, yg, row0, ch);
        else if (grp == 2) poolmix_item<8>(tt, sg, scale, prevt, yg, row0, ch);
        else poolmix_item<16>(tt, sg, scale, prevt, yg, row0, ch);
    }
}
__device__ __forceinline__ void final_phase(int wv, const Params& p) {
    const int tid = otid(wv), lane = tid & 63, gw = blockIdx.x * NWAVES + (tid >> 6), NGW = gridDim.x * NWAVES;
    const float* xres = (const float*)(p.ws + WS_XRES); const float* ssq = (const float*)(p.ws + WS_SSQ) + (size_t)4 * MT; const float* g = p.in[17];
    for (int m = gw; m < MT; m += NGW) { const float rr = rsqrtf(ssq[m] * (1.0f / DM) + EPS);
        const f32x4* xr = (const f32x4*)(xres + (size_t)m * DM) + lane; f32x4* o = (f32x4*)(p.out + (m < MP ? O_YP + (size_t)m * DM : O_YS + (size_t)(m - MP) * DM)) + lane;
        f32x4 xv[8];
#pragma unroll
        for (int j = 0; j < 8; ++j) xv[j] = xr[64 * j] * rr * ((const f32x4*)g)[lane + 64 * j];
#pragma unroll
        for (int j = 0; j < 8; ++j) o[64 * j] = xv[j]; }
}

constexpr int NPHASES = 15;
typedef const __attribute__((address_space(4))) Params* KArgPtr;
#if defined(__HIP_DEVICE_COMPILE__)
#define LOADP_() KArgPtr kp_ = (KArgPtr)__builtin_amdgcn_kernarg_segment_ptr(); asm volatile("" : "+s"(kp_)); Params lp; _Pragma("unroll") for (int i_ = 0; i_ < 18; ++i_) lp.in[i_] = kp_->in[i_]; lp.out = kp_->out; lp.ws = kp_->ws; lp.ph_lo = 0; lp.ph_hi = 0
#else
#define LOADP_() const Params lp = p
#endif
#define LOADP() LOADP_(); unsigned char* const ws = lp.ws; \
    float* const ssq = (float*)(ws + WS_SSQ); bf16_t* const xb = (bf16_t*)(ws + WS_XB); float* const xres = (float*)(ws + WS_XRES); (void)ssq; (void)xb; (void)xres
__global__ void __launch_bounds__(NTHREADS, 2) yoco_fwd(Params p) {
    extern __shared__ __attribute__((aligned(16))) unsigned char lds_raw[];
    char* lds = (char*)lds_raw; LAS unsigned char* ldsl = (LAS unsigned char*)lds_raw;
    const int G = gridDim.x, bx = blockIdx.x, wv = __builtin_amdgcn_readfirstlane(threadIdx.x >> 6);
#ifndef ONLY_PHASE
#define ONLY_PHASE -1
#endif
#define IN(k) ((ONLY_PHASE < 0 || ONLY_PHASE == (k)) && p.ph_lo <= (k) && (k) < p.ph_hi)
#ifndef SAT_REP
#define SAT_REP 1
#endif
#ifndef REPEAT_MASK
#define REPEAT_MASK 0
#endif
#define NREP(k) (1 + (int)(((unsigned)(REPEAT_MASK) >> (k)) & 1u))
#define SEAM(k) do { if (rep_ + 1 < NREP(k) || (k) + 1 < p.ph_hi) cg::this_grid().sync(); } while (0)
    if (IN(0)) for (int rep_ = 0; rep_ < NREP(0); ++rep_) { { LOADP(); prologue_phase(wv, lp, lds); } SEAM(0); }
    if (IN(1)) for (int rep_ = 0; rep_ < NREP(1); ++rep_) {
        { LOADP(); pg8::Gemm g{(const bf16_t*)(ws + WS_WGRP), (const bf16_t*)(ws + WS_WINUS), 1024, 1024, EA, 2, nullptr, nullptr}; pg8::StaticOrder S; S.init(32, 8, G, bx);
          pg8::EpiStore E{(bf16_t*)(ws + WS_WINA), DM, 1};
          pg8::gemm_phase<pg8::EpiStore, pg8::StaticOrder>(wv, ldsl, g, S, E); }
        { LOADP(); pg8::Gemm g{(const bf16_t*)(ws + WS_PREVB), (const bf16_t*)(ws + WS_WGRP), 1024, EA, 1024, 3, nullptr, nullptr}; pg8::StaticOrder S; S.init(2, 16, G, bx);
          pg8::EpiStore E{(bf16_t*)(ws + WS_PREVT), EA, 0};
          pg8::gemm_phase<pg8::EpiStore, pg8::StaticOrder>(wv, ldsl, g, S, E); }
        SEAM(1); }
#pragma unroll 1
    for (int l = 0; l < 2; ++l) {
        int wv_o = wv, bx_o = bx, G_o = G; asm volatile("" : "+s"(wv_o), "+s"(bx_o), "+s"(G_o));
        const int wv = wv_o, bx = bx_o, G = G_o;
        if (IN(2 + 3 * l)) for (int rep_ = 0; rep_ < NREP(2 + 3 * l); ++rep_) {
            { LOADP(); bf16_t* u = (bf16_t*)(ws + WS_U); bf16_t* sg = (bf16_t*)(ws + WS_SG);
              pg8::Gemm g{xb, (const bf16_t*)(ws + WS_WINA) + (size_t)l * 2 * EA * DM, DM, DM, DM, 0, nullptr, nullptr}; pg8::StaticOrder S; S.init(65, 32, G, bx);
              pg8::EpiInA E{ssq + (size_t)l * MT, u, sg};
              pg8::gemm_phase<pg8::EpiInA, pg8::StaticOrder>(wv, ldsl, g, S, E); }
            { LOADP(); pg8::Gemm g{xb, (const bf16_t*)(ws + WS_WINUT) + (size_t)l * EA * DM, DM, DM, DM, 0, nullptr, nullptr}; pg8::StateOrder S{G, bx};
              pg8::EpiUState E{ssq + (size_t)l * MT, lp.out + O_PP + (size_t)l * NBATCH * PPAD * EA, lp.out + O_PS + (size_t)l * NDB * PPAD * EA};
              pg8::gemm_phase<pg8::EpiUState, pg8::StateOrder>(wv, ldsl, g, S, E); }
            SEAM(2 + 3 * l); }
        if (IN(3 + 3 * l)) for (int rep_ = 0; rep_ < NREP(3 + 3 * l); ++rep_) { { LOADP(); poolmix_phase(wv, lp, l); } SEAM(3 + 3 * l); }
        if (IN(4 + 3 * l)) for (int rep_ = 0; rep_ < NREP(4 + 3 * l); ++rep_) { { LOADP(); bf16_t* yg = (bf16_t*)(ws + WS_D);
            pg8::Gemm g{yg, (const bf16_t*)(ws + WS_WOUTA) + (size_t)l * DM * EA, EA, EA, EA, 0, (float*)(ws + WS_SPLIT) + (size_t)l * 8 * 65536, (unsigned*)(ws + WS_SPCNT) + l * 64}; pg8::SplitOrder S; S.init(8, 8, G, bx);
            pg8::EpiRes E{l == 0 ? lp.in[0] : xres, l == 0 ? lp.in[1] : xres + (size_t)MP * DM, xres, xb, ssq + (size_t)(l + 1) * MT};
            pg8::gemm_phase<pg8::EpiRes, pg8::SplitOrder>(wv, ldsl, g, S, E); } SEAM(4 + 3 * l); }
    }
#pragma unroll 1
    for (int lb = 0; lb < 2; ++lb) {
        int wv_o = wv, bx_o = bx, G_o = G; asm volatile("" : "+s"(wv_o), "+s"(bx_o), "+s"(G_o));
        const int wv = wv_o, bx = bx_o, G = G_o;
        if (IN(8 + 3 * lb)) for (int rep_ = 0; rep_ < NREP(8 + 3 * lb); ++rep_) { { LOADP();
            pg8::EpiKVQ E{lb == 0 ? 0 : 17, ssq + (size_t)(2 + lb) * MT, lp.out, ws, lp.in[13]};
            if (lb == 0) { pg8::Gemm g{xb, (const bf16_t*)(ws + WS_W4), DM, DM, DM, 0, nullptr, nullptr}; pg8::StaticOrder S; S.init(65, 33, G, bx);
                pg8::gemm_phase<pg8::EpiKVQ, pg8::StaticOrder>(wv, ldsl, g, S, E); }
            else { pg8::Gemm g{xb, (const bf16_t*)(ws + WS_WINB1), DM, DM, DM, 0, (float*)(ws + WS_SPLIT) + (size_t)32 * 65536, (unsigned*)(ws + WS_SPCNT) + 256}; pg8::SplitOrder S; S.init(16, 4, G, bx);
                pg8::gemm_phase<pg8::EpiKVQ, pg8::SplitOrder>(wv, ldsl, g, S, E); } } SEAM(8 + 3 * lb); }
        if (IN(9 + 3 * lb)) for (int rep_ = 0; rep_ < NREP(9 + 3 * lb); ++rep_) {
            { const int xcd = bx & 7, j = bx >> 3;
              if (G != 256 || j >= 24) { LOADP();
                  sat::Tensors ST{(const bf16_t*)(ws + WS_QB), (const bf16_t*)(ws + WS_KB), (const bf16_t*)(ws + WS_VB), (bf16_t*)(ws + WS_OG), (const bf16_t*)(ws + WS_SGB),
                                  lp.in[2], lp.in[3], lp.in[4], (const float*)(ws + WS_LFTS)};
                  const int s0 = G == 256 ? xcd * 8 + (j - 24) : bx, sstep = G == 256 ? 64 : G;
                  for (int it = s0; it < NDB * NH; it += sstep) sat::item(wv, lds, ST, it >> 4, it & 15); }
              if (G != 256 || j < 24) { LOADP();
                  att::Tensors AT{(const bf16_t*)(ws + WS_QB), (const bf16_t*)(ws + WS_KB), (const bf16_t*)(ws + WS_VB), (bf16_t*)(ws + WS_OG), (const bf16_t*)(ws + WS_SGB), (const float*)(ws + WS_LFTP)};
                  const int p0 = G == 256 ? xcd * 24 + j : bx, pstep = G == 256 ? 192 : G;
                  for (int pw = p0; pw < 192; pw += pstep) att::prompt_phase(wv, lds, AT, (const float*)(ws + WS_KNRM), (const float*)(ws + WS_QNRM), pw); } }
            SEAM(9 + 3 * lb); }
        if (IN(10 + 3 * lb)) for (int rep_ = 0; rep_ < NREP(10 + 3 * lb); ++rep_) { { LOADP();
            pg8::Gemm g{(const bf16_t*)(ws + WS_OG), (const bf16_t*)(ws + WS_WOUTB) + (size_t)lb * DM * DM, DM, DM, DM, 0, (float*)(ws + WS_SPLIT) + (size_t)(2 + lb) * 8 * 65536, (unsigned*)(ws + WS_SPCNT) + (2 + lb) * 64}; pg8::SplitOrder S; S.init(8, 4, G, bx);
            pg8::EpiRes E{xres, xres + (size_t)MP * DM, xres, xb, ssq + (size_t)(3 + lb) * MT};
            pg8::gemm_phase<pg8::EpiRes, pg8::SplitOrder>(wv, ldsl, g, S, E); } SEAM(10 + 3 * lb); }
    }
    if (IN(14)) { LOADP(); final_phase(wv, lp); }
#undef IN
#undef SEAM
}

extern "C" void kernel_launch(void* const* d_in, const int* in_sizes, int n_in, void* d_out, int out_size, void* d_ws, size_t ws_size, hipStream_t stream) {
    static int grid = 0;
    if (grid == 0) {
        if (n_in != 18 || (size_t)out_size != O_END || ws_size < WS_END) { fprintf(stderr, "kernel_launch: unexpected shapes: n_in %d out %d (want %zu) ws %zu (need %zu)\n", n_in, out_size, (size_t)O_END, ws_size, (size_t)WS_END); grid = -1; return; }
        int dev = 0, cus = 0, per_cu = 0;
        (void)hipGetDevice(&dev); (void)hipDeviceGetAttribute(&cus, hipDeviceAttributeMultiprocessorCount, dev);
        if (hipFuncSetAttribute((const void*)yoco_fwd, hipFuncAttributeMaxDynamicSharedMemorySize, LDS_BYTES) != hipSuccess) { fprintf(stderr, "kernel_launch: hipFuncSetAttribute failed\n"); grid = -1; return; }
        if (hipOccupancyMaxActiveBlocksPerMultiprocessor(&per_cu, (const void*)yoco_fwd, NTHREADS, LDS_BYTES) != hipSuccess || per_cu < 1) { fprintf(stderr, "kernel_launch: occupancy query gave %d\n", per_cu); per_cu = 1; }
        (void)hipGetLastError();
        grid = cus > 0 ? cus : 256;
    }
    if (grid < 0) return;
    Params p{};
    for (int i = 0; i < 18; ++i) p.in[i] = (const float*)d_in[i];
    p.out = (float*)d_out; p.ws = (unsigned char*)d_ws;
#if MULTI_LAUNCH
    for (int ph = 0; ph < NPHASES; ++ph) { p.ph_lo = ph; p.ph_hi = ph + 1; hipLaunchKernelGGL(yoco_fwd, dim3(grid), dim3(NTHREADS), LDS_BYTES, stream, p); }
#else
    p.ph_lo = 0; p.ph_hi = NPHASES;
    void* args[] = {&p};
    hipError_t e = hipLaunchCooperativeKernel((const void*)yoco_fwd, dim3(grid), dim3(NTHREADS), args, LDS_BYTES, stream);
    if (e != hipSuccess) fprintf(stderr, "kernel_launch: cooperative launch failed: %s (grid %d)\n", hipGetErrorString(e), grid);
#endif
}
```

```cpp
#include <hip/hip_runtime.h>
#include <hip/hip_cooperative_groups.h>
#include <cstdio>
#include <cstdint>
namespace cg = cooperative_groups;

#ifndef MULTI_LAUNCH
#define MULTI_LAUNCH 0
#endif

#define LAS __attribute__((address_space(3)))
typedef unsigned short bf16_t;
typedef short bf16x8 __attribute__((ext_vector_type(8)));
typedef short s16x4 __attribute__((ext_vector_type(4)));
typedef float f32x4 __attribute__((ext_vector_type(4)));
typedef float f32x16 __attribute__((ext_vector_type(16)));
typedef unsigned u32x4 __attribute__((ext_vector_type(4)));
typedef unsigned u32x2 __attribute__((ext_vector_type(2)));

constexpr int DM = 2048, NBATCH = 4, SEQ = 4096, NDB = 16, DSEQ = 16, PAST = 2048, EA = 4096, NH = 16, HD = 128, PPAD = 15;
constexpr int MP = NBATCH * SEQ, MS = NDB * DSEQ, MT = MP + MS;
constexpr float EPS = 1e-6f;
constexpr float LOG2E = 1.4426950408889634f;
constexpr float QSCALE = 0.08838834764831845f * 1.4426950408889634f;
constexpr int NTHREADS = 512, NWAVES = 8;
constexpr int LDS_BYTES = 131072;

constexpr size_t O_YP = 0, O_YS = O_YP + (size_t)MP * DM, O_KP = O_YS + (size_t)MS * DM, O_VP = O_KP + (size_t)MP * DM,
                 O_LFP = O_VP + (size_t)MP * DM, O_PP = O_LFP + (size_t)MP * NH, O_KS = O_PP + (size_t)2 * NBATCH * PPAD * EA,
                 O_VS = O_KS + (size_t)MS * DM, O_LFS = O_VS + (size_t)MS * DM, O_PS = O_LFS + (size_t)MS * NH, O_END = O_PS + (size_t)2 * NDB * PPAD * EA;

constexpr size_t al256(size_t x) { return (x + 255) & ~(size_t)255; }
constexpr size_t WS_WINA = 0;
constexpr size_t WS_WGRP = WS_WINA + (size_t)2 * 8192 * 2048 * 2;
constexpr size_t WS_WOUTA = WS_WGRP + (size_t)2 * 4096 * 1024 * 2;
constexpr size_t WS_W4 = WS_WOUTA + (size_t)2 * 2048 * 4096 * 2;
constexpr size_t WS_WINB1 = WS_W4 + (size_t)8448 * 2048 * 2;
constexpr size_t WS_WOUTB = WS_WINB1 + (size_t)4096 * 2048 * 2;
constexpr size_t WS_XB = WS_WOUTB + (size_t)2 * 2048 * 2048 * 2;
constexpr size_t WS_XRES = WS_XB + (size_t)MT * DM * 2;
constexpr size_t WS_SSQ = WS_XRES + (size_t)MT * DM * 4;
constexpr size_t WS_LFTP = al256(WS_SSQ + (size_t)5 * MT * 4);
constexpr size_t WS_LFTS = WS_LFTP + (size_t)NBATCH * NH * SEQ * 4;
constexpr size_t WS_KNRM = al256(WS_LFTS + (size_t)NDB * NH * DSEQ * 4);
constexpr size_t WS_QNRM = WS_KNRM + (size_t)MT * NH * 4 * 4;
constexpr size_t WS_WINUT = al256(WS_QNRM + (size_t)MT * NH * 4 * 4);
constexpr size_t WS_WINUS = WS_WINUT + (size_t)2 * EA * DM * 2;
constexpr size_t WS_PREVB = WS_WINUS + (size_t)2 * DM * EA * 2;
constexpr size_t WS_PREVT = WS_PREVB + (size_t)2 * 256 * EA * 2;
constexpr size_t WS_SPLIT = al256(WS_PREVT + (size_t)2 * 256 * EA * 2);
constexpr size_t SPLIT_TILE = 65536 * 4, SPLIT_TILES = 8 * 4 + 16;
constexpr size_t WS_SPCNT = WS_SPLIT + SPLIT_TILES * SPLIT_TILE;
constexpr size_t WS_ACT = al256(WS_SPCNT + SPLIT_TILES * 8 * 4);
constexpr size_t SZ_A = (size_t)MT * EA * 2, SZ_B = (size_t)MT * DM * 2;
constexpr size_t WS_U = WS_ACT, WS_SG = WS_U + SZ_A, WS_D = WS_SG + SZ_A;
constexpr size_t WS_KB = WS_ACT, WS_VB = WS_KB + SZ_B, WS_QB = WS_VB + SZ_B, WS_SGB = WS_QB + SZ_B, WS_OG = WS_SGB + SZ_B;
constexpr size_t WS_END = (WS_D + SZ_A) > (WS_OG + SZ_B) ? (WS_D + SZ_A) : (WS_OG + SZ_B);

struct Params { const float* in[18]; float* out; unsigned char* ws; int ph_lo, ph_hi; };

__device__ __forceinline__ unsigned cvtpk(float lo, float hi) { unsigned r; asm volatile("v_cvt_pk_bf16_f32 %0, %1, %2" : "=v"(r) : "v"(lo), "v"(hi)); return r; }
__device__ __forceinline__ bf16x8 pack8(f32x4 a, f32x4 b) { u32x4 w = {cvtpk(a[0], a[1]), cvtpk(a[2], a[3]), cvtpk(b[0], b[1]), cvtpk(b[2], b[3])}; return *reinterpret_cast<bf16x8*>(&w); }
__device__ __forceinline__ float bflo(unsigned w) { return __uint_as_float(w << 16); }
__device__ __forceinline__ float bfhi(unsigned w) { return __uint_as_float(w & 0xffff0000u); }
__device__ __forceinline__ float silu_f(float x) { return x * __builtin_amdgcn_rcpf(1.0f + __builtin_amdgcn_exp2f(-x * LOG2E)); }
__device__ __forceinline__ float wave_sum(float v) {
#pragma unroll
    for (int o = 1; o < 64; o <<= 1) v += __shfl_xor(v, o);
    return v;
}
__device__ __forceinline__ int otid(int wv) { int l; asm volatile("v_mbcnt_lo_u32_b32 %0, -1, 0\n\tv_mbcnt_hi_u32_b32 %0, -1, %0" : "=v"(l)); return wv * 64 + l; }
__device__ __forceinline__ float xsum16(float v) { auto r = __builtin_amdgcn_permlane16_swap(__float_as_uint(v), __float_as_uint(v), false, false); return __uint_as_float(r[0]) + __uint_as_float(r[1]); }
__device__ __forceinline__ float xsum32(float v) { auto r = __builtin_amdgcn_permlane32_swap(__float_as_uint(v), __float_as_uint(v), false, false); return __uint_as_float(r[0]) + __uint_as_float(r[1]); }
__device__ __forceinline__ float xmax16(float v) { auto r = __builtin_amdgcn_permlane16_swap(__float_as_uint(v), __float_as_uint(v), false, false); return fmaxf(__uint_as_float(r[0]), __uint_as_float(r[1])); }
__device__ __forceinline__ float xmax32(float v) { auto r = __builtin_amdgcn_permlane32_swap(__float_as_uint(v), __float_as_uint(v), false, false); return fmaxf(__uint_as_float(r[0]), __uint_as_float(r[1])); }
__device__ __forceinline__ float bperm(float v, int srclane) { return __uint_as_float((unsigned)__builtin_amdgcn_ds_bpermute(srclane << 2, (int)__float_as_uint(v))); }
__device__ __forceinline__ float logsig(float x) { return fminf(x, 0.f) - log1pf(__expf(-fabsf(x))); }

namespace pg8 {
constexpr int BM = 256, BK = 64, HALF = 128, HTB = HALF * BK * 2, NXCD = 8, WGM = 8;
__device__ __forceinline__ int lds_byte(int r, int c) { const int st = (r >> 4) * 2 + (c >> 5), rr = r & 15, cc = c & 31, ob = rr * 64 + cc * 2; return st * 1024 + (ob ^ (((ob >> 9) & 1) << 5)); }
__device__ __forceinline__ void stage_rc(int b, int& R, int& C) { const int st = b / 1024, sb = b % 1024, swz = sb ^ (((sb >> 9) & 1) << 5); R = (st >> 1) * 16 + swz / 64; C = (st & 1) * 32 + (swz % 64) / 2; }
__device__ __forceinline__ int perm32(int rho) { const int n = rho >> 4, i = rho & 15; return 8 * (i >> 2) + 4 * n + (i & 3); }
struct Unit { int pm, pn, ks, nks; };
struct Gemm { const bf16_t* A; const bf16_t* Bt; int K, lda, ldb, mode; float* sp_acc; unsigned* sp_cnt; };
__device__ __forceinline__ void unit_off(const Gemm& g, const Unit& u, size_t& oa, size_t& ob) {
    if (g.mode == 2) { oa = (size_t)u.pm * 256 * g.lda; ob = (size_t)(u.pm >> 4) * DM * EA + (size_t)((u.pm >> 2) & 3) * 1024 + (size_t)u.pn * 256 * g.ldb; }
    else if (g.mode == 3) { oa = (size_t)u.pm * 256 * g.lda + (size_t)(u.pn >> 2) * 1024; ob = (size_t)(u.pm * 16 + u.pn) * 256 * g.ldb; }
    else { oa = (size_t)u.pm * 256 * g.lda; ob = (size_t)u.pn * 256 * g.ldb; }
    const size_t ko = (size_t)u.ks * (size_t)(g.K / u.nks); oa = (oa + ko) * 2; ob = (ob + ko) * 2;
}
struct StaticOrder {
    int nM, nN, nwg, G, c;
    __device__ void init(int nM_, int nN_, int G_, int c_) { nM = nM_; nN = nN_; nwg = nM * nN; G = G_; c = c_; }
    __device__ bool next(int i, Unit& u) const {
        const long L = (long)i * G + c; if (L >= nwg) return false;
        int wgid = (int)L; { const int q = nwg / NXCD, r = nwg % NXCD, xcd = wgid % NXCD, off = wgid / NXCD; wgid = (xcd < r ? xcd * (q + 1) : r * (q + 1) + (xcd - r) * q) + off; }
        const int nig = WGM * nN, gid = wgid / nig, fm = gid * WGM, gsz = (nM - fm) < WGM ? (nM - fm) : WGM;
        u.pm = fm + ((wgid % nig) % gsz); u.pn = (wgid % nig) / gsz; u.ks = 0; u.nks = 1; return true;
    }
};
struct SplitOrder {
    StaticOrder S0; int nN, nks, i0;
    __device__ void init(int nN_, int nks_, int G_, int c_) { S0.init(64, nN_, G_, c_); nN = nN_; nks = nks_; i0 = c_ < S0.nwg ? (S0.nwg - c_ + G_ - 1) / G_ : 0; }
    __device__ bool next(int i, Unit& u) const {
        if (i < i0) return S0.next(i, u);
        const int idx = (i - i0) * S0.G + S0.c; if (idx >= nN * nks) return false;
        u.pm = 64; u.pn = idx / nks; u.ks = idx % nks; u.nks = nks; return true;
    }
};
struct MidOrder {
    int c;
    __device__ bool next(int i, Unit& u) const { const int idx = c - 32; if (i != 0 || idx < 0 || idx >= 32) return false; u.pm = idx >> 4; u.pn = idx & 15; u.ks = 0; u.nks = 1; return true; }
};
struct StateOrder {
    int G, c;
    __device__ bool next(int i, Unit& u) const { const int idx = G - 1 - c; if (i != 0 || idx >= 80) return false; const int k = idx >> 4; u.pm = k < 4 ? 16 * k + 15 : 64; u.pn = idx & 15; u.ks = 0; u.nks = 1; return true; }
};
template <class Epi, class Ord>
__device__ __forceinline__ void gemm_phase(int wv, LAS unsigned char* lds, const Gemm g, const Ord& S, const Epi& E) {
    const int tid = otid(wv), wid = __builtin_amdgcn_readfirstlane(tid >> 6), lane = tid & 63, wr = wid >> 2, wc = wid & 3, fr = lane & 15, fq = lane >> 4;
    const int K = g.K, nt = K / BK;
    unsigned voffA[2], voffB[2];
#pragma unroll
    for (int i = 0; i < 2; ++i) { int R, C; stage_rc(tid * 16 + i * 8192, R, C); const int Rb = Epi::PERM ? ((R & ~31) + perm32(R & 31)) : R;
        voffA[i] = (unsigned)(R * g.lda + C) * 2u; voffB[i] = (unsigned)(Rb * g.ldb + C) * 2u; }
    const size_t kstep = (size_t)(BK * 2);
    const size_t hstepA = (size_t)HALF * g.lda * 2;
    const size_t hstepB = (size_t)HALF * g.ldb * 2;
    const unsigned ldsw = (unsigned)wid * 1024u;
    const int aoff = lds_byte(wr * 64 + fr, fq * 8), boff = lds_byte(wc * 32 + fr, fq * 8);
#define PG8_SA(b, h) (((b) * 2 + (h)) * HTB)
#define PG8_SB(b, h) ((4 + (b) * 2 + (h)) * HTB)
#define PG8_STAGE(bufoff, gbase, voff) do { _Pragma("unroll") for (int _i = 0; _i < 2; ++_i) \
        __builtin_amdgcn_global_load_lds((const unsigned*)((const char*)(gbase) + (voff)[_i]), (LAS unsigned*)(lds + (bufoff) + ldsw + _i * 8192), 16, 0, 0); } while (0)
#define PG8_LDA(dst, b, h) do { _Pragma("unroll") for (int m = 0; m < 4; ++m) _Pragma("unroll") for (int k = 0; k < 2; ++k) dst[m][k] = *(const LAS bf16x8*)(lds + PG8_SA(b, h) + aoff + m * 2048 + k * 1024); } while (0)
#define PG8_LDB(dst, b, h) do { _Pragma("unroll") for (int n = 0; n < 2; ++n) _Pragma("unroll") for (int k = 0; k < 2; ++k) dst[n][k] = *(const LAS bf16x8*)(lds + PG8_SB(b, h) + boff + n * 2048 + k * 1024); } while (0)
#define PG8_MMA(ai, bj, At, Bt) do { __builtin_amdgcn_s_setprio(1); _Pragma("unroll") for (int m = 0; m < 4; ++m) _Pragma("unroll") for (int n = 0; n < 2; ++n) _Pragma("unroll") for (int k = 0; k < 2; ++k) \
        acc[ai][bj][m][n] = __builtin_amdgcn_mfma_f32_16x16x32_bf16(Bt[n][k], At[m][k], acc[ai][bj][m][n], 0, 0, 0); __builtin_amdgcn_s_setprio(0); } while (0)
#define PG8_WAIT_V(n) asm volatile("s_waitcnt vmcnt(" #n ")" ::: "memory")
#define PG8_WAIT_L(n) asm volatile("s_waitcnt lgkmcnt(" #n ")" ::: "memory")
#define PG8_BAR __builtin_amdgcn_s_barrier()
#define PG8_SCHED __builtin_amdgcn_sched_barrier(0)
    Unit cur, nxt; int ui = 0;
    if (!S.next(0, cur)) return;
    f32x4 acc[2][2][4][2];
#pragma unroll
    for (int a = 0; a < 2; ++a)
#pragma unroll
        for (int b = 0; b < 2; ++b)
#pragma unroll
            for (int m = 0; m < 4; ++m)
#pragma unroll
                for (int n = 0; n < 2; ++n) acc[a][b][m][n] = (f32x4){0.f, 0.f, 0.f, 0.f};
    bf16x8 At[4][2], B0[2][2], B1[2][2];
    size_t oa_, ob_; unit_off(g, cur, oa_, ob_);
    const char* cA = (const char*)g.A + oa_; const char* cB = (const char*)g.Bt + ob_;
    PG8_STAGE(PG8_SB(0, 0), cB, voffB); PG8_STAGE(PG8_SA(0, 0), cA, voffA); PG8_STAGE(PG8_SB(0, 1), cB + hstepB, voffB); PG8_STAGE(PG8_SA(0, 1), cA + hstepA, voffA);
    if (wr == 1) PG8_BAR;
    PG8_WAIT_V(4); PG8_BAR;
    PG8_STAGE(PG8_SB(1, 0), cB + kstep, voffB); PG8_STAGE(PG8_SA(1, 0), cA + kstep, voffA); PG8_STAGE(PG8_SB(1, 1), cB + hstepB + kstep, voffB);
    PG8_WAIT_V(6); PG8_BAR;
    for (;;) {
        const bool has_next = S.next(ui + 1, nxt);
        const char* nA = cA; const char* nB = cB;
        if (has_next) { unit_off(g, nxt, oa_, ob_); nA = (const char*)g.A + oa_; nB = (const char*)g.Bt + ob_; }
        const int ntc = nt / cur.nks;
        for (int t = 0; t < ntc; t += 2) {
            const bool last = (t == ntc - 2);
            const char* a1 = cA + (size_t)(t + 1) * kstep;
            const char* a2 = last ? nA : cA + (size_t)(t + 2) * kstep; const char* b2 = last ? nB : cB + (size_t)(t + 2) * kstep;
            const char* a3 = a2 + kstep; const char* b3 = b2 + kstep;
            PG8_LDB(B0, 0, 0); PG8_SCHED; PG8_LDA(At, 0, 0); PG8_STAGE(PG8_SA(1, 1), a1 + hstepA, voffA);
            PG8_WAIT_L(8); PG8_BAR; PG8_WAIT_L(0); PG8_MMA(0, 0, At, B0); PG8_BAR; PG8_SCHED;
            PG8_LDB(B1, 0, 1); PG8_STAGE(PG8_SB(0, 0), b2, voffB);
            PG8_BAR; PG8_WAIT_L(0); PG8_MMA(0, 1, At, B1); PG8_BAR;
            PG8_LDA(At, 0, 1); PG8_STAGE(PG8_SA(0, 0), a2, voffA);
            PG8_BAR; PG8_WAIT_L(0); PG8_MMA(1, 0, At, B0); PG8_BAR; PG8_SCHED;
            PG8_STAGE(PG8_SB(0, 1), b2 + hstepB, voffB);
            PG8_WAIT_V(6); PG8_BAR; PG8_MMA(1, 1, At, B1); PG8_BAR;
            PG8_LDB(B0, 1, 0); PG8_SCHED; PG8_LDA(At, 1, 0); PG8_STAGE(PG8_SA(0, 1), a2 + hstepA, voffA);
            PG8_WAIT_L(8); PG8_BAR; PG8_WAIT_L(0); PG8_MMA(0, 0, At, B0); PG8_BAR; PG8_SCHED;
            PG8_LDB(B1, 1, 1); PG8_STAGE(PG8_SB(1, 0), b3, voffB);
            PG8_BAR; PG8_WAIT_L(0); PG8_MMA(0, 1, At, B1); PG8_BAR;
            PG8_LDA(At, 1, 1); PG8_STAGE(PG8_SA(1, 0), a3, voffA);
            PG8_BAR; PG8_WAIT_L(0); PG8_MMA(1, 0, At, B0); PG8_BAR; PG8_SCHED;
            PG8_STAGE(PG8_SB(1, 1), b3 + hstepB, voffB);
            PG8_WAIT_V(6); PG8_BAR; PG8_MMA(1, 1, At, B1); PG8_BAR;
        }
        bool do_epi = true;
        if (cur.nks > 1) {
            float* sc0 = g.sp_acc + (size_t)cur.pn * 65536 + (wid * 64 + lane); float* sc = sc0;
#pragma unroll
            for (int a = 0; a < 2; ++a)
#pragma unroll
                for (int b = 0; b < 2; ++b)
#pragma unroll
                    for (int m = 0; m < 4; ++m)
#pragma unroll
                        for (int n = 0; n < 2; ++n) {
#pragma unroll
                            for (int j = 0; j < 4; ++j) unsafeAtomicAdd(sc + j * 512, acc[a][b][m][n][j]);
                            sc += 2048; asm volatile("" : "+v"(sc)); }
            asm volatile("s_waitcnt vmcnt(0)" ::: "memory");
            __builtin_amdgcn_fence(__ATOMIC_RELEASE, "agent");
            unsigned old = 0u; if (lane == 0) old = __hip_atomic_fetch_add(g.sp_cnt + cur.pn * 8 + wid, 1u, __ATOMIC_RELAXED, __HIP_MEMORY_SCOPE_AGENT);
            old = (unsigned)__builtin_amdgcn_readfirstlane((int)old);
            do_epi = (old == (unsigned)cur.nks - 1u);
            if (do_epi) {
                __builtin_amdgcn_fence(__ATOMIC_ACQUIRE, "agent");
                sc = sc0;
#pragma unroll
                for (int a = 0; a < 2; ++a)
#pragma unroll
                    for (int b = 0; b < 2; ++b)
#pragma unroll
                        for (int m = 0; m < 4; ++m)
#pragma unroll
                            for (int n = 0; n < 2; ++n) {
#pragma unroll
                                for (int j = 0; j < 4; ++j) acc[a][b][m][n][j] = __hip_atomic_load(sc + j * 512, __ATOMIC_RELAXED, __HIP_MEMORY_SCOPE_AGENT);
                                sc += 2048; asm volatile("" : "+v"(sc)); } }
        }
        if (do_epi) E(acc, cur, wr, wc, fr, fq);
        if (!has_next) break;
#pragma unroll
        for (int a = 0; a < 2; ++a)
#pragma unroll
            for (int b = 0; b < 2; ++b)
#pragma unroll
                for (int m = 0; m < 4; ++m)
#pragma unroll
                    for (int n = 0; n < 2; ++n) acc[a][b][m][n] = (f32x4){0.f, 0.f, 0.f, 0.f};
        cur = nxt; cA = nA; cB = nB; ++ui;
    }
    PG8_WAIT_V(0);
    if (wr == 0) PG8_BAR;
    PG8_BAR;
#undef PG8_SA
#undef PG8_SB
#undef PG8_STAGE
#undef PG8_LDA
#undef PG8_LDB
#undef PG8_MMA
#undef PG8_WAIT_V
#undef PG8_WAIT_L
#undef PG8_BAR
#undef PG8_SCHED
}

typedef const f32x4 (&AccRef)[2][2][4][2];

struct EpiInA {
    static constexpr bool PERM = true;
    const float* ssq; bf16_t* tt; bf16_t* sg;
    __device__ __forceinline__ void operator()(AccRef acc, const Unit& un, int wr, int wc, int fr, int fq) const {
        const int row0 = un.pm * BM + wr * 64 + fr, colt = un.pn * BM + wc * 32 + 8 * fq;
        const bool is_t = un.pn < 16;
        float rrs[2][4];
#pragma unroll
        for (int ai = 0; ai < 2; ++ai)
#pragma unroll
            for (int m = 0; m < 4; ++m) rrs[ai][m] = ssq[row0 + ai * HALF + m * 16];
#pragma unroll
        for (int ai = 0; ai < 2; ++ai)
#pragma unroll
            for (int m = 0; m < 4; ++m) { const int row = row0 + ai * HALF + m * 16; const float rr = rsqrtf(rrs[ai][m] * (1.0f / DM) + EPS);
#pragma unroll
                for (int bj = 0; bj < 2; ++bj) { f32x4 v0 = acc[ai][bj][m][0] * rr, v1 = acc[ai][bj][m][1] * rr; const int col = colt + bj * HALF;
                    if (is_t) *(bf16x8*)(tt + (size_t)row * EA + col) = pack8(v0, v1);
                    else {
#pragma unroll
                        for (int j = 0; j < 4; ++j) { v0[j] = silu_f(v0[j]); v1[j] = silu_f(v1[j]); }
                        *(bf16x8*)(sg + (size_t)row * EA + (col - EA)) = pack8(v0, v1); } } }
    }
};
struct EpiUState {
    static constexpr bool PERM = true;
    const float* ssq; float* pool_p; float* pool_s;
    __device__ __forceinline__ void operator()(AccRef acc, const Unit& un, int wr, int wc, int fr, int fq) const {
        const int row0 = un.pm * BM + wr * 64 + fr, colt = un.pn * BM + wc * 32 + 8 * fq;
#pragma unroll
        for (int ai = 0; ai < 2; ++ai)
#pragma unroll
            for (int m = 0; m < 4; ++m) { const int row = row0 + ai * HALF + m * 16;
                float* pp = nullptr;
                if (row < MP) { const int t = row & (SEQ - 1); if (t >= SEQ - PPAD) pp = pool_p + ((size_t)(row >> 12) * PPAD + (t - (SEQ - PPAD))) * EA; }
                else { const int rs = row - MP, t = rs & 15; if (t >= 1) pp = pool_s + ((size_t)(rs >> 4) * PPAD + (t - 1)) * EA; }
                if (pp) { const float rr = rsqrtf(ssq[row] * (1.0f / DM) + EPS);
#pragma unroll
                    for (int bj = 0; bj < 2; ++bj) { *(f32x4*)(pp + colt + bj * HALF) = acc[ai][bj][m][0] * rr; *(f32x4*)(pp + colt + bj * HALF + 4) = acc[ai][bj][m][1] * rr; } } }
    }
};
struct EpiStore {
    static constexpr bool PERM = true;
    bf16_t* O; int ldc, wmode;
    __device__ __forceinline__ void operator()(AccRef acc, const Unit& un, int wr, int wc, int fr, int fq) const {
        const int rbase = wmode ? (un.pm >> 4) * 2 * EA + (un.pm & 15) * BM : un.pm * BM;
        const int row0 = rbase + wr * 64 + fr, colt = un.pn * BM + wc * 32 + 8 * fq;
#pragma unroll
        for (int ai = 0; ai < 2; ++ai)
#pragma unroll
            for (int m = 0; m < 4; ++m)
#pragma unroll
                for (int bj = 0; bj < 2; ++bj) *(bf16x8*)(O + (size_t)(row0 + ai * HALF + m * 16) * ldc + colt + bj * HALF) = pack8(acc[ai][bj][m][0], acc[ai][bj][m][1]);
    }
};
struct EpiRes {
    static constexpr bool PERM = false;
    const float* base_p; const float* base_s; float* xres; bf16_t* xb; float* ssq_next;
    __device__ __forceinline__ void operator()(AccRef acc, const Unit& un, int wr, int wc, int fr, int fq) const {
        const int row0 = un.pm * BM + wr * 64 + fr, col0 = un.pn * BM + wc * 32 + 4 * fq;
#pragma unroll
        for (int ai = 0; ai < 2; ++ai) {
            f32x4 bx_[4][2][2];
#pragma unroll
            for (int m = 0; m < 4; ++m) { const int row = row0 + ai * HALF + m * 16;
                const float* bp = (row < MP ? base_p + (size_t)row * DM : base_s + (size_t)(row - MP) * DM) + col0;
#pragma unroll
                for (int bj = 0; bj < 2; ++bj)
#pragma unroll
                    for (int n = 0; n < 2; ++n) bx_[m][bj][n] = *(const f32x4*)(bp + bj * HALF + n * 16); }
#pragma unroll
            for (int m = 0; m < 4; ++m) { const int row = row0 + ai * HALF + m * 16;
                float* xo = xres + (size_t)row * DM + col0; bf16_t* bo = xb + (size_t)row * DM + col0; float s = 0.f;
#pragma unroll
                for (int bj = 0; bj < 2; ++bj)
#pragma unroll
                    for (int n = 0; n < 2; ++n) { const f32x4 x = bx_[m][bj][n] + acc[ai][bj][m][n];
                        *(f32x4*)(xo + bj * HALF + n * 16) = x; u32x2 w; w.x = cvtpk(x[0], x[1]); w.y = cvtpk(x[2], x[3]); *(u32x2*)(bo + bj * HALF + n * 16) = w;
                        s += (x[0] * x[0] + x[1] * x[1]) + (x[2] * x[2] + x[3] * x[3]); }
                s = xsum16(s); s = xsum32(s);
                if (fq == 0) unsafeAtomicAdd(ssq_next + row, s); } }
    }
};
struct EpiKVQ {
    static constexpr bool PERM = true;
    int pn_off; const float* ssq; float* out; unsigned char* ws; const float* b_f;
    __device__ __forceinline__ void operator()(AccRef acc, const Unit& un, int wr, int wc, int fr, int fq) const {
        const int tt = un.pn + pn_off;
        const int row0 = un.pm * BM + wr * 64 + fr, cw = wc * 32 + 8 * fq;
        float rrs[2][4];
#pragma unroll
        for (int ai = 0; ai < 2; ++ai)
#pragma unroll
            for (int m = 0; m < 4; ++m) rrs[ai][m] = ssq[row0 + ai * HALF + m * 16];
        if (tt == 16) {
            if (wc == 0 && fq < 2) {
            const f32x4 bf0 = *(const f32x4*)(b_f + 8 * fq), bf1 = *(const f32x4*)(b_f + 8 * fq + 4);
            float* lft_p = (float*)(ws + WS_LFTP); float* lft_s = (float*)(ws + WS_LFTS);
#pragma unroll
            for (int ai = 0; ai < 2; ++ai)
#pragma unroll
                for (int m = 0; m < 4; ++m) { const int row = row0 + ai * HALF + m * 16; const float rr = rsqrtf(rrs[ai][m] * (1.0f / DM) + EPS);
                    f32x4 v0 = acc[ai][0][m][0] * rr + bf0, v1 = acc[ai][0][m][1] * rr + bf1;
#pragma unroll
                    for (int j = 0; j < 4; ++j) { v0[j] = logsig(v0[j]); v1[j] = logsig(v1[j]); }
                    if (row < MP) { float* o = out + O_LFP + (size_t)row * NH + 8 * fq; *(f32x4*)o = v0; *(f32x4*)(o + 4) = v1;
                        float* tp = lft_p + ((size_t)(row >> 12) * NH + 8 * fq) * SEQ + (row & (SEQ - 1));
#pragma unroll
                        for (int j = 0; j < 4; ++j) { tp[(size_t)j * SEQ] = v0[j]; tp[(size_t)(j + 4) * SEQ] = v1[j]; } }
                    else { const int rs = row - MP; float* o = out + O_LFS + (size_t)rs * NH + 8 * fq; *(f32x4*)o = v0; *(f32x4*)(o + 4) = v1;
                        float* tp = lft_s + ((size_t)(rs >> 4) * NH + 8 * fq) * DSEQ + (rs & 15);
#pragma unroll
                        for (int j = 0; j < 4; ++j) { tp[j * DSEQ] = v0[j]; tp[(j + 4) * DSEQ] = v1[j]; } } }
            }
        } else {
        const int kind = tt < 8 ? 0 : (tt < 16 ? 1 : (tt < 25 ? 2 : 3));
        const int colt = (tt - (kind == 0 ? 0 : kind == 1 ? 8 : kind == 2 ? 17 : 25)) * BM + cw;
        float* fo_p = out + (kind == 0 ? O_KP : O_VP); float* fo_s = out + (kind == 0 ? O_KS : O_VS);
        bf16_t* bo = (bf16_t*)(ws + (kind == 0 ? WS_KB : (kind == 1 ? WS_VB : (kind == 2 ? WS_QB : WS_SGB))));
#pragma unroll
        for (int ai = 0; ai < 2; ++ai)
#pragma unroll
            for (int m = 0; m < 4; ++m) { const int row = row0 + ai * HALF + m * 16; float rr = rsqrtf(rrs[ai][m] * (1.0f / DM) + EPS);
                if (kind == 2) rr *= QSCALE;
                float* fo = (row < MP ? fo_p + (size_t)row * DM : fo_s + (size_t)(row - MP) * DM) + colt;
#pragma unroll
                for (int bj = 0; bj < 2; ++bj) { f32x4 v0 = acc[ai][bj][m][0] * rr, v1 = acc[ai][bj][m][1] * rr;
                    if (kind < 2) { *(f32x4*)(fo + bj * HALF) = v0; *(f32x4*)(fo + bj * HALF + 4) = v1; }
                    if (kind == 3) {
#pragma unroll
                        for (int j = 0; j < 4; ++j) { v0[j] = silu_f(v0[j]); v1[j] = silu_f(v1[j]); } }
                    *(bf16x8*)(bo + (size_t)row * DM + colt + bj * HALF) = pack8(v0, v1);
                    if (kind == 0 || kind == 2) {
                        float ss = (v0[0] * v0[0] + v0[1] * v0[1]) + (v0[2] * v0[2] + v0[3] * v0[3]) + (v1[0] * v1[0] + v1[1] * v1[1]) + (v1[2] * v1[2] + v1[3] * v1[3]);
                        ss = xsum16(ss); ss = xsum32(ss);
                        float* nt = (float*)(ws + (kind == 0 ? WS_KNRM : WS_QNRM));
                        if (fq == 0) nt[((size_t)row * NH + 2 * (colt >> 8) + bj) * 4 + wc] = ss; } } }
        }
    }
};
}

namespace att {
constexpr int NW = 8, QBLK = 32, KVBLK = 64, QB = NW * QBLK, D = 128, LD = 2048;
constexpr int SHM_V = KVBLK * D * 2, SHM_K = KVBLK * D * 2;
constexpr int OFF_WS = 2 * SHM_V + 2 * SHM_K, OFF_F = OFF_WS + NW * 64 * 4, OFF_SC = OFF_F + SEQ * 4, OFF_KT = OFF_SC + 64, OFF_QM = OFF_KT + 256, OFF_JL = OFF_QM + 128;
constexpr float SKIP_T = 32.f;
constexpr float THR2 = 11.5f;
#define KSWZ(row, colB) ((row) * 256 + ((colB) ^ (((row) & 7) << 4)))
#define SBAR() __builtin_amdgcn_sched_barrier(0)
__device__ __forceinline__ int v_st(int k, int c) { const int kk = (k & ~0xC) | ((k & 4) << 1) | ((k & 8) >> 1); return ((kk >> 3) * 4 + (c >> 5)) * 512 + ((kk & 7) * 32 + (c & 31)) * 2; }
__device__ __forceinline__ int v_rd_base(int lane) { return ((lane & 3) << 3) | (((lane >> 2) & 3) << 6) | (((lane >> 4) & 1) << 5) | (((lane >> 5) & 1) << 8); }
constexpr int v_rd_off(int d0, int ks, int half) { return d0 * 512 + ks * 4096 + half * 2048; }
__device__ __forceinline__ int crow(int r, int hi) { return (r & 3) + 8 * (r >> 2) + 4 * hi; }
__device__ __forceinline__ void mask_tile(f32x16& p0, f32x16& p1, int dq) {
    const float NEG = -__builtin_inff();
#pragma unroll
    for (int r = 0; r < 16; ++r) { const int c = (r & 3) + 8 * (r >> 2);
        if (dq - c < 0) p0[r] = NEG;
        if (dq - c - 32 < 0) p1[r] = NEG; }
}
__device__ __forceinline__ void partialSM(f32x16& p0, f32x16& p1, float& m_reg, float& mn, float& alpha) {
    float pmax = p0[0];
#pragma unroll
    for (int r = 1; r < 16; ++r) pmax = fmaxf(pmax, p0[r]);
#pragma unroll
    for (int r = 0; r < 16; ++r) pmax = fmaxf(pmax, p1[r]);
    { auto rr = __builtin_amdgcn_permlane32_swap(__float_as_uint(pmax), __float_as_uint(pmax), false, false);
      pmax = fmaxf(__uint_as_float(rr[0]), __uint_as_float(rr[1])); }
    if (__builtin_expect(__all((pmax - m_reg) <= THR2), 1)) { mn = m_reg; alpha = 1.f; }
    else { mn = fmaxf(m_reg, pmax); alpha = __builtin_amdgcn_exp2f(m_reg - mn); m_reg = mn; }
#pragma unroll
    for (int r = 0; r < 16; ++r) p0[r] = p0[r] - mn;
#pragma unroll
    for (int r = 0; r < 16; ++r) p1[r] = p1[r] - mn;
#pragma unroll
    for (int r = 0; r < 16; ++r) p0[r] = __builtin_amdgcn_exp2f(p0[r]);
}
__device__ __forceinline__ void finishSM(f32x16& p0, f32x16& p1, float alpha, float& l_reg, bf16x8& pa0, bf16x8& pa1, bf16x8& pa2, bf16x8& pa3) {
#pragma unroll
    for (int r = 0; r < 16; ++r) p1[r] = __builtin_amdgcn_exp2f(p1[r]);
    float ps = 0;
#pragma unroll
    for (int r = 0; r < 16; ++r) ps += p0[r];
#pragma unroll
    for (int r = 0; r < 16; ++r) ps += p1[r];
    { auto rr = __builtin_amdgcn_permlane32_swap(__float_as_uint(ps), __float_as_uint(ps), false, false);
      ps = __uint_as_float(rr[0]) + __uint_as_float(rr[1]); }
    l_reg = l_reg * alpha + ps;
#define PK4(P, B_, OUT) do { unsigned a0 = cvtpk(P[B_+0], P[B_+1]), a1 = cvtpk(P[B_+2], P[B_+3]);                          \
        unsigned b0 = cvtpk(P[B_+4], P[B_+5]), b1 = cvtpk(P[B_+6], P[B_+7]);                                             \
        auto r0 = __builtin_amdgcn_permlane32_swap(a0, b0, false, false); auto r1 = __builtin_amdgcn_permlane32_swap(a1, b1, false, false); \
        u32x4 w = {r0[0], r1[0], r0[1], r1[1]}; OUT = *reinterpret_cast<bf16x8*>(&w); } while (0)
    PK4(p0, 0, pa0); PK4(p0, 8, pa1); PK4(p1, 0, pa2); PK4(p1, 8, pa3);
#undef PK4
}
template <int KB>
__device__ __forceinline__ void qkt(f32x16& p0, f32x16& p1, const char* K_lds, const float* fl, int r32, int hi, const bf16x8* qr) {
    { const f32x4 a0 = *(const f32x4*)(fl), a1 = *(const f32x4*)(fl + 8), a2 = *(const f32x4*)(fl + 16), a3 = *(const f32x4*)(fl + 24);
      const f32x4 b0 = *(const f32x4*)(fl + 32), b1 = *(const f32x4*)(fl + 40), b2 = *(const f32x4*)(fl + 48), b3 = *(const f32x4*)(fl + 56);
      p0 = (f32x16){a0[0], a0[1], a0[2], a0[3], a1[0], a1[1], a1[2], a1[3], a2[0], a2[1], a2[2], a2[3], a3[0], a3[1], a3[2], a3[3]};
      p1 = (f32x16){b0[0], b0[1], b0[2], b0[3], b1[0], b1[1], b1[2], b1[3], b2[0], b2[1], b2[2], b2[3], b3[0], b3[1], b3[2], b3[3]}; }
    const char* kb[4];
#pragma unroll
    for (int dd = 0; dd < 4; ++dd) kb[dd] = K_lds + KB * SHM_K + KSWZ(r32, (dd * 16 + hi * 8) * 2);
#pragma unroll
    for (int d0 = 0; d0 < 8; ++d0) { const char* a = kb[d0 & 3] + (d0 >> 2) * 128;
        bf16x8 b0 = *reinterpret_cast<const bf16x8*>(a);
        bf16x8 b1 = *reinterpret_cast<const bf16x8*>(a + 32 * 256);
        p0 = __builtin_amdgcn_mfma_f32_32x32x16_bf16(b0, qr[d0], p0, 0, 0, 0);
        p1 = __builtin_amdgcn_mfma_f32_32x32x16_bf16(b1, qr[d0], p1, 0, 0, 0); }
}
template <int VB>
__device__ __forceinline__ void pv_tile(f32x16* o, int vb0, bf16x8 pa0, bf16x8 pa1, bf16x8 pa2, bf16x8 pa3) {
#define TRRD(dst, off) asm volatile("ds_read_b64_tr_b16 %0, %1 offset:%2" : "=&v"(dst) : "v"(vb0), "i"(off) : "memory")
#define PV_D0(d0) do { s16x4 l0, l1, l2, l3, h0, h1, h2, h3; constexpr int b_ = VB * SHM_V + v_rd_off(d0, 0, 0);   \
        TRRD(l0, b_); TRRD(h0, b_ + 2048); TRRD(l1, b_ + 4096); TRRD(h1, b_ + 6144); TRRD(l2, b_ + 8192); TRRD(h2, b_ + 10240); TRRD(l3, b_ + 12288); TRRD(h3, b_ + 14336); \
        asm volatile("s_waitcnt lgkmcnt(0)" ::: "memory"); SBAR();   \
        o[d0] = __builtin_amdgcn_mfma_f32_32x32x16_bf16(pa0, (bf16x8){l0[0], l0[1], l0[2], l0[3], h0[0], h0[1], h0[2], h0[3]}, o[d0], 0, 0, 0);   \
        o[d0] = __builtin_amdgcn_mfma_f32_32x32x16_bf16(pa1, (bf16x8){l1[0], l1[1], l1[2], l1[3], h1[0], h1[1], h1[2], h1[3]}, o[d0], 0, 0, 0);   \
        o[d0] = __builtin_amdgcn_mfma_f32_32x32x16_bf16(pa2, (bf16x8){l2[0], l2[1], l2[2], l2[3], h2[0], h2[1], h2[2], h2[3]}, o[d0], 0, 0, 0);   \
        o[d0] = __builtin_amdgcn_mfma_f32_32x32x16_bf16(pa3, (bf16x8){l3[0], l3[1], l3[2], l3[3], h3[0], h3[1], h3[2], h3[3]}, o[d0], 0, 0, 0); } while (0)
    PV_D0(0); PV_D0(1); PV_D0(2); PV_D0(3);
#undef PV_D0
#undef TRRD
}
struct Tensors { const bf16_t* q; const bf16_t* k; const bf16_t* v; bf16_t* og; const bf16_t* sg; const float* lft; };
struct BlockRef { unsigned q0, s0; int P0, jlo; };
struct Seam { bf16x8 qr[8]; bf16x8 st_v0, st_v1, st_k0, st_k1; };
#define ROWP(p, k0) ((p) + (unsigned)(k0) * (unsigned)LD)
#define VMW() asm volatile("s_waitcnt vmcnt(0)" ::: "memory")
#define VMWN(n) asm volatile("s_waitcnt vmcnt(%0)" :: "i"(n) : "memory")
#define LD8(p) (*reinterpret_cast<const bf16x8*>(p))
#define SLOAD_H(Kp, Vp, k0) do { S.st_v0 = LD8(ROWP(Vp, k0) + voff); S.st_v1 = LD8(ROWP(Vp, (k0) + 32) + voff);              \
                         S.st_k0 = LD8(ROWP(Kp, k0) + voff); S.st_k1 = LD8(ROWP(Kp, (k0) + 32) + voff); } while (0)
#define SWRITE_HK(bf) do { *(bf16x8*)(K_lds + (bf) * SHM_K + kws) = S.st_k0; *(bf16x8*)(K_lds + (bf) * SHM_K + kws + 32 * 256) = S.st_k1; } while (0)
#define SWRITE_HV(bf) do { *(bf16x8*)(V_lds + (bf) * SHM_V + vst0) = S.st_v0; *(bf16x8*)(V_lds + (bf) * SHM_V + vst0 + VST1) = S.st_v1; } while (0)
#define SWRITE_H(bf) do { SWRITE_HV(bf); SWRITE_HK(bf); } while (0)
__device__ __forceinline__ void prime(int wv, const Tensors& T, const BlockRef& cur, char* lds, Seam& S) {
    const int tid = otid(wv), wid = __builtin_amdgcn_readfirstlane(tid >> 6), lane = tid & 63, r32 = lane & 31, hi = lane >> 5;
    const int sr = tid >> 4, sc = (tid & 15) * 8, kws = KSWZ(sr, sc * 2); char* K_lds = lds + 2 * SHM_V;
    const unsigned voff = (unsigned)sr * LD + sc, qoff = (unsigned)(wid * QBLK + r32) * LD + hi * 8;
    const bf16_t* Qp = T.q + cur.q0; const bf16_t* Kh = T.k + cur.s0; const bf16_t* Vh = T.v + cur.s0;
#pragma unroll
    for (int d0 = 0; d0 < 8; ++d0) S.qr[d0] = LD8(Qp + qoff + d0 * 16);
    SLOAD_H(Kh, Vh, cur.jlo * KVBLK); VMW(); SWRITE_HK(0);
    __syncthreads();
}
__device__ __forceinline__ void block(int wv, const Tensors& T, const BlockRef& cur, const BlockRef& nxt, char* lds, Seam& S) {
    const int tid = otid(wv), wid = __builtin_amdgcn_readfirstlane(tid >> 6), lane = tid & 63, r32 = lane & 31, hi = lane >> 5;
    const int j_lo = cur.jlo, NT = (cur.P0 + QB) / KVBLK - j_lo;
    const int qlo = cur.P0 - j_lo * KVBLK + wid * QBLK, qm = qlo + r32 - 4 * hi;
    char* V_lds = lds; char* K_lds = lds + 2 * SHM_V;
    float* wsl = (float*)(lds + OFF_WS) + wid * 64; float* li_l = wsl, * al_l = wsl + 32;
    float* Fl = (float*)(lds + OFF_F);
    float m_reg = -1e30f, l_reg = 0; f32x16 o[4] = {};
    const int sr = tid >> 4, sc = (tid & 15) * 8, vst0 = v_st(sr, sc), kws = KSWZ(sr, sc * 2); constexpr int VST1 = 8192;
    const int vb0 = (int)(uintptr_t)V_lds + v_rd_base(lane);
    const bf16_t* Kh = T.k + cur.s0 + (unsigned)(j_lo * KVBLK) * LD; const bf16_t* Vh = T.v + cur.s0 + (unsigned)(j_lo * KVBLK) * LD;
    const unsigned voff = (unsigned)sr * LD + sc, qoff = (unsigned)(wid * QBLK + r32) * LD + hi * 8;
    const float* flb = Fl + j_lo * KVBLK + 4 * hi;
#define RESC(a) do { if (__any((a) < 1.f)) { if (hi == 0) al_l[r32] = (a); asm volatile("s_waitcnt lgkmcnt(0)" ::: "memory");              \
                     for (int d_ = 0; d_ < 4; ++d_) for (int r = 0; r < 16; ++r) o[d_][r] *= al_l[crow(r, hi)]; } } while (0)
#define KBASE(t) ((t) * KVBLK)
#define MASKT(P0_, P1_, t) do { const int kb_ = KBASE(t); if (kb_ + KVBLK - 1 > qlo) mask_tile(P0_, P1_, qm - kb_); } while (0)
#define SEAM_K0() do { VMWN(8); SWRITE_HK(0); SBAR(); } while (0)
    f32x16 pA0, pA1, pB0, pB1; float mnA, mnB, alA, alB; bf16x8 pa0, pa1, pa2, pa3;
    SWRITE_HV(0); SBAR();
    if (NT > 1) { SLOAD_H(Kh, Vh, KBASE(1)); }
    SBAR(); qkt<0>(pA0, pA1, K_lds, flb + KBASE(0), r32, hi, S.qr);
    MASKT(pA0, pA1, 0); partialSM(pA0, pA1, m_reg, mnA, alA);
    if (NT > 1) { VMW(); SWRITE_H(1); }
    __syncthreads();
#define HALF_STEP(PX0, PX1, mnX, alX, PY0, PY1, alY, t, KB, VB, SB) do {                                                      \
        SBAR(); qkt<KB>(PX0, PX1, K_lds, flb + KBASE(t), r32, hi, S.qr);                                             \
        finishSM(PY0, PY1, alY, l_reg, pa0, pa1, pa2, pa3); SBAR();                                                           \
        if ((t) + 1 < NT) { SLOAD_H(Kh, Vh, KBASE((t) + 1)); SBAR(); }                                               \
        pv_tile<VB>(o, vb0, pa0, pa1, pa2, pa3); MASKT(PX0, PX1, (t)); partialSM(PX0, PX1, m_reg, mnX, alX);                                        \
        __syncthreads();                                                                                                      \
        if ((t) + 1 < NT) { VMW(); SWRITE_H(SB); }                                                                          \
        RESC(alX); __syncthreads(); } while (0)
    for (int t = 1; t + 1 < NT; t += 2) {
        HALF_STEP(pB0, pB1, mnB, alB, pA0, pA1, alA, t, 1, 0, 0);
        HALF_STEP(pA0, pA1, mnA, alA, pB0, pB1, alB, t + 1, 0, 1, 1);
    }
    const bool even = (NT & 1) == 0;
    if (even) { SBAR(); qkt<1>(pB0, pB1, K_lds, flb + KBASE(NT - 1), r32, hi, S.qr); SBAR(); }
    { const bf16_t* Kn = T.k + nxt.s0; const bf16_t* Vn = T.v + nxt.s0; SLOAD_H(Kn, Vn, nxt.jlo * KVBLK); } SBAR();
    { const bf16_t* Qn = T.q + nxt.q0;
#pragma unroll
      for (int d0 = 0; d0 < 8; ++d0) S.qr[d0] = LD8(Qn + qoff + d0 * 16); }
    SBAR();
    finishSM(pA0, pA1, alA, l_reg, pa0, pa1, pa2, pa3); SBAR();
    pv_tile<0>(o, vb0, pa0, pa1, pa2, pa3);
    if (even) { MASKT(pB0, pB1, NT - 1); partialSM(pB0, pB1, m_reg, mnB, alB); __syncthreads(); RESC(alB);
        finishSM(pB0, pB1, alB, l_reg, pa0, pa1, pa2, pa3); SBAR(); pv_tile<1>(o, vb0, pa0, pa1, pa2, pa3); }
    SBAR(); SEAM_K0();
    if (hi == 0) li_l[r32] = l_reg; asm volatile("s_waitcnt lgkmcnt(0)" ::: "memory");
    float rli[16];
#pragma unroll
    for (int r = 0; r < 16; ++r) rli[r] = __builtin_amdgcn_rcpf(li_l[crow(r, hi)]);
    { const unsigned eoff = (unsigned)(4 * hi) * LD + r32;
      unsigned gg[16][4];
#pragma unroll
      for (int r = 0; r < 16; ++r) { const bf16_t* Grow = T.sg + cur.q0 + (unsigned)(wid * QBLK + (r & 3) + 8 * (r >> 2)) * LD;
#pragma unroll
        for (int d0 = 0; d0 < 4; ++d0) gg[r][d0] = *(const unsigned*)(Grow + (eoff & ~1u) + d0 * 32); }
#pragma unroll
      for (int r = 0; r < 16; ++r) { bf16_t* Orow = T.og + cur.q0 + (unsigned)(wid * QBLK + (r & 3) + 8 * (r >> 2)) * LD;
#pragma unroll
        for (int d0 = 0; d0 < 4; ++d0) { const float v = o[d0][r] * rli[r];
            const float vn = __shfl_xor(v, 1);
            if ((r32 & 1) == 0) *(unsigned*)(Orow + eoff + d0 * 32) = cvtpk(v * bflo(gg[r][d0]), vn * bfhi(gg[r][d0])); } } }
    __syncthreads();
#undef RESC
#undef KBASE
#undef MASKT
#undef SEAM_K0
#undef HALF_STEP
}
#undef ROWP
#undef VMW
#undef VMWN
#undef SLOAD_H
#undef SWRITE_HK
#undef SWRITE_HV
#undef SWRITE_H
#undef LD8

__device__ __forceinline__ BlockRef mkref(int bh, int qb) {
    const int b = bh >> 4, h = bh & 15; BlockRef r; r.s0 = (unsigned)b * SEQ * LD + h * D; r.q0 = r.s0 + (unsigned)qb * QB * LD; r.jlo = 0; r.P0 = qb * QB; return r;
}
__device__ __forceinline__ void item_setup(int wv, const Tensors& T, const float* knrm, const float* qnrm, int bh, unsigned blks, int nb, char* lds) {
    const int tid = otid(wv), wid = __builtin_amdgcn_readfirstlane(tid >> 6), lane = tid & 63;
    float* Fl = (float*)(lds + OFF_F); float* scn = (float*)(lds + OFF_SC); float* Kt = (float*)(lds + OFF_KT); float* Qm = (float*)(lds + OFF_QM); int* JL = (int*)(lds + OFF_JL);
    const int b = bh >> 4, h = bh & 15, xmax = (int)((blks >> (4 * (nb - 1))) & 15u), nkeys = (xmax + 1) * QB, t0 = tid * 8;
    const float* LF = T.lft + (size_t)bh * SEQ;
    f32x4 a = {0.f, 0.f, 0.f, 0.f}, c = {0.f, 0.f, 0.f, 0.f};
    float kmx = 0.f;
    if (t0 < nkeys) { a = *(const f32x4*)(LF + t0); c = *(const f32x4*)(LF + t0 + 4);
        const float* kn = knrm + ((size_t)(b * SEQ + t0) * NH + h) * 4;
#pragma unroll
        for (int i = 0; i < 8; ++i) { const f32x4 p = *(const f32x4*)(kn + (size_t)i * NH * 4); kmx = fmaxf(kmx, (p[0] + p[1]) + (p[2] + p[3])); } }
    kmx = fmaxf(kmx, bperm(kmx, lane ^ 1)); kmx = fmaxf(kmx, bperm(kmx, lane ^ 2)); kmx = fmaxf(kmx, bperm(kmx, lane ^ 4));
    if ((tid & 7) == 0 && t0 < nkeys) Kt[tid >> 3] = sqrtf(kmx) * 1.01f;
#pragma unroll 1
    for (int bi = 0; bi < nb; bi += 2) { const int bsel = bi + (tid >> 8);
        if (bsel < nb) { const int x = (int)((blks >> (4 * bsel)) & 15u), qrow = b * SEQ + x * QB + (tid & 255);
            const f32x4 p = *(const f32x4*)(qnrm + ((size_t)qrow * NH + h) * 4); float qm = (p[0] + p[1]) + (p[2] + p[3]);
#pragma unroll
            for (int o = 1; o < 64; o <<= 1) qm = fmaxf(qm, bperm(qm, lane ^ o));
            if (lane == 0) Qm[bsel * 4 + (wid & 3)] = qm; } }
    a[1] += a[0]; a[2] += a[1]; a[3] += a[2]; c[0] += a[3]; c[1] += c[0]; c[2] += c[1]; c[3] += c[2];
    const float tot = c[3]; float inc = tot;
#pragma unroll
    for (int o = 1; o < 64; o <<= 1) { const float v = bperm(inc, (lane - o) & 63); if (lane >= o) inc += v; }
    if (lane == 63) scn[wid] = inc;
    if (tid < nb) JL[tid] = (int)((blks >> (4 * tid)) & 15u) * 4;
    __syncthreads();
    float base = inc - tot;
    for (int w = 0; w < wid; ++w) base += scn[w];
    a = (a + base) * (-LOG2E); c = (c + base) * (-LOG2E);
    if (t0 < nkeys) { *(f32x4*)(Fl + t0) = a; *(f32x4*)(Fl + t0 + 4) = c; }
    __syncthreads();
    { const int which = tid >> 6, j = tid & 63;
      if (which < nb) { const int x = (int)((blks >> (4 * which)) & 15u), nd = x * 4;
        if (j < nd) { const float qmax = sqrtf(fmaxf(fmaxf(Qm[which * 4], Qm[which * 4 + 1]), fmaxf(Qm[which * 4 + 2], Qm[which * 4 + 3]))) * 1.01f;
            const float kdiag = fmaxf(fmaxf(Kt[nd], Kt[nd + 1]), fmaxf(Kt[nd + 2], Kt[nd + 3]));
            const bool skip = qmax * (Kt[j] + kdiag) + Fl[64 * j + 63] - Fl[x * QB] < -SKIP_T;
            if (!skip) atomicMin(JL + which, j); } } }
    __syncthreads();
}
__device__ __forceinline__ void prompt_phase(int wv, char* lds, const Tensors& T, const float* knrm, const float* qnrm, int pw) {
    const int bh = pw / 3, gsel = pw - bh * 3;
    const unsigned blks = gsel == 0 ? 0xDA742u : (gsel == 1 ? 0xEB8510u : 0xFC963u); const int nb = gsel == 1 ? 6 : 5;
    item_setup(wv, T, knrm, qnrm, bh, blks, nb, lds);
    const int* JL = (const int*)(lds + OFF_JL);
    Seam S;
    BlockRef cur = mkref(bh, (int)(blks & 15u)); cur.jlo = __builtin_amdgcn_readfirstlane(JL[0]);
    prime(wv, T, cur, lds, S);
#pragma unroll 1
    for (int i = 0; i < nb; ++i) { const int in = i + 1 < nb ? i + 1 : i;
        BlockRef nxt = mkref(bh, (int)((blks >> (4 * in)) & 15u)); nxt.jlo = __builtin_amdgcn_readfirstlane(JL[in]);
        block(wv, T, cur, nxt, lds, S);
        cur = nxt; }
}
}

namespace sat {
constexpr int OFF_F = 0, OFF_SC = 8448, OFF_P = 8704, OFF_A = OFF_P + 8 * 4096, OFF_ML = OFF_A + 512, OFF_O = OFF_ML + 1024;
struct Tensors { const bf16_t* q; const bf16_t* kb; const bf16_t* vb; bf16_t* og; const bf16_t* sg; const float* ck; const float* cv; const float* clf; const float* lfts; };
__device__ __forceinline__ void item(int wv, char* lds, const Tensors& T, int b, int h) {
    const int tid = otid(wv), wid = __builtin_amdgcn_readfirstlane(tid >> 6), lane = tid & 63, fr = lane & 15, fq = lane >> 4;
    float* Fl = (float*)(lds + OFF_F); float* scn = (float*)(lds + OFF_SC);
    float* ML = (float*)(lds + OFF_ML); float* Op = (float*)(lds + OFF_O);
    { const float* cl = T.clf + ((size_t)b * PAST + tid * 4) * NH + h;
      float a0 = cl[0], a1 = cl[NH], a2 = cl[2 * NH], a3 = cl[3 * NH];
      a1 += a0; a2 += a1; a3 += a2;
      const float tot = a3; float inc = tot;
#pragma unroll
      for (int o = 1; o < 64; o <<= 1) { const float v = bperm(inc, (lane - o) & 63); if (lane >= o) inc += v; }
      if (lane == 63) scn[wid] = inc;
      __syncthreads();
      float base = inc - tot, all = 0.f;
      for (int w = 0; w < 8; ++w) { const float sw = scn[w]; if (w < wid) base += sw; all += sw; }
      *(f32x4*)(Fl + tid * 4) = (f32x4){(a0 + base) * (-LOG2E), (a1 + base) * (-LOG2E), (a2 + base) * (-LOG2E), (a3 + base) * (-LOG2E)};
      if (tid < DSEQ) { const float* nl = T.lfts + ((size_t)b * NH + h) * DSEQ; float s = all; for (int i = 0; i <= tid; ++i) s += nl[i]; Fl[PAST + tid] = s * (-LOG2E); }
      __syncthreads(); }
    const size_t qrow = (size_t)(MP + b * DSEQ);
    bf16x8 qf[4];
#pragma unroll
    for (int dc = 0; dc < 4; ++dc) qf[dc] = *(const bf16x8*)(T.q + (qrow + fr) * DM + h * HD + dc * 32 + fq * 8);
    float m_run = -1e30f, l_run = 0.f;
    f32x4 ot[8];
#pragma unroll
    for (int dt = 0; dt < 8; ++dt) ot[dt] = (f32x4){0.f, 0.f, 0.f, 0.f};
    const unsigned vlo = (unsigned)(fq * 4) * (NH * HD) + fr;
    for (int ch = 0; ch < 4; ++ch) {
        const int key0 = (ch * 8 + wid) * 64;
        f32x4 s4[4];
        { f32x4 kk[4][4][2];
#pragma unroll
          for (int tl = 0; tl < 4; ++tl) { const float* kp = T.ck + (((size_t)b * PAST + key0 + tl * 16 + fr) * NH + h) * HD + fq * 8;
#pragma unroll
            for (int dc = 0; dc < 4; ++dc) { kk[tl][dc][0] = *(const f32x4*)(kp + dc * 32); kk[tl][dc][1] = *(const f32x4*)(kp + dc * 32 + 4); } }
          __builtin_amdgcn_sched_barrier(0);
#pragma unroll
          for (int tl = 0; tl < 4; ++tl) { f32x4 acc = *(const f32x4*)(Fl + key0 + tl * 16 + fq * 4);
#pragma unroll
            for (int dc = 0; dc < 4; ++dc) acc = __builtin_amdgcn_mfma_f32_16x16x32_bf16(pack8(kk[tl][dc][0], kk[tl][dc][1]), qf[dc], acc, 0, 0, 0);
            s4[tl] = acc; } }
        __builtin_amdgcn_sched_barrier(0);
        float vv[2][8][8];
        { const float* vb_c = T.cv + (((size_t)b * PAST + key0) * NH + h) * HD;
#pragma unroll
          for (int hf = 0; hf < 2; ++hf)
#pragma unroll
            for (int dt = 0; dt < 8; ++dt)
#pragma unroll
                for (int i = 0; i < 4; ++i) { vv[hf][dt][i] = (vb_c + (size_t)(hf * 32 + i) * (NH * HD) + dt * 16)[vlo]; vv[hf][dt][4 + i] = (vb_c + (size_t)(hf * 32 + 16 + i) * (NH * HD) + dt * 16)[vlo]; } }
        float cm = s4[0][0];
#pragma unroll
        for (int tl = 0; tl < 4; ++tl)
#pragma unroll
            for (int j = 0; j < 4; ++j) cm = fmaxf(cm, s4[tl][j]);
        cm = xmax16(cm); cm = xmax32(cm);
        const float mn = fmaxf(m_run, cm), alpha = __builtin_amdgcn_exp2f(m_run - mn); m_run = mn;
        float ps = 0.f;
#pragma unroll
        for (int tl = 0; tl < 4; ++tl)
#pragma unroll
            for (int j = 0; j < 4; ++j) { s4[tl][j] = __builtin_amdgcn_exp2f(s4[tl][j] - mn); ps += s4[tl][j]; }
        ps = xsum16(ps); ps = xsum32(ps);
        l_run = l_run * alpha + ps;
#pragma unroll
        for (int dt = 0; dt < 8; ++dt) ot[dt] *= alpha;
#pragma unroll
        for (int hf = 0; hf < 2; ++hf) {
            const bf16x8 pb = pack8(s4[2 * hf], s4[2 * hf + 1]);
#pragma unroll
            for (int dt = 0; dt < 8; ++dt) { const f32x4 v0 = {vv[hf][dt][0], vv[hf][dt][1], vv[hf][dt][2], vv[hf][dt][3]}, v1 = {vv[hf][dt][4], vv[hf][dt][5], vv[hf][dt][6], vv[hf][dt][7]};
                ot[dt] = __builtin_amdgcn_mfma_f32_16x16x32_bf16(pack8(v0, v1), pb, ot[dt], 0, 0, 0); } }
    }
    if (wid == 0) {
        f32x4 acc = *(const f32x4*)(Fl + PAST + fq * 4);
        const bf16_t* kp = T.kb + (qrow + fr) * DM + h * HD + fq * 8;
#pragma unroll
        for (int dc = 0; dc < 4; ++dc) acc = __builtin_amdgcn_mfma_f32_16x16x32_bf16(*(const bf16x8*)(kp + dc * 32), qf[dc], acc, 0, 0, 0);
#pragma unroll
        for (int j = 0; j < 4; ++j) if (fq * 4 + j > fr) acc[j] = -__builtin_inff();
        float cm = fmaxf(fmaxf(acc[0], acc[1]), fmaxf(acc[2], acc[3]));
        cm = xmax16(cm); cm = xmax32(cm);
        const float mn = fmaxf(m_run, cm), alpha = __builtin_amdgcn_exp2f(m_run - mn); m_run = mn;
        float ps = 0.f;
#pragma unroll
        for (int j = 0; j < 4; ++j) { acc[j] = __builtin_amdgcn_exp2f(acc[j] - mn); ps += acc[j]; }
        ps = xsum16(ps); ps = xsum32(ps);
        l_run = l_run * alpha + ps;
        const bf16x8 pb = pack8(acc, (f32x4){0.f, 0.f, 0.f, 0.f});
        const bf16_t* vb_u = T.vb + qrow * DM + h * HD; const unsigned vlo2 = (unsigned)(fq * 4) * DM + fr;
#pragma unroll
        for (int dt = 0; dt < 8; ++dt) { ot[dt] *= alpha;
            unsigned w0 = (unsigned)(vb_u + dt * 16)[vlo2] | ((unsigned)(vb_u + DM + dt * 16)[vlo2] << 16), w1 = (unsigned)(vb_u + 2 * DM + dt * 16)[vlo2] | ((unsigned)(vb_u + 3 * DM + dt * 16)[vlo2] << 16);
            u32x4 w = {w0, w1, 0u, 0u};
            ot[dt] = __builtin_amdgcn_mfma_f32_16x16x32_bf16(*reinterpret_cast<bf16x8*>(&w), pb, ot[dt], 0, 0, 0); }
    }
#pragma unroll
    for (int dt = 0; dt < 8; ++dt) *(f32x4*)(Op + (wid * 16 + fr) * HD + dt * 16 + fq * 4) = ot[dt];
    if (fq == 0) { ML[(wid * 16 + fr) * 2] = m_run; ML[(wid * 16 + fr) * 2 + 1] = l_run; }
    __syncthreads();
    { const int q = tid >> 5, d4 = (tid & 31) * 4;
      float mx = ML[q * 2];
#pragma unroll
      for (int w = 1; w < 8; ++w) mx = fmaxf(mx, ML[(w * 16 + q) * 2]);
      float L = 0.f; f32x4 O = {0.f, 0.f, 0.f, 0.f};
#pragma unroll
      for (int w = 0; w < 8; ++w) { const float s = __builtin_amdgcn_exp2f(ML[(w * 16 + q) * 2] - mx); L += s * ML[(w * 16 + q) * 2 + 1]; O += *(const f32x4*)(Op + (w * 16 + q) * HD + d4) * s; }
      const float il = 1.0f / L; const size_t off = (qrow + q) * DM + h * HD + d4;
      const u32x2 gw = *(const u32x2*)(T.sg + off);
      u32x2 w; w.x = cvtpk(O[0] * il * bflo(gw.x), O[1] * il * bfhi(gw.x)); w.y = cvtpk(O[2] * il * bflo(gw.y), O[3] * il * bfhi(gw.y));
      *(u32x2*)(T.og + off) = w; }
    __syncthreads();
}
}

struct TrV { f32x4 v[8]; };
__device__ __forceinline__ void tr_load(const float* W, int ldw, int N, const float* g, int item, int lane, TrV& t) {
    const int nblk = (N + 31) / 32, kb = item / nblk, nb = item % nblk, k0 = 64 * kb, n0 = 32 * nb;
    const int c4 = (lane & 7) * 4, kr = lane >> 3; const bool nok = n0 + c4 < N;
#pragma unroll
    for (int i = 0; i < 8; ++i) t.v[i] = nok ? *(const f32x4*)(W + (size_t)(k0 + 8 * i + kr) * ldw + n0 + c4) : (f32x4){0.f, 0.f, 0.f, 0.f};
    if (g) {
#pragma unroll
        for (int i = 0; i < 8; ++i) t.v[i] *= g[k0 + 8 * i + kr]; }
}
__device__ __forceinline__ void tr_emit(int N, bf16_t* WT, int K, float* scr, int item, int lane, const TrV& t) {
    const int nblk = (N + 31) / 32, kb = item / nblk, nb = item % nblk, k0 = 64 * kb, n0 = 32 * nb;
    const int c4 = (lane & 7) * 4, kr = lane >> 3;
#pragma unroll
    for (int i = 0; i < 8; ++i) { float* s = scr + (8 * i + kr) * 33 + c4; s[0] = t.v[i][0]; s[1] = t.v[i][1]; s[2] = t.v[i][2]; s[3] = t.v[i][3]; }
    asm volatile("s_waitcnt lgkmcnt(0)" ::: "memory");
    const int c = lane & 7;
#pragma unroll
    for (int j = 0; j < 4; ++j) { const int nn = (lane >> 3) + 8 * j; const float* s = scr + (8 * c) * 33 + nn;
        u32x4 o; o.x = cvtpk(s[0 * 33], s[1 * 33]); o.y = cvtpk(s[2 * 33], s[3 * 33]); o.z = cvtpk(s[4 * 33], s[5 * 33]); o.w = cvtpk(s[6 * 33], s[7 * 33]);
        if (n0 + nn < N) *(u32x4*)(WT + (size_t)(n0 + nn) * K + k0 + 8 * c) = o; }
    asm volatile("s_waitcnt lgkmcnt(0)" ::: "memory");
}
struct TJob { const float* W; bf16_t* WT; const float* g; int K, N, ldw; };
__device__ __forceinline__ TJob get_job(const Params& p, int j) {
    unsigned char* ws = p.ws; TJob t; t.g = nullptr; t.ldw = 0;
    if (j < 2) { t.W = p.in[7] + (size_t)j * DM * 2 * EA + EA; t.WT = (bf16_t*)(ws + WS_WINA) + (size_t)j * 2 * EA * DM + (size_t)EA * DM; t.g = p.in[6] + j * DM; t.K = DM; t.N = EA; t.ldw = 2 * EA; }
    else if (j >= 17) { const int l = j - 17; t.W = p.in[7] + (size_t)l * DM * 2 * EA; t.WT = (bf16_t*)(ws + WS_WINUT) + (size_t)l * EA * DM; t.g = p.in[6] + l * DM; t.K = DM; t.N = EA; t.ldw = 2 * EA; }
    else if (j < 10) { const int i = j - 2; t.W = p.in[8] + (size_t)i * 1024 * 1024; t.WT = (bf16_t*)(ws + WS_WGRP) + (size_t)i * 1024 * 1024; t.K = 1024; t.N = 1024; }
    else if (j < 12) { const int l = j - 10; t.W = p.in[10] + (size_t)l * EA * DM; t.WT = (bf16_t*)(ws + WS_WOUTA) + (size_t)l * DM * EA; t.K = EA; t.N = DM; }
    else if (j == 12) { t.W = p.in[12]; t.WT = (bf16_t*)(ws + WS_W4); t.g = p.in[11]; t.K = DM; t.N = 2 * DM + NH; }
    else if (j == 13) { t.W = p.in[15]; t.WT = (bf16_t*)(ws + WS_W4) + (size_t)4352 * DM; t.g = p.in[14]; t.K = DM; t.N = 2 * DM; }
    else if (j == 14) { t.W = p.in[15] + (size_t)DM * 2 * DM; t.WT = (bf16_t*)(ws + WS_WINB1); t.g = p.in[14] + DM; t.K = DM; t.N = 2 * DM; }
    else { const int l = j - 15; t.W = p.in[16] + (size_t)l * DM * DM; t.WT = (bf16_t*)(ws + WS_WOUTB) + (size_t)l * DM * DM; t.K = DM; t.N = DM; }
    if (t.ldw == 0) t.ldw = t.N;
    return t;
}
__device__ __forceinline__ void prologue_phase(int wv, const Params& p, char* lds) {
    const int tid = otid(wv), lane = tid & 63, wid = tid >> 6, G = gridDim.x;
    const int gw = blockIdx.x * NWAVES + wid, NGW = G * NWAVES;
    float* scr = (float*)(lds + wid * 8704);
    int rot = 0;
    for (int j = 0; j < 19; ++j) { const TJob t = get_job(p, j); const int nitems = (t.K / 64) * ((t.N + 31) / 32);
        int start = gw - rot; if (start < 0) start += NGW;
        TrV cur_v, nxt_v;
        if (start < nitems) tr_load(t.W, t.ldw, t.N, t.g, start, lane, cur_v);
        for (int it = start; it < nitems; it += NGW) { const bool more = it + NGW < nitems;
            if (more) tr_load(t.W, t.ldw, t.N, t.g, it + NGW, lane, nxt_v);
            tr_emit(t.N, t.WT, t.K, scr, it, lane, cur_v);
            if (more) {
#pragma unroll
                for (int i = 0; i < 8; ++i) cur_v.v[i] = nxt_v.v[i]; } }
        rot = (rot + nitems) % NGW; }
    float* ssq = (float*)(p.ws + WS_SSQ); bf16_t* xb = (bf16_t*)(p.ws + WS_XB);
    for (int m = gw; m < MT; m += NGW) { const float* xr = m < MP ? p.in[0] + (size_t)m * DM : p.in[1] + (size_t)(m - MP) * DM;
        float s = 0.f; unsigned long long* o8 = (unsigned long long*)(xb + (size_t)m * DM) + lane;
        f32x4 xv[8];
#pragma unroll
        for (int j = 0; j < 8; ++j) xv[j] = *((const f32x4*)xr + lane + 64 * j);
#pragma unroll
        for (int j = 0; j < 8; ++j) { const f32x4 v = xv[j]; s += (v[0] * v[0] + v[1] * v[1]) + (v[2] * v[2] + v[3] * v[3]);
            o8[64 * j] = (unsigned long long)cvtpk(v[0], v[1]) | ((unsigned long long)cvtpk(v[2], v[3]) << 32); }
        s = wave_sum(s); if (lane == 0) ssq[m] = s; }
    for (int i = blockIdx.x * NTHREADS + tid; i < 4 * MT; i += G * NTHREADS) ssq[MT + i] = 0.f;
    { f32x4* z = (f32x4*)(p.ws + WS_SPLIT); const size_t nz = (SPLIT_TILES * SPLIT_TILE + SPLIT_TILES * 8 * 4) / 16;
      for (size_t i = (size_t)blockIdx.x * NTHREADS + tid; i < nz; i += (size_t)G * NTHREADS) z[i] = (f32x4){0.f, 0.f, 0.f, 0.f}; }
    { bf16_t* wus = (bf16_t*)(p.ws + WS_WINUS);
      const int nth_ = G * NTHREADS;
      for (int i0 = blockIdx.x * NTHREADS + tid; i0 < 2 * DM * (EA / 8); i0 += 4 * nth_) {
          f32x4 av[4], bv[4]; float gk[4];
#pragma unroll
          for (int u = 0; u < 4; ++u) { const int i = i0 + u * nth_; if (i < 2 * DM * (EA / 8)) { const int r = i >> 9, c = (i & 511) * 8, l = r >> 11, k = r & (DM - 1);
              const float* s = p.in[7] + ((size_t)l * DM + k) * 2 * EA + c; av[u] = *(const f32x4*)s; bv[u] = *(const f32x4*)(s + 4); gk[u] = p.in[6][l * DM + k]; } }
#pragma unroll
          for (int u = 0; u < 4; ++u) { const int i = i0 + u * nth_; if (i < 2 * DM * (EA / 8)) { const int r = i >> 9, c = (i & 511) * 8;
              *(bf16x8*)(wus + (size_t)r * EA + c) = pack8(av[u] * gk[u], bv[u] * gk[u]); } } }
      bf16_t* pb = (bf16_t*)(p.ws + WS_PREVB);
      for (int i = blockIdx.x * NTHREADS + tid; i < 2 * 256 * (EA / 8); i += G * NTHREADS) { const int r = i >> 9, c = (i & 511) * 8, l = r >> 8, rr = r & 255;
          f32x4 a = {0.f, 0.f, 0.f, 0.f}, b = a;
          if (rr < NDB * PPAD) { const float* s = p.in[5] + ((size_t)l * NDB * PPAD + rr) * EA + c; a = *(const f32x4*)s; b = *(const f32x4*)(s + 4); }
          *(bf16x8*)(pb + (size_t)r * EA + c) = pack8(a, b); } }
}
template <int W>
__device__ __forceinline__ void poolmix_item(const bf16_t* tt, const bf16_t* sg, const float* scale, const bf16_t* prevt, bf16_t* yg, int row0, int ch) {
    constexpr int NR = 16 + W - 1;
    u32x4 rows[NR];
    const bool samp = row0 >= MP; const int t0 = samp ? 0 : (row0 & (SEQ - 1));
    const bf16_t* up = tt + (size_t)row0 * EA + ch;
    if (t0 != 0) {
#pragma unroll
        for (int i = 0; i < NR; ++i) rows[i] = *(const u32x4*)(up + (ptrdiff_t)(i - (W - 1)) * EA);
    } else {
#pragma unroll
        for (int i = W - 1; i < NR; ++i) rows[i] = *(const u32x4*)(up + (ptrdiff_t)(i - (W - 1)) * EA);
        if (samp) { const bf16_t* pp = prevt + ((size_t)((row0 - MP) >> 4) * PPAD + (PPAD - (W - 1))) * EA + ch;
#pragma unroll
            for (int i = 0; i < W - 1; ++i) rows[i] = *(const u32x4*)(pp + (size_t)i * EA); }
        else {
#pragma unroll
            for (int i = 0; i < W - 1; ++i) rows[i] = (u32x4){0u, 0u, 0u, 0u}; }
    }
    const f32x4 sc0 = *(const f32x4*)(scale + ch), sc1 = *(const f32x4*)(scale + ch + 4);
    float s[8] = {0.f, 0.f, 0.f, 0.f, 0.f, 0.f, 0.f, 0.f};
#define ROWF(v, f) const float f[8] = {bflo(v.x), bfhi(v.x), bflo(v.y), bfhi(v.y), bflo(v.z), bfhi(v.z), bflo(v.w), bfhi(v.w)}
#pragma unroll
    for (int i = 0; i < W - 1; ++i) { ROWF(rows[i], f);
#pragma unroll
        for (int c = 0; c < 8; ++c) s[c] += f[c]; }
    constexpr int GB = W == 16 ? 2 : (W == 8 ? 8 : 16);
    u32x4 gvs[GB];
#pragma unroll
    for (int j = 0; j < 16; ++j) { ROWF(rows[j + W - 1], f);
        if ((j & (GB - 1)) == 0) {
#pragma unroll
            for (int jj = 0; jj < GB; ++jj) gvs[jj] = *(const u32x4*)(sg + (size_t)(row0 + j + jj) * EA + ch); }
        const u32x4 gv = gvs[j & (GB - 1)]; ROWF(gv, gt);
#pragma unroll
        for (int c = 0; c < 8; ++c) s[c] += f[c];
        const int nv = (!samp && t0 + j + 1 < W) ? t0 + j + 1 : W; const float ic = 1.0f / (float)nv;
        u32x4 o; o.x = cvtpk((s[0] * ic - f[0]) * sc0[0] * gt[0], (s[1] * ic - f[1]) * sc0[1] * gt[1]); o.y = cvtpk((s[2] * ic - f[2]) * sc0[2] * gt[2], (s[3] * ic - f[3]) * sc0[3] * gt[3]);
        o.z = cvtpk((s[4] * ic - f[4]) * sc1[0] * gt[4], (s[5] * ic - f[5]) * sc1[1] * gt[5]); o.w = cvtpk((s[6] * ic - f[6]) * sc1[2] * gt[6], (s[7] * ic - f[7]) * sc1[3] * gt[7]);
        *(u32x4*)(yg + (size_t)(row0 + j) * EA + ch) = o;
        ROWF(rows[j], g);
#pragma unroll
        for (int c = 0; c < 8; ++c) s[c] -= g[c]; }
#undef ROWF
}
__device__ __forceinline__ void poolmix_phase(int wv, const Params& p, int l) {
    const bf16_t* tt = (const bf16_t*)(p.ws + WS_U); const bf16_t* sg = (const bf16_t*)(p.ws + WS_SG); bf16_t* yg = (bf16_t*)(p.ws + WS_D);
    const bf16_t* prevt = (const bf16_t*)(p.ws + WS_PREVT) + (size_t)l * 256 * EA; const float* scale = p.in[9] + (size_t)l * EA;
    const int nth = gridDim.x * NTHREADS;
    for (int idx = blockIdx.x * NTHREADS + otid(wv); idx < (MT / 16) * (EA / 8); idx += nth) {
        const int row0 = (idx >> 9) * 16, ch = (idx & 511) * 8, grp = __builtin_amdgcn_readfirstlane(ch >> 10);
        if (grp == 0) poolmix_item<2>(tt, sg, scale, prevt, yg, row0, ch);
        else if (grp == 1) poolmix_item<4>(tt, sg, scale, prevt, yg, row0, ch);
        else if (grp == 2) poolmix_item<8>(tt, sg, scale, prevt, yg, row0, ch);
        else poolmix_item<16>(tt, sg, scale, prevt, yg, row0, ch);
    }
}
__device__ __forceinline__ void final_phase(int wv, const Params& p) {
    const int tid = otid(wv), lane = tid & 63, gw = blockIdx.x * NWAVES + (tid >> 6), NGW = gridDim.x * NWAVES;
    const float* xres = (const float*)(p.ws + WS_XRES); const float* ssq = (const float*)(p.ws + WS_SSQ) + (size_t)4 * MT; const float* g = p.in[17];
    for (int m = gw; m < MT; m += NGW) { const float rr = rsqrtf(ssq[m] * (1.0f / DM) + EPS);
        const f32x4* xr = (const f32x4*)(xres + (size_t)m * DM) + lane; f32x4* o = (f32x4*)(p.out + (m < MP ? O_YP + (size_t)m * DM : O_YS + (size_t)(m - MP) * DM)) + lane;
        f32x4 xv[8];
#pragma unroll
        for (int j = 0; j < 8; ++j) xv[j] = xr[64 * j] * rr * ((const f32x4*)g)[lane + 64 * j];
#pragma unroll
        for (int j = 0; j < 8; ++j) o[64 * j] = xv[j]; }
}

constexpr int NPHASES = 15;
typedef const __attribute__((address_space(4))) Params* KArgPtr;
#if defined(__HIP_DEVICE_COMPILE__)
#define LOADP_() KArgPtr kp_ = (KArgPtr)__builtin_amdgcn_kernarg_segment_ptr(); asm volatile("" : "+s"(kp_)); Params lp; _Pragma("unroll") for (int i_ = 0; i_ < 18; ++i_) lp.in[i_] = kp_->in[i_]; lp.out = kp_->out; lp.ws = kp_->ws; lp.ph_lo = 0; lp.ph_hi = 0
#else
#define LOADP_() const Params lp = p
#endif
#define LOADP() LOADP_(); unsigned char* const ws = lp.ws; \
    float* const ssq = (float*)(ws + WS_SSQ); bf16_t* const xb = (bf16_t*)(ws + WS_XB); float* const xres = (float*)(ws + WS_XRES); (void)ssq; (void)xb; (void)xres
__global__ void __launch_bounds__(NTHREADS, 2) yoco_fwd(Params p) {
    extern __shared__ __attribute__((aligned(16))) unsigned char lds_raw[];
    char* lds = (char*)lds_raw; LAS unsigned char* ldsl = (LAS unsigned char*)lds_raw;
    const int G = gridDim.x, bx = blockIdx.x, wv = __builtin_amdgcn_readfirstlane(threadIdx.x >> 6);
#ifndef ONLY_PHASE
#define ONLY_PHASE -1
#endif
#define IN(k) ((ONLY_PHASE < 0 || ONLY_PHASE == (k)) && p.ph_lo <= (k) && (k) < p.ph_hi)
#ifndef SAT_REP
#define SAT_REP 1
#endif
#ifndef REPEAT_MASK
#define REPEAT_MASK 0
#endif
#define NREP(k) (1 + (int)(((unsigned)(REPEAT_MASK) >> (k)) & 1u))
#define SEAM(k) do { if (rep_ + 1 < NREP(k) || (k) + 1 < p.ph_hi) cg::this_grid().sync(); } while (0)
    if (IN(0)) for (int rep_ = 0; rep_ < NREP(0); ++rep_) { { LOADP(); prologue_phase(wv, lp, lds); } SEAM(0); }
    if (IN(1)) for (int rep_ = 0; rep_ < NREP(1); ++rep_) {
        { LOADP(); pg8::Gemm g{(const bf16_t*)(ws + WS_WGRP), (const bf16_t*)(ws + WS_WINUS), 1024, 1024, EA, 2, nullptr, nullptr}; pg8::StaticOrder S; S.init(32, 8, G, bx);
          pg8::EpiStore E{(bf16_t*)(ws + WS_WINA), DM, 1};
          pg8::gemm_phase<pg8::EpiStore, pg8::StaticOrder>(wv, ldsl, g, S, E); }
        SEAM(1); }
#pragma unroll 1
    for (int l = 0; l < 2; ++l) {
        int wv_o = wv, bx_o = bx, G_o = G; asm volatile("" : "+s"(wv_o), "+s"(bx_o), "+s"(G_o));
        const int wv = wv_o, bx = bx_o, G = G_o;
        if (IN(2 + 3 * l)) for (int rep_ = 0; rep_ < NREP(2 + 3 * l); ++rep_) {
            { LOADP(); bf16_t* u = (bf16_t*)(ws + WS_U); bf16_t* sg = (bf16_t*)(ws + WS_SG);
              pg8::Gemm g{xb, (const bf16_t*)(ws + WS_WINA) + (size_t)l * 2 * EA * DM, DM, DM, DM, 0, nullptr, nullptr}; pg8::StaticOrder S; S.init(65, 32, G, bx);
              pg8::EpiInA E{ssq + (size_t)l * MT, u, sg};
              pg8::gemm_phase<pg8::EpiInA, pg8::StaticOrder>(wv, ldsl, g, S, E); }
            { LOADP(); pg8::Gemm g{xb, (const bf16_t*)(ws + WS_WINUT) + (size_t)l * EA * DM, DM, DM, DM, 0, nullptr, nullptr}; pg8::StateOrder S{G, bx};
              pg8::EpiUState E{ssq + (size_t)l * MT, lp.out + O_PP + (size_t)l * NBATCH * PPAD * EA, lp.out + O_PS + (size_t)l * NDB * PPAD * EA};
              pg8::gemm_phase<pg8::EpiUState, pg8::StateOrder>(wv, ldsl, g, S, E); }
            if (l == 0) { LOADP(); pg8::Gemm g{(const bf16_t*)(ws + WS_PREVB), (const bf16_t*)(ws + WS_WGRP), 1024, EA, 1024, 3, nullptr, nullptr}; pg8::MidOrder S{bx};
              pg8::EpiStore E{(bf16_t*)(ws + WS_PREVT), EA, 0};
              pg8::gemm_phase<pg8::EpiStore, pg8::MidOrder>(wv, ldsl, g, S, E); }
            SEAM(2 + 3 * l); }
        if (IN(3 + 3 * l)) for (int rep_ = 0; rep_ < NREP(3 + 3 * l); ++rep_) { { LOADP(); poolmix_phase(wv, lp, l); } SEAM(3 + 3 * l); }
        if (IN(4 + 3 * l)) for (int rep_ = 0; rep_ < NREP(4 + 3 * l); ++rep_) { { LOADP(); bf16_t* yg = (bf16_t*)(ws + WS_D);
            pg8::Gemm g{yg, (const bf16_t*)(ws + WS_WOUTA) + (size_t)l * DM * EA, EA, EA, EA, 0, (float*)(ws + WS_SPLIT) + (size_t)l * 8 * 65536, (unsigned*)(ws + WS_SPCNT) + l * 64}; pg8::SplitOrder S; S.init(8, 8, G, bx);
            pg8::EpiRes E{l == 0 ? lp.in[0] : xres, l == 0 ? lp.in[1] : xres + (size_t)MP * DM, xres, xb, ssq + (size_t)(l + 1) * MT};
            pg8::gemm_phase<pg8::EpiRes, pg8::SplitOrder>(wv, ldsl, g, S, E); } SEAM(4 + 3 * l); }
    }
#pragma unroll 1
    for (int lb = 0; lb < 2; ++lb) {
        int wv_o = wv, bx_o = bx, G_o = G; asm volatile("" : "+s"(wv_o), "+s"(bx_o), "+s"(G_o));
        const int wv = wv_o, bx = bx_o, G = G_o;
        if (IN(8 + 3 * lb)) for (int rep_ = 0; rep_ < NREP(8 + 3 * lb); ++rep_) { { LOADP();
            pg8::EpiKVQ E{lb == 0 ? 0 : 17, ssq + (size_t)(2 + lb) * MT, lp.out, ws, lp.in[13]};
            if (lb == 0) { pg8::Gemm g{xb, (const bf16_t*)(ws + WS_W4), DM, DM, DM, 0, nullptr, nullptr}; pg8::StaticOrder S; S.init(65, 33, G, bx);
                pg8::gemm_phase<pg8::EpiKVQ, pg8::StaticOrder>(wv, ldsl, g, S, E); }
            else { pg8::Gemm g{xb, (const bf16_t*)(ws + WS_WINB1), DM, DM, DM, 0, (float*)(ws + WS_SPLIT) + (size_t)32 * 65536, (unsigned*)(ws + WS_SPCNT) + 256}; pg8::SplitOrder S; S.init(16, 4, G, bx);
                pg8::gemm_phase<pg8::EpiKVQ, pg8::SplitOrder>(wv, ldsl, g, S, E); } } SEAM(8 + 3 * lb); }
        if (IN(9 + 3 * lb)) for (int rep_ = 0; rep_ < NREP(9 + 3 * lb); ++rep_) {
            { const int xcd = bx & 7, j = bx >> 3;
              if (G != 256 || j >= 24) { LOADP();
                  sat::Tensors ST{(const bf16_t*)(ws + WS_QB), (const bf16_t*)(ws + WS_KB), (const bf16_t*)(ws + WS_VB), (bf16_t*)(ws + WS_OG), (const bf16_t*)(ws + WS_SGB),
                                  lp.in[2], lp.in[3], lp.in[4], (const float*)(ws + WS_LFTS)};
                  const int s0 = G == 256 ? xcd * 8 + (j - 24) : bx, sstep = G == 256 ? 64 : G;
                  for (int it = s0; it < NDB * NH; it += sstep) sat::item(wv, lds, ST, it >> 4, it & 15); }
              if (G != 256 || j < 24) { LOADP();
                  att::Tensors AT{(const bf16_t*)(ws + WS_QB), (const bf16_t*)(ws + WS_KB), (const bf16_t*)(ws + WS_VB), (bf16_t*)(ws + WS_OG), (const bf16_t*)(ws + WS_SGB), (const float*)(ws + WS_LFTP)};
                  const int p0 = G == 256 ? xcd * 24 + j : bx, pstep = G == 256 ? 192 : G;
                  for (int pw = p0; pw < 192; pw += pstep) att::prompt_phase(wv, lds, AT, (const float*)(ws + WS_KNRM), (const float*)(ws + WS_QNRM), pw); } }
            SEAM(9 + 3 * lb); }
        if (IN(10 + 3 * lb)) for (int rep_ = 0; rep_ < NREP(10 + 3 * lb); ++rep_) { { LOADP();
            pg8::Gemm g{(const bf16_t*)(ws + WS_OG), (const bf16_t*)(ws + WS_WOUTB) + (size_t)lb * DM * DM, DM, DM, DM, 0, (float*)(ws + WS_SPLIT) + (size_t)(2 + lb) * 8 * 65536, (unsigned*)(ws + WS_SPCNT) + (2 + lb) * 64}; pg8::SplitOrder S; S.init(8, 4, G, bx);
            pg8::EpiRes E{xres, xres + (size_t)MP * DM, xres, xb, ssq + (size_t)(3 + lb) * MT};
            pg8::gemm_phase<pg8::EpiRes, pg8::SplitOrder>(wv, ldsl, g, S, E); } SEAM(10 + 3 * lb); }
    }
    if (IN(14)) { LOADP(); final_phase(wv, lp); }
#undef IN
#undef SEAM
}

extern "C" void kernel_launch(void* const* d_in, const int* in_sizes, int n_in, void* d_out, int out_size, void* d_ws, size_t ws_size, hipStream_t stream) {
    static int grid = 0;
    if (grid == 0) {
        if (n_in != 18 || (size_t)out_size != O_END || ws_size < WS_END) { fprintf(stderr, "kernel_launch: unexpected shapes: n_in %d out %d (want %zu) ws %zu (need %zu)\n", n_in, out_size, (size_t)O_END, ws_size, (size_t)WS_END); grid = -1; return; }
        int dev = 0, cus = 0, per_cu = 0;
        (void)hipGetDevice(&dev); (void)hipDeviceGetAttribute(&cus, hipDeviceAttributeMultiprocessorCount, dev);
        if (hipFuncSetAttribute((const void*)yoco_fwd, hipFuncAttributeMaxDynamicSharedMemorySize, LDS_BYTES) != hipSuccess) { fprintf(stderr, "kernel_launch: hipFuncSetAttribute failed\n"); grid = -1; return; }
        if (hipOccupancyMaxActiveBlocksPerMultiprocessor(&per_cu, (const void*)yoco_fwd, NTHREADS, LDS_BYTES) != hipSuccess || per_cu < 1) { fprintf(stderr, "kernel_launch: occupancy query gave %d\n", per_cu); per_cu = 1; }
        (void)hipGetLastError();
        grid = cus > 0 ? cus : 256;
    }
    if (grid < 0) return;
    Params p{};
    for (int i = 0; i < 18; ++i) p.in[i] = (const float*)d_in[i];
    p.out = (float*)d_out; p.ws = (unsigned char*)d_ws;
#if MULTI_LAUNCH
    for (int ph = 0; ph < NPHASES; ++ph) { p.ph_lo = ph; p.ph_hi = ph + 1; hipLaunchKernelGGL(yoco_fwd, dim3(grid), dim3(NTHREADS), LDS_BYTES, stream, p); }
#else
    p.ph_lo = 0; p.ph_hi = NPHASES;
    void* args[] = {&p};
    hipError_t e = hipLaunchCooperativeKernel((const void*)yoco_fwd, dim3(grid), dim3(NTHREADS), args, LDS_BYTES, stream);
    if (e != hipSuccess) fprintf(stderr, "kernel_launch: cooperative launch failed: %s (grid %d)\n", hipGetErrorString(e), grid);
#endif
}
```

```cpp
#include <hip/hip_runtime.h>
#include <hip/hip_cooperative_groups.h>
#include <cstdio>
#include <cstdint>
namespace cg = cooperative_groups;

#ifndef MULTI_LAUNCH
#define MULTI_LAUNCH 0
#endif

#define LAS __attribute__((address_space(3)))
typedef unsigned short bf16_t;
typedef short bf16x8 __attribute__((ext_vector_type(8)));
typedef short s16x4 __attribute__((ext_vector_type(4)));
typedef float f32x4 __attribute__((ext_vector_type(4)));
typedef float f32x16 __attribute__((ext_vector_type(16)));
typedef unsigned u32x4 __attribute__((ext_vector_type(4)));
typedef unsigned u32x2 __attribute__((ext_vector_type(2)));

constexpr int DM = 2048, NBATCH = 4, SEQ = 4096, NDB = 16, DSEQ = 16, PAST = 2048, EA = 4096, NH = 16, HD = 128, PPAD = 15;
constexpr int MP = NBATCH * SEQ, MS = NDB * DSEQ, MT = MP + MS;
constexpr float EPS = 1e-6f;
constexpr float LOG2E = 1.4426950408889634f;
constexpr float QSCALE = 0.08838834764831845f * 1.4426950408889634f;
constexpr int NTHREADS = 512, NWAVES = 8;
constexpr int LDS_PHASE_BYTES = 131072, LDS_BYTES = LDS_PHASE_BYTES + 16;

constexpr size_t O_YP = 0, O_YS = O_YP + (size_t)MP * DM, O_KP = O_YS + (size_t)MS * DM, O_VP = O_KP + (size_t)MP * DM,
                 O_LFP = O_VP + (size_t)MP * DM, O_PP = O_LFP + (size_t)MP * NH, O_KS = O_PP + (size_t)2 * NBATCH * PPAD * EA,
                 O_VS = O_KS + (size_t)MS * DM, O_LFS = O_VS + (size_t)MS * DM, O_PS = O_LFS + (size_t)MS * NH, O_END = O_PS + (size_t)2 * NDB * PPAD * EA;

constexpr size_t al256(size_t x) { return (x + 255) & ~(size_t)255; }
constexpr size_t WS_WINA = 0;
constexpr size_t WS_WGRP = WS_WINA + (size_t)2 * 8192 * 2048 * 2;
constexpr size_t WS_WOUTA = WS_WGRP + (size_t)2 * 4096 * 1024 * 2;
constexpr size_t WS_W4 = WS_WOUTA + (size_t)2 * 2048 * 4096 * 2;
constexpr size_t WS_WINB1 = WS_W4 + (size_t)8448 * 2048 * 2;
constexpr size_t WS_WOUTB = WS_WINB1 + (size_t)4096 * 2048 * 2;
constexpr size_t WS_XB = WS_WOUTB + (size_t)2 * 2048 * 2048 * 2;
constexpr size_t WS_XRES = WS_XB + (size_t)MT * DM * 2;
constexpr size_t WS_SSQ = WS_XRES + (size_t)MT * DM * 4;
constexpr size_t WS_LFTP = al256(WS_SSQ + (size_t)5 * MT * 4);
constexpr size_t WS_LFTS = WS_LFTP + (size_t)NBATCH * NH * SEQ * 4;
constexpr size_t WS_KNRM = al256(WS_LFTS + (size_t)NDB * NH * DSEQ * 4);
constexpr size_t WS_QNRM = WS_KNRM + (size_t)MT * NH * 4 * 4;
constexpr size_t WS_WINUT = al256(WS_QNRM + (size_t)MT * NH * 4 * 4);
constexpr size_t WS_WINUS = WS_WINUT + (size_t)2 * EA * DM * 2;
constexpr size_t WS_PREVB = WS_WINUS + (size_t)2 * DM * EA * 2;
constexpr size_t WS_PREVT = WS_PREVB + (size_t)2 * 256 * EA * 2;
constexpr size_t WS_SPLIT = al256(WS_PREVT + (size_t)2 * 256 * EA * 2);
constexpr size_t SPLIT_TILE = 65536 * 4, SPLIT_TILES = 8 * 4 + 16;
constexpr size_t WS_SPCNT = WS_SPLIT + SPLIT_TILES * SPLIT_TILE;
constexpr size_t WS_BAR = al256(WS_SPCNT + SPLIT_TILES * 8 * 4);
constexpr size_t WS_ACT = al256(WS_BAR + 3456 * 4);
constexpr size_t SZ_A = (size_t)MT * EA * 2, SZ_B = (size_t)MT * DM * 2;
constexpr size_t WS_U = WS_ACT, WS_SG = WS_U + SZ_A, WS_D = WS_SG + SZ_A;
constexpr size_t WS_KB = WS_ACT, WS_VB = WS_KB + SZ_B, WS_QB = WS_VB + SZ_B, WS_SGB = WS_QB + SZ_B, WS_OG = WS_SGB + SZ_B;
constexpr size_t WS_END = (WS_D + SZ_A) > (WS_OG + SZ_B) ? (WS_D + SZ_A) : (WS_OG + SZ_B);

struct Params { const float* in[18]; float* out; unsigned char* ws; int ph_lo, ph_hi; };

__device__ __forceinline__ unsigned cvtpk(float lo, float hi) { unsigned r; asm volatile("v_cvt_pk_bf16_f32 %0, %1, %2" : "=v"(r) : "v"(lo), "v"(hi)); return r; }
__device__ __forceinline__ bf16x8 pack8(f32x4 a, f32x4 b) { u32x4 w = {cvtpk(a[0], a[1]), cvtpk(a[2], a[3]), cvtpk(b[0], b[1]), cvtpk(b[2], b[3])}; return *reinterpret_cast<bf16x8*>(&w); }
__device__ __forceinline__ float bflo(unsigned w) { return __uint_as_float(w << 16); }
__device__ __forceinline__ float bfhi(unsigned w) { return __uint_as_float(w & 0xffff0000u); }
__device__ __forceinline__ float silu_f(float x) { return x * __builtin_amdgcn_rcpf(1.0f + __builtin_amdgcn_exp2f(-x * LOG2E)); }
__device__ __forceinline__ float wave_sum(float v) {
#pragma unroll
    for (int o = 1; o < 64; o <<= 1) v += __shfl_xor(v, o);
    return v;
}
__device__ __forceinline__ int otid(int wv) { int l; asm volatile("v_mbcnt_lo_u32_b32 %0, -1, 0\n\tv_mbcnt_hi_u32_b32 %0, -1, %0" : "=v"(l)); return wv * 64 + l; }
__device__ __forceinline__ float xsum16(float v) { auto r = __builtin_amdgcn_permlane16_swap(__float_as_uint(v), __float_as_uint(v), false, false); return __uint_as_float(r[0]) + __uint_as_float(r[1]); }
__device__ __forceinline__ float xsum32(float v) { auto r = __builtin_amdgcn_permlane32_swap(__float_as_uint(v), __float_as_uint(v), false, false); return __uint_as_float(r[0]) + __uint_as_float(r[1]); }
__device__ __forceinline__ float xmax16(float v) { auto r = __builtin_amdgcn_permlane16_swap(__float_as_uint(v), __float_as_uint(v), false, false); return fmaxf(__uint_as_float(r[0]), __uint_as_float(r[1])); }
__device__ __forceinline__ float xmax32(float v) { auto r = __builtin_amdgcn_permlane32_swap(__float_as_uint(v), __float_as_uint(v), false, false); return fmaxf(__uint_as_float(r[0]), __uint_as_float(r[1])); }
__device__ __forceinline__ float bperm(float v, int srclane) { return __uint_as_float((unsigned)__builtin_amdgcn_ds_bpermute(srclane << 2, (int)__float_as_uint(v))); }
__device__ __forceinline__ float logsig(float x) { return fminf(x, 0.f) - log1pf(__expf(-fabsf(x))); }

namespace pg8 {
constexpr int BM = 256, BK = 64, HALF = 128, HTB = HALF * BK * 2, NXCD = 8, WGM = 8;
__device__ __forceinline__ int lds_byte(int r, int c) { const int st = (r >> 4) * 2 + (c >> 5), rr = r & 15, cc = c & 31, ob = rr * 64 + cc * 2; return st * 1024 + (ob ^ (((ob >> 9) & 1) << 5)); }
__device__ __forceinline__ void stage_rc(int b, int& R, int& C) { const int st = b / 1024, sb = b % 1024, swz = sb ^ (((sb >> 9) & 1) << 5); R = (st >> 1) * 16 + swz / 64; C = (st & 1) * 32 + (swz % 64) / 2; }
__device__ __forceinline__ int perm32(int rho) { const int n = rho >> 4, i = rho & 15; return 8 * (i >> 2) + 4 * n + (i & 3); }
struct Unit { int pm, pn, ks, nks; };
struct Gemm { const bf16_t* A; const bf16_t* Bt; int K, lda, ldb, mode; float* sp_acc; unsigned* sp_cnt; };
__device__ __forceinline__ void unit_off(const Gemm& g, const Unit& u, size_t& oa, size_t& ob) {
    if (g.mode == 2) { oa = (size_t)u.pm * 256 * g.lda; ob = (size_t)(u.pm >> 4) * DM * EA + (size_t)((u.pm >> 2) & 3) * 1024 + (size_t)u.pn * 256 * g.ldb; }
    else if (g.mode == 3) { oa = (size_t)u.pm * 256 * g.lda + (size_t)(u.pn >> 2) * 1024; ob = (size_t)(u.pm * 16 + u.pn) * 256 * g.ldb; }
    else { oa = (size_t)u.pm * 256 * g.lda; ob = (size_t)u.pn * 256 * g.ldb; }
    const size_t ko = (size_t)u.ks * (size_t)(g.K / u.nks); oa = (oa + ko) * 2; ob = (ob + ko) * 2;
}
struct StaticOrder {
    int nM, nN, nwg, G, c;
    __device__ __forceinline__ void init(int nM_, int nN_, int G_, int c_) { nM = nM_; nN = nN_; nwg = nM * nN; G = G_; c = c_; }
    __device__ __forceinline__ bool next(int i, Unit& u) const {
        const long L = (long)i * G + c; if (L >= nwg) return false;
        int wgid = (int)L; { const int q = nwg / NXCD, r = nwg % NXCD, xcd = wgid % NXCD, off = wgid / NXCD; wgid = (xcd < r ? xcd * (q + 1) : r * (q + 1) + (xcd - r) * q) + off; }
        const int nig = WGM * nN, gid = wgid / nig, fm = gid * WGM, gsz = (nM - fm) < WGM ? (nM - fm) : WGM;
        u.pm = fm + ((wgid % nig) % gsz); u.pn = (wgid % nig) / gsz; u.ks = 0; u.nks = 1; return true;
    }
};
struct SplitOrder {
    StaticOrder S0; int nN, nks, i0;
    __device__ __forceinline__ void init(int nN_, int nks_, int G_, int c_) { S0.init(64, nN_, G_, c_); nN = nN_; nks = nks_; i0 = c_ < S0.nwg ? (S0.nwg - c_ + G_ - 1) / G_ : 0; }
    __device__ __forceinline__ bool next(int i, Unit& u) const {
        if (i < i0) return S0.next(i, u);
        const int idx = (i - i0) * S0.G + S0.c; if (idx >= nN * nks) return false;
        u.pm = 64; u.pn = idx / nks; u.ks = idx % nks; u.nks = nks; return true;
    }
};
struct MidOrder {
    int c;
    __device__ __forceinline__ bool next(int i, Unit& u) const { const int idx = c - 32; if (i != 0 || idx < 0 || idx >= 32) return false; u.pm = idx >> 4; u.pn = idx & 15; u.ks = 0; u.nks = 1; return true; }
};
struct StateOrder {
    int G, c;
    __device__ __forceinline__ bool next(int i, Unit& u) const { const int idx = G - 1 - c; if (i != 0 || idx >= 80) return false; const int k = idx >> 4; u.pm = k < 4 ? 16 * k + 15 : 64; u.pn = idx & 15; u.ks = 0; u.nks = 1; return true; }
};
template <class Epi, class Ord>
__device__ __forceinline__ void gemm_phase(int wv, LAS unsigned char* lds, const Gemm g, const Ord& S, const Epi& E) {
    const int tid = otid(wv), wid = __builtin_amdgcn_readfirstlane(tid >> 6), lane = tid & 63, wr = wid >> 2, wc = wid & 3, fr = lane & 15, fq = lane >> 4;
    const int K = g.K, nt = K / BK;
    unsigned voffA[2], voffB[2];
#pragma unroll
    for (int i = 0; i < 2; ++i) { int R, C; stage_rc(tid * 16 + i * 8192, R, C); const int Rb = Epi::PERM ? ((R & ~31) + perm32(R & 31)) : R;
        voffA[i] = (unsigned)(R * g.lda + C) * 2u; voffB[i] = (unsigned)(Rb * g.ldb + C) * 2u; }
    const size_t kstep = (size_t)(BK * 2);
    const size_t hstepA = (size_t)HALF * g.lda * 2;
    const size_t hstepB = (size_t)HALF * g.ldb * 2;
    const unsigned ldsw = (unsigned)wid * 1024u;
    const int aoff = lds_byte(wr * 64 + fr, fq * 8), boff = lds_byte(wc * 32 + fr, fq * 8);
#define PG8_SA(b, h) (((b) * 2 + (h)) * HTB)
#define PG8_SB(b, h) ((4 + (b) * 2 + (h)) * HTB)
#define PG8_STAGE(bufoff, gbase, voff) do { _Pragma("unroll") for (int _i = 0; _i < 2; ++_i) \
        __builtin_amdgcn_global_load_lds((const unsigned*)((const char*)(gbase) + (voff)[_i]), (LAS unsigned*)(lds + (bufoff) + ldsw + _i * 8192), 16, 0, 0); } while (0)
#define PG8_LDA(dst, b, h) do { _Pragma("unroll") for (int m = 0; m < 4; ++m) _Pragma("unroll") for (int k = 0; k < 2; ++k) dst[m][k] = *(const LAS bf16x8*)(lds + PG8_SA(b, h) + aoff + m * 2048 + k * 1024); } while (0)
#define PG8_LDB(dst, b, h) do { _Pragma("unroll") for (int n = 0; n < 2; ++n) _Pragma("unroll") for (int k = 0; k < 2; ++k) dst[n][k] = *(const LAS bf16x8*)(lds + PG8_SB(b, h) + boff + n * 2048 + k * 1024); } while (0)
#define PG8_MMA(ai, bj, At, Bt) do { __builtin_amdgcn_s_setprio(1); _Pragma("unroll") for (int m = 0; m < 4; ++m) _Pragma("unroll") for (int n = 0; n < 2; ++n) _Pragma("unroll") for (int k = 0; k < 2; ++k) \
        acc[ai][bj][m][n] = __builtin_amdgcn_mfma_f32_16x16x32_bf16(Bt[n][k], At[m][k], acc[ai][bj][m][n], 0, 0, 0); __builtin_amdgcn_s_setprio(0); } while (0)
#define PG8_WAIT_V(n) asm volatile("s_waitcnt vmcnt(" #n ")" ::: "memory")
#define PG8_WAIT_L(n) asm volatile("s_waitcnt lgkmcnt(" #n ")" ::: "memory")
#define PG8_BAR __builtin_amdgcn_s_barrier()
#define PG8_SCHED __builtin_amdgcn_sched_barrier(0)
    Unit cur, nxt; int ui = 0;
    if (!S.next(0, cur)) return;
    f32x4 acc[2][2][4][2];
#pragma unroll
    for (int a = 0; a < 2; ++a)
#pragma unroll
        for (int b = 0; b < 2; ++b)
#pragma unroll
            for (int m = 0; m < 4; ++m)
#pragma unroll
                for (int n = 0; n < 2; ++n) acc[a][b][m][n] = (f32x4){0.f, 0.f, 0.f, 0.f};
    bf16x8 At[4][2], B0[2][2], B1[2][2];
    size_t oa_, ob_; unit_off(g, cur, oa_, ob_);
    const char* cA = (const char*)g.A + oa_; const char* cB = (const char*)g.Bt + ob_;
    PG8_STAGE(PG8_SB(0, 0), cB, voffB); PG8_STAGE(PG8_SA(0, 0), cA, voffA); PG8_STAGE(PG8_SB(0, 1), cB + hstepB, voffB); PG8_STAGE(PG8_SA(0, 1), cA + hstepA, voffA);
    if (wr == 1) PG8_BAR;
    PG8_WAIT_V(4); PG8_BAR;
    PG8_STAGE(PG8_SB(1, 0), cB + kstep, voffB); PG8_STAGE(PG8_SA(1, 0), cA + kstep, voffA); PG8_STAGE(PG8_SB(1, 1), cB + hstepB + kstep, voffB);
    PG8_WAIT_V(6); PG8_BAR;
    for (;;) {
        const bool has_next = S.next(ui + 1, nxt);
        const char* nA = cA; const char* nB = cB;
        if (has_next) { unit_off(g, nxt, oa_, ob_); nA = (const char*)g.A + oa_; nB = (const char*)g.Bt + ob_; }
        const int ntc = nt / cur.nks;
        for (int t = 0; t < ntc; t += 2) {
            const bool last = (t == ntc - 2);
            const char* a1 = cA + (size_t)(t + 1) * kstep;
            const char* a2 = last ? nA : cA + (size_t)(t + 2) * kstep; const char* b2 = last ? nB : cB + (size_t)(t + 2) * kstep;
            const char* a3 = a2 + kstep; const char* b3 = b2 + kstep;
            PG8_LDB(B0, 0, 0); PG8_SCHED; PG8_LDA(At, 0, 0); PG8_STAGE(PG8_SA(1, 1), a1 + hstepA, voffA);
            PG8_WAIT_L(8); PG8_BAR; PG8_WAIT_L(0); PG8_MMA(0, 0, At, B0); PG8_BAR; PG8_SCHED;
            PG8_LDB(B1, 0, 1); PG8_STAGE(PG8_SB(0, 0), b2, voffB);
            PG8_BAR; PG8_WAIT_L(0); PG8_MMA(0, 1, At, B1); PG8_BAR;
            PG8_LDA(At, 0, 1); PG8_STAGE(PG8_SA(0, 0), a2, voffA);
            PG8_BAR; PG8_WAIT_L(0); PG8_MMA(1, 0, At, B0); PG8_BAR; PG8_SCHED;
            PG8_STAGE(PG8_SB(0, 1), b2 + hstepB, voffB);
            PG8_WAIT_V(6); PG8_BAR; PG8_MMA(1, 1, At, B1); PG8_BAR;
            PG8_LDB(B0, 1, 0); PG8_SCHED; PG8_LDA(At, 1, 0); PG8_STAGE(PG8_SA(0, 1), a2 + hstepA, voffA);
            PG8_WAIT_L(8); PG8_BAR; PG8_WAIT_L(0); PG8_MMA(0, 0, At, B0); PG8_BAR; PG8_SCHED;
            PG8_LDB(B1, 1, 1); PG8_STAGE(PG8_SB(1, 0), b3, voffB);
            PG8_BAR; PG8_WAIT_L(0); PG8_MMA(0, 1, At, B1); PG8_BAR;
            PG8_LDA(At, 1, 1); PG8_STAGE(PG8_SA(1, 0), a3, voffA);
            PG8_BAR; PG8_WAIT_L(0); PG8_MMA(1, 0, At, B0); PG8_BAR; PG8_SCHED;
            PG8_STAGE(PG8_SB(1, 1), b3 + hstepB, voffB);
            PG8_WAIT_V(6); PG8_BAR; PG8_MMA(1, 1, At, B1); PG8_BAR;
        }
        bool do_epi = true;
        if (cur.nks > 1) {
            float* sc0 = g.sp_acc + (size_t)cur.pn * 65536 + (wid * 64 + lane); float* sc = sc0;
#pragma unroll
            for (int a = 0; a < 2; ++a)
#pragma unroll
                for (int b = 0; b < 2; ++b)
#pragma unroll
                    for (int m = 0; m < 4; ++m)
#pragma unroll
                        for (int n = 0; n < 2; ++n) {
#pragma unroll
                            for (int j = 0; j < 4; ++j) unsafeAtomicAdd(sc + j * 512, acc[a][b][m][n][j]);
                            sc += 2048; asm volatile("" : "+v"(sc)); }
            asm volatile("s_waitcnt vmcnt(0)" ::: "memory");
            __builtin_amdgcn_fence(__ATOMIC_RELEASE, "agent");
            unsigned old = 0u; if (lane == 0) old = __hip_atomic_fetch_add(g.sp_cnt + cur.pn * 8 + wid, 1u, __ATOMIC_RELAXED, __HIP_MEMORY_SCOPE_AGENT);
            old = (unsigned)__builtin_amdgcn_readfirstlane((int)old);
            do_epi = (old == (unsigned)cur.nks - 1u);
            if (do_epi) {
                __builtin_amdgcn_fence(__ATOMIC_ACQUIRE, "agent");
                sc = sc0;
#pragma unroll
                for (int a = 0; a < 2; ++a)
#pragma unroll
                    for (int b = 0; b < 2; ++b)
#pragma unroll
                        for (int m = 0; m < 4; ++m)
#pragma unroll
                            for (int n = 0; n < 2; ++n) {
#pragma unroll
                                for (int j = 0; j < 4; ++j) acc[a][b][m][n][j] = __hip_atomic_load(sc + j * 512, __ATOMIC_RELAXED, __HIP_MEMORY_SCOPE_AGENT);
                                sc += 2048; asm volatile("" : "+v"(sc)); } }
        }
        if (do_epi) E(acc, cur, wr, wc, fr, fq);
        if (!has_next) break;
#pragma unroll
        for (int a = 0; a < 2; ++a)
#pragma unroll
            for (int b = 0; b < 2; ++b)
#pragma unroll
                for (int m = 0; m < 4; ++m)
#pragma unroll
                    for (int n = 0; n < 2; ++n) acc[a][b][m][n] = (f32x4){0.f, 0.f, 0.f, 0.f};
        cur = nxt; cA = nA; cB = nB; ++ui;
    }
    PG8_WAIT_V(0);
    if (wr == 0) PG8_BAR;
    PG8_BAR;
#undef PG8_SA
#undef PG8_SB
#undef PG8_STAGE
#undef PG8_LDA
#undef PG8_LDB
#undef PG8_MMA
#undef PG8_WAIT_V
#undef PG8_WAIT_L
#undef PG8_BAR
#undef PG8_SCHED
}

typedef const f32x4 (&AccRef)[2][2][4][2];

struct EpiInA {
    static constexpr bool PERM = true;
    const float* ssq; bf16_t* tt; bf16_t* sg;
    __device__ __forceinline__ void operator()(AccRef acc, const Unit& un, int wr, int wc, int fr, int fq) const {
        const int row0 = un.pm * BM + wr * 64 + fr, colt = un.pn * BM + wc * 32 + 8 * fq;
        const bool is_t = un.pn < 16;
        float rrs[2][4];
#pragma unroll
        for (int ai = 0; ai < 2; ++ai)
#pragma unroll
            for (int m = 0; m < 4; ++m) rrs[ai][m] = ssq[row0 + ai * HALF + m * 16];
#pragma unroll
        for (int ai = 0; ai < 2; ++ai)
#pragma unroll
            for (int m = 0; m < 4; ++m) { const int row = row0 + ai * HALF + m * 16; const float rr = rsqrtf(rrs[ai][m] * (1.0f / DM) + EPS);
#pragma unroll
                for (int bj = 0; bj < 2; ++bj) { f32x4 v0 = acc[ai][bj][m][0] * rr, v1 = acc[ai][bj][m][1] * rr; const int col = colt + bj * HALF;
                    if (is_t) *(bf16x8*)(tt + (size_t)row * EA + col) = pack8(v0, v1);
                    else {
#pragma unroll
                        for (int j = 0; j < 4; ++j) { v0[j] = silu_f(v0[j]); v1[j] = silu_f(v1[j]); }
                        *(bf16x8*)(sg + (size_t)row * EA + (col - EA)) = pack8(v0, v1); } } }
    }
};
struct EpiUState {
    static constexpr bool PERM = true;
    const float* ssq; float* pool_p; float* pool_s;
    __device__ __forceinline__ void operator()(AccRef acc, const Unit& un, int wr, int wc, int fr, int fq) const {
        const int row0 = un.pm * BM + wr * 64 + fr, colt = un.pn * BM + wc * 32 + 8 * fq;
#pragma unroll
        for (int ai = 0; ai < 2; ++ai)
#pragma unroll
            for (int m = 0; m < 4; ++m) { const int row = row0 + ai * HALF + m * 16;
                float* pp = nullptr;
                if (row < MP) { const int t = row & (SEQ - 1); if (t >= SEQ - PPAD) pp = pool_p + ((size_t)(row >> 12) * PPAD + (t - (SEQ - PPAD))) * EA; }
                else { const int rs = row - MP, t = rs & 15; if (t >= 1) pp = pool_s + ((size_t)(rs >> 4) * PPAD + (t - 1)) * EA; }
                if (pp) { const float rr = rsqrtf(ssq[row] * (1.0f / DM) + EPS);
#pragma unroll
                    for (int bj = 0; bj < 2; ++bj) { *(f32x4*)(pp + colt + bj * HALF) = acc[ai][bj][m][0] * rr; *(f32x4*)(pp + colt + bj * HALF + 4) = acc[ai][bj][m][1] * rr; } } }
    }
};
struct EpiStore {
    static constexpr bool PERM = true;
    bf16_t* O; int ldc, wmode;
    __device__ __forceinline__ void operator()(AccRef acc, const Unit& un, int wr, int wc, int fr, int fq) const {
        const int rbase = wmode ? (un.pm >> 4) * 2 * EA + (un.pm & 15) * BM : un.pm * BM;
        const int row0 = rbase + wr * 64 + fr, colt = un.pn * BM + wc * 32 + 8 * fq;
#pragma unroll
        for (int ai = 0; ai < 2; ++ai)
#pragma unroll
            for (int m = 0; m < 4; ++m)
#pragma unroll
                for (int bj = 0; bj < 2; ++bj) *(bf16x8*)(O + (size_t)(row0 + ai * HALF + m * 16) * ldc + colt + bj * HALF) = pack8(acc[ai][bj][m][0], acc[ai][bj][m][1]);
    }
};
struct EpiRes {
    static constexpr bool PERM = false;
    const float* base_p; const float* base_s; float* xres; bf16_t* xb; float* ssq_next;
    __device__ __forceinline__ void operator()(AccRef acc, const Unit& un, int wr, int wc, int fr, int fq) const {
        const int row0 = un.pm * BM + wr * 64 + fr, col0 = un.pn * BM + wc * 32 + 4 * fq;
#pragma unroll
        for (int ai = 0; ai < 2; ++ai) {
            f32x4 bx_[4][2][2];
#pragma unroll
            for (int m = 0; m < 4; ++m) { const int row = row0 + ai * HALF + m * 16;
                const float* bp = (row < MP ? base_p + (size_t)row * DM : base_s + (size_t)(row - MP) * DM) + col0;
#pragma unroll
                for (int bj = 0; bj < 2; ++bj)
#pragma unroll
                    for (int n = 0; n < 2; ++n) bx_[m][bj][n] = *(const f32x4*)(bp + bj * HALF + n * 16); }
#pragma unroll
            for (int m = 0; m < 4; ++m) { const int row = row0 + ai * HALF + m * 16;
                float* xo = xres + (size_t)row * DM + col0; bf16_t* bo = xb + (size_t)row * DM + col0; float s = 0.f;
#pragma unroll
                for (int bj = 0; bj < 2; ++bj)
#pragma unroll
                    for (int n = 0; n < 2; ++n) { const f32x4 x = bx_[m][bj][n] + acc[ai][bj][m][n];
                        *(f32x4*)(xo + bj * HALF + n * 16) = x; u32x2 w; w.x = cvtpk(x[0], x[1]); w.y = cvtpk(x[2], x[3]); *(u32x2*)(bo + bj * HALF + n * 16) = w;
                        s += (x[0] * x[0] + x[1] * x[1]) + (x[2] * x[2] + x[3] * x[3]); }
                s = xsum16(s); s = xsum32(s);
                if (fq == 0) unsafeAtomicAdd(ssq_next + row, s); } }
    }
};
struct EpiKVQ {
    static constexpr bool PERM = true;
    int pn_off; const float* ssq; float* out; unsigned char* ws; const float* b_f;
    __device__ __forceinline__ void operator()(AccRef acc, const Unit& un, int wr, int wc, int fr, int fq) const {
        const int tt = un.pn + pn_off;
        const int row0 = un.pm * BM + wr * 64 + fr, cw = wc * 32 + 8 * fq;
        float rrs[2][4];
#pragma unroll
        for (int ai = 0; ai < 2; ++ai)
#pragma unroll
            for (int m = 0; m < 4; ++m) rrs[ai][m] = ssq[row0 + ai * HALF + m * 16];
        if (tt == 16) {
            if (wc == 0 && fq < 2) {
            const f32x4 bf0 = *(const f32x4*)(b_f + 8 * fq), bf1 = *(const f32x4*)(b_f + 8 * fq + 4);
            float* lft_p = (float*)(ws + WS_LFTP); float* lft_s = (float*)(ws + WS_LFTS);
#pragma unroll
            for (int ai = 0; ai < 2; ++ai)
#pragma unroll
                for (int m = 0; m < 4; ++m) { const int row = row0 + ai * HALF + m * 16; const float rr = rsqrtf(rrs[ai][m] * (1.0f / DM) + EPS);
                    f32x4 v0 = acc[ai][0][m][0] * rr + bf0, v1 = acc[ai][0][m][1] * rr + bf1;
#pragma unroll
                    for (int j = 0; j < 4; ++j) { v0[j] = logsig(v0[j]); v1[j] = logsig(v1[j]); }
                    if (row < MP) { float* o = out + O_LFP + (size_t)row * NH + 8 * fq; *(f32x4*)o = v0; *(f32x4*)(o + 4) = v1;
                        float* tp = lft_p + ((size_t)(row >> 12) * NH + 8 * fq) * SEQ + (row & (SEQ - 1));
#pragma unroll
                        for (int j = 0; j < 4; ++j) { tp[(size_t)j * SEQ] = v0[j]; tp[(size_t)(j + 4) * SEQ] = v1[j]; } }
                    else { const int rs = row - MP; float* o = out + O_LFS + (size_t)rs * NH + 8 * fq; *(f32x4*)o = v0; *(f32x4*)(o + 4) = v1;
                        float* tp = lft_s + ((size_t)(rs >> 4) * NH + 8 * fq) * DSEQ + (rs & 15);
#pragma unroll
                        for (int j = 0; j < 4; ++j) { tp[j * DSEQ] = v0[j]; tp[(j + 4) * DSEQ] = v1[j]; } } }
            }
        } else {
        const int kind = tt < 8 ? 0 : (tt < 16 ? 1 : (tt < 25 ? 2 : 3));
        const int colt = (tt - (kind == 0 ? 0 : kind == 1 ? 8 : kind == 2 ? 17 : 25)) * BM + cw;
        float* fo_p = out + (kind == 0 ? O_KP : O_VP); float* fo_s = out + (kind == 0 ? O_KS : O_VS);
        bf16_t* bo = (bf16_t*)(ws + (kind == 0 ? WS_KB : (kind == 1 ? WS_VB : (kind == 2 ? WS_QB : WS_SGB))));
#pragma unroll
        for (int ai = 0; ai < 2; ++ai)
#pragma unroll
            for (int m = 0; m < 4; ++m) { const int row = row0 + ai * HALF + m * 16; float rr = rsqrtf(rrs[ai][m] * (1.0f / DM) + EPS);
                if (kind == 2) rr *= QSCALE;
                float* fo = (row < MP ? fo_p + (size_t)row * DM : fo_s + (size_t)(row - MP) * DM) + colt;
#pragma unroll
                for (int bj = 0; bj < 2; ++bj) { f32x4 v0 = acc[ai][bj][m][0] * rr, v1 = acc[ai][bj][m][1] * rr;
                    if (kind < 2) { *(f32x4*)(fo + bj * HALF) = v0; *(f32x4*)(fo + bj * HALF + 4) = v1; }
                    if (kind == 3) {
#pragma unroll
                        for (int j = 0; j < 4; ++j) { v0[j] = silu_f(v0[j]); v1[j] = silu_f(v1[j]); } }
                    *(bf16x8*)(bo + (size_t)row * DM + colt + bj * HALF) = pack8(v0, v1);
                    if (kind == 0 || kind == 2) {
                        float ss = (v0[0] * v0[0] + v0[1] * v0[1]) + (v0[2] * v0[2] + v0[3] * v0[3]) + (v1[0] * v1[0] + v1[1] * v1[1]) + (v1[2] * v1[2] + v1[3] * v1[3]);
                        ss = xsum16(ss); ss = xsum32(ss);
                        float* nt = (float*)(ws + (kind == 0 ? WS_KNRM : WS_QNRM));
                        if (fq == 0) nt[((size_t)row * NH + 2 * (colt >> 8) + bj) * 4 + wc] = ss; } } }
        }
    }
};
}

namespace att {
constexpr int NW = 8, QBLK = 32, KVBLK = 64, QB = NW * QBLK, D = 128, LD = 2048;
constexpr int SHM_V = KVBLK * D * 2, SHM_K = KVBLK * D * 2;
constexpr int OFF_WS = 2 * SHM_V + 2 * SHM_K, OFF_F = OFF_WS + NW * 64 * 4, OFF_SC = OFF_F + SEQ * 4, OFF_KT = OFF_SC + 64, OFF_QM = OFF_KT + 256, OFF_JL = OFF_QM + 128;
constexpr float SKIP_T = 32.f;
constexpr float THR2 = 11.5f;
#define KSWZ(row, colB) ((row) * 256 + ((colB) ^ (((row) & 7) << 4)))
#define SBAR() __builtin_amdgcn_sched_barrier(0)
__device__ __forceinline__ int v_st(int k, int c) { const int kk = (k & ~0xC) | ((k & 4) << 1) | ((k & 8) >> 1); return ((kk >> 3) * 4 + (c >> 5)) * 512 + ((kk & 7) * 32 + (c & 31)) * 2; }
__device__ __forceinline__ int v_rd_base(int lane) { return ((lane & 3) << 3) | (((lane >> 2) & 3) << 6) | (((lane >> 4) & 1) << 5) | (((lane >> 5) & 1) << 8); }
constexpr int v_rd_off(int d0, int ks, int half) { return d0 * 512 + ks * 4096 + half * 2048; }
__device__ __forceinline__ int crow(int r, int hi) { return (r & 3) + 8 * (r >> 2) + 4 * hi; }
__device__ __forceinline__ void mask_tile(f32x16& p0, f32x16& p1, int dq) {
    const float NEG = -__builtin_inff();
#pragma unroll
    for (int r = 0; r < 16; ++r) { const int c = (r & 3) + 8 * (r >> 2);
        if (dq - c < 0) p0[r] = NEG;
        if (dq - c - 32 < 0) p1[r] = NEG; }
}
__device__ __forceinline__ void partialSM(f32x16& p0, f32x16& p1, float& m_reg, float& mn, float& alpha) {
    float pmax = p0[0];
#pragma unroll
    for (int r = 1; r < 16; ++r) pmax = fmaxf(pmax, p0[r]);
#pragma unroll
    for (int r = 0; r < 16; ++r) pmax = fmaxf(pmax, p1[r]);
    { auto rr = __builtin_amdgcn_permlane32_swap(__float_as_uint(pmax), __float_as_uint(pmax), false, false);
      pmax = fmaxf(__uint_as_float(rr[0]), __uint_as_float(rr[1])); }
    if (__builtin_expect(__all((pmax - m_reg) <= THR2), 1)) { mn = m_reg; alpha = 1.f; }
    else { mn = fmaxf(m_reg, pmax); alpha = __builtin_amdgcn_exp2f(m_reg - mn); m_reg = mn; }
#pragma unroll
    for (int r = 0; r < 16; ++r) p0[r] = p0[r] - mn;
#pragma unroll
    for (int r = 0; r < 16; ++r) p1[r] = p1[r] - mn;
#pragma unroll
    for (int r = 0; r < 16; ++r) p0[r] = __builtin_amdgcn_exp2f(p0[r]);
}
__device__ __forceinline__ void finishSM(f32x16& p0, f32x16& p1, float alpha, float& l_reg, bf16x8& pa0, bf16x8& pa1, bf16x8& pa2, bf16x8& pa3) {
#pragma unroll
    for (int r = 0; r < 16; ++r) p1[r] = __builtin_amdgcn_exp2f(p1[r]);
    float ps = 0;
#pragma unroll
    for (int r = 0; r < 16; ++r) ps += p0[r];
#pragma unroll
    for (int r = 0; r < 16; ++r) ps += p1[r];
    { auto rr = __builtin_amdgcn_permlane32_swap(__float_as_uint(ps), __float_as_uint(ps), false, false);
      ps = __uint_as_float(rr[0]) + __uint_as_float(rr[1]); }
    l_reg = l_reg * alpha + ps;
#define PK4(P, B_, OUT) do { unsigned a0 = cvtpk(P[B_+0], P[B_+1]), a1 = cvtpk(P[B_+2], P[B_+3]);                          \
        unsigned b0 = cvtpk(P[B_+4], P[B_+5]), b1 = cvtpk(P[B_+6], P[B_+7]);                                             \
        auto r0 = __builtin_amdgcn_permlane32_swap(a0, b0, false, false); auto r1 = __builtin_amdgcn_permlane32_swap(a1, b1, false, false); \
        u32x4 w = {r0[0], r1[0], r0[1], r1[1]}; OUT = *reinterpret_cast<bf16x8*>(&w); } while (0)
    PK4(p0, 0, pa0); PK4(p0, 8, pa1); PK4(p1, 0, pa2); PK4(p1, 8, pa3);
#undef PK4
}
template <int KB>
__device__ __forceinline__ void qkt(f32x16& p0, f32x16& p1, const char* K_lds, const float* fl, int r32, int hi, const bf16x8* qr) {
    { const f32x4 a0 = *(const f32x4*)(fl), a1 = *(const f32x4*)(fl + 8), a2 = *(const f32x4*)(fl + 16), a3 = *(const f32x4*)(fl + 24);
      const f32x4 b0 = *(const f32x4*)(fl + 32), b1 = *(const f32x4*)(fl + 40), b2 = *(const f32x4*)(fl + 48), b3 = *(const f32x4*)(fl + 56);
      p0 = (f32x16){a0[0], a0[1], a0[2], a0[3], a1[0], a1[1], a1[2], a1[3], a2[0], a2[1], a2[2], a2[3], a3[0], a3[1], a3[2], a3[3]};
      p1 = (f32x16){b0[0], b0[1], b0[2], b0[3], b1[0], b1[1], b1[2], b1[3], b2[0], b2[1], b2[2], b2[3], b3[0], b3[1], b3[2], b3[3]}; }
    const char* kb[4];
#pragma unroll
    for (int dd = 0; dd < 4; ++dd) kb[dd] = K_lds + KB * SHM_K + KSWZ(r32, (dd * 16 + hi * 8) * 2);
#pragma unroll
    for (int d0 = 0; d0 < 8; ++d0) { const char* a = kb[d0 & 3] + (d0 >> 2) * 128;
        bf16x8 b0 = *reinterpret_cast<const bf16x8*>(a);
        bf16x8 b1 = *reinterpret_cast<const bf16x8*>(a + 32 * 256);
        p0 = __builtin_amdgcn_mfma_f32_32x32x16_bf16(b0, qr[d0], p0, 0, 0, 0);
        p1 = __builtin_amdgcn_mfma_f32_32x32x16_bf16(b1, qr[d0], p1, 0, 0, 0); }
}
template <int VB>
__device__ __forceinline__ void pv_tile(f32x16* o, int vb0, bf16x8 pa0, bf16x8 pa1, bf16x8 pa2, bf16x8 pa3) {
#define TRRD(dst, off) asm volatile("ds_read_b64_tr_b16 %0, %1 offset:%2" : "=&v"(dst) : "v"(vb0), "i"(off) : "memory")
#define PV_D0(d0) do { s16x4 l0, l1, l2, l3, h0, h1, h2, h3; constexpr int b_ = VB * SHM_V + v_rd_off(d0, 0, 0);   \
        TRRD(l0, b_); TRRD(h0, b_ + 2048); TRRD(l1, b_ + 4096); TRRD(h1, b_ + 6144); TRRD(l2, b_ + 8192); TRRD(h2, b_ + 10240); TRRD(l3, b_ + 12288); TRRD(h3, b_ + 14336); \
        asm volatile("s_waitcnt lgkmcnt(0)" ::: "memory"); SBAR();   \
        o[d0] = __builtin_amdgcn_mfma_f32_32x32x16_bf16(pa0, (bf16x8){l0[0], l0[1], l0[2], l0[3], h0[0], h0[1], h0[2], h0[3]}, o[d0], 0, 0, 0);   \
        o[d0] = __builtin_amdgcn_mfma_f32_32x32x16_bf16(pa1, (bf16x8){l1[0], l1[1], l1[2], l1[3], h1[0], h1[1], h1[2], h1[3]}, o[d0], 0, 0, 0);   \
        o[d0] = __builtin_amdgcn_mfma_f32_32x32x16_bf16(pa2, (bf16x8){l2[0], l2[1], l2[2], l2[3], h2[0], h2[1], h2[2], h2[3]}, o[d0], 0, 0, 0);   \
        o[d0] = __builtin_amdgcn_mfma_f32_32x32x16_bf16(pa3, (bf16x8){l3[0], l3[1], l3[2], l3[3], h3[0], h3[1], h3[2], h3[3]}, o[d0], 0, 0, 0); } while (0)
    PV_D0(0); PV_D0(1); PV_D0(2); PV_D0(3);
#undef PV_D0
#undef TRRD
}
struct Tensors { const bf16_t* q; const bf16_t* k; const bf16_t* v; bf16_t* og; const bf16_t* sg; const float* lft; };
struct BlockRef { unsigned q0, s0; int P0, jlo; };
struct Seam { bf16x8 qr[8]; bf16x8 st_v0, st_v1, st_k0, st_k1; };
#define ROWP(p, k0) ((p) + (unsigned)(k0) * (unsigned)LD)
#define VMW() asm volatile("s_waitcnt vmcnt(0)" ::: "memory")
#define VMWN(n) asm volatile("s_waitcnt vmcnt(%0)" :: "i"(n) : "memory")
#define LD8(p) (*reinterpret_cast<const bf16x8*>(p))
#define SLOAD_H(Kp, Vp, k0) do { S.st_v0 = LD8(ROWP(Vp, k0) + voff); S.st_v1 = LD8(ROWP(Vp, (k0) + 32) + voff);              \
                         S.st_k0 = LD8(ROWP(Kp, k0) + voff); S.st_k1 = LD8(ROWP(Kp, (k0) + 32) + voff); } while (0)
#define SWRITE_HK(bf) do { *(bf16x8*)(K_lds + (bf) * SHM_K + kws) = S.st_k0; *(bf16x8*)(K_lds + (bf) * SHM_K + kws + 32 * 256) = S.st_k1; } while (0)
#define SWRITE_HV(bf) do { *(bf16x8*)(V_lds + (bf) * SHM_V + vst0) = S.st_v0; *(bf16x8*)(V_lds + (bf) * SHM_V + vst0 + VST1) = S.st_v1; } while (0)
#define SWRITE_H(bf) do { SWRITE_HV(bf); SWRITE_HK(bf); } while (0)
__device__ __forceinline__ void prime(int wv, const Tensors& T, const BlockRef& cur, char* lds, Seam& S) {
    const int tid = otid(wv), wid = __builtin_amdgcn_readfirstlane(tid >> 6), lane = tid & 63, r32 = lane & 31, hi = lane >> 5;
    const int sr = tid >> 4, sc = (tid & 15) * 8, kws = KSWZ(sr, sc * 2); char* K_lds = lds + 2 * SHM_V;
    const unsigned voff = (unsigned)sr * LD + sc, qoff = (unsigned)(wid * QBLK + r32) * LD + hi * 8;
    const bf16_t* Qp = T.q + cur.q0; const bf16_t* Kh = T.k + cur.s0; const bf16_t* Vh = T.v + cur.s0;
#pragma unroll
    for (int d0 = 0; d0 < 8; ++d0) S.qr[d0] = LD8(Qp + qoff + d0 * 16);
    SLOAD_H(Kh, Vh, cur.jlo * KVBLK); VMW(); SWRITE_HK(0);
    __syncthreads();
}
__device__ __forceinline__ void block(int wv, const Tensors& T, const BlockRef& cur, const BlockRef& nxt, char* lds, Seam& S) {
    const int tid = otid(wv), wid = __builtin_amdgcn_readfirstlane(tid >> 6), lane = tid & 63, r32 = lane & 31, hi = lane >> 5;
    const int j_lo = cur.jlo, NT = (cur.P0 + QB) / KVBLK - j_lo;
    const int qlo = cur.P0 - j_lo * KVBLK + wid * QBLK, qm = qlo + r32 - 4 * hi;
    char* V_lds = lds; char* K_lds = lds + 2 * SHM_V;
    float* wsl = (float*)(lds + OFF_WS) + wid * 64; float* li_l = wsl, * al_l = wsl + 32;
    float* Fl = (float*)(lds + OFF_F);
    float m_reg = -1e30f, l_reg = 0; f32x16 o[4] = {};
    const int sr = tid >> 4, sc = (tid & 15) * 8, vst0 = v_st(sr, sc), kws = KSWZ(sr, sc * 2); constexpr int VST1 = 8192;
    const int vb0 = (int)(uintptr_t)V_lds + v_rd_base(lane);
    const bf16_t* Kh = T.k + cur.s0 + (unsigned)(j_lo * KVBLK) * LD; const bf16_t* Vh = T.v + cur.s0 + (unsigned)(j_lo * KVBLK) * LD;
    const unsigned voff = (unsigned)sr * LD + sc, qoff = (unsigned)(wid * QBLK + r32) * LD + hi * 8;
    const float* flb = Fl + j_lo * KVBLK + 4 * hi;
#define RESC(a) do { if (__any((a) < 1.f)) { if (hi == 0) al_l[r32] = (a); asm volatile("s_waitcnt lgkmcnt(0)" ::: "memory");              \
                     for (int d_ = 0; d_ < 4; ++d_) for (int r = 0; r < 16; ++r) o[d_][r] *= al_l[crow(r, hi)]; } } while (0)
#define KBASE(t) ((t) * KVBLK)
#define MASKT(P0_, P1_, t) do { const int kb_ = KBASE(t); if (kb_ + KVBLK - 1 > qlo) mask_tile(P0_, P1_, qm - kb_); } while (0)
#define SEAM_K0() do { VMWN(8); SWRITE_HK(0); SBAR(); } while (0)
    f32x16 pA0, pA1, pB0, pB1; float mnA, mnB, alA, alB; bf16x8 pa0, pa1, pa2, pa3;
    SWRITE_HV(0); SBAR();
    if (NT > 1) { SLOAD_H(Kh, Vh, KBASE(1)); }
    SBAR(); qkt<0>(pA0, pA1, K_lds, flb + KBASE(0), r32, hi, S.qr);
    MASKT(pA0, pA1, 0); partialSM(pA0, pA1, m_reg, mnA, alA);
    if (NT > 1) { VMW(); SWRITE_H(1); }
    __syncthreads();
#define HALF_STEP(PX0, PX1, mnX, alX, PY0, PY1, alY, t, KB, VB, SB) do {                                                      \
        SBAR(); qkt<KB>(PX0, PX1, K_lds, flb + KBASE(t), r32, hi, S.qr);                                             \
        finishSM(PY0, PY1, alY, l_reg, pa0, pa1, pa2, pa3); SBAR();                                                           \
        if ((t) + 1 < NT) { SLOAD_H(Kh, Vh, KBASE((t) + 1)); SBAR(); }                                               \
        pv_tile<VB>(o, vb0, pa0, pa1, pa2, pa3); MASKT(PX0, PX1, (t)); partialSM(PX0, PX1, m_reg, mnX, alX);                                        \
        __syncthreads();                                                                                                      \
        if ((t) + 1 < NT) { VMW(); SWRITE_H(SB); }                                                                          \
        RESC(alX); __syncthreads(); } while (0)
    for (int t = 1; t + 1 < NT; t += 2) {
        HALF_STEP(pB0, pB1, mnB, alB, pA0, pA1, alA, t, 1, 0, 0);
        HALF_STEP(pA0, pA1, mnA, alA, pB0, pB1, alB, t + 1, 0, 1, 1);
    }
    const bool even = (NT & 1) == 0;
    if (even) { SBAR(); qkt<1>(pB0, pB1, K_lds, flb + KBASE(NT - 1), r32, hi, S.qr); SBAR(); }
    { const bf16_t* Kn = T.k + nxt.s0; const bf16_t* Vn = T.v + nxt.s0; SLOAD_H(Kn, Vn, nxt.jlo * KVBLK); } SBAR();
    { const bf16_t* Qn = T.q + nxt.q0;
#pragma unroll
      for (int d0 = 0; d0 < 8; ++d0) S.qr[d0] = LD8(Qn + qoff + d0 * 16); }
    SBAR();
    finishSM(pA0, pA1, alA, l_reg, pa0, pa1, pa2, pa3); SBAR();
    pv_tile<0>(o, vb0, pa0, pa1, pa2, pa3);
    if (even) { MASKT(pB0, pB1, NT - 1); partialSM(pB0, pB1, m_reg, mnB, alB); __syncthreads(); RESC(alB);
        finishSM(pB0, pB1, alB, l_reg, pa0, pa1, pa2, pa3); SBAR(); pv_tile<1>(o, vb0, pa0, pa1, pa2, pa3); }
    SBAR(); SEAM_K0();
    if (hi == 0) li_l[r32] = l_reg; asm volatile("s_waitcnt lgkmcnt(0)" ::: "memory");
    float rli[16];
#pragma unroll
    for (int r = 0; r < 16; ++r) rli[r] = __builtin_amdgcn_rcpf(li_l[crow(r, hi)]);
    { const unsigned eoff = (unsigned)(4 * hi) * LD + r32;
      unsigned gg[16][4];
#pragma unroll
      for (int r = 0; r < 16; ++r) { const bf16_t* Grow = T.sg + cur.q0 + (unsigned)(wid * QBLK + (r & 3) + 8 * (r >> 2)) * LD;
#pragma unroll
        for (int d0 = 0; d0 < 4; ++d0) gg[r][d0] = *(const unsigned*)(Grow + (eoff & ~1u) + d0 * 32); }
#pragma unroll
      for (int r = 0; r < 16; ++r) { bf16_t* Orow = T.og + cur.q0 + (unsigned)(wid * QBLK + (r & 3) + 8 * (r >> 2)) * LD;
#pragma unroll
        for (int d0 = 0; d0 < 4; ++d0) { const float v = o[d0][r] * rli[r];
            const float vn = __shfl_xor(v, 1);
            if ((r32 & 1) == 0) *(unsigned*)(Orow + eoff + d0 * 32) = cvtpk(v * bflo(gg[r][d0]), vn * bfhi(gg[r][d0])); } } }
    __syncthreads();
#undef RESC
#undef KBASE
#undef MASKT
#undef SEAM_K0
#undef HALF_STEP
}
#undef ROWP
#undef VMW
#undef VMWN
#undef SLOAD_H
#undef SWRITE_HK
#undef SWRITE_HV
#undef SWRITE_H
#undef LD8

__device__ __forceinline__ BlockRef mkref(int bh, int qb) {
    const int b = bh >> 4, h = bh & 15; BlockRef r; r.s0 = (unsigned)b * SEQ * LD + h * D; r.q0 = r.s0 + (unsigned)qb * QB * LD; r.jlo = 0; r.P0 = qb * QB; return r;
}
__device__ __forceinline__ void item_setup(int wv, const Tensors& T, const float* knrm, const float* qnrm, int bh, unsigned blks, int nb, char* lds) {
    const int tid = otid(wv), wid = __builtin_amdgcn_readfirstlane(tid >> 6), lane = tid & 63;
    float* Fl = (float*)(lds + OFF_F); float* scn = (float*)(lds + OFF_SC); float* Kt = (float*)(lds + OFF_KT); float* Qm = (float*)(lds + OFF_QM); int* JL = (int*)(lds + OFF_JL);
    const int b = bh >> 4, h = bh & 15, xmax = (int)((blks >> (4 * (nb - 1))) & 15u), nkeys = (xmax + 1) * QB, t0 = tid * 8;
    const float* LF = T.lft + (size_t)bh * SEQ;
    f32x4 a = {0.f, 0.f, 0.f, 0.f}, c = {0.f, 0.f, 0.f, 0.f};
    float kmx = 0.f;
    if (t0 < nkeys) { a = *(const f32x4*)(LF + t0); c = *(const f32x4*)(LF + t0 + 4);
        const float* kn = knrm + ((size_t)(b * SEQ + t0) * NH + h) * 4;
#pragma unroll
        for (int i = 0; i < 8; ++i) { const f32x4 p = *(const f32x4*)(kn + (size_t)i * NH * 4); kmx = fmaxf(kmx, (p[0] + p[1]) + (p[2] + p[3])); } }
    kmx = fmaxf(kmx, bperm(kmx, lane ^ 1)); kmx = fmaxf(kmx, bperm(kmx, lane ^ 2)); kmx = fmaxf(kmx, bperm(kmx, lane ^ 4));
    if ((tid & 7) == 0 && t0 < nkeys) Kt[tid >> 3] = sqrtf(kmx) * 1.01f;
#pragma unroll 1
    for (int bi = 0; bi < nb; bi += 2) { const int bsel = bi + (tid >> 8);
        if (bsel < nb) { const int x = (int)((blks >> (4 * bsel)) & 15u), qrow = b * SEQ + x * QB + (tid & 255);
            const f32x4 p = *(const f32x4*)(qnrm + ((size_t)qrow * NH + h) * 4); float qm = (p[0] + p[1]) + (p[2] + p[3]);
#pragma unroll
            for (int o = 1; o < 64; o <<= 1) qm = fmaxf(qm, bperm(qm, lane ^ o));
            if (lane == 0) Qm[bsel * 4 + (wid & 3)] = qm; } }
    a[1] += a[0]; a[2] += a[1]; a[3] += a[2]; c[0] += a[3]; c[1] += c[0]; c[2] += c[1]; c[3] += c[2];
    const float tot = c[3]; float inc = tot;
#pragma unroll
    for (int o = 1; o < 64; o <<= 1) { const float v = bperm(inc, (lane - o) & 63); if (lane >= o) inc += v; }
    if (lane == 63) scn[wid] = inc;
    if (tid < nb) JL[tid] = (int)((blks >> (4 * tid)) & 15u) * 4;
    __syncthreads();
    float base = inc - tot;
    for (int w = 0; w < wid; ++w) base += scn[w];
    a = (a + base) * (-LOG2E); c = (c + base) * (-LOG2E);
    if (t0 < nkeys) { *(f32x4*)(Fl + t0) = a; *(f32x4*)(Fl + t0 + 4) = c; }
    __syncthreads();
    { const int which = tid >> 6, j = tid & 63;
      if (which < nb) { const int x = (int)((blks >> (4 * which)) & 15u), nd = x * 4;
        if (j < nd) { const float qmax = sqrtf(fmaxf(fmaxf(Qm[which * 4], Qm[which * 4 + 1]), fmaxf(Qm[which * 4 + 2], Qm[which * 4 + 3]))) * 1.01f;
            const float kdiag = fmaxf(fmaxf(Kt[nd], Kt[nd + 1]), fmaxf(Kt[nd + 2], Kt[nd + 3]));
            const bool skip = qmax * (Kt[j] + kdiag) + Fl[64 * j + 63] - Fl[x * QB] < -SKIP_T;
            if (!skip) atomicMin(JL + which, j); } } }
    __syncthreads();
}
__device__ __forceinline__ void prompt_phase(int wv, char* lds, const Tensors& T, const float* knrm, const float* qnrm, int pw) {
    const int bh = pw / 3, gsel = pw - bh * 3;
    const unsigned blks = gsel == 0 ? 0xDA742u : (gsel == 1 ? 0xEB8510u : 0xFC963u); const int nb = gsel == 1 ? 6 : 5;
    item_setup(wv, T, knrm, qnrm, bh, blks, nb, lds);
    const int* JL = (const int*)(lds + OFF_JL);
    Seam S;
    BlockRef cur = mkref(bh, (int)(blks & 15u)); cur.jlo = __builtin_amdgcn_readfirstlane(JL[0]);
    prime(wv, T, cur, lds, S);
#pragma unroll 1
    for (int i = 0; i < nb; ++i) { const int in = i + 1 < nb ? i + 1 : i;
        BlockRef nxt = mkref(bh, (int)((blks >> (4 * in)) & 15u)); nxt.jlo = __builtin_amdgcn_readfirstlane(JL[in]);
        block(wv, T, cur, nxt, lds, S);
        cur = nxt; }
}
}

namespace sat {
constexpr int OFF_F = 0, OFF_SC = 8448, OFF_P = 8704, OFF_A = OFF_P + 8 * 4096, OFF_ML = OFF_A + 512, OFF_O = OFF_ML + 1024;
struct Tensors { const bf16_t* q; const bf16_t* kb; const bf16_t* vb; bf16_t* og; const bf16_t* sg; const float* ck; const float* cv; const float* clf; const float* lfts; };
__device__ __forceinline__ void item(int wv, char* lds, const Tensors& T, int b, int h) {
    const int tid = otid(wv), wid = __builtin_amdgcn_readfirstlane(tid >> 6), lane = tid & 63, fr = lane & 15, fq = lane >> 4;
    float* Fl = (float*)(lds + OFF_F); float* scn = (float*)(lds + OFF_SC);
    float* ML = (float*)(lds + OFF_ML); float* Op = (float*)(lds + OFF_O);
    { const float* cl = T.clf + ((size_t)b * PAST + tid * 4) * NH + h;
      float a0 = cl[0], a1 = cl[NH], a2 = cl[2 * NH], a3 = cl[3 * NH];
      a1 += a0; a2 += a1; a3 += a2;
      const float tot = a3; float inc = tot;
#pragma unroll
      for (int o = 1; o < 64; o <<= 1) { const float v = bperm(inc, (lane - o) & 63); if (lane >= o) inc += v; }
      if (lane == 63) scn[wid] = inc;
      __syncthreads();
      float base = inc - tot, all = 0.f;
      for (int w = 0; w < 8; ++w) { const float sw = scn[w]; if (w < wid) base += sw; all += sw; }
      *(f32x4*)(Fl + tid * 4) = (f32x4){(a0 + base) * (-LOG2E), (a1 + base) * (-LOG2E), (a2 + base) * (-LOG2E), (a3 + base) * (-LOG2E)};
      if (tid < DSEQ) { const float* nl = T.lfts + ((size_t)b * NH + h) * DSEQ; float s = all; for (int i = 0; i <= tid; ++i) s += nl[i]; Fl[PAST + tid] = s * (-LOG2E); }
      __syncthreads(); }
    const size_t qrow = (size_t)(MP + b * DSEQ);
    bf16x8 qf[4];
#pragma unroll
    for (int dc = 0; dc < 4; ++dc) qf[dc] = *(const bf16x8*)(T.q + (qrow + fr) * DM + h * HD + dc * 32 + fq * 8);
    float m_run = -1e30f, l_run = 0.f;
    f32x4 ot[8];
#pragma unroll
    for (int dt = 0; dt < 8; ++dt) ot[dt] = (f32x4){0.f, 0.f, 0.f, 0.f};
    const unsigned vlo = (unsigned)(fq * 4) * (NH * HD) + fr;
    for (int ch = 0; ch < 4; ++ch) {
        const int key0 = (ch * 8 + wid) * 64;
        f32x4 s4[4];
        { f32x4 kk[4][4][2];
#pragma unroll
          for (int tl = 0; tl < 4; ++tl) { const float* kp = T.ck + (((size_t)b * PAST + key0 + tl * 16 + fr) * NH + h) * HD + fq * 8;
#pragma unroll
            for (int dc = 0; dc < 4; ++dc) { kk[tl][dc][0] = *(const f32x4*)(kp + dc * 32); kk[tl][dc][1] = *(const f32x4*)(kp + dc * 32 + 4); } }
          __builtin_amdgcn_sched_barrier(0);
#pragma unroll
          for (int tl = 0; tl < 4; ++tl) { f32x4 acc = *(const f32x4*)(Fl + key0 + tl * 16 + fq * 4);
#pragma unroll
            for (int dc = 0; dc < 4; ++dc) acc = __builtin_amdgcn_mfma_f32_16x16x32_bf16(pack8(kk[tl][dc][0], kk[tl][dc][1]), qf[dc], acc, 0, 0, 0);
            s4[tl] = acc; } }
        __builtin_amdgcn_sched_barrier(0);
        float vv[2][8][8];
        { const float* vb_c = T.cv + (((size_t)b * PAST + key0) * NH + h) * HD;
#pragma unroll
          for (int hf = 0; hf < 2; ++hf)
#pragma unroll
            for (int dt = 0; dt < 8; ++dt)
#pragma unroll
                for (int i = 0; i < 4; ++i) { vv[hf][dt][i] = (vb_c + (size_t)(hf * 32 + i) * (NH * HD) + dt * 16)[vlo]; vv[hf][dt][4 + i] = (vb_c + (size_t)(hf * 32 + 16 + i) * (NH * HD) + dt * 16)[vlo]; } }
        float cm = s4[0][0];
#pragma unroll
        for (int tl = 0; tl < 4; ++tl)
#pragma unroll
            for (int j = 0; j < 4; ++j) cm = fmaxf(cm, s4[tl][j]);
        cm = xmax16(cm); cm = xmax32(cm);
        const float mn = fmaxf(m_run, cm), alpha = __builtin_amdgcn_exp2f(m_run - mn); m_run = mn;
        float ps = 0.f;
#pragma unroll
        for (int tl = 0; tl < 4; ++tl)
#pragma unroll
            for (int j = 0; j < 4; ++j) { s4[tl][j] = __builtin_amdgcn_exp2f(s4[tl][j] - mn); ps += s4[tl][j]; }
        ps = xsum16(ps); ps = xsum32(ps);
        l_run = l_run * alpha + ps;
#pragma unroll
        for (int dt = 0; dt < 8; ++dt) ot[dt] *= alpha;
#pragma unroll
        for (int hf = 0; hf < 2; ++hf) {
            const bf16x8 pb = pack8(s4[2 * hf], s4[2 * hf + 1]);
#pragma unroll
            for (int dt = 0; dt < 8; ++dt) { const f32x4 v0 = {vv[hf][dt][0], vv[hf][dt][1], vv[hf][dt][2], vv[hf][dt][3]}, v1 = {vv[hf][dt][4], vv[hf][dt][5], vv[hf][dt][6], vv[hf][dt][7]};
                ot[dt] = __builtin_amdgcn_mfma_f32_16x16x32_bf16(pack8(v0, v1), pb, ot[dt], 0, 0, 0); } }
    }
    if (wid == 0) {
        f32x4 acc = *(const f32x4*)(Fl + PAST + fq * 4);
        const bf16_t* kp = T.kb + (qrow + fr) * DM + h * HD + fq * 8;
#pragma unroll
        for (int dc = 0; dc < 4; ++dc) acc = __builtin_amdgcn_mfma_f32_16x16x32_bf16(*(const bf16x8*)(kp + dc * 32), qf[dc], acc, 0, 0, 0);
#pragma unroll
        for (int j = 0; j < 4; ++j) if (fq * 4 + j > fr) acc[j] = -__builtin_inff();
        float cm = fmaxf(fmaxf(acc[0], acc[1]), fmaxf(acc[2], acc[3]));
        cm = xmax16(cm); cm = xmax32(cm);
        const float mn = fmaxf(m_run, cm), alpha = __builtin_amdgcn_exp2f(m_run - mn); m_run = mn;
        float ps = 0.f;
#pragma unroll
        for (int j = 0; j < 4; ++j) { acc[j] = __builtin_amdgcn_exp2f(acc[j] - mn); ps += acc[j]; }
        ps = xsum16(ps); ps = xsum32(ps);
        l_run = l_run * alpha + ps;
        const bf16x8 pb = pack8(acc, (f32x4){0.f, 0.f, 0.f, 0.f});
        const bf16_t* vb_u = T.vb + qrow * DM + h * HD; const unsigned vlo2 = (unsigned)(fq * 4) * DM + fr;
#pragma unroll
        for (int dt = 0; dt < 8; ++dt) { ot[dt] *= alpha;
            unsigned w0 = (unsigned)(vb_u + dt * 16)[vlo2] | ((unsigned)(vb_u + DM + dt * 16)[vlo2] << 16), w1 = (unsigned)(vb_u + 2 * DM + dt * 16)[vlo2] | ((unsigned)(vb_u + 3 * DM + dt * 16)[vlo2] << 16);
            u32x4 w = {w0, w1, 0u, 0u};
            ot[dt] = __builtin_amdgcn_mfma_f32_16x16x32_bf16(*reinterpret_cast<bf16x8*>(&w), pb, ot[dt], 0, 0, 0); }
    }
#pragma unroll
    for (int dt = 0; dt < 8; ++dt) *(f32x4*)(Op + (wid * 16 + fr) * HD + dt * 16 + fq * 4) = ot[dt];
    if (fq == 0) { ML[(wid * 16 + fr) * 2] = m_run; ML[(wid * 16 + fr) * 2 + 1] = l_run; }
    __syncthreads();
    { const int q = tid >> 5, d4 = (tid & 31) * 4;
      float mx = ML[q * 2];
#pragma unroll
      for (int w = 1; w < 8; ++w) mx = fmaxf(mx, ML[(w * 16 + q) * 2]);
      float L = 0.f; f32x4 O = {0.f, 0.f, 0.f, 0.f};
#pragma unroll
      for (int w = 0; w < 8; ++w) { const float s = __builtin_amdgcn_exp2f(ML[(w * 16 + q) * 2] - mx); L += s * ML[(w * 16 + q) * 2 + 1]; O += *(const f32x4*)(Op + (w * 16 + q) * HD + d4) * s; }
      const float il = 1.0f / L; const size_t off = (qrow + q) * DM + h * HD + d4;
      const u32x2 gw = *(const u32x2*)(T.sg + off);
      u32x2 w; w.x = cvtpk(O[0] * il * bflo(gw.x), O[1] * il * bfhi(gw.x)); w.y = cvtpk(O[2] * il * bflo(gw.y), O[3] * il * bfhi(gw.y));
      *(u32x2*)(T.og + off) = w; }
    __syncthreads();
}
}

struct TrV { f32x4 v[8]; };
__device__ __forceinline__ void tr_load(const float* W, int ldw, int N, const float* g, int item, int lane, TrV& t) {
    const int nblk = (N + 31) / 32, kb = item / nblk, nb = item % nblk, k0 = 64 * kb, n0 = 32 * nb;
    const int c4 = (lane & 7) * 4, kr = lane >> 3; const bool nok = n0 + c4 < N;
#pragma unroll
    for (int i = 0; i < 8; ++i) t.v[i] = nok ? *(const f32x4*)(W + (size_t)(k0 + 8 * i + kr) * ldw + n0 + c4) : (f32x4){0.f, 0.f, 0.f, 0.f};
    if (g) {
#pragma unroll
        for (int i = 0; i < 8; ++i) t.v[i] *= g[k0 + 8 * i + kr]; }
}
__device__ __forceinline__ void tr_emit(int N, bf16_t* WT, int K, float* scr, int item, int lane, const TrV& t) {
    const int nblk = (N + 31) / 32, kb = item / nblk, nb = item % nblk, k0 = 64 * kb, n0 = 32 * nb;
    const int c4 = (lane & 7) * 4, kr = lane >> 3;
#pragma unroll
    for (int i = 0; i < 8; ++i) { float* s = scr + (8 * i + kr) * 33 + c4; s[0] = t.v[i][0]; s[1] = t.v[i][1]; s[2] = t.v[i][2]; s[3] = t.v[i][3]; }
    asm volatile("s_waitcnt lgkmcnt(0)" ::: "memory");
    const int c = lane & 7;
#pragma unroll
    for (int j = 0; j < 4; ++j) { const int nn = (lane >> 3) + 8 * j; const float* s = scr + (8 * c) * 33 + nn;
        u32x4 o; o.x = cvtpk(s[0 * 33], s[1 * 33]); o.y = cvtpk(s[2 * 33], s[3 * 33]); o.z = cvtpk(s[4 * 33], s[5 * 33]); o.w = cvtpk(s[6 * 33], s[7 * 33]);
        if (n0 + nn < N) *(u32x4*)(WT + (size_t)(n0 + nn) * K + k0 + 8 * c) = o; }
    asm volatile("s_waitcnt lgkmcnt(0)" ::: "memory");
}
struct TJob { const float* W; bf16_t* WT; const float* g; int K, N, ldw; };
__device__ __forceinline__ TJob get_job(const Params& p, int j) {
    unsigned char* ws = p.ws; TJob t; t.g = nullptr; t.ldw = 0;
    if (j < 2) { t.W = p.in[7] + (size_t)j * DM * 2 * EA + EA; t.WT = (bf16_t*)(ws + WS_WINA) + (size_t)j * 2 * EA * DM + (size_t)EA * DM; t.g = p.in[6] + j * DM; t.K = DM; t.N = EA; t.ldw = 2 * EA; }
    else if (j >= 17) { const int l = j - 17; t.W = p.in[7] + (size_t)l * DM * 2 * EA; t.WT = (bf16_t*)(ws + WS_WINUT) + (size_t)l * EA * DM; t.g = p.in[6] + l * DM; t.K = DM; t.N = EA; t.ldw = 2 * EA; }
    else if (j < 10) { const int i = j - 2; t.W = p.in[8] + (size_t)i * 1024 * 1024; t.WT = (bf16_t*)(ws + WS_WGRP) + (size_t)i * 1024 * 1024; t.K = 1024; t.N = 1024; }
    else if (j < 12) { const int l = j - 10; t.W = p.in[10] + (size_t)l * EA * DM; t.WT = (bf16_t*)(ws + WS_WOUTA) + (size_t)l * DM * EA; t.K = EA; t.N = DM; }
    else if (j == 12) { t.W = p.in[12]; t.WT = (bf16_t*)(ws + WS_W4); t.g = p.in[11]; t.K = DM; t.N = 2 * DM + NH; }
    else if (j == 13) { t.W = p.in[15]; t.WT = (bf16_t*)(ws + WS_W4) + (size_t)4352 * DM; t.g = p.in[14]; t.K = DM; t.N = 2 * DM; }
    else if (j == 14) { t.W = p.in[15] + (size_t)DM * 2 * DM; t.WT = (bf16_t*)(ws + WS_WINB1); t.g = p.in[14] + DM; t.K = DM; t.N = 2 * DM; }
    else { const int l = j - 15; t.W = p.in[16] + (size_t)l * DM * DM; t.WT = (bf16_t*)(ws + WS_WOUTB) + (size_t)l * DM * DM; t.K = DM; t.N = DM; }
    if (t.ldw == 0) t.ldw = t.N;
    return t;
}
__device__ __forceinline__ void prologue_phase(int wv, const Params& p, char* lds) {
    const int tid = otid(wv), lane = tid & 63, wid = tid >> 6, G = gridDim.x;
    const int gw = blockIdx.x * NWAVES + wid, NGW = G * NWAVES;
    float* scr = (float*)(lds + wid * 8704);
    int rot = 0;
    for (int j = 0; j < 19; ++j) { const TJob t = get_job(p, j); const int nitems = (t.K / 64) * ((t.N + 31) / 32);
        int start = gw - rot; if (start < 0) start += NGW;
        TrV cur_v, nxt_v;
        if (start < nitems) tr_load(t.W, t.ldw, t.N, t.g, start, lane, cur_v);
        for (int it = start; it < nitems; it += NGW) { const bool more = it + NGW < nitems;
            if (more) tr_load(t.W, t.ldw, t.N, t.g, it + NGW, lane, nxt_v);
            tr_emit(t.N, t.WT, t.K, scr, it, lane, cur_v);
            if (more) {
#pragma unroll
                for (int i = 0; i < 8; ++i) cur_v.v[i] = nxt_v.v[i]; } }
        rot = (rot + nitems) % NGW; }
    float* ssq = (float*)(p.ws + WS_SSQ); bf16_t* xb = (bf16_t*)(p.ws + WS_XB);
    for (int m = gw; m < MT; m += NGW) { const float* xr = m < MP ? p.in[0] + (size_t)m * DM : p.in[1] + (size_t)(m - MP) * DM;
        float s = 0.f; unsigned long long* o8 = (unsigned long long*)(xb + (size_t)m * DM) + lane;
        f32x4 xv[8];
#pragma unroll
        for (int j = 0; j < 8; ++j) xv[j] = *((const f32x4*)xr + lane + 64 * j);
#pragma unroll
        for (int j = 0; j < 8; ++j) { const f32x4 v = xv[j]; s += (v[0] * v[0] + v[1] * v[1]) + (v[2] * v[2] + v[3] * v[3]);
            o8[64 * j] = (unsigned long long)cvtpk(v[0], v[1]) | ((unsigned long long)cvtpk(v[2], v[3]) << 32); }
        s = wave_sum(s); if (lane == 0) ssq[m] = s; }
    for (int i = blockIdx.x * NTHREADS + tid; i < 4 * MT; i += G * NTHREADS) ssq[MT + i] = 0.f;
    { f32x4* z = (f32x4*)(p.ws + WS_SPLIT); const size_t nz = (SPLIT_TILES * SPLIT_TILE + SPLIT_TILES * 8 * 4) / 16;
      for (size_t i = (size_t)blockIdx.x * NTHREADS + tid; i < nz; i += (size_t)G * NTHREADS) z[i] = (f32x4){0.f, 0.f, 0.f, 0.f}; }
    if (blockIdx.x == 0) { unsigned* bw = (unsigned*)(p.ws + WS_BAR); for (int i = tid; i < 3456; i += NTHREADS) bw[i] = 0u; }
    { bf16_t* wus = (bf16_t*)(p.ws + WS_WINUS);
      const int nth_ = G * NTHREADS;
      for (int i0 = blockIdx.x * NTHREADS + tid; i0 < 2 * DM * (EA / 8); i0 += 4 * nth_) {
          f32x4 av[4], bv[4]; float gk[4];
#pragma unroll
          for (int u = 0; u < 4; ++u) { const int i = i0 + u * nth_; if (i < 2 * DM * (EA / 8)) { const int r = i >> 9, c = (i & 511) * 8, l = r >> 11, k = r & (DM - 1);
              const float* s = p.in[7] + ((size_t)l * DM + k) * 2 * EA + c; av[u] = *(const f32x4*)s; bv[u] = *(const f32x4*)(s + 4); gk[u] = p.in[6][l * DM + k]; } }
#pragma unroll
          for (int u = 0; u < 4; ++u) { const int i = i0 + u * nth_; if (i < 2 * DM * (EA / 8)) { const int r = i >> 9, c = (i & 511) * 8;
              *(bf16x8*)(wus + (size_t)r * EA + c) = pack8(av[u] * gk[u], bv[u] * gk[u]); } } }
      bf16_t* pb = (bf16_t*)(p.ws + WS_PREVB);
      for (int i = blockIdx.x * NTHREADS + tid; i < 2 * 256 * (EA / 8); i += G * NTHREADS) { const int r = i >> 9, c = (i & 511) * 8, l = r >> 8, rr = r & 255;
          f32x4 a = {0.f, 0.f, 0.f, 0.f}, b = a;
          if (rr < NDB * PPAD) { const float* s = p.in[5] + ((size_t)l * NDB * PPAD + rr) * EA + c; a = *(const f32x4*)s; b = *(const f32x4*)(s + 4); }
          *(bf16x8*)(pb + (size_t)r * EA + c) = pack8(a, b); } }
}
template <int W>
__device__ __forceinline__ void poolmix_item(const bf16_t* tt, const bf16_t* sg, const float* scale, const bf16_t* prevt, bf16_t* yg, int row0, int ch) {
    constexpr int NR = 16 + W - 1;
    u32x4 rows[NR];
    const bool samp = row0 >= MP; const int t0 = samp ? 0 : (row0 & (SEQ - 1));
    const bf16_t* up = tt + (size_t)row0 * EA + ch;
    if (t0 != 0) {
#pragma unroll
        for (int i = 0; i < NR; ++i) rows[i] = *(const u32x4*)(up + (ptrdiff_t)(i - (W - 1)) * EA);
    } else {
#pragma unroll
        for (int i = W - 1; i < NR; ++i) rows[i] = *(const u32x4*)(up + (ptrdiff_t)(i - (W - 1)) * EA);
        if (samp) { const bf16_t* pp = prevt + ((size_t)((row0 - MP) >> 4) * PPAD + (PPAD - (W - 1))) * EA + ch;
#pragma unroll
            for (int i = 0; i < W - 1; ++i) rows[i] = *(const u32x4*)(pp + (size_t)i * EA); }
        else {
#pragma unroll
            for (int i = 0; i < W - 1; ++i) rows[i] = (u32x4){0u, 0u, 0u, 0u}; }
    }
    const f32x4 sc0 = *(const f32x4*)(scale + ch), sc1 = *(const f32x4*)(scale + ch + 4);
    float s[8] = {0.f, 0.f, 0.f, 0.f, 0.f, 0.f, 0.f, 0.f};
#define ROWF(v, f) const float f[8] = {bflo(v.x), bfhi(v.x), bflo(v.y), bfhi(v.y), bflo(v.z), bfhi(v.z), bflo(v.w), bfhi(v.w)}
#pragma unroll
    for (int i = 0; i < W - 1; ++i) { ROWF(rows[i], f);
#pragma unroll
        for (int c = 0; c < 8; ++c) s[c] += f[c]; }
    constexpr int GB = W == 16 ? 2 : (W == 8 ? 8 : 16);
    u32x4 gvs[GB];
#pragma unroll
    for (int j = 0; j < 16; ++j) { ROWF(rows[j + W - 1], f);
        if ((j & (GB - 1)) == 0) {
#pragma unroll
            for (int jj = 0; jj < GB; ++jj) gvs[jj] = *(const u32x4*)(sg + (size_t)(row0 + j + jj) * EA + ch); }
        const u32x4 gv = gvs[j & (GB - 1)]; ROWF(gv, gt);
#pragma unroll
        for (int c = 0; c < 8; ++c) s[c] += f[c];
        const int nv = (!samp && t0 + j + 1 < W) ? t0 + j + 1 : W; const float ic = 1.0f / (float)nv;
        u32x4 o; o.x = cvtpk((s[0] * ic - f[0]) * sc0[0] * gt[0], (s[1] * ic - f[1]) * sc0[1] * gt[1]); o.y = cvtpk((s[2] * ic - f[2]) * sc0[2] * gt[2], (s[3] * ic - f[3]) * sc0[3] * gt[3]);
        o.z = cvtpk((s[4] * ic - f[4]) * sc1[0] * gt[4], (s[5] * ic - f[5]) * sc1[1] * gt[5]); o.w = cvtpk((s[6] * ic - f[6]) * sc1[2] * gt[6], (s[7] * ic - f[7]) * sc1[3] * gt[7]);
        *(u32x4*)(yg + (size_t)(row0 + j) * EA + ch) = o;
        ROWF(rows[j], g);
#pragma unroll
        for (int c = 0; c < 8; ++c) s[c] -= g[c]; }
#undef ROWF
}
__device__ __forceinline__ void poolmix_phase(int wv, const Params& p, int l) {
    const bf16_t* tt = (const bf16_t*)(p.ws + WS_U); const bf16_t* sg = (const bf16_t*)(p.ws + WS_SG); bf16_t* yg = (bf16_t*)(p.ws + WS_D);
    const bf16_t* prevt = (const bf16_t*)(p.ws + WS_PREVT) + (size_t)l * 256 * EA; const float* scale = p.in[9] + (size_t)l * EA;
    const int nth = gridDim.x * NTHREADS;
    for (int idx = blockIdx.x * NTHREADS + otid(wv); idx < (MT / 16) * (EA / 8); idx += nth) {
        const int row0 = (idx >> 9) * 16, ch = (idx & 511) * 8, grp = __builtin_amdgcn_readfirstlane(ch >> 10);
        if (grp == 0) poolmix_item<2>(tt, sg, scale, prevt, yg, row0, ch);
        else if (grp == 1) poolmix_item<4>(tt, sg, scale, prevt, yg, row0, ch);
        else if (grp == 2) poolmix_item<8>(tt, sg, scale, prevt, yg, row0, ch);
        else poolmix_item<16>(tt, sg, scale, prevt, yg, row0, ch);
    }
}
__device__ __forceinline__ void final_phase(int wv, const Params& p) {
    const int tid = otid(wv), lane = tid & 63, gw = blockIdx.x * NWAVES + (tid >> 6), NGW = gridDim.x * NWAVES;
    const float* xres = (const float*)(p.ws + WS_XRES); const float* ssq = (const float*)(p.ws + WS_SSQ) + (size_t)4 * MT; const float* g = p.in[17];
    for (int m = gw; m < MT; m += NGW) { const float rr = rsqrtf(ssq[m] * (1.0f / DM) + EPS);
        const f32x4* xr = (const f32x4*)(xres + (size_t)m * DM) + lane; f32x4* o = (f32x4*)(p.out + (m < MP ? O_YP + (size_t)m * DM : O_YS + (size_t)(m - MP) * DM)) + lane;
        f32x4 xv[8];
#pragma unroll
        for (int j = 0; j < 8; ++j) xv[j] = xr[64 * j] * rr * ((const f32x4*)g)[lane + 64 * j];
#pragma unroll
        for (int j = 0; j < 8; ++j) o[64 * j] = xv[j]; }
}

#define XB_TMO      128
#define XB_XCNT(j)  (256  + 64 * (j))
#define XB_XSUB(j)  (1280 + 64 * (j))
#define XB_XGEN(j)  (2304 + 64 * (j))
#define XB_TOP      3328
#define XB_TOPGEN   3392
#define XCD_BAR_WORDS 3456
#define XB_SPIN_CAP (1u << 18)

__device__ __forceinline__ unsigned xb_ld(unsigned* p)              { return __hip_atomic_load(p, __ATOMIC_RELAXED, __HIP_MEMORY_SCOPE_AGENT); }
__device__ __forceinline__ unsigned xb_add(unsigned* p, unsigned v) { return __hip_atomic_fetch_add(p, v, __ATOMIC_RELAXED, __HIP_MEMORY_SCOPE_AGENT); }
__device__ __forceinline__ unsigned xb_xcc_id() { return (unsigned)__builtin_amdgcn_s_getreg((3 << 11) | 20) & 0xFu; }
#define XB_SPIN(cond, bar) do { unsigned _sp = 0; while (cond) { __builtin_amdgcn_s_sleep(1); \
    if ((++_sp & 255u) == 0u) { if (xb_ld(&(bar)[XB_TMO])) break; if (_sp > XB_SPIN_CAP) { atomicAdd(&(bar)[XB_TMO], 1u); break; } } } } while (0)

struct XcdBarrier {
    unsigned* bar; unsigned x;
    volatile LAS unsigned* st;
};

__device__ __forceinline__ XcdBarrier xcd_barrier_post(unsigned* bar, volatile LAS unsigned* st) {
    XcdBarrier b; b.bar = bar; b.x = xb_xcc_id(); b.st = st;
    if (threadIdx.x == 0) (void)xb_add(&bar[XB_XCNT(b.x)], 1u);
    return b;
}
__device__ __forceinline__ void xcd_barrier_complete(unsigned* bar, unsigned x, unsigned& nloc, unsigned& nx) {
    const unsigned G = gridDim.x * gridDim.y * gridDim.z;
    unsigned sum, cnt, mine, sp = 0u;
    for (;;) {
        sum = 0u; cnt = 0u; mine = 0u;
#pragma unroll
        for (unsigned j = 0; j < 16; ++j) { const unsigned c = xb_ld(&bar[XB_XCNT(j)]); sum += c; cnt += (c > 0u) ? 1u : 0u; mine = (j == x) ? c : mine; }
        if (sum == G) break;
        __builtin_amdgcn_s_sleep(1);
        if ((++sp & 255u) == 0u) { if (xb_ld(&bar[XB_TMO])) break; if (sp > XB_SPIN_CAP) { atomicAdd(&bar[XB_TMO], 1u); break; } }
    }
    nloc = mine > 0u ? mine : 1u; nx = cnt > 0u ? cnt : 1u;
}

__device__ __forceinline__ void xcd_barrier(const XcdBarrier& b) {
    asm volatile("s_waitcnt vmcnt(0)" ::: "memory");
    __syncthreads();
    if (threadIdx.x == 0) {
        unsigned* bar = b.bar;
        __builtin_amdgcn_s_waitcnt(0);
        unsigned nloc = b.st[0], nx = b.st[1];
        if (nloc == 0u) { xcd_barrier_complete(bar, b.x, nloc, nx); b.st[0] = nloc; b.st[1] = nx; }
        const unsigned old = xb_add(&bar[XB_XSUB(b.x)], 1u);
        const unsigned gen = old / nloc;
        if (old + 1u == (gen + 1u) * nloc) {
            __builtin_amdgcn_fence(__ATOMIC_RELEASE, "agent");
            asm volatile("s_waitcnt vmcnt(0)" ::: "memory");
            const unsigned og = xb_add(&bar[XB_TOP], 1u);
            const unsigned tg = og / nx;
            if (og + 1u == (tg + 1u) * nx) xb_add(&bar[XB_TOPGEN], 1u);
            else XB_SPIN(xb_ld(&bar[XB_TOPGEN]) == tg, bar);
            __builtin_amdgcn_fence(__ATOMIC_ACQUIRE, "agent");
            xb_add(&bar[XB_XGEN(b.x)], 1u);
            asm volatile("s_waitcnt vmcnt(0)" ::: "memory");
        } else {
            XB_SPIN(xb_ld(&bar[XB_XGEN(b.x)]) == gen, bar);
            __builtin_amdgcn_fence(__ATOMIC_ACQUIRE, "agent");
            asm volatile("s_waitcnt vmcnt(0)" ::: "memory");
        }
    }
    __syncthreads();
}


constexpr int NPHASES = 15;
typedef const __attribute__((address_space(4))) Params* KArgPtr;
#if defined(__HIP_DEVICE_COMPILE__)
#define LOADP_() KArgPtr kp_ = (KArgPtr)__builtin_amdgcn_kernarg_segment_ptr(); asm volatile("" : "+s"(kp_)); Params lp; _Pragma("unroll") for (int i_ = 0; i_ < 18; ++i_) lp.in[i_] = kp_->in[i_]; lp.out = kp_->out; lp.ws = kp_->ws; lp.ph_lo = 0; lp.ph_hi = 0
#else
#define LOADP_() const Params lp = p
#endif
#define LOADP() LOADP_(); unsigned char* const ws = lp.ws; \
    float* const ssq = (float*)(ws + WS_SSQ); bf16_t* const xb = (bf16_t*)(ws + WS_XB); float* const xres = (float*)(ws + WS_XRES); (void)ssq; (void)xb; (void)xres
__global__ void __launch_bounds__(NTHREADS, 2) yoco_fwd(Params p) {
    extern __shared__ __attribute__((aligned(16))) unsigned char lds_raw[];
    char* lds = (char*)lds_raw; LAS unsigned char* ldsl = (LAS unsigned char*)lds_raw;
    const int G = gridDim.x, bx = blockIdx.x, wv = __builtin_amdgcn_readfirstlane(threadIdx.x >> 6);
#ifndef ONLY_PHASE
#define ONLY_PHASE -1
#endif
#define IN(k) ((ONLY_PHASE < 0 || ONLY_PHASE == (k)) && p.ph_lo <= (k) && (k) < p.ph_hi)
#ifndef SAT_REP
#define SAT_REP 1
#endif
#ifndef REPEAT_MASK
#define REPEAT_MASK 0
#endif
#define NREP(k) (1 + (int)(((unsigned)(REPEAT_MASK) >> (k)) & 1u))
    XcdBarrier xbar; xbar.bar = nullptr; xbar.x = 0; xbar.st = (volatile LAS unsigned*)(ldsl + LDS_PHASE_BYTES);
#define SEAM(k) do { if (rep_ + 1 < NREP(k) || (k) + 1 < p.ph_hi) { \
        if ((k) == 0 || xbar.bar == nullptr) { cg::this_grid().sync(); \
            if ((k) == 0 && rep_ + 1 == NREP(k)) { KArgPtr kq_ = (KArgPtr)__builtin_amdgcn_kernarg_segment_ptr(); \
                if (threadIdx.x < 4) ((LAS unsigned*)(ldsl + LDS_PHASE_BYTES))[threadIdx.x] = 0u; __syncthreads(); \
                xbar = xcd_barrier_post((unsigned*)(kq_->ws + WS_BAR), (volatile LAS unsigned*)(ldsl + LDS_PHASE_BYTES)); } } \
        else xcd_barrier(xbar); } } while (0)
    if (IN(0)) for (int rep_ = 0; rep_ < NREP(0); ++rep_) { { LOADP(); prologue_phase(wv, lp, lds); } SEAM(0); }
    if (IN(1)) for (int rep_ = 0; rep_ < NREP(1); ++rep_) {
        { LOADP(); pg8::Gemm g{(const bf16_t*)(ws + WS_WGRP), (const bf16_t*)(ws + WS_WINUS), 1024, 1024, EA, 2, nullptr, nullptr}; pg8::StaticOrder S; S.init(32, 8, G, bx);
          pg8::EpiStore E{(bf16_t*)(ws + WS_WINA), DM, 1};
          pg8::gemm_phase<pg8::EpiStore, pg8::StaticOrder>(wv, ldsl, g, S, E); }
        SEAM(1); }
#pragma unroll 1
    for (int l = 0; l < 2; ++l) {
        int wv_o = wv, bx_o = bx, G_o = G; asm volatile("" : "+s"(wv_o), "+s"(bx_o), "+s"(G_o));
        const int wv = wv_o, bx = bx_o, G = G_o;
        if (IN(2 + 3 * l)) for (int rep_ = 0; rep_ < NREP(2 + 3 * l); ++rep_) {
            { LOADP(); bf16_t* u = (bf16_t*)(ws + WS_U); bf16_t* sg = (bf16_t*)(ws + WS_SG);
              pg8::Gemm g{xb, (const bf16_t*)(ws + WS_WINA) + (size_t)l * 2 * EA * DM, DM, DM, DM, 0, nullptr, nullptr}; pg8::StaticOrder S; S.init(65, 32, G, bx);
              pg8::EpiInA E{ssq + (size_t)l * MT, u, sg};
              pg8::gemm_phase<pg8::EpiInA, pg8::StaticOrder>(wv, ldsl, g, S, E); }
            { LOADP(); pg8::Gemm g{xb, (const bf16_t*)(ws + WS_WINUT) + (size_t)l * EA * DM, DM, DM, DM, 0, nullptr, nullptr}; pg8::StateOrder S{G, bx};
              pg8::EpiUState E{ssq + (size_t)l * MT, lp.out + O_PP + (size_t)l * NBATCH * PPAD * EA, lp.out + O_PS + (size_t)l * NDB * PPAD * EA};
              pg8::gemm_phase<pg8::EpiUState, pg8::StateOrder>(wv, ldsl, g, S, E); }
            if (l == 0) { LOADP(); pg8::Gemm g{(const bf16_t*)(ws + WS_PREVB), (const bf16_t*)(ws + WS_WGRP), 1024, EA, 1024, 3, nullptr, nullptr}; pg8::MidOrder S{bx};
              pg8::EpiStore E{(bf16_t*)(ws + WS_PREVT), EA, 0};
              pg8::gemm_phase<pg8::EpiStore, pg8::MidOrder>(wv, ldsl, g, S, E); }
            SEAM(2 + 3 * l); }
        if (IN(3 + 3 * l)) for (int rep_ = 0; rep_ < NREP(3 + 3 * l); ++rep_) { { LOADP(); poolmix_phase(wv, lp, l); } SEAM(3 + 3 * l); }
        if (IN(4 + 3 * l)) for (int rep_ = 0; rep_ < NREP(4 + 3 * l); ++rep_) { { LOADP(); bf16_t* yg = (bf16_t*)(ws + WS_D);
            pg8::Gemm g{yg, (const bf16_t*)(ws + WS_WOUTA) + (size_t)l * DM * EA, EA, EA, EA, 0, (float*)(ws + WS_SPLIT) + (size_t)l * 8 * 65536, (unsigned*)(ws + WS_SPCNT) + l * 64}; pg8::SplitOrder S; S.init(8, 8, G, bx);
            pg8::EpiRes E{l == 0 ? lp.in[0] : xres, l == 0 ? lp.in[1] : xres + (size_t)MP * DM, xres, xb, ssq + (size_t)(l + 1) * MT};
            pg8::gemm_phase<pg8::EpiRes, pg8::SplitOrder>(wv, ldsl, g, S, E); } SEAM(4 + 3 * l); }
    }
#pragma unroll 1
    for (int lb = 0; lb < 2; ++lb) {
        int wv_o = wv, bx_o = bx, G_o = G; asm volatile("" : "+s"(wv_o), "+s"(bx_o), "+s"(G_o));
        const int wv = wv_o, bx = bx_o, G = G_o;
        if (IN(8 + 3 * lb)) for (int rep_ = 0; rep_ < NREP(8 + 3 * lb); ++rep_) { { LOADP();
            pg8::EpiKVQ E{lb == 0 ? 0 : 17, ssq + (size_t)(2 + lb) * MT, lp.out, ws, lp.in[13]};
            if (lb == 0) { pg8::Gemm g{xb, (const bf16_t*)(ws + WS_W4), DM, DM, DM, 0, nullptr, nullptr}; pg8::StaticOrder S; S.init(65, 33, G, bx);
                pg8::gemm_phase<pg8::EpiKVQ, pg8::StaticOrder>(wv, ldsl, g, S, E); }
            else { pg8::Gemm g{xb, (const bf16_t*)(ws + WS_WINB1), DM, DM, DM, 0, (float*)(ws + WS_SPLIT) + (size_t)32 * 65536, (unsigned*)(ws + WS_SPCNT) + 256}; pg8::SplitOrder S; S.init(16, 4, G, bx);
                pg8::gemm_phase<pg8::EpiKVQ, pg8::SplitOrder>(wv, ldsl, g, S, E); } } SEAM(8 + 3 * lb); }
        if (IN(9 + 3 * lb)) for (int rep_ = 0; rep_ < NREP(9 + 3 * lb); ++rep_) {
            { const int xcd = bx & 7, j = bx >> 3;
              if (G != 256 || j >= 24) { LOADP();
                  sat::Tensors ST{(const bf16_t*)(ws + WS_QB), (const bf16_t*)(ws + WS_KB), (const bf16_t*)(ws + WS_VB), (bf16_t*)(ws + WS_OG), (const bf16_t*)(ws + WS_SGB),
                                  lp.in[2], lp.in[3], lp.in[4], (const float*)(ws + WS_LFTS)};
                  const int s0 = G == 256 ? xcd * 8 + (j - 24) : bx, sstep = G == 256 ? 64 : G;
                  for (int it = s0; it < NDB * NH; it += sstep) sat::item(wv, lds, ST, it >> 4, it & 15); }
              if (G != 256 || j < 24) { LOADP();
                  att::Tensors AT{(const bf16_t*)(ws + WS_QB), (const bf16_t*)(ws + WS_KB), (const bf16_t*)(ws + WS_VB), (bf16_t*)(ws + WS_OG), (const bf16_t*)(ws + WS_SGB), (const float*)(ws + WS_LFTP)};
                  const int p0 = G == 256 ? xcd * 24 + j : bx, pstep = G == 256 ? 192 : G;
                  for (int pw = p0; pw < 192; pw += pstep) att::prompt_phase(wv, lds, AT, (const float*)(ws + WS_KNRM), (const float*)(ws + WS_QNRM), pw); } }
            SEAM(9 + 3 * lb); }
        if (IN(10 + 3 * lb)) for (int rep_ = 0; rep_ < NREP(10 + 3 * lb); ++rep_) { { LOADP();
            pg8::Gemm g{(const bf16_t*)(ws + WS_OG), (const bf16_t*)(ws + WS_WOUTB) + (size_t)lb * DM * DM, DM, DM, DM, 0, (float*)(ws + WS_SPLIT) + (size_t)(2 + lb) * 8 * 65536, (unsigned*)(ws + WS_SPCNT) + (2 + lb) * 64}; pg8::SplitOrder S; S.init(8, 4, G, bx);
            pg8::EpiRes E{xres, xres + (size_t)MP * DM, xres, xb, ssq + (size_t)(3 + lb) * MT};
            pg8::gemm_phase<pg8::EpiRes, pg8::SplitOrder>(wv, ldsl, g, S, E); } SEAM(10 + 3 * lb); }
    }
    if (IN(14)) { LOADP(); final_phase(wv, lp); }
#undef IN
#undef SEAM
}

extern "C" void kernel_launch(void* const* d_in, const int* in_sizes, int n_in, void* d_out, int out_size, void* d_ws, size_t ws_size, hipStream_t stream) {
    static int grid = 0;
    if (grid == 0) {
        if (n_in != 18 || (size_t)out_size != O_END || ws_size < WS_END) { fprintf(stderr, "kernel_launch: unexpected shapes: n_in %d out %d (want %zu) ws %zu (need %zu)\n", n_in, out_size, (size_t)O_END, ws_size, (size_t)WS_END); grid = -1; return; }
        int dev = 0, cus = 0, per_cu = 0;
        (void)hipGetDevice(&dev); (void)hipDeviceGetAttribute(&cus, hipDeviceAttributeMultiprocessorCount, dev);
        if (hipFuncSetAttribute((const void*)yoco_fwd, hipFuncAttributeMaxDynamicSharedMemorySize, LDS_BYTES) != hipSuccess) { fprintf(stderr, "kernel_launch: hipFuncSetAttribute failed\n"); grid = -1; return; }
        if (hipOccupancyMaxActiveBlocksPerMultiprocessor(&per_cu, (const void*)yoco_fwd, NTHREADS, LDS_BYTES) != hipSuccess || per_cu < 1) { fprintf(stderr, "kernel_launch: occupancy query gave %d\n", per_cu); per_cu = 1; }
        (void)hipGetLastError();
        grid = cus > 0 ? cus : 256;
    }
    if (grid < 0) return;
    Params p{};
    for (int i = 0; i < 18; ++i) p.in[i] = (const float*)d_in[i];
    p.out = (float*)d_out; p.ws = (unsigned char*)d_ws;
#if MULTI_LAUNCH
    for (int ph = 0; ph < NPHASES; ++ph) { p.ph_lo = ph; p.ph_hi = ph + 1; hipLaunchKernelGGL(yoco_fwd, dim3(grid), dim3(NTHREADS), LDS_BYTES, stream, p); }
#else
    p.ph_lo = 0; p.ph_hi = NPHASES;
    void* args[] = {&p};
    hipError_t e = hipLaunchCooperativeKernel((const void*)yoco_fwd, dim3(grid), dim3(NTHREADS), args, LDS_BYTES, stream);
    if (e != hipSuccess) fprintf(stderr, "kernel_launch: cooperative launch failed: %s (grid %d)\n", hipGetErrorString(e), grid);
#endif
}
```

```cpp
#include <hip/hip_runtime.h>
#include <hip/hip_cooperative_groups.h>
#include <cstdio>
#include <cstdint>
namespace cg = cooperative_groups;

#ifndef MULTI_LAUNCH
#define MULTI_LAUNCH 0
#endif

#define LAS __attribute__((address_space(3)))
typedef unsigned short bf16_t;
typedef short bf16x8 __attribute__((ext_vector_type(8)));
typedef short s16x4 __attribute__((ext_vector_type(4)));
typedef float f32x4 __attribute__((ext_vector_type(4)));
typedef float f32x16 __attribute__((ext_vector_type(16)));
typedef unsigned u32x4 __attribute__((ext_vector_type(4)));
typedef unsigned u32x2 __attribute__((ext_vector_type(2)));

constexpr int DM = 2048, NBATCH = 4, SEQ = 4096, NDB = 16, DSEQ = 16, PAST = 2048, EA = 4096, NH = 16, HD = 128, PPAD = 15;
constexpr int MP = NBATCH * SEQ, MS = NDB * DSEQ, MT = MP + MS;
constexpr float EPS = 1e-6f;
constexpr float LOG2E = 1.4426950408889634f;
constexpr float QSCALE = 0.08838834764831845f * 1.4426950408889634f;
constexpr int NTHREADS = 512, NWAVES = 8;
constexpr int LDS_PHASE_BYTES = 131072, LDS_BYTES = LDS_PHASE_BYTES + 16;

constexpr size_t O_YP = 0, O_YS = O_YP + (size_t)MP * DM, O_KP = O_YS + (size_t)MS * DM, O_VP = O_KP + (size_t)MP * DM,
                 O_LFP = O_VP + (size_t)MP * DM, O_PP = O_LFP + (size_t)MP * NH, O_KS = O_PP + (size_t)2 * NBATCH * PPAD * EA,
                 O_VS = O_KS + (size_t)MS * DM, O_LFS = O_VS + (size_t)MS * DM, O_PS = O_LFS + (size_t)MS * NH, O_END = O_PS + (size_t)2 * NDB * PPAD * EA;

constexpr size_t al256(size_t x) { return (x + 255) & ~(size_t)255; }
constexpr size_t WS_WINA = 0;
constexpr size_t WS_WGRP = WS_WINA + (size_t)2 * 8192 * 2048 * 2;
constexpr size_t WS_WOUTA = WS_WGRP + (size_t)2 * 4096 * 1024 * 2;
constexpr size_t WS_W4 = WS_WOUTA + (size_t)2 * 2048 * 4096 * 2;
constexpr size_t WS_WINB1 = WS_W4 + (size_t)8448 * 2048 * 2;
constexpr size_t WS_WOUTB = WS_WINB1 + (size_t)4096 * 2048 * 2;
constexpr size_t WS_XB = WS_WOUTB + (size_t)2 * 2048 * 2048 * 2;
constexpr size_t WS_XRES = WS_XB + (size_t)MT * DM * 2;
constexpr size_t WS_SSQ = WS_XRES + (size_t)MT * DM * 4;
constexpr size_t WS_LFTP = al256(WS_SSQ + (size_t)5 * MT * 4);
constexpr size_t WS_LFTS = WS_LFTP + (size_t)NBATCH * NH * SEQ * 4;
constexpr size_t WS_KNRM = al256(WS_LFTS + (size_t)NDB * NH * DSEQ * 4);
constexpr size_t WS_QNRM = WS_KNRM + (size_t)MT * NH * 4 * 4;
constexpr size_t WS_WINUT = al256(WS_QNRM + (size_t)MT * NH * 4 * 4);
constexpr size_t WS_WINUS = WS_WINUT + (size_t)2 * EA * DM * 2;
constexpr size_t WS_PREVB = WS_WINUS + (size_t)2 * DM * EA * 2;
constexpr size_t WS_PREVT = WS_PREVB + (size_t)2 * 256 * EA * 2;
constexpr size_t WS_SPLIT = al256(WS_PREVT + (size_t)2 * 256 * EA * 2);
constexpr size_t SPLIT_TILE = 65536 * 4, SPLIT_TILES = 8 * 4 + 16;
constexpr size_t WS_SPCNT = WS_SPLIT + SPLIT_TILES * SPLIT_TILE;
constexpr size_t WS_BAR = al256(WS_SPCNT + SPLIT_TILES * 8 * 4);
constexpr size_t WS_ACT = al256(WS_BAR + 3456 * 4);
constexpr size_t SZ_A = (size_t)MT * EA * 2, SZ_B = (size_t)MT * DM * 2;
constexpr size_t WS_U = WS_ACT, WS_SG = WS_U + SZ_A, WS_D = WS_SG + SZ_A;
constexpr size_t WS_KB = WS_ACT, WS_VB = WS_KB + SZ_B, WS_QB = WS_VB + SZ_B, WS_SGB = WS_QB + SZ_B, WS_OG = WS_SGB + SZ_B;
constexpr size_t WS_END = (WS_D + SZ_A) > (WS_OG + SZ_B) ? (WS_D + SZ_A) : (WS_OG + SZ_B);

struct Params { const float* in[18]; float* out; unsigned char* ws; int ph_lo, ph_hi; };

__device__ __forceinline__ unsigned cvtpk(float lo, float hi) { unsigned r; asm volatile("v_cvt_pk_bf16_f32 %0, %1, %2" : "=v"(r) : "v"(lo), "v"(hi)); return r; }
__device__ __forceinline__ bf16x8 pack8(f32x4 a, f32x4 b) { u32x4 w = {cvtpk(a[0], a[1]), cvtpk(a[2], a[3]), cvtpk(b[0], b[1]), cvtpk(b[2], b[3])}; return *reinterpret_cast<bf16x8*>(&w); }
__device__ __forceinline__ float bflo(unsigned w) { return __uint_as_float(w << 16); }
__device__ __forceinline__ float bfhi(unsigned w) { return __uint_as_float(w & 0xffff0000u); }
__device__ __forceinline__ float silu_f(float x) { return x * __builtin_amdgcn_rcpf(1.0f + __builtin_amdgcn_exp2f(-x * LOG2E)); }
__device__ __forceinline__ float wave_sum(float v) {
#pragma unroll
    for (int o = 1; o < 64; o <<= 1) v += __shfl_xor(v, o);
    return v;
}
__device__ __forceinline__ int otid(int wv) { int l; asm volatile("v_mbcnt_lo_u32_b32 %0, -1, 0\n\tv_mbcnt_hi_u32_b32 %0, -1, %0" : "=v"(l)); return wv * 64 + l; }
__device__ __forceinline__ float xsum16(float v) { auto r = __builtin_amdgcn_permlane16_swap(__float_as_uint(v), __float_as_uint(v), false, false); return __uint_as_float(r[0]) + __uint_as_float(r[1]); }
__device__ __forceinline__ float xsum32(float v) { auto r = __builtin_amdgcn_permlane32_swap(__float_as_uint(v), __float_as_uint(v), false, false); return __uint_as_float(r[0]) + __uint_as_float(r[1]); }
__device__ __forceinline__ float xmax16(float v) { auto r = __builtin_amdgcn_permlane16_swap(__float_as_uint(v), __float_as_uint(v), false, false); return fmaxf(__uint_as_float(r[0]), __uint_as_float(r[1])); }
__device__ __forceinline__ float xmax32(float v) { auto r = __builtin_amdgcn_permlane32_swap(__float_as_uint(v), __float_as_uint(v), false, false); return fmaxf(__uint_as_float(r[0]), __uint_as_float(r[1])); }
__device__ __forceinline__ float bperm(float v, int srclane) { return __uint_as_float((unsigned)__builtin_amdgcn_ds_bpermute(srclane << 2, (int)__float_as_uint(v))); }
__device__ __forceinline__ float logsig(float x) { return fminf(x, 0.f) - log1pf(__expf(-fabsf(x))); }

namespace pg8 {
constexpr int BM = 256, BK = 64, HALF = 128, HTB = HALF * BK * 2, NXCD = 8, WGM = 8;
__device__ __forceinline__ int lds_byte(int r, int c) { const int st = (r >> 4) * 2 + (c >> 5), rr = r & 15, cc = c & 31, ob = rr * 64 + cc * 2; return st * 1024 + (ob ^ (((ob >> 9) & 1) << 5)); }
__device__ __forceinline__ void stage_rc(int b, int& R, int& C) { const int st = b / 1024, sb = b % 1024, swz = sb ^ (((sb >> 9) & 1) << 5); R = (st >> 1) * 16 + swz / 64; C = (st & 1) * 32 + (swz % 64) / 2; }
__device__ __forceinline__ int perm32(int rho) { const int n = rho >> 4, i = rho & 15; return 8 * (i >> 2) + 4 * n + (i & 3); }
struct Unit { int pm, pn, ks, nks; };
struct Gemm { const bf16_t* A; const bf16_t* Bt; int K, lda, ldb, mode; float* sp_acc; unsigned* sp_cnt; };
__device__ __forceinline__ void unit_off(const Gemm& g, const Unit& u, size_t& oa, size_t& ob) {
    if (g.mode == 2) { oa = (size_t)u.pm * 256 * g.lda; ob = (size_t)(u.pm >> 4) * DM * EA + (size_t)((u.pm >> 2) & 3) * 1024 + (size_t)u.pn * 256 * g.ldb; }
    else if (g.mode == 3) { oa = (size_t)u.pm * 256 * g.lda + (size_t)(u.pn >> 2) * 1024; ob = (size_t)(u.pm * 16 + u.pn) * 256 * g.ldb; }
    else { oa = (size_t)u.pm * 256 * g.lda; ob = (size_t)u.pn * 256 * g.ldb; }
    const size_t ko = (size_t)u.ks * (size_t)(g.K / u.nks); oa = (oa + ko) * 2; ob = (ob + ko) * 2;
}
struct StaticOrder {
    int nM, nN, nwg, G, c;
    __device__ __forceinline__ void init(int nM_, int nN_, int G_, int c_) { nM = nM_; nN = nN_; nwg = nM * nN; G = G_; c = c_; }
    __device__ __forceinline__ bool next(int i, Unit& u) const {
        const long L = (long)i * G + c; if (L >= nwg) return false;
        int wgid = (int)L; { const int q = nwg / NXCD, r = nwg % NXCD, xcd = wgid % NXCD, off = wgid / NXCD; wgid = (xcd < r ? xcd * (q + 1) : r * (q + 1) + (xcd - r) * q) + off; }
        const int nig = WGM * nN, gid = wgid / nig, fm = gid * WGM, gsz = (nM - fm) < WGM ? (nM - fm) : WGM;
        u.pm = fm + ((wgid % nig) % gsz); u.pn = (wgid % nig) / gsz; u.ks = 0; u.nks = 1; return true;
    }
};
struct SplitOrder {
    StaticOrder S0; int nN, nks, i0;
    __device__ __forceinline__ void init(int nN_, int nks_, int G_, int c_) { S0.init(64, nN_, G_, c_); nN = nN_; nks = nks_; i0 = c_ < S0.nwg ? (S0.nwg - c_ + G_ - 1) / G_ : 0; }
    __device__ __forceinline__ bool next(int i, Unit& u) const {
        if (i < i0) return S0.next(i, u);
        const int idx = (i - i0) * S0.G + S0.c; if (idx >= nN * nks) return false;
        u.pm = 64; u.pn = idx / nks; u.ks = idx % nks; u.nks = nks; return true;
    }
};
struct MidOrder {
    int c;
    __device__ __forceinline__ bool next(int i, Unit& u) const { const int idx = c - 32; if (i != 0 || idx < 0 || idx >= 32) return false; u.pm = idx >> 4; u.pn = idx & 15; u.ks = 0; u.nks = 1; return true; }
};
struct StateOrder {
    int G, c;
    __device__ __forceinline__ bool next(int i, Unit& u) const { const int idx = G - 1 - c; if (i != 0 || idx >= 80) return false; const int k = idx >> 4; u.pm = k < 4 ? 16 * k + 15 : 64; u.pn = idx & 15; u.ks = 0; u.nks = 1; return true; }
};
template <class Epi, class Ord>
__device__ __forceinline__ void gemm_phase(int wv, LAS unsigned char* lds, const Gemm g, const Ord& S, const Epi& E) {
    const int tid = otid(wv), wid = __builtin_amdgcn_readfirstlane(tid >> 6), lane = tid & 63, wr = wid >> 2, wc = wid & 3, fr = lane & 15, fq = lane >> 4;
    const int K = g.K, nt = K / BK;
    unsigned voffA[2], voffB[2];
#pragma unroll
    for (int i = 0; i < 2; ++i) { int R, C; stage_rc(tid * 16 + i * 8192, R, C); const int Rb = Epi::PERM ? ((R & ~31) + perm32(R & 31)) : R;
        voffA[i] = (unsigned)(R * g.lda + C) * 2u; voffB[i] = (unsigned)(Rb * g.ldb + C) * 2u; }
    const size_t kstep = (size_t)(BK * 2);
    const size_t hstepA = (size_t)HALF * g.lda * 2;
    const size_t hstepB = (size_t)HALF * g.ldb * 2;
    const unsigned ldsw = (unsigned)wid * 1024u;
    const int aoff = lds_byte(wr * 64 + fr, fq * 8), boff = lds_byte(wc * 32 + fr, fq * 8);
#define PG8_SA(b, h) (((b) * 2 + (h)) * HTB)
#define PG8_SB(b, h) ((4 + (b) * 2 + (h)) * HTB)
#define PG8_STAGE(bufoff, gbase, voff) do { _Pragma("unroll") for (int _i = 0; _i < 2; ++_i) \
        __builtin_amdgcn_global_load_lds((const unsigned*)((const char*)(gbase) + (voff)[_i]), (LAS unsigned*)(lds + (bufoff) + ldsw + _i * 8192), 16, 0, 0); } while (0)
#define PG8_LDA(dst, b, h) do { _Pragma("unroll") for (int m = 0; m < 4; ++m) _Pragma("unroll") for (int k = 0; k < 2; ++k) dst[m][k] = *(const LAS bf16x8*)(lds + PG8_SA(b, h) + aoff + m * 2048 + k * 1024); } while (0)
#define PG8_LDB(dst, b, h) do { _Pragma("unroll") for (int n = 0; n < 2; ++n) _Pragma("unroll") for (int k = 0; k < 2; ++k) dst[n][k] = *(const LAS bf16x8*)(lds + PG8_SB(b, h) + boff + n * 2048 + k * 1024); } while (0)
#define PG8_MMA(ai, bj, At, Bt) do { __builtin_amdgcn_s_setprio(1); _Pragma("unroll") for (int m = 0; m < 4; ++m) _Pragma("unroll") for (int n = 0; n < 2; ++n) _Pragma("unroll") for (int k = 0; k < 2; ++k) \
        acc[ai][bj][m][n] = __builtin_amdgcn_mfma_f32_16x16x32_bf16(Bt[n][k], At[m][k], acc[ai][bj][m][n], 0, 0, 0); __builtin_amdgcn_s_setprio(0); } while (0)
#define PG8_WAIT_V(n) asm volatile("s_waitcnt vmcnt(" #n ")" ::: "memory")
#define PG8_WAIT_L(n) asm volatile("s_waitcnt lgkmcnt(" #n ")" ::: "memory")
#define PG8_BAR __builtin_amdgcn_s_barrier()
#define PG8_SCHED __builtin_amdgcn_sched_barrier(0)
    Unit cur, nxt; int ui = 0;
    if (!S.next(0, cur)) return;
    f32x4 acc[2][2][4][2];
#pragma unroll
    for (int a = 0; a < 2; ++a)
#pragma unroll
        for (int b = 0; b < 2; ++b)
#pragma unroll
            for (int m = 0; m < 4; ++m)
#pragma unroll
                for (int n = 0; n < 2; ++n) acc[a][b][m][n] = (f32x4){0.f, 0.f, 0.f, 0.f};
    bf16x8 At[4][2], B0[2][2], B1[2][2];
    size_t oa_, ob_; unit_off(g, cur, oa_, ob_);
    const char* cA = (const char*)g.A + oa_; const char* cB = (const char*)g.Bt + ob_;
    PG8_STAGE(PG8_SB(0, 0), cB, voffB); PG8_STAGE(PG8_SA(0, 0), cA, voffA); PG8_STAGE(PG8_SB(0, 1), cB + hstepB, voffB); PG8_STAGE(PG8_SA(0, 1), cA + hstepA, voffA);
    if (wr == 1) PG8_BAR;
    PG8_WAIT_V(4); PG8_BAR;
    PG8_STAGE(PG8_SB(1, 0), cB + kstep, voffB); PG8_STAGE(PG8_SA(1, 0), cA + kstep, voffA); PG8_STAGE(PG8_SB(1, 1), cB + hstepB + kstep, voffB);
    PG8_WAIT_V(6); PG8_BAR;
    for (;;) {
        const bool has_next = S.next(ui + 1, nxt);
        const char* nA = cA; const char* nB = cB;
        if (has_next) { unit_off(g, nxt, oa_, ob_); nA = (const char*)g.A + oa_; nB = (const char*)g.Bt + ob_; }
        const int ntc = nt / cur.nks;
        for (int t = 0; t < ntc; t += 2) {
            const bool last = (t == ntc - 2);
            const char* a1 = cA + (size_t)(t + 1) * kstep;
            const char* a2 = last ? nA : cA + (size_t)(t + 2) * kstep; const char* b2 = last ? nB : cB + (size_t)(t + 2) * kstep;
            const char* a3 = a2 + kstep; const char* b3 = b2 + kstep;
            PG8_LDB(B0, 0, 0); PG8_SCHED; PG8_LDA(At, 0, 0); PG8_STAGE(PG8_SA(1, 1), a1 + hstepA, voffA);
            PG8_WAIT_L(8); PG8_BAR; PG8_WAIT_L(0); PG8_MMA(0, 0, At, B0); PG8_BAR; PG8_SCHED;
            PG8_LDB(B1, 0, 1); PG8_STAGE(PG8_SB(0, 0), b2, voffB);
            PG8_BAR; PG8_WAIT_L(0); PG8_MMA(0, 1, At, B1); PG8_BAR;
            PG8_LDA(At, 0, 1); PG8_STAGE(PG8_SA(0, 0), a2, voffA);
            PG8_BAR; PG8_WAIT_L(0); PG8_MMA(1, 0, At, B0); PG8_BAR; PG8_SCHED;
            PG8_STAGE(PG8_SB(0, 1), b2 + hstepB, voffB);
            PG8_WAIT_V(6); PG8_BAR; PG8_MMA(1, 1, At, B1); PG8_BAR;
            PG8_LDB(B0, 1, 0); PG8_SCHED; PG8_LDA(At, 1, 0); PG8_STAGE(PG8_SA(0, 1), a2 + hstepA, voffA);
            PG8_WAIT_L(8); PG8_BAR; PG8_WAIT_L(0); PG8_MMA(0, 0, At, B0); PG8_BAR; PG8_SCHED;
            PG8_LDB(B1, 1, 1); PG8_STAGE(PG8_SB(1, 0), b3, voffB);
            PG8_BAR; PG8_WAIT_L(0); PG8_MMA(0, 1, At, B1); PG8_BAR;
            PG8_LDA(At, 1, 1); PG8_STAGE(PG8_SA(1, 0), a3, voffA);
            PG8_BAR; PG8_WAIT_L(0); PG8_MMA(1, 0, At, B0); PG8_BAR; PG8_SCHED;
            PG8_STAGE(PG8_SB(1, 1), b3 + hstepB, voffB);
            PG8_WAIT_V(6); PG8_BAR; PG8_MMA(1, 1, At, B1); PG8_BAR;
        }
        bool do_epi = true;
        if (cur.nks > 1) {
            float* sc0 = g.sp_acc + (size_t)cur.pn * 65536 + (wid * 64 + lane); float* sc = sc0;
#pragma unroll
            for (int a = 0; a < 2; ++a)
#pragma unroll
                for (int b = 0; b < 2; ++b)
#pragma unroll
                    for (int m = 0; m < 4; ++m)
#pragma unroll
                        for (int n = 0; n < 2; ++n) {
#pragma unroll
                            for (int j = 0; j < 4; ++j) unsafeAtomicAdd(sc + j * 512, acc[a][b][m][n][j]);
                            sc += 2048; asm volatile("" : "+v"(sc)); }
            asm volatile("s_waitcnt vmcnt(0)" ::: "memory");
            __builtin_amdgcn_fence(__ATOMIC_RELEASE, "agent");
            unsigned old = 0u; if (lane == 0) old = __hip_atomic_fetch_add(g.sp_cnt + cur.pn * 8 + wid, 1u, __ATOMIC_RELAXED, __HIP_MEMORY_SCOPE_AGENT);
            old = (unsigned)__builtin_amdgcn_readfirstlane((int)old);
            do_epi = (old == (unsigned)cur.nks - 1u);
            if (do_epi) {
                __builtin_amdgcn_fence(__ATOMIC_ACQUIRE, "agent");
                sc = sc0;
#pragma unroll
                for (int a = 0; a < 2; ++a)
#pragma unroll
                    for (int b = 0; b < 2; ++b)
#pragma unroll
                        for (int m = 0; m < 4; ++m)
#pragma unroll
                            for (int n = 0; n < 2; ++n) {
#pragma unroll
                                for (int j = 0; j < 4; ++j) acc[a][b][m][n][j] = __hip_atomic_load(sc + j * 512, __ATOMIC_RELAXED, __HIP_MEMORY_SCOPE_AGENT);
                                sc += 2048; asm volatile("" : "+v"(sc)); } }
        }
        if (do_epi) E(acc, cur, wr, wc, fr, fq);
        if (!has_next) break;
#pragma unroll
        for (int a = 0; a < 2; ++a)
#pragma unroll
            for (int b = 0; b < 2; ++b)
#pragma unroll
                for (int m = 0; m < 4; ++m)
#pragma unroll
                    for (int n = 0; n < 2; ++n) acc[a][b][m][n] = (f32x4){0.f, 0.f, 0.f, 0.f};
        cur = nxt; cA = nA; cB = nB; ++ui;
    }
    PG8_WAIT_V(0);
    if (wr == 0) PG8_BAR;
    PG8_BAR;
#undef PG8_SA
#undef PG8_SB
#undef PG8_STAGE
#undef PG8_LDA
#undef PG8_LDB
#undef PG8_MMA
#undef PG8_WAIT_V
#undef PG8_WAIT_L
#undef PG8_BAR
#undef PG8_SCHED
}

typedef const f32x4 (&AccRef)[2][2][4][2];

struct EpiInA {
    static constexpr bool PERM = true;
    const float* ssq; bf16_t* tt; bf16_t* sg;
    __device__ __forceinline__ void operator()(AccRef acc, const Unit& un, int wr, int wc, int fr, int fq) const {
        const int row0 = un.pm * BM + wr * 64 + fr, colt = un.pn * BM + wc * 32 + 8 * fq;
        const bool is_t = un.pn < 16;
        float rrs[2][4];
#pragma unroll
        for (int ai = 0; ai < 2; ++ai)
#pragma unroll
            for (int m = 0; m < 4; ++m) rrs[ai][m] = ssq[row0 + ai * HALF + m * 16];
#pragma unroll
        for (int ai = 0; ai < 2; ++ai)
#pragma unroll
            for (int m = 0; m < 4; ++m) { const int row = row0 + ai * HALF + m * 16; const float rr = rsqrtf(rrs[ai][m] * (1.0f / DM) + EPS);
#pragma unroll
                for (int bj = 0; bj < 2; ++bj) { f32x4 v0 = acc[ai][bj][m][0] * rr, v1 = acc[ai][bj][m][1] * rr; const int col = colt + bj * HALF;
                    if (is_t) *(bf16x8*)(tt + (size_t)row * EA + col) = pack8(v0, v1);
                    else {
#pragma unroll
                        for (int j = 0; j < 4; ++j) { v0[j] = silu_f(v0[j]); v1[j] = silu_f(v1[j]); }
                        *(bf16x8*)(sg + (size_t)row * EA + (col - EA)) = pack8(v0, v1); } } }
    }
};
struct EpiUState {
    static constexpr bool PERM = true;
    const float* ssq; float* pool_p; float* pool_s;
    __device__ __forceinline__ void operator()(AccRef acc, const Unit& un, int wr, int wc, int fr, int fq) const {
        const int row0 = un.pm * BM + wr * 64 + fr, colt = un.pn * BM + wc * 32 + 8 * fq;
#pragma unroll
        for (int ai = 0; ai < 2; ++ai)
#pragma unroll
            for (int m = 0; m < 4; ++m) { const int row = row0 + ai * HALF + m * 16;
                float* pp = nullptr;
                if (row < MP) { const int t = row & (SEQ - 1); if (t >= SEQ - PPAD) pp = pool_p + ((size_t)(row >> 12) * PPAD + (t - (SEQ - PPAD))) * EA; }
                else { const int rs = row - MP, t = rs & 15; if (t >= 1) pp = pool_s + ((size_t)(rs >> 4) * PPAD + (t - 1)) * EA; }
                if (pp) { const float rr = rsqrtf(ssq[row] * (1.0f / DM) + EPS);
#pragma unroll
                    for (int bj = 0; bj < 2; ++bj) { *(f32x4*)(pp + colt + bj * HALF) = acc[ai][bj][m][0] * rr; *(f32x4*)(pp + colt + bj * HALF + 4) = acc[ai][bj][m][1] * rr; } } }
    }
};
struct EpiStore {
    static constexpr bool PERM = true;
    bf16_t* O; int ldc, wmode;
    __device__ __forceinline__ void operator()(AccRef acc, const Unit& un, int wr, int wc, int fr, int fq) const {
        const int rbase = wmode ? (un.pm >> 4) * 2 * EA + (un.pm & 15) * BM : un.pm * BM;
        const int row0 = rbase + wr * 64 + fr, colt = un.pn * BM + wc * 32 + 8 * fq;
#pragma unroll
        for (int ai = 0; ai < 2; ++ai)
#pragma unroll
            for (int m = 0; m < 4; ++m)
#pragma unroll
                for (int bj = 0; bj < 2; ++bj) *(bf16x8*)(O + (size_t)(row0 + ai * HALF + m * 16) * ldc + colt + bj * HALF) = pack8(acc[ai][bj][m][0], acc[ai][bj][m][1]);
    }
};
struct EpiRes {
    static constexpr bool PERM = false;
    const float* base_p; const float* base_s; float* xres; bf16_t* xb; float* ssq_next; int write_xb;
    __device__ __forceinline__ void operator()(AccRef acc, const Unit& un, int wr, int wc, int fr, int fq) const {
        const int row0 = un.pm * BM + wr * 64 + fr, col0 = un.pn * BM + wc * 32 + 4 * fq;
#pragma unroll
        for (int ai = 0; ai < 2; ++ai) {
            f32x4 bx_[4][2][2];
#pragma unroll
            for (int m = 0; m < 4; ++m) { const int row = row0 + ai * HALF + m * 16;
                const float* bp = (row < MP ? base_p + (size_t)row * DM : base_s + (size_t)(row - MP) * DM) + col0;
#pragma unroll
                for (int bj = 0; bj < 2; ++bj)
#pragma unroll
                    for (int n = 0; n < 2; ++n) bx_[m][bj][n] = *(const f32x4*)(bp + bj * HALF + n * 16); }
#pragma unroll
            for (int m = 0; m < 4; ++m) { const int row = row0 + ai * HALF + m * 16;
                float* xo = xres + (size_t)row * DM + col0; bf16_t* bo = xb + (size_t)row * DM + col0; float s = 0.f;
#pragma unroll
                for (int bj = 0; bj < 2; ++bj)
#pragma unroll
                    for (int n = 0; n < 2; ++n) { const f32x4 x = bx_[m][bj][n] + acc[ai][bj][m][n];
                        *(f32x4*)(xo + bj * HALF + n * 16) = x; if (write_xb) { u32x2 w; w.x = cvtpk(x[0], x[1]); w.y = cvtpk(x[2], x[3]); *(u32x2*)(bo + bj * HALF + n * 16) = w; }
                        s += (x[0] * x[0] + x[1] * x[1]) + (x[2] * x[2] + x[3] * x[3]); }
                s = xsum16(s); s = xsum32(s);
                if (fq == 0) unsafeAtomicAdd(ssq_next + row, s); } }
    }
};
struct EpiKVQ {
    static constexpr bool PERM = true;
    int pn_off; const float* ssq; float* out; unsigned char* ws; const float* b_f;
    __device__ __forceinline__ void operator()(AccRef acc, const Unit& un, int wr, int wc, int fr, int fq) const {
        const int tt = un.pn + pn_off;
        const int row0 = un.pm * BM + wr * 64 + fr, cw = wc * 32 + 8 * fq;
        float rrs[2][4];
#pragma unroll
        for (int ai = 0; ai < 2; ++ai)
#pragma unroll
            for (int m = 0; m < 4; ++m) rrs[ai][m] = ssq[row0 + ai * HALF + m * 16];
        if (tt == 16) {
            if (wc == 0 && fq < 2) {
            const f32x4 bf0 = *(const f32x4*)(b_f + 8 * fq), bf1 = *(const f32x4*)(b_f + 8 * fq + 4);
            float* lft_p = (float*)(ws + WS_LFTP); float* lft_s = (float*)(ws + WS_LFTS);
#pragma unroll
            for (int ai = 0; ai < 2; ++ai)
#pragma unroll
                for (int m = 0; m < 4; ++m) { const int row = row0 + ai * HALF + m * 16; const float rr = rsqrtf(rrs[ai][m] * (1.0f / DM) + EPS);
                    f32x4 v0 = acc[ai][0][m][0] * rr + bf0, v1 = acc[ai][0][m][1] * rr + bf1;
#pragma unroll
                    for (int j = 0; j < 4; ++j) { v0[j] = logsig(v0[j]); v1[j] = logsig(v1[j]); }
                    if (row < MP) { float* o = out + O_LFP + (size_t)row * NH + 8 * fq; *(f32x4*)o = v0; *(f32x4*)(o + 4) = v1;
                        float* tp = lft_p + ((size_t)(row >> 12) * NH + 8 * fq) * SEQ + (row & (SEQ - 1));
#pragma unroll
                        for (int j = 0; j < 4; ++j) { tp[(size_t)j * SEQ] = v0[j]; tp[(size_t)(j + 4) * SEQ] = v1[j]; } }
                    else { const int rs = row - MP; float* o = out + O_LFS + (size_t)rs * NH + 8 * fq; *(f32x4*)o = v0; *(f32x4*)(o + 4) = v1;
                        float* tp = lft_s + ((size_t)(rs >> 4) * NH + 8 * fq) * DSEQ + (rs & 15);
#pragma unroll
                        for (int j = 0; j < 4; ++j) { tp[j * DSEQ] = v0[j]; tp[(j + 4) * DSEQ] = v1[j]; } } }
            }
        } else {
        const int kind = tt < 8 ? 0 : (tt < 16 ? 1 : (tt < 25 ? 2 : 3));
        const int colt = (tt - (kind == 0 ? 0 : kind == 1 ? 8 : kind == 2 ? 17 : 25)) * BM + cw;
        float* fo_p = out + (kind == 0 ? O_KP : O_VP); float* fo_s = out + (kind == 0 ? O_KS : O_VS);
        bf16_t* bo = (bf16_t*)(ws + (kind == 0 ? WS_KB : (kind == 1 ? WS_VB : (kind == 2 ? WS_QB : WS_SGB))));
#pragma unroll
        for (int ai = 0; ai < 2; ++ai)
#pragma unroll
            for (int m = 0; m < 4; ++m) { const int row = row0 + ai * HALF + m * 16; float rr = rsqrtf(rrs[ai][m] * (1.0f / DM) + EPS);
                if (kind == 2) rr *= QSCALE;
                float* fo = (row < MP ? fo_p + (size_t)row * DM : fo_s + (size_t)(row - MP) * DM) + colt;
#pragma unroll
                for (int bj = 0; bj < 2; ++bj) { f32x4 v0 = acc[ai][bj][m][0] * rr, v1 = acc[ai][bj][m][1] * rr;
                    if (kind < 2) { *(f32x4*)(fo + bj * HALF) = v0; *(f32x4*)(fo + bj * HALF + 4) = v1; }
                    if (kind == 3) {
#pragma unroll
                        for (int j = 0; j < 4; ++j) { v0[j] = silu_f(v0[j]); v1[j] = silu_f(v1[j]); } }
                    *(bf16x8*)(bo + (size_t)row * DM + colt + bj * HALF) = pack8(v0, v1);
                    if (kind == 0 || kind == 2) {
                        float ss = (v0[0] * v0[0] + v0[1] * v0[1]) + (v0[2] * v0[2] + v0[3] * v0[3]) + (v1[0] * v1[0] + v1[1] * v1[1]) + (v1[2] * v1[2] + v1[3] * v1[3]);
                        ss = xsum16(ss); ss = xsum32(ss);
                        float* nt = (float*)(ws + (kind == 0 ? WS_KNRM : WS_QNRM));
                        if (fq == 0) nt[((size_t)row * NH + 2 * (colt >> 8) + bj) * 4 + wc] = ss; } } }
        }
    }
};
}

namespace att {
constexpr int NW = 8, QBLK = 32, KVBLK = 64, QB = NW * QBLK, D = 128, LD = 2048;
constexpr int SHM_V = KVBLK * D * 2, SHM_K = KVBLK * D * 2;
constexpr int OFF_WS = 2 * SHM_V + 2 * SHM_K, OFF_F = OFF_WS + NW * 64 * 4, OFF_SC = OFF_F + SEQ * 4, OFF_KT = OFF_SC + 64, OFF_QM = OFF_KT + 256, OFF_JL = OFF_QM + 128;
constexpr float SKIP_T = 32.f;
constexpr float THR2 = 11.5f;
#define KSWZ(row, colB) ((row) * 256 + ((colB) ^ (((row) & 7) << 4)))
#define SBAR() __builtin_amdgcn_sched_barrier(0)
__device__ __forceinline__ int v_st(int k, int c) { const int kk = (k & ~0xC) | ((k & 4) << 1) | ((k & 8) >> 1); return ((kk >> 3) * 4 + (c >> 5)) * 512 + ((kk & 7) * 32 + (c & 31)) * 2; }
__device__ __forceinline__ int v_rd_base(int lane) { return ((lane & 3) << 3) | (((lane >> 2) & 3) << 6) | (((lane >> 4) & 1) << 5) | (((lane >> 5) & 1) << 8); }
constexpr int v_rd_off(int d0, int ks, int half) { return d0 * 512 + ks * 4096 + half * 2048; }
__device__ __forceinline__ int crow(int r, int hi) { return (r & 3) + 8 * (r >> 2) + 4 * hi; }
__device__ __forceinline__ void mask_tile(f32x16& p0, f32x16& p1, int dq) {
    const float NEG = -__builtin_inff();
#pragma unroll
    for (int r = 0; r < 16; ++r) { const int c = (r & 3) + 8 * (r >> 2);
        if (dq - c < 0) p0[r] = NEG;
        if (dq - c - 32 < 0) p1[r] = NEG; }
}
__device__ __forceinline__ void partialSM(f32x16& p0, f32x16& p1, float& m_reg, float& mn, float& alpha) {
    float pmax = p0[0];
#pragma unroll
    for (int r = 1; r < 16; ++r) pmax = fmaxf(pmax, p0[r]);
#pragma unroll
    for (int r = 0; r < 16; ++r) pmax = fmaxf(pmax, p1[r]);
    { auto rr = __builtin_amdgcn_permlane32_swap(__float_as_uint(pmax), __float_as_uint(pmax), false, false);
      pmax = fmaxf(__uint_as_float(rr[0]), __uint_as_float(rr[1])); }
    if (__builtin_expect(__all((pmax - m_reg) <= THR2), 1)) { mn = m_reg; alpha = 1.f; }
    else { mn = fmaxf(m_reg, pmax); alpha = __builtin_amdgcn_exp2f(m_reg - mn); m_reg = mn; }
#pragma unroll
    for (int r = 0; r < 16; ++r) p0[r] = p0[r] - mn;
#pragma unroll
    for (int r = 0; r < 16; ++r) p1[r] = p1[r] - mn;
#pragma unroll
    for (int r = 0; r < 16; ++r) p0[r] = __builtin_amdgcn_exp2f(p0[r]);
}
__device__ __forceinline__ void finishSM(f32x16& p0, f32x16& p1, float alpha, float& l_reg, bf16x8& pa0, bf16x8& pa1, bf16x8& pa2, bf16x8& pa3) {
#pragma unroll
    for (int r = 0; r < 16; ++r) p1[r] = __builtin_amdgcn_exp2f(p1[r]);
    float ps = 0;
#pragma unroll
    for (int r = 0; r < 16; ++r) ps += p0[r];
#pragma unroll
    for (int r = 0; r < 16; ++r) ps += p1[r];
    { auto rr = __builtin_amdgcn_permlane32_swap(__float_as_uint(ps), __float_as_uint(ps), false, false);
      ps = __uint_as_float(rr[0]) + __uint_as_float(rr[1]); }
    l_reg = l_reg * alpha + ps;
#define PK4(P, B_, OUT) do { unsigned a0 = cvtpk(P[B_+0], P[B_+1]), a1 = cvtpk(P[B_+2], P[B_+3]);                          \
        unsigned b0 = cvtpk(P[B_+4], P[B_+5]), b1 = cvtpk(P[B_+6], P[B_+7]);                                             \
        auto r0 = __builtin_amdgcn_permlane32_swap(a0, b0, false, false); auto r1 = __builtin_amdgcn_permlane32_swap(a1, b1, false, false); \
        u32x4 w = {r0[0], r1[0], r0[1], r1[1]}; OUT = *reinterpret_cast<bf16x8*>(&w); } while (0)
    PK4(p0, 0, pa0); PK4(p0, 8, pa1); PK4(p1, 0, pa2); PK4(p1, 8, pa3);
#undef PK4
}
template <int KB>
__device__ __forceinline__ void qkt(f32x16& p0, f32x16& p1, const char* K_lds, const float* fl, int r32, int hi, const bf16x8* qr) {
    { const f32x4 a0 = *(const f32x4*)(fl), a1 = *(const f32x4*)(fl + 8), a2 = *(const f32x4*)(fl + 16), a3 = *(const f32x4*)(fl + 24);
      const f32x4 b0 = *(const f32x4*)(fl + 32), b1 = *(const f32x4*)(fl + 40), b2 = *(const f32x4*)(fl + 48), b3 = *(const f32x4*)(fl + 56);
      p0 = (f32x16){a0[0], a0[1], a0[2], a0[3], a1[0], a1[1], a1[2], a1[3], a2[0], a2[1], a2[2], a2[3], a3[0], a3[1], a3[2], a3[3]};
      p1 = (f32x16){b0[0], b0[1], b0[2], b0[3], b1[0], b1[1], b1[2], b1[3], b2[0], b2[1], b2[2], b2[3], b3[0], b3[1], b3[2], b3[3]}; }
    const char* kb[4];
#pragma unroll
    for (int dd = 0; dd < 4; ++dd) kb[dd] = K_lds + KB * SHM_K + KSWZ(r32, (dd * 16 + hi * 8) * 2);
#pragma unroll
    for (int d0 = 0; d0 < 8; ++d0) { const char* a = kb[d0 & 3] + (d0 >> 2) * 128;
        bf16x8 b0 = *reinterpret_cast<const bf16x8*>(a);
        bf16x8 b1 = *reinterpret_cast<const bf16x8*>(a + 32 * 256);
        p0 = __builtin_amdgcn_mfma_f32_32x32x16_bf16(b0, qr[d0], p0, 0, 0, 0);
        p1 = __builtin_amdgcn_mfma_f32_32x32x16_bf16(b1, qr[d0], p1, 0, 0, 0); }
}
template <int VB>
__device__ __forceinline__ void pv_tile(f32x16* o, int vb0, bf16x8 pa0, bf16x8 pa1, bf16x8 pa2, bf16x8 pa3) {
#define TRRD(dst, off) asm volatile("ds_read_b64_tr_b16 %0, %1 offset:%2" : "=&v"(dst) : "v"(vb0), "i"(off) : "memory")
#define PV_D0(d0) do { s16x4 l0, l1, l2, l3, h0, h1, h2, h3; constexpr int b_ = VB * SHM_V + v_rd_off(d0, 0, 0);   \
        TRRD(l0, b_); TRRD(h0, b_ + 2048); TRRD(l1, b_ + 4096); TRRD(h1, b_ + 6144); TRRD(l2, b_ + 8192); TRRD(h2, b_ + 10240); TRRD(l3, b_ + 12288); TRRD(h3, b_ + 14336); \
        asm volatile("s_waitcnt lgkmcnt(0)" ::: "memory"); SBAR();   \
        o[d0] = __builtin_amdgcn_mfma_f32_32x32x16_bf16(pa0, (bf16x8){l0[0], l0[1], l0[2], l0[3], h0[0], h0[1], h0[2], h0[3]}, o[d0], 0, 0, 0);   \
        o[d0] = __builtin_amdgcn_mfma_f32_32x32x16_bf16(pa1, (bf16x8){l1[0], l1[1], l1[2], l1[3], h1[0], h1[1], h1[2], h1[3]}, o[d0], 0, 0, 0);   \
        o[d0] = __builtin_amdgcn_mfma_f32_32x32x16_bf16(pa2, (bf16x8){l2[0], l2[1], l2[2], l2[3], h2[0], h2[1], h2[2], h2[3]}, o[d0], 0, 0, 0);   \
        o[d0] = __builtin_amdgcn_mfma_f32_32x32x16_bf16(pa3, (bf16x8){l3[0], l3[1], l3[2], l3[3], h3[0], h3[1], h3[2], h3[3]}, o[d0], 0, 0, 0); } while (0)
    PV_D0(0); PV_D0(1); PV_D0(2); PV_D0(3);
#undef PV_D0
#undef TRRD
}
struct Tensors { const bf16_t* q; const bf16_t* k; const bf16_t* v; bf16_t* og; const bf16_t* sg; const float* lft; };
struct BlockRef { unsigned q0, s0; int P0, jlo; };
struct Seam { bf16x8 qr[8]; bf16x8 st_v0, st_v1, st_k0, st_k1; };
#define ROWP(p, k0) ((p) + (unsigned)(k0) * (unsigned)LD)
#define VMW() asm volatile("s_waitcnt vmcnt(0)" ::: "memory")
#define VMWN(n) asm volatile("s_waitcnt vmcnt(%0)" :: "i"(n) : "memory")
#define LD8(p) (*reinterpret_cast<const bf16x8*>(p))
#define SLOAD_H(Kp, Vp, k0) do { S.st_v0 = LD8(ROWP(Vp, k0) + voff); S.st_v1 = LD8(ROWP(Vp, (k0) + 32) + voff);              \
                         S.st_k0 = LD8(ROWP(Kp, k0) + voff); S.st_k1 = LD8(ROWP(Kp, (k0) + 32) + voff); } while (0)
#define SWRITE_HK(bf) do { *(bf16x8*)(K_lds + (bf) * SHM_K + kws) = S.st_k0; *(bf16x8*)(K_lds + (bf) * SHM_K + kws + 32 * 256) = S.st_k1; } while (0)
#define SWRITE_HV(bf) do { *(bf16x8*)(V_lds + (bf) * SHM_V + vst0) = S.st_v0; *(bf16x8*)(V_lds + (bf) * SHM_V + vst0 + VST1) = S.st_v1; } while (0)
#define SWRITE_H(bf) do { SWRITE_HV(bf); SWRITE_HK(bf); } while (0)
__device__ __forceinline__ void prime(int wv, const Tensors& T, const BlockRef& cur, char* lds, Seam& S) {
    const int tid = otid(wv), wid = __builtin_amdgcn_readfirstlane(tid >> 6), lane = tid & 63, r32 = lane & 31, hi = lane >> 5;
    const int sr = tid >> 4, sc = (tid & 15) * 8, kws = KSWZ(sr, sc * 2); char* K_lds = lds + 2 * SHM_V;
    const unsigned voff = (unsigned)sr * LD + sc, qoff = (unsigned)(wid * QBLK + r32) * LD + hi * 8;
    const bf16_t* Qp = T.q + cur.q0; const bf16_t* Kh = T.k + cur.s0; const bf16_t* Vh = T.v + cur.s0;
#pragma unroll
    for (int d0 = 0; d0 < 8; ++d0) S.qr[d0] = LD8(Qp + qoff + d0 * 16);
    SLOAD_H(Kh, Vh, cur.jlo * KVBLK); VMW(); SWRITE_HK(0);
    __syncthreads();
}
__device__ __forceinline__ void block(int wv, const Tensors& T, const BlockRef& cur, const BlockRef& nxt, char* lds, Seam& S) {
    const int tid = otid(wv), wid = __builtin_amdgcn_readfirstlane(tid >> 6), lane = tid & 63, r32 = lane & 31, hi = lane >> 5;
    const int j_lo = cur.jlo, NT = (cur.P0 + QB) / KVBLK - j_lo;
    const int qlo = cur.P0 - j_lo * KVBLK + wid * QBLK, qm = qlo + r32 - 4 * hi;
    char* V_lds = lds; char* K_lds = lds + 2 * SHM_V;
    float* wsl = (float*)(lds + OFF_WS) + wid * 64; float* li_l = wsl, * al_l = wsl + 32;
    float* Fl = (float*)(lds + OFF_F);
    float m_reg = -1e30f, l_reg = 0; f32x16 o[4] = {};
    const int sr = tid >> 4, sc = (tid & 15) * 8, vst0 = v_st(sr, sc), kws = KSWZ(sr, sc * 2); constexpr int VST1 = 8192;
    const int vb0 = (int)(uintptr_t)V_lds + v_rd_base(lane);
    const bf16_t* Kh = T.k + cur.s0 + (unsigned)(j_lo * KVBLK) * LD; const bf16_t* Vh = T.v + cur.s0 + (unsigned)(j_lo * KVBLK) * LD;
    const unsigned voff = (unsigned)sr * LD + sc, qoff = (unsigned)(wid * QBLK + r32) * LD + hi * 8;
    const float* flb = Fl + j_lo * KVBLK + 4 * hi;
#define RESC(a) do { if (__any((a) < 1.f)) { if (hi == 0) al_l[r32] = (a); asm volatile("s_waitcnt lgkmcnt(0)" ::: "memory");              \
                     for (int d_ = 0; d_ < 4; ++d_) for (int r = 0; r < 16; ++r) o[d_][r] *= al_l[crow(r, hi)]; } } while (0)
#define KBASE(t) ((t) * KVBLK)
#define MASKT(P0_, P1_, t) do { const int kb_ = KBASE(t); if (kb_ + KVBLK - 1 > qlo) mask_tile(P0_, P1_, qm - kb_); } while (0)
#define SEAM_K0() do { VMWN(8); SWRITE_HK(0); SBAR(); } while (0)
    f32x16 pA0, pA1, pB0, pB1; float mnA, mnB, alA, alB; bf16x8 pa0, pa1, pa2, pa3;
    SWRITE_HV(0); SBAR();
    if (NT > 1) { SLOAD_H(Kh, Vh, KBASE(1)); }
    SBAR(); qkt<0>(pA0, pA1, K_lds, flb + KBASE(0), r32, hi, S.qr);
    MASKT(pA0, pA1, 0); partialSM(pA0, pA1, m_reg, mnA, alA);
    if (NT > 1) { VMW(); SWRITE_H(1); }
    __syncthreads();
#define HALF_STEP(PX0, PX1, mnX, alX, PY0, PY1, alY, t, KB, VB, SB) do {                                                      \
        SBAR(); qkt<KB>(PX0, PX1, K_lds, flb + KBASE(t), r32, hi, S.qr);                                             \
        finishSM(PY0, PY1, alY, l_reg, pa0, pa1, pa2, pa3); SBAR();                                                           \
        if ((t) + 1 < NT) { SLOAD_H(Kh, Vh, KBASE((t) + 1)); SBAR(); }                                               \
        pv_tile<VB>(o, vb0, pa0, pa1, pa2, pa3); MASKT(PX0, PX1, (t)); partialSM(PX0, PX1, m_reg, mnX, alX);                                        \
        __syncthreads();                                                                                                      \
        if ((t) + 1 < NT) { VMW(); SWRITE_H(SB); }                                                                          \
        RESC(alX); __syncthreads(); } while (0)
    for (int t = 1; t + 1 < NT; t += 2) {
        HALF_STEP(pB0, pB1, mnB, alB, pA0, pA1, alA, t, 1, 0, 0);
        HALF_STEP(pA0, pA1, mnA, alA, pB0, pB1, alB, t + 1, 0, 1, 1);
    }
    const bool even = (NT & 1) == 0;
    if (even) { SBAR(); qkt<1>(pB0, pB1, K_lds, flb + KBASE(NT - 1), r32, hi, S.qr); SBAR(); }
    { const bf16_t* Kn = T.k + nxt.s0; const bf16_t* Vn = T.v + nxt.s0; SLOAD_H(Kn, Vn, nxt.jlo * KVBLK); } SBAR();
    { const bf16_t* Qn = T.q + nxt.q0;
#pragma unroll
      for (int d0 = 0; d0 < 8; ++d0) S.qr[d0] = LD8(Qn + qoff + d0 * 16); }
    SBAR();
    finishSM(pA0, pA1, alA, l_reg, pa0, pa1, pa2, pa3); SBAR();
    pv_tile<0>(o, vb0, pa0, pa1, pa2, pa3);
    if (even) { MASKT(pB0, pB1, NT - 1); partialSM(pB0, pB1, m_reg, mnB, alB); __syncthreads(); RESC(alB);
        finishSM(pB0, pB1, alB, l_reg, pa0, pa1, pa2, pa3); SBAR(); pv_tile<1>(o, vb0, pa0, pa1, pa2, pa3); }
    SBAR(); SEAM_K0();
    if (hi == 0) li_l[r32] = l_reg; asm volatile("s_waitcnt lgkmcnt(0)" ::: "memory");
    float rli[16];
#pragma unroll
    for (int r = 0; r < 16; ++r) rli[r] = __builtin_amdgcn_rcpf(li_l[crow(r, hi)]);
    { const unsigned eoff = (unsigned)(4 * hi) * LD + r32;
      unsigned gg[16][4];
#pragma unroll
      for (int r = 0; r < 16; ++r) { const bf16_t* Grow = T.sg + cur.q0 + (unsigned)(wid * QBLK + (r & 3) + 8 * (r >> 2)) * LD;
#pragma unroll
        for (int d0 = 0; d0 < 4; ++d0) gg[r][d0] = *(const unsigned*)(Grow + (eoff & ~1u) + d0 * 32); }
#pragma unroll
      for (int r = 0; r < 16; ++r) { bf16_t* Orow = T.og + cur.q0 + (unsigned)(wid * QBLK + (r & 3) + 8 * (r >> 2)) * LD;
#pragma unroll
        for (int d0 = 0; d0 < 4; ++d0) { const float v = o[d0][r] * rli[r];
            const float vn = __shfl_xor(v, 1);
            if ((r32 & 1) == 0) *(unsigned*)(Orow + eoff + d0 * 32) = cvtpk(v * bflo(gg[r][d0]), vn * bfhi(gg[r][d0])); } } }
    __syncthreads();
#undef RESC
#undef KBASE
#undef MASKT
#undef SEAM_K0
#undef HALF_STEP
}
#undef ROWP
#undef VMW
#undef VMWN
#undef SLOAD_H
#undef SWRITE_HK
#undef SWRITE_HV
#undef SWRITE_H
#undef LD8

__device__ __forceinline__ BlockRef mkref(int bh, int qb) {
    const int b = bh >> 4, h = bh & 15; BlockRef r; r.s0 = (unsigned)b * SEQ * LD + h * D; r.q0 = r.s0 + (unsigned)qb * QB * LD; r.jlo = 0; r.P0 = qb * QB; return r;
}
__device__ __forceinline__ void item_setup(int wv, const Tensors& T, const float* knrm, const float* qnrm, int bh, unsigned blks, int nb, char* lds) {
    const int tid = otid(wv), wid = __builtin_amdgcn_readfirstlane(tid >> 6), lane = tid & 63;
    float* Fl = (float*)(lds + OFF_F); float* scn = (float*)(lds + OFF_SC); float* Kt = (float*)(lds + OFF_KT); float* Qm = (float*)(lds + OFF_QM); int* JL = (int*)(lds + OFF_JL);
    const int b = bh >> 4, h = bh & 15, xmax = (int)((blks >> (4 * (nb - 1))) & 15u), nkeys = (xmax + 1) * QB, t0 = tid * 8;
    const float* LF = T.lft + (size_t)bh * SEQ;
    f32x4 a = {0.f, 0.f, 0.f, 0.f}, c = {0.f, 0.f, 0.f, 0.f};
    float kmx = 0.f;
    if (t0 < nkeys) { a = *(const f32x4*)(LF + t0); c = *(const f32x4*)(LF + t0 + 4);
        const float* kn = knrm + ((size_t)(b * SEQ + t0) * NH + h) * 4;
#pragma unroll
        for (int i = 0; i < 8; ++i) { const f32x4 p = *(const f32x4*)(kn + (size_t)i * NH * 4); kmx = fmaxf(kmx, (p[0] + p[1]) + (p[2] + p[3])); } }
    kmx = fmaxf(kmx, bperm(kmx, lane ^ 1)); kmx = fmaxf(kmx, bperm(kmx, lane ^ 2)); kmx = fmaxf(kmx, bperm(kmx, lane ^ 4));
    if ((tid & 7) == 0 && t0 < nkeys) Kt[tid >> 3] = sqrtf(kmx) * 1.01f;
#pragma unroll 1
    for (int bi = 0; bi < nb; bi += 2) { const int bsel = bi + (tid >> 8);
        if (bsel < nb) { const int x = (int)((blks >> (4 * bsel)) & 15u), qrow = b * SEQ + x * QB + (tid & 255);
            const f32x4 p = *(const f32x4*)(qnrm + ((size_t)qrow * NH + h) * 4); float qm = (p[0] + p[1]) + (p[2] + p[3]);
#pragma unroll
            for (int o = 1; o < 64; o <<= 1) qm = fmaxf(qm, bperm(qm, lane ^ o));
            if (lane == 0) Qm[bsel * 4 + (wid & 3)] = qm; } }
    a[1] += a[0]; a[2] += a[1]; a[3] += a[2]; c[0] += a[3]; c[1] += c[0]; c[2] += c[1]; c[3] += c[2];
    const float tot = c[3]; float inc = tot;
#pragma unroll
    for (int o = 1; o < 64; o <<= 1) { const float v = bperm(inc, (lane - o) & 63); if (lane >= o) inc += v; }
    if (lane == 63) scn[wid] = inc;
    if (tid < nb) JL[tid] = (int)((blks >> (4 * tid)) & 15u) * 4;
    __syncthreads();
    float base = inc - tot;
    for (int w = 0; w < wid; ++w) base += scn[w];
    a = (a + base) * (-LOG2E); c = (c + base) * (-LOG2E);
    if (t0 < nkeys) { *(f32x4*)(Fl + t0) = a; *(f32x4*)(Fl + t0 + 4) = c; }
    __syncthreads();
    { const int which = tid >> 6, j = tid & 63;
      if (which < nb) { const int x = (int)((blks >> (4 * which)) & 15u), nd = x * 4;
        if (j < nd) { const float qmax = sqrtf(fmaxf(fmaxf(Qm[which * 4], Qm[which * 4 + 1]), fmaxf(Qm[which * 4 + 2], Qm[which * 4 + 3]))) * 1.01f;
            const float kdiag = fmaxf(fmaxf(Kt[nd], Kt[nd + 1]), fmaxf(Kt[nd + 2], Kt[nd + 3]));
            const bool skip = qmax * (Kt[j] + kdiag) + Fl[64 * j + 63] - Fl[x * QB] < -SKIP_T;
            if (!skip) atomicMin(JL + which, j); } } }
    __syncthreads();
}
__device__ __forceinline__ void prompt_phase(int wv, char* lds, const Tensors& T, const float* knrm, const float* qnrm, int pw) {
    const int bh = pw / 3, gsel = pw - bh * 3;
    const unsigned blks = gsel == 0 ? 0xDA742u : (gsel == 1 ? 0xEB8510u : 0xFC963u); const int nb = gsel == 1 ? 6 : 5;
    item_setup(wv, T, knrm, qnrm, bh, blks, nb, lds);
    const int* JL = (const int*)(lds + OFF_JL);
    Seam S;
    BlockRef cur = mkref(bh, (int)(blks & 15u)); cur.jlo = __builtin_amdgcn_readfirstlane(JL[0]);
    prime(wv, T, cur, lds, S);
#pragma unroll 1
    for (int i = 0; i < nb; ++i) { const int in = i + 1 < nb ? i + 1 : i;
        BlockRef nxt = mkref(bh, (int)((blks >> (4 * in)) & 15u)); nxt.jlo = __builtin_amdgcn_readfirstlane(JL[in]);
        block(wv, T, cur, nxt, lds, S);
        cur = nxt; }
}
}

namespace sat {
constexpr int OFF_F = 0, OFF_SC = 8448, OFF_P = 8704, OFF_A = OFF_P + 8 * 4096, OFF_ML = OFF_A + 512, OFF_O = OFF_ML + 1024;
struct Tensors { const bf16_t* q; const bf16_t* kb; const bf16_t* vb; bf16_t* og; const bf16_t* sg; const float* ck; const float* cv; const float* clf; const float* lfts; };
__device__ __forceinline__ void item(int wv, char* lds, const Tensors& T, int b, int h) {
    const int tid = otid(wv), wid = __builtin_amdgcn_readfirstlane(tid >> 6), lane = tid & 63, fr = lane & 15, fq = lane >> 4;
    float* Fl = (float*)(lds + OFF_F); float* scn = (float*)(lds + OFF_SC);
    float* ML = (float*)(lds + OFF_ML); float* Op = (float*)(lds + OFF_O);
    { const float* cl = T.clf + ((size_t)b * PAST + tid * 4) * NH + h;
      float a0 = cl[0], a1 = cl[NH], a2 = cl[2 * NH], a3 = cl[3 * NH];
      a1 += a0; a2 += a1; a3 += a2;
      const float tot = a3; float inc = tot;
#pragma unroll
      for (int o = 1; o < 64; o <<= 1) { const float v = bperm(inc, (lane - o) & 63); if (lane >= o) inc += v; }
      if (lane == 63) scn[wid] = inc;
      __syncthreads();
      float base = inc - tot, all = 0.f;
      for (int w = 0; w < 8; ++w) { const float sw = scn[w]; if (w < wid) base += sw; all += sw; }
      *(f32x4*)(Fl + tid * 4) = (f32x4){(a0 + base) * (-LOG2E), (a1 + base) * (-LOG2E), (a2 + base) * (-LOG2E), (a3 + base) * (-LOG2E)};
      if (tid < DSEQ) { const float* nl = T.lfts + ((size_t)b * NH + h) * DSEQ; float s = all; for (int i = 0; i <= tid; ++i) s += nl[i]; Fl[PAST + tid] = s * (-LOG2E); }
      __syncthreads(); }
    const size_t qrow = (size_t)(MP + b * DSEQ);
    bf16x8 qf[4];
#pragma unroll
    for (int dc = 0; dc < 4; ++dc) qf[dc] = *(const bf16x8*)(T.q + (qrow + fr) * DM + h * HD + dc * 32 + fq * 8);
    float m_run = -1e30f, l_run = 0.f;
    f32x4 ot[8];
#pragma unroll
    for (int dt = 0; dt < 8; ++dt) ot[dt] = (f32x4){0.f, 0.f, 0.f, 0.f};
    const unsigned vlo = (unsigned)(fq * 4) * (NH * HD) + fr;
    for (int ch = 0; ch < 4; ++ch) {
        const int key0 = (ch * 8 + wid) * 64;
        f32x4 s4[4];
        { f32x4 kk[4][4][2];
#pragma unroll
          for (int tl = 0; tl < 4; ++tl) { const float* kp = T.ck + (((size_t)b * PAST + key0 + tl * 16 + fr) * NH + h) * HD + fq * 8;
#pragma unroll
            for (int dc = 0; dc < 4; ++dc) { kk[tl][dc][0] = *(const f32x4*)(kp + dc * 32); kk[tl][dc][1] = *(const f32x4*)(kp + dc * 32 + 4); } }
          __builtin_amdgcn_sched_barrier(0);
#pragma unroll
          for (int tl = 0; tl < 4; ++tl) { f32x4 acc = *(const f32x4*)(Fl + key0 + tl * 16 + fq * 4);
#pragma unroll
            for (int dc = 0; dc < 4; ++dc) acc = __builtin_amdgcn_mfma_f32_16x16x32_bf16(pack8(kk[tl][dc][0], kk[tl][dc][1]), qf[dc], acc, 0, 0, 0);
            s4[tl] = acc; } }
        __builtin_amdgcn_sched_barrier(0);
        float vv[2][8][8];
        { const float* vb_c = T.cv + (((size_t)b * PAST + key0) * NH + h) * HD;
#pragma unroll
          for (int hf = 0; hf < 2; ++hf)
#pragma unroll
            for (int dt = 0; dt < 8; ++dt)
#pragma unroll
                for (int i = 0; i < 4; ++i) { vv[hf][dt][i] = (vb_c + (size_t)(hf * 32 + i) * (NH * HD) + dt * 16)[vlo]; vv[hf][dt][4 + i] = (vb_c + (size_t)(hf * 32 + 16 + i) * (NH * HD) + dt * 16)[vlo]; } }
        float cm = s4[0][0];
#pragma unroll
        for (int tl = 0; tl < 4; ++tl)
#pragma unroll
            for (int j = 0; j < 4; ++j) cm = fmaxf(cm, s4[tl][j]);
        cm = xmax16(cm); cm = xmax32(cm);
        const float mn = fmaxf(m_run, cm), alpha = __builtin_amdgcn_exp2f(m_run - mn); m_run = mn;
        float ps = 0.f;
#pragma unroll
        for (int tl = 0; tl < 4; ++tl)
#pragma unroll
            for (int j = 0; j < 4; ++j) { s4[tl][j] = __builtin_amdgcn_exp2f(s4[tl][j] - mn); ps += s4[tl][j]; }
        ps = xsum16(ps); ps = xsum32(ps);
        l_run = l_run * alpha + ps;
#pragma unroll
        for (int dt = 0; dt < 8; ++dt) ot[dt] *= alpha;
#pragma unroll
        for (int hf = 0; hf < 2; ++hf) {
            const bf16x8 pb = pack8(s4[2 * hf], s4[2 * hf + 1]);
#pragma unroll
            for (int dt = 0; dt < 8; ++dt) { const f32x4 v0 = {vv[hf][dt][0], vv[hf][dt][1], vv[hf][dt][2], vv[hf][dt][3]}, v1 = {vv[hf][dt][4], vv[hf][dt][5], vv[hf][dt][6], vv[hf][dt][7]};
                ot[dt] = __builtin_amdgcn_mfma_f32_16x16x32_bf16(pack8(v0, v1), pb, ot[dt], 0, 0, 0); } }
    }
    if (wid == 0) {
        f32x4 acc = *(const f32x4*)(Fl + PAST + fq * 4);
        const bf16_t* kp = T.kb + (qrow + fr) * DM + h * HD + fq * 8;
#pragma unroll
        for (int dc = 0; dc < 4; ++dc) acc = __builtin_amdgcn_mfma_f32_16x16x32_bf16(*(const bf16x8*)(kp + dc * 32), qf[dc], acc, 0, 0, 0);
#pragma unroll
        for (int j = 0; j < 4; ++j) if (fq * 4 + j > fr) acc[j] = -__builtin_inff();
        float cm = fmaxf(fmaxf(acc[0], acc[1]), fmaxf(acc[2], acc[3]));
        cm = xmax16(cm); cm = xmax32(cm);
        const float mn = fmaxf(m_run, cm), alpha = __builtin_amdgcn_exp2f(m_run - mn); m_run = mn;
        float ps = 0.f;
#pragma unroll
        for (int j = 0; j < 4; ++j) { acc[j] = __builtin_amdgcn_exp2f(acc[j] - mn); ps += acc[j]; }
        ps = xsum16(ps); ps = xsum32(ps);
        l_run = l_run * alpha + ps;
        const bf16x8 pb = pack8(acc, (f32x4){0.f, 0.f, 0.f, 0.f});
        const bf16_t* vb_u = T.vb + qrow * DM + h * HD; const unsigned vlo2 = (unsigned)(fq * 4) * DM + fr;
#pragma unroll
        for (int dt = 0; dt < 8; ++dt) { ot[dt] *= alpha;
            unsigned w0 = (unsigned)(vb_u + dt * 16)[vlo2] | ((unsigned)(vb_u + DM + dt * 16)[vlo2] << 16), w1 = (unsigned)(vb_u + 2 * DM + dt * 16)[vlo2] | ((unsigned)(vb_u + 3 * DM + dt * 16)[vlo2] << 16);
            u32x4 w = {w0, w1, 0u, 0u};
            ot[dt] = __builtin_amdgcn_mfma_f32_16x16x32_bf16(*reinterpret_cast<bf16x8*>(&w), pb, ot[dt], 0, 0, 0); }
    }
#pragma unroll
    for (int dt = 0; dt < 8; ++dt) *(f32x4*)(Op + (wid * 16 + fr) * HD + dt * 16 + fq * 4) = ot[dt];
    if (fq == 0) { ML[(wid * 16 + fr) * 2] = m_run; ML[(wid * 16 + fr) * 2 + 1] = l_run; }
    __syncthreads();
    { const int q = tid >> 5, d4 = (tid & 31) * 4;
      float mx = ML[q * 2];
#pragma unroll
      for (int w = 1; w < 8; ++w) mx = fmaxf(mx, ML[(w * 16 + q) * 2]);
      float L = 0.f; f32x4 O = {0.f, 0.f, 0.f, 0.f};
#pragma unroll
      for (int w = 0; w < 8; ++w) { const float s = __builtin_amdgcn_exp2f(ML[(w * 16 + q) * 2] - mx); L += s * ML[(w * 16 + q) * 2 + 1]; O += *(const f32x4*)(Op + (w * 16 + q) * HD + d4) * s; }
      const float il = 1.0f / L; const size_t off = (qrow + q) * DM + h * HD + d4;
      const u32x2 gw = *(const u32x2*)(T.sg + off);
      u32x2 w; w.x = cvtpk(O[0] * il * bflo(gw.x), O[1] * il * bfhi(gw.x)); w.y = cvtpk(O[2] * il * bflo(gw.y), O[3] * il * bfhi(gw.y));
      *(u32x2*)(T.og + off) = w; }
    __syncthreads();
}
}

struct TrV { f32x4 v[8]; };
__device__ __forceinline__ void tr_load(const float* W, int ldw, int N, const float* g, int item, int lane, TrV& t) {
    const int nblk = (N + 31) / 32, kb = item / nblk, nb = item % nblk, k0 = 64 * kb, n0 = 32 * nb;
    const int c4 = (lane & 7) * 4, kr = lane >> 3; const bool nok = n0 + c4 < N;
#pragma unroll
    for (int i = 0; i < 8; ++i) t.v[i] = nok ? *(const f32x4*)(W + (size_t)(k0 + 8 * i + kr) * ldw + n0 + c4) : (f32x4){0.f, 0.f, 0.f, 0.f};
    if (g) {
#pragma unroll
        for (int i = 0; i < 8; ++i) t.v[i] *= g[k0 + 8 * i + kr]; }
}
__device__ __forceinline__ void tr_emit(int N, bf16_t* WT, int K, float* scr, int item, int lane, const TrV& t, bf16_t* plain) {
    const int nblk = (N + 31) / 32, kb = item / nblk, nb = item % nblk, k0 = 64 * kb, n0 = 32 * nb;
    const int c4 = (lane & 7) * 4, kr = lane >> 3;
#pragma unroll
    for (int i = 0; i < 8; ++i) { float* s = scr + (8 * i + kr) * 33 + c4; s[0] = t.v[i][0]; s[1] = t.v[i][1]; s[2] = t.v[i][2]; s[3] = t.v[i][3]; }
    if (plain && n0 + c4 < N) {
#pragma unroll
        for (int i = 0; i < 8; ++i) { u32x2 w; w.x = cvtpk(t.v[i][0], t.v[i][1]); w.y = cvtpk(t.v[i][2], t.v[i][3]); *(u32x2*)(plain + (size_t)(k0 + 8 * i + kr) * N + n0 + c4) = w; } }
    asm volatile("s_waitcnt lgkmcnt(0)" ::: "memory");
    const int c = lane & 7;
#pragma unroll
    for (int j = 0; j < 4; ++j) { const int nn = (lane >> 3) + 8 * j; const float* s = scr + (8 * c) * 33 + nn;
        u32x4 o; o.x = cvtpk(s[0 * 33], s[1 * 33]); o.y = cvtpk(s[2 * 33], s[3 * 33]); o.z = cvtpk(s[4 * 33], s[5 * 33]); o.w = cvtpk(s[6 * 33], s[7 * 33]);
        if (n0 + nn < N) *(u32x4*)(WT + (size_t)(n0 + nn) * K + k0 + 8 * c) = o; }
    asm volatile("s_waitcnt lgkmcnt(0)" ::: "memory");
}
struct TJob { const float* W; bf16_t* WT; const float* g; int K, N, ldw; bf16_t* plain; };
__device__ __forceinline__ TJob get_job(const Params& p, int j) {
    unsigned char* ws = p.ws; TJob t; t.g = nullptr; t.ldw = 0; t.plain = nullptr;
    if (j < 2) { t.W = p.in[7] + (size_t)j * DM * 2 * EA + EA; t.WT = (bf16_t*)(ws + WS_WINA) + (size_t)j * 2 * EA * DM + (size_t)EA * DM; t.g = p.in[6] + j * DM; t.K = DM; t.N = EA; t.ldw = 2 * EA; }
    else if (j >= 17) { const int l = j - 17; t.W = p.in[7] + (size_t)l * DM * 2 * EA; t.WT = (bf16_t*)(ws + WS_WINUT) + (size_t)l * EA * DM; t.g = p.in[6] + l * DM; t.K = DM; t.N = EA; t.ldw = 2 * EA; t.plain = (bf16_t*)(ws + WS_WINUS) + (size_t)l * DM * EA; }
    else if (j < 10) { const int i = j - 2; t.W = p.in[8] + (size_t)i * 1024 * 1024; t.WT = (bf16_t*)(ws + WS_WGRP) + (size_t)i * 1024 * 1024; t.K = 1024; t.N = 1024; }
    else if (j < 12) { const int l = j - 10; t.W = p.in[10] + (size_t)l * EA * DM; t.WT = (bf16_t*)(ws + WS_WOUTA) + (size_t)l * DM * EA; t.K = EA; t.N = DM; }
    else if (j == 12) { t.W = p.in[12]; t.WT = (bf16_t*)(ws + WS_W4); t.g = p.in[11]; t.K = DM; t.N = 2 * DM + NH; }
    else if (j == 13) { t.W = p.in[15]; t.WT = (bf16_t*)(ws + WS_W4) + (size_t)4352 * DM; t.g = p.in[14]; t.K = DM; t.N = 2 * DM; }
    else if (j == 14) { t.W = p.in[15] + (size_t)DM * 2 * DM; t.WT = (bf16_t*)(ws + WS_WINB1); t.g = p.in[14] + DM; t.K = DM; t.N = 2 * DM; }
    else { const int l = j - 15; t.W = p.in[16] + (size_t)l * DM * DM; t.WT = (bf16_t*)(ws + WS_WOUTB) + (size_t)l * DM * DM; t.K = DM; t.N = DM; }
    if (t.ldw == 0) t.ldw = t.N;
    return t;
}
__device__ __forceinline__ void prologue_phase(int wv, const Params& p, char* lds) {
    const int tid = otid(wv), lane = tid & 63, wid = tid >> 6, G = gridDim.x;
    const int gw = blockIdx.x * NWAVES + wid, NGW = G * NWAVES;
    float* scr = (float*)(lds + wid * 8704);
    int rot = 0;
    for (int j = 0; j < 19; ++j) { const TJob t = get_job(p, j); const int nitems = (t.K / 64) * ((t.N + 31) / 32);
        int start = gw - rot; if (start < 0) start += NGW;
        TrV cur_v, nxt_v;
        if (start < nitems) tr_load(t.W, t.ldw, t.N, t.g, start, lane, cur_v);
        for (int it = start; it < nitems; it += NGW) { const bool more = it + NGW < nitems;
            if (more) tr_load(t.W, t.ldw, t.N, t.g, it + NGW, lane, nxt_v);
            tr_emit(t.N, t.WT, t.K, scr, it, lane, cur_v, t.plain);
            if (more) {
#pragma unroll
                for (int i = 0; i < 8; ++i) cur_v.v[i] = nxt_v.v[i]; } }
        rot = (rot + nitems) % NGW; }
    float* ssq = (float*)(p.ws + WS_SSQ); bf16_t* xb = (bf16_t*)(p.ws + WS_XB);
    for (int m = gw; m < MT; m += NGW) { const float* xr = m < MP ? p.in[0] + (size_t)m * DM : p.in[1] + (size_t)(m - MP) * DM;
        float s = 0.f; unsigned long long* o8 = (unsigned long long*)(xb + (size_t)m * DM) + lane;
        f32x4 xv[8];
#pragma unroll
        for (int j = 0; j < 8; ++j) xv[j] = *((const f32x4*)xr + lane + 64 * j);
#pragma unroll
        for (int j = 0; j < 8; ++j) { const f32x4 v = xv[j]; s += (v[0] * v[0] + v[1] * v[1]) + (v[2] * v[2] + v[3] * v[3]);
            o8[64 * j] = (unsigned long long)cvtpk(v[0], v[1]) | ((unsigned long long)cvtpk(v[2], v[3]) << 32); }
        s = wave_sum(s); if (lane == 0) ssq[m] = s; }
    for (int i = blockIdx.x * NTHREADS + tid; i < 4 * MT; i += G * NTHREADS) ssq[MT + i] = 0.f;
    { f32x4* z = (f32x4*)(p.ws + WS_SPLIT); const size_t nz = (SPLIT_TILES * SPLIT_TILE + SPLIT_TILES * 8 * 4) / 16;
      for (size_t i = (size_t)blockIdx.x * NTHREADS + tid; i < nz; i += (size_t)G * NTHREADS) z[i] = (f32x4){0.f, 0.f, 0.f, 0.f}; }
    if (blockIdx.x == 0) { unsigned* bw = (unsigned*)(p.ws + WS_BAR); for (int i = tid; i < 3456; i += NTHREADS) bw[i] = 0u; }
    {
      bf16_t* pb = (bf16_t*)(p.ws + WS_PREVB);
      for (int i = blockIdx.x * NTHREADS + tid; i < 2 * 256 * (EA / 8); i += G * NTHREADS) { const int r = i >> 9, c = (i & 511) * 8, l = r >> 8, rr = r & 255;
          f32x4 a = {0.f, 0.f, 0.f, 0.f}, b = a;
          if (rr < NDB * PPAD) { const float* s = p.in[5] + ((size_t)l * NDB * PPAD + rr) * EA + c; a = *(const f32x4*)s; b = *(const f32x4*)(s + 4); }
          *(bf16x8*)(pb + (size_t)r * EA + c) = pack8(a, b); } }
}
template <int W>
__device__ __forceinline__ void poolmix_item(const bf16_t* tt, const bf16_t* sg, const float* scale, const bf16_t* prevt, bf16_t* yg, int row0, int ch) {
    constexpr int NR = 16 + W - 1;
    u32x4 rows[NR];
    const bool samp = row0 >= MP; const int t0 = samp ? 0 : (row0 & (SEQ - 1));
    const bf16_t* up = tt + (size_t)row0 * EA + ch;
    if (t0 != 0) {
#pragma unroll
        for (int i = 0; i < NR; ++i) rows[i] = *(const u32x4*)(up + (ptrdiff_t)(i - (W - 1)) * EA);
    } else {
#pragma unroll
        for (int i = W - 1; i < NR; ++i) rows[i] = *(const u32x4*)(up + (ptrdiff_t)(i - (W - 1)) * EA);
        if (samp) { const bf16_t* pp = prevt + ((size_t)((row0 - MP) >> 4) * PPAD + (PPAD - (W - 1))) * EA + ch;
#pragma unroll
            for (int i = 0; i < W - 1; ++i) rows[i] = *(const u32x4*)(pp + (size_t)i * EA); }
        else {
#pragma unroll
            for (int i = 0; i < W - 1; ++i) rows[i] = (u32x4){0u, 0u, 0u, 0u}; }
    }
    const f32x4 sc0 = *(const f32x4*)(scale + ch), sc1 = *(const f32x4*)(scale + ch + 4);
    float s[8] = {0.f, 0.f, 0.f, 0.f, 0.f, 0.f, 0.f, 0.f};
#define ROWF(v, f) const float f[8] = {bflo(v.x), bfhi(v.x), bflo(v.y), bfhi(v.y), bflo(v.z), bfhi(v.z), bflo(v.w), bfhi(v.w)}
#pragma unroll
    for (int i = 0; i < W - 1; ++i) { ROWF(rows[i], f);
#pragma unroll
        for (int c = 0; c < 8; ++c) s[c] += f[c]; }
    constexpr int GB = W == 16 ? 2 : (W == 8 ? 8 : 16);
    u32x4 gvs[GB];
#pragma unroll
    for (int j = 0; j < 16; ++j) { ROWF(rows[j + W - 1], f);
        if ((j & (GB - 1)) == 0) {
#pragma unroll
            for (int jj = 0; jj < GB; ++jj) gvs[jj] = *(const u32x4*)(sg + (size_t)(row0 + j + jj) * EA + ch); }
        const u32x4 gv = gvs[j & (GB - 1)]; ROWF(gv, gt);
#pragma unroll
        for (int c = 0; c < 8; ++c) s[c] += f[c];
        const int nv = (!samp && t0 + j + 1 < W) ? t0 + j + 1 : W; const float ic = 1.0f / (float)nv;
        u32x4 o; o.x = cvtpk((s[0] * ic - f[0]) * sc0[0] * gt[0], (s[1] * ic - f[1]) * sc0[1] * gt[1]); o.y = cvtpk((s[2] * ic - f[2]) * sc0[2] * gt[2], (s[3] * ic - f[3]) * sc0[3] * gt[3]);
        o.z = cvtpk((s[4] * ic - f[4]) * sc1[0] * gt[4], (s[5] * ic - f[5]) * sc1[1] * gt[5]); o.w = cvtpk((s[6] * ic - f[6]) * sc1[2] * gt[6], (s[7] * ic - f[7]) * sc1[3] * gt[7]);
        *(u32x4*)(yg + (size_t)(row0 + j) * EA + ch) = o;
        ROWF(rows[j], g);
#pragma unroll
        for (int c = 0; c < 8; ++c) s[c] -= g[c]; }
#undef ROWF
}
__device__ __forceinline__ void poolmix_phase(int wv, const Params& p, int l) {
    const bf16_t* tt = (const bf16_t*)(p.ws + WS_U); const bf16_t* sg = (const bf16_t*)(p.ws + WS_SG); bf16_t* yg = (bf16_t*)(p.ws + WS_D);
    const bf16_t* prevt = (const bf16_t*)(p.ws + WS_PREVT) + (size_t)l * 256 * EA; const float* scale = p.in[9] + (size_t)l * EA;
    const int nth = gridDim.x * NTHREADS;
    for (int idx = blockIdx.x * NTHREADS + otid(wv); idx < (MT / 16) * (EA / 8); idx += nth) {
        const int row0 = (idx >> 9) * 16, ch = (idx & 511) * 8, grp = __builtin_amdgcn_readfirstlane(ch >> 10);
        if (grp == 0) poolmix_item<2>(tt, sg, scale, prevt, yg, row0, ch);
        else if (grp == 1) poolmix_item<4>(tt, sg, scale, prevt, yg, row0, ch);
        else if (grp == 2) poolmix_item<8>(tt, sg, scale, prevt, yg, row0, ch);
        else poolmix_item<16>(tt, sg, scale, prevt, yg, row0, ch);
    }
}
__device__ __forceinline__ void final_phase(int wv, const Params& p) {
    const int tid = otid(wv), lane = tid & 63, gw = blockIdx.x * NWAVES + (tid >> 6), NGW = gridDim.x * NWAVES;
    const float* xres = (const float*)(p.ws + WS_XRES); const float* ssq = (const float*)(p.ws + WS_SSQ) + (size_t)4 * MT; const float* g = p.in[17];
    for (int m = gw; m < MT; m += NGW) { const float rr = rsqrtf(ssq[m] * (1.0f / DM) + EPS);
        const f32x4* xr = (const f32x4*)(xres + (size_t)m * DM) + lane; f32x4* o = (f32x4*)(p.out + (m < MP ? O_YP + (size_t)m * DM : O_YS + (size_t)(m - MP) * DM)) + lane;
        f32x4 xv[8];
#pragma unroll
        for (int j = 0; j < 8; ++j) xv[j] = xr[64 * j] * rr * ((const f32x4*)g)[lane + 64 * j];
#pragma unroll
        for (int j = 0; j < 8; ++j) o[64 * j] = xv[j]; }
}

#define XB_TMO      128
#define XB_XCNT(j)  (256  + 64 * (j))
#define XB_XSUB(j)  (1280 + 64 * (j))
#define XB_XGEN(j)  (2304 + 64 * (j))
#define XB_TOP      3328
#define XB_TOPGEN   3392
#define XCD_BAR_WORDS 3456
#define XB_SPIN_CAP (1u << 18)

__device__ __forceinline__ unsigned xb_ld(unsigned* p)              { return __hip_atomic_load(p, __ATOMIC_RELAXED, __HIP_MEMORY_SCOPE_AGENT); }
__device__ __forceinline__ unsigned xb_add(unsigned* p, unsigned v) { return __hip_atomic_fetch_add(p, v, __ATOMIC_RELAXED, __HIP_MEMORY_SCOPE_AGENT); }
__device__ __forceinline__ unsigned xb_xcc_id() { return (unsigned)__builtin_amdgcn_s_getreg((3 << 11) | 20) & 0xFu; }
#define XB_SPIN(cond, bar) do { unsigned _sp = 0; while (cond) { __builtin_amdgcn_s_sleep(1); \
    if ((++_sp & 255u) == 0u) { if (xb_ld(&(bar)[XB_TMO])) break; if (_sp > XB_SPIN_CAP) { atomicAdd(&(bar)[XB_TMO], 1u); break; } } } } while (0)

struct XcdBarrier {
    unsigned* bar; unsigned x;
    volatile LAS unsigned* st;
};

__device__ __forceinline__ XcdBarrier xcd_barrier_post(unsigned* bar, volatile LAS unsigned* st) {
    XcdBarrier b; b.bar = bar; b.x = xb_xcc_id(); b.st = st;
    if (threadIdx.x == 0) (void)xb_add(&bar[XB_XCNT(b.x)], 1u);
    return b;
}
__device__ __forceinline__ void xcd_barrier_complete(unsigned* bar, unsigned x, unsigned& nloc, unsigned& nx) {
    const unsigned G = gridDim.x * gridDim.y * gridDim.z;
    unsigned sum, cnt, mine, sp = 0u;
    for (;;) {
        sum = 0u; cnt = 0u; mine = 0u;
#pragma unroll
        for (unsigned j = 0; j < 16; ++j) { const unsigned c = xb_ld(&bar[XB_XCNT(j)]); sum += c; cnt += (c > 0u) ? 1u : 0u; mine = (j == x) ? c : mine; }
        if (sum == G) break;
        __builtin_amdgcn_s_sleep(1);
        if ((++sp & 255u) == 0u) { if (xb_ld(&bar[XB_TMO])) break; if (sp > XB_SPIN_CAP) { atomicAdd(&bar[XB_TMO], 1u); break; } }
    }
    nloc = mine > 0u ? mine : 1u; nx = cnt > 0u ? cnt : 1u;
}

__device__ __forceinline__ void xcd_barrier(const XcdBarrier& b) {
    asm volatile("s_waitcnt vmcnt(0)" ::: "memory");
    __syncthreads();
    if (threadIdx.x == 0) {
        unsigned* bar = b.bar;
        __builtin_amdgcn_s_waitcnt(0);
        unsigned nloc = b.st[0], nx = b.st[1];
        if (nloc == 0u) { xcd_barrier_complete(bar, b.x, nloc, nx); b.st[0] = nloc; b.st[1] = nx; }
        const unsigned old = xb_add(&bar[XB_XSUB(b.x)], 1u);
        const unsigned gen = old / nloc;
        if (old + 1u == (gen + 1u) * nloc) {
            __builtin_amdgcn_fence(__ATOMIC_RELEASE, "agent");
            asm volatile("s_waitcnt vmcnt(0)" ::: "memory");
            const unsigned og = xb_add(&bar[XB_TOP], 1u);
            const unsigned tg = og / nx;
            if (og + 1u == (tg + 1u) * nx) xb_add(&bar[XB_TOPGEN], 1u);
            else XB_SPIN(xb_ld(&bar[XB_TOPGEN]) == tg, bar);
            __builtin_amdgcn_fence(__ATOMIC_ACQUIRE, "agent");
            xb_add(&bar[XB_XGEN(b.x)], 1u);
            asm volatile("s_waitcnt vmcnt(0)" ::: "memory");
        } else {
            XB_SPIN(xb_ld(&bar[XB_XGEN(b.x)]) == gen, bar);
            __builtin_amdgcn_fence(__ATOMIC_ACQUIRE, "agent");
            asm volatile("s_waitcnt vmcnt(0)" ::: "memory");
        }
    }
    __syncthreads();
}


constexpr int NPHASES = 15;
typedef const __attribute__((address_space(4))) Params* KArgPtr;
#if defined(__HIP_DEVICE_COMPILE__)
#define LOADP_() KArgPtr kp_ = (KArgPtr)__builtin_amdgcn_kernarg_segment_ptr(); asm volatile("" : "+s"(kp_)); Params lp; _Pragma("unroll") for (int i_ = 0; i_ < 18; ++i_) lp.in[i_] = kp_->in[i_]; lp.out = kp_->out; lp.ws = kp_->ws; lp.ph_lo = 0; lp.ph_hi = 0
#else
#define LOADP_() const Params lp = p
#endif
#define LOADP() LOADP_(); unsigned char* const ws = lp.ws; \
    float* const ssq = (float*)(ws + WS_SSQ); bf16_t* const xb = (bf16_t*)(ws + WS_XB); float* const xres = (float*)(ws + WS_XRES); (void)ssq; (void)xb; (void)xres
__global__ void __launch_bounds__(NTHREADS, 2) yoco_fwd(Params p) {
    extern __shared__ __attribute__((aligned(16))) unsigned char lds_raw[];
    char* lds = (char*)lds_raw; LAS unsigned char* ldsl = (LAS unsigned char*)lds_raw;
    const int G = gridDim.x, bx = blockIdx.x, wv = __builtin_amdgcn_readfirstlane(threadIdx.x >> 6);
#ifndef ONLY_PHASE
#define ONLY_PHASE -1
#endif
#define IN(k) ((ONLY_PHASE < 0 || ONLY_PHASE == (k)) && p.ph_lo <= (k) && (k) < p.ph_hi)
#ifndef SAT_REP
#define SAT_REP 1
#endif
#ifndef REPEAT_MASK
#define REPEAT_MASK 0
#endif
#define NREP(k) (1 + (int)(((unsigned)(REPEAT_MASK) >> (k)) & 1u))
    XcdBarrier xbar; xbar.bar = nullptr; xbar.x = 0; xbar.st = (volatile LAS unsigned*)(ldsl + LDS_PHASE_BYTES);
#define SEAM(k) do { if (rep_ + 1 < NREP(k) || (k) + 1 < p.ph_hi) { \
        if ((k) == 0 || xbar.bar == nullptr) { cg::this_grid().sync(); \
            if ((k) == 0 && rep_ + 1 == NREP(k)) { KArgPtr kq_ = (KArgPtr)__builtin_amdgcn_kernarg_segment_ptr(); \
                if (threadIdx.x < 4) ((LAS unsigned*)(ldsl + LDS_PHASE_BYTES))[threadIdx.x] = 0u; __syncthreads(); \
                xbar = xcd_barrier_post((unsigned*)(kq_->ws + WS_BAR), (volatile LAS unsigned*)(ldsl + LDS_PHASE_BYTES)); } } \
        else xcd_barrier(xbar); } } while (0)
    if (IN(0)) for (int rep_ = 0; rep_ < NREP(0); ++rep_) { { LOADP(); prologue_phase(wv, lp, lds); } SEAM(0); }
    if (IN(1)) for (int rep_ = 0; rep_ < NREP(1); ++rep_) {
        { LOADP(); pg8::Gemm g{(const bf16_t*)(ws + WS_WGRP), (const bf16_t*)(ws + WS_WINUS), 1024, 1024, EA, 2, nullptr, nullptr}; pg8::StaticOrder S; S.init(32, 8, G, bx);
          pg8::EpiStore E{(bf16_t*)(ws + WS_WINA), DM, 1};
          pg8::gemm_phase<pg8::EpiStore, pg8::StaticOrder>(wv, ldsl, g, S, E); }
        SEAM(1); }
#pragma unroll 1
    for (int l = 0; l < 2; ++l) {
        int wv_o = wv, bx_o = bx, G_o = G; asm volatile("" : "+s"(wv_o), "+s"(bx_o), "+s"(G_o));
        const int wv = wv_o, bx = bx_o, G = G_o;
        if (IN(2 + 3 * l)) for (int rep_ = 0; rep_ < NREP(2 + 3 * l); ++rep_) {
            { LOADP(); bf16_t* u = (bf16_t*)(ws + WS_U); bf16_t* sg = (bf16_t*)(ws + WS_SG);
              pg8::Gemm g{xb, (const bf16_t*)(ws + WS_WINA) + (size_t)l * 2 * EA * DM, DM, DM, DM, 0, nullptr, nullptr}; pg8::StaticOrder S; S.init(65, 32, G, bx);
              pg8::EpiInA E{ssq + (size_t)l * MT, u, sg};
              pg8::gemm_phase<pg8::EpiInA, pg8::StaticOrder>(wv, ldsl, g, S, E); }
            { LOADP(); pg8::Gemm g{xb, (const bf16_t*)(ws + WS_WINUT) + (size_t)l * EA * DM, DM, DM, DM, 0, nullptr, nullptr}; pg8::StateOrder S{G, bx};
              pg8::EpiUState E{ssq + (size_t)l * MT, lp.out + O_PP + (size_t)l * NBATCH * PPAD * EA, lp.out + O_PS + (size_t)l * NDB * PPAD * EA};
              pg8::gemm_phase<pg8::EpiUState, pg8::StateOrder>(wv, ldsl, g, S, E); }
            if (l == 0) { LOADP(); pg8::Gemm g{(const bf16_t*)(ws + WS_PREVB), (const bf16_t*)(ws + WS_WGRP), 1024, EA, 1024, 3, nullptr, nullptr}; pg8::MidOrder S{bx};
              pg8::EpiStore E{(bf16_t*)(ws + WS_PREVT), EA, 0};
              pg8::gemm_phase<pg8::EpiStore, pg8::MidOrder>(wv, ldsl, g, S, E); }
            SEAM(2 + 3 * l); }
        if (IN(3 + 3 * l)) for (int rep_ = 0; rep_ < NREP(3 + 3 * l); ++rep_) { { LOADP(); poolmix_phase(wv, lp, l); } SEAM(3 + 3 * l); }
        if (IN(4 + 3 * l)) for (int rep_ = 0; rep_ < NREP(4 + 3 * l); ++rep_) { { LOADP(); bf16_t* yg = (bf16_t*)(ws + WS_D);
            pg8::Gemm g{yg, (const bf16_t*)(ws + WS_WOUTA) + (size_t)l * DM * EA, EA, EA, EA, 0, (float*)(ws + WS_SPLIT) + (size_t)l * 8 * 65536, (unsigned*)(ws + WS_SPCNT) + l * 64}; pg8::SplitOrder S; S.init(8, 8, G, bx);
            pg8::EpiRes E{l == 0 ? lp.in[0] : xres, l == 0 ? lp.in[1] : xres + (size_t)MP * DM, xres, xb, ssq + (size_t)(l + 1) * MT, 1};
            pg8::gemm_phase<pg8::EpiRes, pg8::SplitOrder>(wv, ldsl, g, S, E); } SEAM(4 + 3 * l); }
    }
#pragma unroll 1
    for (int lb = 0; lb < 2; ++lb) {
        int wv_o = wv, bx_o = bx, G_o = G; asm volatile("" : "+s"(wv_o), "+s"(bx_o), "+s"(G_o));
        const int wv = wv_o, bx = bx_o, G = G_o;
        if (IN(8 + 3 * lb)) for (int rep_ = 0; rep_ < NREP(8 + 3 * lb); ++rep_) { { LOADP();
            pg8::EpiKVQ E{lb == 0 ? 0 : 17, ssq + (size_t)(2 + lb) * MT, lp.out, ws, lp.in[13]};
            if (lb == 0) { pg8::Gemm g{xb, (const bf16_t*)(ws + WS_W4), DM, DM, DM, 0, nullptr, nullptr}; pg8::StaticOrder S; S.init(65, 33, G, bx);
                pg8::gemm_phase<pg8::EpiKVQ, pg8::StaticOrder>(wv, ldsl, g, S, E); }
            else { pg8::Gemm g{xb, (const bf16_t*)(ws + WS_WINB1), DM, DM, DM, 0, (float*)(ws + WS_SPLIT) + (size_t)32 * 65536, (unsigned*)(ws + WS_SPCNT) + 256}; pg8::SplitOrder S; S.init(16, 8, G, bx);
                pg8::gemm_phase<pg8::EpiKVQ, pg8::SplitOrder>(wv, ldsl, g, S, E); } } SEAM(8 + 3 * lb); }
        if (IN(9 + 3 * lb)) for (int rep_ = 0; rep_ < NREP(9 + 3 * lb); ++rep_) {
            { const int xcd = bx & 7, j = bx >> 3;
              if (G != 256 || j >= 24) { LOADP();
                  sat::Tensors ST{(const bf16_t*)(ws + WS_QB), (const bf16_t*)(ws + WS_KB), (const bf16_t*)(ws + WS_VB), (bf16_t*)(ws + WS_OG), (const bf16_t*)(ws + WS_SGB),
                                  lp.in[2], lp.in[3], lp.in[4], (const float*)(ws + WS_LFTS)};
                  const int s0 = G == 256 ? xcd * 8 + (j - 24) : bx, sstep = G == 256 ? 64 : G;
                  for (int it = s0; it < NDB * NH; it += sstep) sat::item(wv, lds, ST, it >> 4, it & 15); }
              if (G != 256 || j < 24) { LOADP();
                  att::Tensors AT{(const bf16_t*)(ws + WS_QB), (const bf16_t*)(ws + WS_KB), (const bf16_t*)(ws + WS_VB), (bf16_t*)(ws + WS_OG), (const bf16_t*)(ws + WS_SGB), (const float*)(ws + WS_LFTP)};
                  const int p0 = G == 256 ? xcd * 24 + j : bx, pstep = G == 256 ? 192 : G;
                  for (int pw = p0; pw < 192; pw += pstep) att::prompt_phase(wv, lds, AT, (const float*)(ws + WS_KNRM), (const float*)(ws + WS_QNRM), pw); } }
            SEAM(9 + 3 * lb); }
        if (IN(10 + 3 * lb)) for (int rep_ = 0; rep_ < NREP(10 + 3 * lb); ++rep_) { { LOADP();
            pg8::Gemm g{(const bf16_t*)(ws + WS_OG), (const bf16_t*)(ws + WS_WOUTB) + (size_t)lb * DM * DM, DM, DM, DM, 0, (float*)(ws + WS_SPLIT) + (size_t)(2 + lb) * 8 * 65536, (unsigned*)(ws + WS_SPCNT) + (2 + lb) * 64}; pg8::SplitOrder S; S.init(8, 8, G, bx);
            pg8::EpiRes E{xres, xres + (size_t)MP * DM, xres, xb, ssq + (size_t)(3 + lb) * MT, lb == 0 ? 1 : 0};
            pg8::gemm_phase<pg8::EpiRes, pg8::SplitOrder>(wv, ldsl, g, S, E); } SEAM(10 + 3 * lb); }
    }
    if (IN(14)) { LOADP(); final_phase(wv, lp); }
#undef IN
#undef SEAM
}

extern "C" void kernel_launch(void* const* d_in, const int* in_sizes, int n_in, void* d_out, int out_size, void* d_ws, size_t ws_size, hipStream_t stream) {
    static int grid = 0;
    if (grid == 0) {
        if (n_in != 18 || (size_t)out_size != O_END || ws_size < WS_END) { fprintf(stderr, "kernel_launch: unexpected shapes: n_in %d out %d (want %zu) ws %zu (need %zu)\n", n_in, out_size, (size_t)O_END, ws_size, (size_t)WS_END); grid = -1; return; }
        int dev = 0, cus = 0, per_cu = 0;
        (void)hipGetDevice(&dev); (void)hipDeviceGetAttribute(&cus, hipDeviceAttributeMultiprocessorCount, dev);
        if (hipFuncSetAttribute((const void*)yoco_fwd, hipFuncAttributeMaxDynamicSharedMemorySize, LDS_BYTES) != hipSuccess) { fprintf(stderr, "kernel_launch: hipFuncSetAttribute failed\n"); grid = -1; return; }
        if (hipOccupancyMaxActiveBlocksPerMultiprocessor(&per_cu, (const void*)yoco_fwd, NTHREADS, LDS_BYTES) != hipSuccess || per_cu < 1) { fprintf(stderr, "kernel_launch: occupancy query gave %d\n", per_cu); per_cu = 1; }
        (void)hipGetLastError();
        grid = cus > 0 ? cus : 256;
    }
    if (grid < 0) return;
    Params p{};
    for (int i = 0; i < 18; ++i) p.in[i] = (const float*)d_in[i];
    p.out = (float*)d_out; p.ws = (unsigned char*)d_ws;
#if MULTI_LAUNCH
    for (int ph = 0; ph < NPHASES; ++ph) { p.ph_lo = ph; p.ph_hi = ph + 1; hipLaunchKernelGGL(yoco_fwd, dim3(grid), dim3(NTHREADS), LDS_BYTES, stream, p); }
#else
    p.ph_lo = 0; p.ph_hi = NPHASES;
    void* args[] = {&p};
    hipError_t e = hipLaunchCooperativeKernel((const void*)yoco_fwd, dim3(grid), dim3(NTHREADS), args, LDS_BYTES, stream);
    if (e != hipSuccess) fprintf(stderr, "kernel_launch: cooperative launch failed: %s (grid %d)\n", hipGetErrorString(e), grid);
#endif
}
```

```cpp
#include <hip/hip_runtime.h>
#include <hip/hip_cooperative_groups.h>
#include <cstdio>
#include <cstdint>
namespace cg = cooperative_groups;

#ifndef MULTI_LAUNCH
#define MULTI_LAUNCH 0
#endif

#define LAS __attribute__((address_space(3)))
typedef unsigned short bf16_t;
typedef short bf16x8 __attribute__((ext_vector_type(8)));
typedef short s16x4 __attribute__((ext_vector_type(4)));
typedef float f32x4 __attribute__((ext_vector_type(4)));
typedef float f32x16 __attribute__((ext_vector_type(16)));
typedef unsigned u32x4 __attribute__((ext_vector_type(4)));
typedef unsigned u32x2 __attribute__((ext_vector_type(2)));

constexpr int DM = 2048, NBATCH = 4, SEQ = 4096, NDB = 16, DSEQ = 16, PAST = 2048, EA = 4096, NH = 16, HD = 128, PPAD = 15;
constexpr int MP = NBATCH * SEQ, MS = NDB * DSEQ, MT = MP + MS;
constexpr float EPS = 1e-6f;
constexpr float LOG2E = 1.4426950408889634f;
constexpr float QSCALE = 0.08838834764831845f * 1.4426950408889634f;
constexpr int NTHREADS = 512, NWAVES = 8;
constexpr int LDS_PHASE_BYTES = 131072, LDS_BYTES = LDS_PHASE_BYTES + 16;

constexpr size_t O_YP = 0, O_YS = O_YP + (size_t)MP * DM, O_KP = O_YS + (size_t)MS * DM, O_VP = O_KP + (size_t)MP * DM,
                 O_LFP = O_VP + (size_t)MP * DM, O_PP = O_LFP + (size_t)MP * NH, O_KS = O_PP + (size_t)2 * NBATCH * PPAD * EA,
                 O_VS = O_KS + (size_t)MS * DM, O_LFS = O_VS + (size_t)MS * DM, O_PS = O_LFS + (size_t)MS * NH, O_END = O_PS + (size_t)2 * NDB * PPAD * EA;

constexpr size_t al256(size_t x) { return (x + 255) & ~(size_t)255; }
constexpr size_t WS_WINA = 0;
constexpr size_t WS_WGRP = WS_WINA + (size_t)2 * 8192 * 2048 * 2;
constexpr size_t WS_WOUTA = WS_WGRP + (size_t)2 * 4096 * 1024 * 2;
constexpr size_t WS_W4 = WS_WOUTA + (size_t)2 * 2048 * 4096 * 2;
constexpr size_t WS_WINB1 = WS_W4 + (size_t)8448 * 2048 * 2;
constexpr size_t WS_WOUTB = WS_WINB1 + (size_t)4096 * 2048 * 2;
constexpr size_t WS_XB = WS_WOUTB + (size_t)2 * 2048 * 2048 * 2;
constexpr size_t WS_XRES = WS_XB + (size_t)MT * DM * 2;
constexpr size_t WS_SSQ = WS_XRES + (size_t)MT * DM * 4;
constexpr size_t WS_LFTP = al256(WS_SSQ + (size_t)5 * MT * 4);
constexpr size_t WS_LFTS = WS_LFTP + (size_t)NBATCH * NH * SEQ * 4;
constexpr size_t WS_KNRM = al256(WS_LFTS + (size_t)NDB * NH * DSEQ * 4);
constexpr size_t WS_QNRM = WS_KNRM + (size_t)MT * NH * 4 * 4;
constexpr size_t WS_WINUT = al256(WS_QNRM + (size_t)MT * NH * 4 * 4);
constexpr size_t WS_WINUS = WS_WINUT + (size_t)2 * EA * DM * 2;
constexpr size_t WS_PREVB = WS_WINUS + (size_t)2 * DM * EA * 2;
constexpr size_t WS_PREVT = WS_PREVB + (size_t)2 * 256 * EA * 2;
constexpr size_t WS_SPLIT = al256(WS_PREVT + (size_t)2 * 256 * EA * 2);
constexpr size_t SPLIT_TILE = 65536 * 4, SPLIT_TILES = 8 * 4 + 16;
constexpr size_t WS_SPCNT = WS_SPLIT + SPLIT_TILES * SPLIT_TILE;
constexpr size_t WS_BAR = al256(WS_SPCNT + SPLIT_TILES * 8 * 4);
constexpr size_t WS_ACT = al256(WS_BAR + 3456 * 4);
constexpr size_t SZ_A = (size_t)MT * EA * 2, SZ_B = (size_t)MT * DM * 2;
constexpr size_t WS_U = WS_ACT, WS_SG = WS_U + SZ_A, WS_D = WS_SG + SZ_A;
constexpr size_t WS_KB = WS_ACT, WS_VB = WS_KB + SZ_B, WS_QB = WS_VB + SZ_B, WS_SGB = WS_QB + SZ_B, WS_OG = WS_SGB + SZ_B;
constexpr size_t WS_END = (WS_D + SZ_A) > (WS_OG + SZ_B) ? (WS_D + SZ_A) : (WS_OG + SZ_B);

struct Params { const float* in[18]; float* out; unsigned char* ws; int ph_lo, ph_hi; };

__device__ __forceinline__ unsigned cvtpk(float lo, float hi) { unsigned r; asm volatile("v_cvt_pk_bf16_f32 %0, %1, %2" : "=v"(r) : "v"(lo), "v"(hi)); return r; }
__device__ __forceinline__ bf16x8 pack8(f32x4 a, f32x4 b) { u32x4 w = {cvtpk(a[0], a[1]), cvtpk(a[2], a[3]), cvtpk(b[0], b[1]), cvtpk(b[2], b[3])}; return *reinterpret_cast<bf16x8*>(&w); }
__device__ __forceinline__ float bflo(unsigned w) { return __uint_as_float(w << 16); }
__device__ __forceinline__ float bfhi(unsigned w) { return __uint_as_float(w & 0xffff0000u); }
__device__ __forceinline__ float silu_f(float x) { return x * __builtin_amdgcn_rcpf(1.0f + __builtin_amdgcn_exp2f(-x * LOG2E)); }
__device__ __forceinline__ float wave_sum(float v) {
#pragma unroll
    for (int o = 1; o < 64; o <<= 1) v += __shfl_xor(v, o);
    return v;
}
__device__ __forceinline__ int otid(int wv) { int l; asm volatile("v_mbcnt_lo_u32_b32 %0, -1, 0\n\tv_mbcnt_hi_u32_b32 %0, -1, %0" : "=v"(l)); return wv * 64 + l; }
__device__ __forceinline__ float xsum16(float v) { auto r = __builtin_amdgcn_permlane16_swap(__float_as_uint(v), __float_as_uint(v), false, false); return __uint_as_float(r[0]) + __uint_as_float(r[1]); }
__device__ __forceinline__ float xsum32(float v) { auto r = __builtin_amdgcn_permlane32_swap(__float_as_uint(v), __float_as_uint(v), false, false); return __uint_as_float(r[0]) + __uint_as_float(r[1]); }
__device__ __forceinline__ float xmax16(float v) { auto r = __builtin_amdgcn_permlane16_swap(__float_as_uint(v), __float_as_uint(v), false, false); return fmaxf(__uint_as_float(r[0]), __uint_as_float(r[1])); }
__device__ __forceinline__ float xmax32(float v) { auto r = __builtin_amdgcn_permlane32_swap(__float_as_uint(v), __float_as_uint(v), false, false); return fmaxf(__uint_as_float(r[0]), __uint_as_float(r[1])); }
__device__ __forceinline__ float bperm(float v, int srclane) { return __uint_as_float((unsigned)__builtin_amdgcn_ds_bpermute(srclane << 2, (int)__float_as_uint(v))); }
__device__ __forceinline__ float logsig(float x) { return fminf(x, 0.f) - log1pf(__expf(-fabsf(x))); }

namespace pg8 {
constexpr int BM = 256, BK = 64, HALF = 128, HTB = HALF * BK * 2, NXCD = 8, WGM = 8;
__device__ __forceinline__ int lds_byte(int r, int c) { const int st = (r >> 4) * 2 + (c >> 5), rr = r & 15, cc = c & 31, ob = rr * 64 + cc * 2; return st * 1024 + (ob ^ (((ob >> 9) & 1) << 5)); }
__device__ __forceinline__ void stage_rc(int b, int& R, int& C) { const int st = b / 1024, sb = b % 1024, swz = sb ^ (((sb >> 9) & 1) << 5); R = (st >> 1) * 16 + swz / 64; C = (st & 1) * 32 + (swz % 64) / 2; }
__device__ __forceinline__ int perm32(int rho) { const int n = rho >> 4, i = rho & 15; return 8 * (i >> 2) + 4 * n + (i & 3); }
struct Unit { int pm, pn, ks, nks; };
struct Gemm { const bf16_t* A; const bf16_t* Bt; int K, lda, ldb, mode; float* sp_acc; unsigned* sp_cnt; };
__device__ __forceinline__ void unit_off(const Gemm& g, const Unit& u, size_t& oa, size_t& ob) {
    if (g.mode == 2) { oa = (size_t)u.pm * 256 * g.lda; ob = (size_t)(u.pm >> 4) * DM * EA + (size_t)((u.pm >> 2) & 3) * 1024 + (size_t)u.pn * 256 * g.ldb; }
    else if (g.mode == 3) { oa = (size_t)u.pm * 256 * g.lda + (size_t)(u.pn >> 2) * 1024; ob = (size_t)(u.pm * 16 + u.pn) * 256 * g.ldb; }
    else { oa = (size_t)u.pm * 256 * g.lda; ob = (size_t)u.pn * 256 * g.ldb; }
    const size_t ko = (size_t)u.ks * (size_t)(g.K / u.nks); oa = (oa + ko) * 2; ob = (ob + ko) * 2;
}
struct StaticOrder {
    int nM, nN, nwg, G, c;
    __device__ __forceinline__ void init(int nM_, int nN_, int G_, int c_) { nM = nM_; nN = nN_; nwg = nM * nN; G = G_; c = c_; }
    __device__ __forceinline__ bool next(int i, Unit& u) const {
        const long L = (long)i * G + c; if (L >= nwg) return false;
        int wgid = (int)L; { const int q = nwg / NXCD, r = nwg % NXCD, xcd = wgid % NXCD, off = wgid / NXCD; wgid = (xcd < r ? xcd * (q + 1) : r * (q + 1) + (xcd - r) * q) + off; }
        const int nig = WGM * nN, gid = wgid / nig, fm = gid * WGM, gsz = (nM - fm) < WGM ? (nM - fm) : WGM;
        u.pm = fm + ((wgid % nig) % gsz); u.pn = (wgid % nig) / gsz; u.ks = 0; u.nks = 1; return true;
    }
};
struct SplitOrder {
    StaticOrder S0; int nN, nks, i0;
    __device__ __forceinline__ void init(int nN_, int nks_, int G_, int c_) { S0.init(64, nN_, G_, c_); nN = nN_; nks = nks_; i0 = c_ < S0.nwg ? (S0.nwg - c_ + G_ - 1) / G_ : 0; }
    __device__ __forceinline__ bool next(int i, Unit& u) const {
        if (i < i0) return S0.next(i, u);
        const int idx = (i - i0) * S0.G + S0.c; if (idx >= nN * nks) return false;
        u.pm = 64; u.pn = idx / nks; u.ks = idx % nks; u.nks = nks; return true;
    }
};
struct MidOrder {
    int c;
    __device__ __forceinline__ bool next(int i, Unit& u) const { const int idx = c - 32; if (i != 0 || idx < 0 || idx >= 32) return false; u.pm = idx >> 4; u.pn = idx & 15; u.ks = 0; u.nks = 1; return true; }
};
struct StateOrder {
    int G, c;
    __device__ __forceinline__ bool next(int i, Unit& u) const { const int idx = G - 1 - c; if (i != 0 || idx >= 80) return false; const int k = idx >> 4; u.pm = k < 4 ? 16 * k + 15 : 64; u.pn = idx & 15; u.ks = 0; u.nks = 1; return true; }
};
template <class Epi, class Ord>
__device__ __forceinline__ void gemm_phase(int wv, LAS unsigned char* lds, const Gemm g, const Ord& S, const Epi& E) {
    const int tid = otid(wv), wid = __builtin_amdgcn_readfirstlane(tid >> 6), lane = tid & 63, wr = wid >> 2, wc = wid & 3, fr = lane & 15, fq = lane >> 4;
    const int K = g.K, nt = K / BK;
    unsigned voffA[2], voffB[2];
#pragma unroll
    for (int i = 0; i < 2; ++i) { int R, C; stage_rc(tid * 16 + i * 8192, R, C); const int Rb = Epi::PERM ? ((R & ~31) + perm32(R & 31)) : R;
        voffA[i] = (unsigned)(R * g.lda + C) * 2u; voffB[i] = (unsigned)(Rb * g.ldb + C) * 2u; }
    const size_t kstep = (size_t)(BK * 2);
    const size_t hstepA = (size_t)HALF * g.lda * 2;
    const size_t hstepB = (size_t)HALF * g.ldb * 2;
    const unsigned ldsw = (unsigned)wid * 1024u;
    const int aoff = lds_byte(wr * 64 + fr, fq * 8), boff = lds_byte(wc * 32 + fr, fq * 8);
#define PG8_SA(b, h) (((b) * 2 + (h)) * HTB)
#define PG8_SB(b, h) ((4 + (b) * 2 + (h)) * HTB)
#define PG8_STAGE(bufoff, gbase, voff) do { _Pragma("unroll") for (int _i = 0; _i < 2; ++_i) \
        __builtin_amdgcn_global_load_lds((const unsigned*)((const char*)(gbase) + (voff)[_i]), (LAS unsigned*)(lds + (bufoff) + ldsw + _i * 8192), 16, 0, 0); } while (0)
#define PG8_LDA(dst, b, h) do { _Pragma("unroll") for (int m = 0; m < 4; ++m) _Pragma("unroll") for (int k = 0; k < 2; ++k) dst[m][k] = *(const LAS bf16x8*)(lds + PG8_SA(b, h) + aoff + m * 2048 + k * 1024); } while (0)
#define PG8_LDB(dst, b, h) do { _Pragma("unroll") for (int n = 0; n < 2; ++n) _Pragma("unroll") for (int k = 0; k < 2; ++k) dst[n][k] = *(const LAS bf16x8*)(lds + PG8_SB(b, h) + boff + n * 2048 + k * 1024); } while (0)
#define PG8_MMA(ai, bj, At, Bt) do { __builtin_amdgcn_s_setprio(1); _Pragma("unroll") for (int m = 0; m < 4; ++m) _Pragma("unroll") for (int n = 0; n < 2; ++n) _Pragma("unroll") for (int k = 0; k < 2; ++k) \
        acc[ai][bj][m][n] = __builtin_amdgcn_mfma_f32_16x16x32_bf16(Bt[n][k], At[m][k], acc[ai][bj][m][n], 0, 0, 0); __builtin_amdgcn_s_setprio(0); } while (0)
#define PG8_WAIT_V(n) asm volatile("s_waitcnt vmcnt(" #n ")" ::: "memory")
#define PG8_WAIT_L(n) asm volatile("s_waitcnt lgkmcnt(" #n ")" ::: "memory")
#define PG8_BAR __builtin_amdgcn_s_barrier()
#define PG8_SCHED __builtin_amdgcn_sched_barrier(0)
    Unit cur, nxt; int ui = 0;
    if (!S.next(0, cur)) return;
    f32x4 acc[2][2][4][2];
#pragma unroll
    for (int a = 0; a < 2; ++a)
#pragma unroll
        for (int b = 0; b < 2; ++b)
#pragma unroll
            for (int m = 0; m < 4; ++m)
#pragma unroll
                for (int n = 0; n < 2; ++n) acc[a][b][m][n] = (f32x4){0.f, 0.f, 0.f, 0.f};
    bf16x8 At[4][2], B0[2][2], B1[2][2];
    size_t oa_, ob_; unit_off(g, cur, oa_, ob_);
    const char* cA = (const char*)g.A + oa_; const char* cB = (const char*)g.Bt + ob_;
    PG8_STAGE(PG8_SB(0, 0), cB, voffB); PG8_STAGE(PG8_SA(0, 0), cA, voffA); PG8_STAGE(PG8_SB(0, 1), cB + hstepB, voffB); PG8_STAGE(PG8_SA(0, 1), cA + hstepA, voffA);
    if (wr == 1) PG8_BAR;
    PG8_WAIT_V(4); PG8_BAR;
    PG8_STAGE(PG8_SB(1, 0), cB + kstep, voffB); PG8_STAGE(PG8_SA(1, 0), cA + kstep, voffA); PG8_STAGE(PG8_SB(1, 1), cB + hstepB + kstep, voffB);
    PG8_WAIT_V(6); PG8_BAR;
    for (;;) {
        const bool has_next = S.next(ui + 1, nxt);
        const char* nA = cA; const char* nB = cB;
        if (has_next) { unit_off(g, nxt, oa_, ob_); nA = (const char*)g.A + oa_; nB = (const char*)g.Bt + ob_; }
        const int ntc = nt / cur.nks;
        for (int t = 0; t < ntc; t += 2) {
            const bool last = (t == ntc - 2);
            const char* a1 = cA + (size_t)(t + 1) * kstep;
            const char* a2 = last ? nA : cA + (size_t)(t + 2) * kstep; const char* b2 = last ? nB : cB + (size_t)(t + 2) * kstep;
            const char* a3 = a2 + kstep; const char* b3 = b2 + kstep;
            PG8_LDB(B0, 0, 0); PG8_SCHED; PG8_LDA(At, 0, 0); PG8_STAGE(PG8_SA(1, 1), a1 + hstepA, voffA);
            PG8_WAIT_L(8); PG8_BAR; PG8_WAIT_L(0); PG8_MMA(0, 0, At, B0); PG8_BAR; PG8_SCHED;
            PG8_LDB(B1, 0, 1); PG8_STAGE(PG8_SB(0, 0), b2, voffB);
            PG8_BAR; PG8_WAIT_L(0); PG8_MMA(0, 1, At, B1); PG8_BAR;
            PG8_LDA(At, 0, 1); PG8_STAGE(PG8_SA(0, 0), a2, voffA);
            PG8_BAR; PG8_WAIT_L(0); PG8_MMA(1, 0, At, B0); PG8_BAR; PG8_SCHED;
            PG8_STAGE(PG8_SB(0, 1), b2 + hstepB, voffB);
            PG8_WAIT_V(6); PG8_BAR; PG8_MMA(1, 1, At, B1); PG8_BAR;
            PG8_LDB(B0, 1, 0); PG8_SCHED; PG8_LDA(At, 1, 0); PG8_STAGE(PG8_SA(0, 1), a2 + hstepA, voffA);
            PG8_WAIT_L(8); PG8_BAR; PG8_WAIT_L(0); PG8_MMA(0, 0, At, B0); PG8_BAR; PG8_SCHED;
            PG8_LDB(B1, 1, 1); PG8_STAGE(PG8_SB(1, 0), b3, voffB);
            PG8_BAR; PG8_WAIT_L(0); PG8_MMA(0, 1, At, B1); PG8_BAR;
            PG8_LDA(At, 1, 1); PG8_STAGE(PG8_SA(1, 0), a3, voffA);
            PG8_BAR; PG8_WAIT_L(0); PG8_MMA(1, 0, At, B0); PG8_BAR; PG8_SCHED;
            PG8_STAGE(PG8_SB(1, 1), b3 + hstepB, voffB);
            PG8_WAIT_V(6); PG8_BAR; PG8_MMA(1, 1, At, B1); PG8_BAR;
        }
        bool do_epi = true;
        if (cur.nks > 1) {
            float* sc0 = g.sp_acc + (size_t)cur.pn * 65536 + (wid * 64 + lane); float* sc = sc0;
#pragma unroll
            for (int a = 0; a < 2; ++a)
#pragma unroll
                for (int b = 0; b < 2; ++b)
#pragma unroll
                    for (int m = 0; m < 4; ++m)
#pragma unroll
                        for (int n = 0; n < 2; ++n) {
#pragma unroll
                            for (int j = 0; j < 4; ++j) unsafeAtomicAdd(sc + j * 512, acc[a][b][m][n][j]);
                            sc += 2048; asm volatile("" : "+v"(sc)); }
            asm volatile("s_waitcnt vmcnt(0)" ::: "memory");
            __builtin_amdgcn_fence(__ATOMIC_RELEASE, "agent");
            unsigned old = 0u; if (lane == 0) old = __hip_atomic_fetch_add(g.sp_cnt + cur.pn * 8 + wid, 1u, __ATOMIC_RELAXED, __HIP_MEMORY_SCOPE_AGENT);
            old = (unsigned)__builtin_amdgcn_readfirstlane((int)old);
            do_epi = (old == (unsigned)cur.nks - 1u);
            if (do_epi) {
                __builtin_amdgcn_fence(__ATOMIC_ACQUIRE, "agent");
                sc = sc0;
#pragma unroll
                for (int a = 0; a < 2; ++a)
#pragma unroll
                    for (int b = 0; b < 2; ++b)
#pragma unroll
                        for (int m = 0; m < 4; ++m)
#pragma unroll
                            for (int n = 0; n < 2; ++n) {
#pragma unroll
                                for (int j = 0; j < 4; ++j) acc[a][b][m][n][j] = __hip_atomic_load(sc + j * 512, __ATOMIC_RELAXED, __HIP_MEMORY_SCOPE_AGENT);
                                sc += 2048; asm volatile("" : "+v"(sc)); } }
        }
        if (do_epi) E(acc, cur, wr, wc, fr, fq);
        if (!has_next) break;
#pragma unroll
        for (int a = 0; a < 2; ++a)
#pragma unroll
            for (int b = 0; b < 2; ++b)
#pragma unroll
                for (int m = 0; m < 4; ++m)
#pragma unroll
                    for (int n = 0; n < 2; ++n) acc[a][b][m][n] = (f32x4){0.f, 0.f, 0.f, 0.f};
        cur = nxt; cA = nA; cB = nB; ++ui;
    }
    PG8_WAIT_V(0);
    if (wr == 0) PG8_BAR;
    PG8_BAR;
#undef PG8_SA
#undef PG8_SB
#undef PG8_STAGE
#undef PG8_LDA
#undef PG8_LDB
#undef PG8_MMA
#undef PG8_WAIT_V
#undef PG8_WAIT_L
#undef PG8_BAR
#undef PG8_SCHED
}

typedef const f32x4 (&AccRef)[2][2][4][2];

struct EpiInA {
    static constexpr bool PERM = true;
    const float* ssq; bf16_t* tt; bf16_t* sg;
    __device__ __forceinline__ void operator()(AccRef acc, const Unit& un, int wr, int wc, int fr, int fq) const {
        const int row0 = un.pm * BM + wr * 64 + fr, colt = un.pn * BM + wc * 32 + 8 * fq;
        const bool is_t = un.pn < 16;
        float rrs[2][4];
#pragma unroll
        for (int ai = 0; ai < 2; ++ai)
#pragma unroll
            for (int m = 0; m < 4; ++m) rrs[ai][m] = ssq[row0 + ai * HALF + m * 16];
#pragma unroll
        for (int ai = 0; ai < 2; ++ai)
#pragma unroll
            for (int m = 0; m < 4; ++m) { const int row = row0 + ai * HALF + m * 16; const float rr = rsqrtf(rrs[ai][m] * (1.0f / DM) + EPS);
#pragma unroll
                for (int bj = 0; bj < 2; ++bj) { f32x4 v0 = acc[ai][bj][m][0] * rr, v1 = acc[ai][bj][m][1] * rr; const int col = colt + bj * HALF;
                    if (is_t) *(bf16x8*)(tt + (size_t)row * EA + col) = pack8(v0, v1);
                    else {
#pragma unroll
                        for (int j = 0; j < 4; ++j) { v0[j] = silu_f(v0[j]); v1[j] = silu_f(v1[j]); }
                        *(bf16x8*)(sg + (size_t)row * EA + (col - EA)) = pack8(v0, v1); } } }
    }
};
struct EpiUState {
    static constexpr bool PERM = true;
    const float* ssq; float* pool_p; float* pool_s;
    __device__ __forceinline__ void operator()(AccRef acc, const Unit& un, int wr, int wc, int fr, int fq) const {
        const int row0 = un.pm * BM + wr * 64 + fr, colt = un.pn * BM + wc * 32 + 8 * fq;
        float rrs[2][4];
#pragma unroll
        for (int ai = 0; ai < 2; ++ai)
#pragma unroll
            for (int m = 0; m < 4; ++m) rrs[ai][m] = ssq[row0 + ai * HALF + m * 16];
#pragma unroll
        for (int ai = 0; ai < 2; ++ai)
#pragma unroll
            for (int m = 0; m < 4; ++m) { const int row = row0 + ai * HALF + m * 16;
                float* pp = nullptr;
                if (row < MP) { const int t = row & (SEQ - 1); if (t >= SEQ - PPAD) pp = pool_p + ((size_t)(row >> 12) * PPAD + (t - (SEQ - PPAD))) * EA; }
                else { const int rs = row - MP, t = rs & 15; if (t >= 1) pp = pool_s + ((size_t)(rs >> 4) * PPAD + (t - 1)) * EA; }
                if (pp) { const float rr = rsqrtf(rrs[ai][m] * (1.0f / DM) + EPS);
#pragma unroll
                    for (int bj = 0; bj < 2; ++bj) { *(f32x4*)(pp + colt + bj * HALF) = acc[ai][bj][m][0] * rr; *(f32x4*)(pp + colt + bj * HALF + 4) = acc[ai][bj][m][1] * rr; } } }
    }
};
struct EpiStore {
    static constexpr bool PERM = true;
    bf16_t* O; int ldc, wmode;
    __device__ __forceinline__ void operator()(AccRef acc, const Unit& un, int wr, int wc, int fr, int fq) const {
        const int rbase = wmode ? (un.pm >> 4) * 2 * EA + (un.pm & 15) * BM : un.pm * BM;
        const int row0 = rbase + wr * 64 + fr, colt = un.pn * BM + wc * 32 + 8 * fq;
#pragma unroll
        for (int ai = 0; ai < 2; ++ai)
#pragma unroll
            for (int m = 0; m < 4; ++m)
#pragma unroll
                for (int bj = 0; bj < 2; ++bj) *(bf16x8*)(O + (size_t)(row0 + ai * HALF + m * 16) * ldc + colt + bj * HALF) = pack8(acc[ai][bj][m][0], acc[ai][bj][m][1]);
    }
};
struct EpiRes {
    static constexpr bool PERM = false;
    const float* base_p; const float* base_s; float* xres; bf16_t* xb; float* ssq_next; int write_xb;
    __device__ __forceinline__ void operator()(AccRef acc, const Unit& un, int wr, int wc, int fr, int fq) const {
        const int row0 = un.pm * BM + wr * 64 + fr, col0 = un.pn * BM + wc * 32 + 4 * fq;
#pragma unroll
        for (int ai = 0; ai < 2; ++ai) {
            f32x4 bx_[4][2][2];
#pragma unroll
            for (int m = 0; m < 4; ++m) { const int row = row0 + ai * HALF + m * 16;
                const float* bp = (row < MP ? base_p + (size_t)row * DM : base_s + (size_t)(row - MP) * DM) + col0;
#pragma unroll
                for (int bj = 0; bj < 2; ++bj)
#pragma unroll
                    for (int n = 0; n < 2; ++n) bx_[m][bj][n] = *(const f32x4*)(bp + bj * HALF + n * 16); }
#pragma unroll
            for (int m = 0; m < 4; ++m) { const int row = row0 + ai * HALF + m * 16;
                float* xo = xres + (size_t)row * DM + col0; bf16_t* bo = xb + (size_t)row * DM + col0; float s = 0.f;
#pragma unroll
                for (int bj = 0; bj < 2; ++bj)
#pragma unroll
                    for (int n = 0; n < 2; ++n) { const f32x4 x = bx_[m][bj][n] + acc[ai][bj][m][n];
                        *(f32x4*)(xo + bj * HALF + n * 16) = x; if (write_xb) { u32x2 w; w.x = cvtpk(x[0], x[1]); w.y = cvtpk(x[2], x[3]); *(u32x2*)(bo + bj * HALF + n * 16) = w; }
                        s += (x[0] * x[0] + x[1] * x[1]) + (x[2] * x[2] + x[3] * x[3]); }
                s = xsum16(s); s = xsum32(s);
                if (fq == 0) unsafeAtomicAdd(ssq_next + row, s); } }
    }
};
struct EpiKVQ {
    static constexpr bool PERM = true;
    int pn_off; const float* ssq; float* out; unsigned char* ws; const float* b_f;
    __device__ __forceinline__ void operator()(AccRef acc, const Unit& un, int wr, int wc, int fr, int fq) const {
        const int tt = un.pn + pn_off;
        const int row0 = un.pm * BM + wr * 64 + fr, cw = wc * 32 + 8 * fq;
        float rrs[2][4];
#pragma unroll
        for (int ai = 0; ai < 2; ++ai)
#pragma unroll
            for (int m = 0; m < 4; ++m) rrs[ai][m] = ssq[row0 + ai * HALF + m * 16];
        if (tt == 16) {
            if (wc == 0 && fq < 2) {
            const f32x4 bf0 = *(const f32x4*)(b_f + 8 * fq), bf1 = *(const f32x4*)(b_f + 8 * fq + 4);
            float* lft_p = (float*)(ws + WS_LFTP); float* lft_s = (float*)(ws + WS_LFTS);
#pragma unroll
            for (int ai = 0; ai < 2; ++ai)
#pragma unroll
                for (int m = 0; m < 4; ++m) { const int row = row0 + ai * HALF + m * 16; const float rr = rsqrtf(rrs[ai][m] * (1.0f / DM) + EPS);
                    f32x4 v0 = acc[ai][0][m][0] * rr + bf0, v1 = acc[ai][0][m][1] * rr + bf1;
#pragma unroll
                    for (int j = 0; j < 4; ++j) { v0[j] = logsig(v0[j]); v1[j] = logsig(v1[j]); }
                    if (row < MP) { float* o = out + O_LFP + (size_t)row * NH + 8 * fq; *(f32x4*)o = v0; *(f32x4*)(o + 4) = v1;
                        float* tp = lft_p + ((size_t)(row >> 12) * NH + 8 * fq) * SEQ + (row & (SEQ - 1));
#pragma unroll
                        for (int j = 0; j < 4; ++j) { tp[(size_t)j * SEQ] = v0[j]; tp[(size_t)(j + 4) * SEQ] = v1[j]; } }
                    else { const int rs = row - MP; float* o = out + O_LFS + (size_t)rs * NH + 8 * fq; *(f32x4*)o = v0; *(f32x4*)(o + 4) = v1;
                        float* tp = lft_s + ((size_t)(rs >> 4) * NH + 8 * fq) * DSEQ + (rs & 15);
#pragma unroll
                        for (int j = 0; j < 4; ++j) { tp[j * DSEQ] = v0[j]; tp[(j + 4) * DSEQ] = v1[j]; } } }
            }
        } else {
        const int kind = tt < 8 ? 0 : (tt < 16 ? 1 : (tt < 25 ? 2 : 3));
        const int colt = (tt - (kind == 0 ? 0 : kind == 1 ? 8 : kind == 2 ? 17 : 25)) * BM + cw;
        float* fo_p = out + (kind == 0 ? O_KP : O_VP); float* fo_s = out + (kind == 0 ? O_KS : O_VS);
        bf16_t* bo = (bf16_t*)(ws + (kind == 0 ? WS_KB : (kind == 1 ? WS_VB : (kind == 2 ? WS_QB : WS_SGB))));
#pragma unroll
        for (int ai = 0; ai < 2; ++ai)
#pragma unroll
            for (int m = 0; m < 4; ++m) { const int row = row0 + ai * HALF + m * 16; float rr = rsqrtf(rrs[ai][m] * (1.0f / DM) + EPS);
                if (kind == 2) rr *= QSCALE;
                float* fo = (row < MP ? fo_p + (size_t)row * DM : fo_s + (size_t)(row - MP) * DM) + colt;
#pragma unroll
                for (int bj = 0; bj < 2; ++bj) { f32x4 v0 = acc[ai][bj][m][0] * rr, v1 = acc[ai][bj][m][1] * rr;
                    if (kind < 2) { *(f32x4*)(fo + bj * HALF) = v0; *(f32x4*)(fo + bj * HALF + 4) = v1; }
                    if (kind == 3) {
#pragma unroll
                        for (int j = 0; j < 4; ++j) { v0[j] = silu_f(v0[j]); v1[j] = silu_f(v1[j]); } }
                    *(bf16x8*)(bo + (size_t)row * DM + colt + bj * HALF) = pack8(v0, v1);
                    if (kind == 0 || kind == 2) {
                        float ss = (v0[0] * v0[0] + v0[1] * v0[1]) + (v0[2] * v0[2] + v0[3] * v0[3]) + (v1[0] * v1[0] + v1[1] * v1[1]) + (v1[2] * v1[2] + v1[3] * v1[3]);
                        ss = xsum16(ss); ss = xsum32(ss);
                        float* nt = (float*)(ws + (kind == 0 ? WS_KNRM : WS_QNRM));
                        if (fq == 0) nt[((size_t)row * NH + 2 * (colt >> 8) + bj) * 4 + wc] = ss; } } }
        }
    }
};
}

namespace att {
constexpr int NW = 8, QBLK = 32, KVBLK = 64, QB = NW * QBLK, D = 128, LD = 2048;
constexpr int SHM_V = KVBLK * D * 2, SHM_K = KVBLK * D * 2;
constexpr int OFF_WS = 2 * SHM_V + 2 * SHM_K, OFF_F = OFF_WS + NW * 64 * 4, OFF_SC = OFF_F + SEQ * 4, OFF_KT = OFF_SC + 64, OFF_QM = OFF_KT + 256, OFF_JL = OFF_QM + 128;
constexpr float SKIP_T = 32.f;
constexpr float THR2 = 11.5f;
#define KSWZ(row, colB) ((row) * 256 + ((colB) ^ (((row) & 7) << 4)))
#define SBAR() __builtin_amdgcn_sched_barrier(0)
__device__ __forceinline__ int v_st(int k, int c) { const int kk = (k & ~0xC) | ((k & 4) << 1) | ((k & 8) >> 1); return ((kk >> 3) * 4 + (c >> 5)) * 512 + ((kk & 7) * 32 + (c & 31)) * 2; }
__device__ __forceinline__ int v_rd_base(int lane) { return ((lane & 3) << 3) | (((lane >> 2) & 3) << 6) | (((lane >> 4) & 1) << 5) | (((lane >> 5) & 1) << 8); }
constexpr int v_rd_off(int d0, int ks, int half) { return d0 * 512 + ks * 4096 + half * 2048; }
__device__ __forceinline__ int crow(int r, int hi) { return (r & 3) + 8 * (r >> 2) + 4 * hi; }
__device__ __forceinline__ void mask_tile(f32x16& p0, f32x16& p1, int dq) {
    const float NEG = -__builtin_inff();
#pragma unroll
    for (int r = 0; r < 16; ++r) { const int c = (r & 3) + 8 * (r >> 2);
        if (dq - c < 0) p0[r] = NEG;
        if (dq - c - 32 < 0) p1[r] = NEG; }
}
__device__ __forceinline__ void partialSM(f32x16& p0, f32x16& p1, float& m_reg, float& mn, float& alpha) {
    float pmax = p0[0];
#pragma unroll
    for (int r = 1; r < 16; ++r) pmax = fmaxf(pmax, p0[r]);
#pragma unroll
    for (int r = 0; r < 16; ++r) pmax = fmaxf(pmax, p1[r]);
    { auto rr = __builtin_amdgcn_permlane32_swap(__float_as_uint(pmax), __float_as_uint(pmax), false, false);
      pmax = fmaxf(__uint_as_float(rr[0]), __uint_as_float(rr[1])); }
    if (__builtin_expect(__all((pmax - m_reg) <= THR2), 1)) { mn = m_reg; alpha = 1.f; }
    else { mn = fmaxf(m_reg, pmax); alpha = __builtin_amdgcn_exp2f(m_reg - mn); m_reg = mn; }
#pragma unroll
    for (int r = 0; r < 16; ++r) p0[r] = p0[r] - mn;
#pragma unroll
    for (int r = 0; r < 16; ++r) p1[r] = p1[r] - mn;
#pragma unroll
    for (int r = 0; r < 16; ++r) p0[r] = __builtin_amdgcn_exp2f(p0[r]);
}
__device__ __forceinline__ void finishSM(f32x16& p0, f32x16& p1, float alpha, float& l_reg, bf16x8& pa0, bf16x8& pa1, bf16x8& pa2, bf16x8& pa3) {
#pragma unroll
    for (int r = 0; r < 16; ++r) p1[r] = __builtin_amdgcn_exp2f(p1[r]);
    float ps = 0;
#pragma unroll
    for (int r = 0; r < 16; ++r) ps += p0[r];
#pragma unroll
    for (int r = 0; r < 16; ++r) ps += p1[r];
    { auto rr = __builtin_amdgcn_permlane32_swap(__float_as_uint(ps), __float_as_uint(ps), false, false);
      ps = __uint_as_float(rr[0]) + __uint_as_float(rr[1]); }
    l_reg = l_reg * alpha + ps;
#define PK4(P, B_, OUT) do { unsigned a0 = cvtpk(P[B_+0], P[B_+1]), a1 = cvtpk(P[B_+2], P[B_+3]);                          \
        unsigned b0 = cvtpk(P[B_+4], P[B_+5]), b1 = cvtpk(P[B_+6], P[B_+7]);                                             \
        auto r0 = __builtin_amdgcn_permlane32_swap(a0, b0, false, false); auto r1 = __builtin_amdgcn_permlane32_swap(a1, b1, false, false); \
        u32x4 w = {r0[0], r1[0], r0[1], r1[1]}; OUT = *reinterpret_cast<bf16x8*>(&w); } while (0)
    PK4(p0, 0, pa0); PK4(p0, 8, pa1); PK4(p1, 0, pa2); PK4(p1, 8, pa3);
#undef PK4
}
template <int KB>
__device__ __forceinline__ void qkt(f32x16& p0, f32x16& p1, const char* K_lds, const float* fl, int r32, int hi, const bf16x8* qr) {
    { const f32x4 a0 = *(const f32x4*)(fl), a1 = *(const f32x4*)(fl + 8), a2 = *(const f32x4*)(fl + 16), a3 = *(const f32x4*)(fl + 24);
      const f32x4 b0 = *(const f32x4*)(fl + 32), b1 = *(const f32x4*)(fl + 40), b2 = *(const f32x4*)(fl + 48), b3 = *(const f32x4*)(fl + 56);
      p0 = (f32x16){a0[0], a0[1], a0[2], a0[3], a1[0], a1[1], a1[2], a1[3], a2[0], a2[1], a2[2], a2[3], a3[0], a3[1], a3[2], a3[3]};
      p1 = (f32x16){b0[0], b0[1], b0[2], b0[3], b1[0], b1[1], b1[2], b1[3], b2[0], b2[1], b2[2], b2[3], b3[0], b3[1], b3[2], b3[3]}; }
    const char* kb[4];
#pragma unroll
    for (int dd = 0; dd < 4; ++dd) kb[dd] = K_lds + KB * SHM_K + KSWZ(r32, (dd * 16 + hi * 8) * 2);
#pragma unroll
    for (int d0 = 0; d0 < 8; ++d0) { const char* a = kb[d0 & 3] + (d0 >> 2) * 128;
        bf16x8 b0 = *reinterpret_cast<const bf16x8*>(a);
        bf16x8 b1 = *reinterpret_cast<const bf16x8*>(a + 32 * 256);
        p0 = __builtin_amdgcn_mfma_f32_32x32x16_bf16(b0, qr[d0], p0, 0, 0, 0);
        p1 = __builtin_amdgcn_mfma_f32_32x32x16_bf16(b1, qr[d0], p1, 0, 0, 0); }
}
template <int VB>
__device__ __forceinline__ void pv_tile(f32x16* o, int vb0, bf16x8 pa0, bf16x8 pa1, bf16x8 pa2, bf16x8 pa3) {
#define TRRD(dst, off) asm volatile("ds_read_b64_tr_b16 %0, %1 offset:%2" : "=&v"(dst) : "v"(vb0), "i"(off) : "memory")
#define PV_D0(d0) do { s16x4 l0, l1, l2, l3, h0, h1, h2, h3; constexpr int b_ = VB * SHM_V + v_rd_off(d0, 0, 0);   \
        TRRD(l0, b_); TRRD(h0, b_ + 2048); TRRD(l1, b_ + 4096); TRRD(h1, b_ + 6144); TRRD(l2, b_ + 8192); TRRD(h2, b_ + 10240); TRRD(l3, b_ + 12288); TRRD(h3, b_ + 14336); \
        asm volatile("s_waitcnt lgkmcnt(0)" ::: "memory"); SBAR();   \
        o[d0] = __builtin_amdgcn_mfma_f32_32x32x16_bf16(pa0, (bf16x8){l0[0], l0[1], l0[2], l0[3], h0[0], h0[1], h0[2], h0[3]}, o[d0], 0, 0, 0);   \
        o[d0] = __builtin_amdgcn_mfma_f32_32x32x16_bf16(pa1, (bf16x8){l1[0], l1[1], l1[2], l1[3], h1[0], h1[1], h1[2], h1[3]}, o[d0], 0, 0, 0);   \
        o[d0] = __builtin_amdgcn_mfma_f32_32x32x16_bf16(pa2, (bf16x8){l2[0], l2[1], l2[2], l2[3], h2[0], h2[1], h2[2], h2[3]}, o[d0], 0, 0, 0);   \
        o[d0] = __builtin_amdgcn_mfma_f32_32x32x16_bf16(pa3, (bf16x8){l3[0], l3[1], l3[2], l3[3], h3[0], h3[1], h3[2], h3[3]}, o[d0], 0, 0, 0); } while (0)
    PV_D0(0); PV_D0(1); PV_D0(2); PV_D0(3);
#undef PV_D0
#undef TRRD
}
struct Tensors { const bf16_t* q; const bf16_t* k; const bf16_t* v; bf16_t* og; const bf16_t* sg; const float* lft; };
struct BlockRef { unsigned q0, s0; int P0, jlo; };
struct Seam { bf16x8 qr[8]; bf16x8 st_v0, st_v1, st_k0, st_k1; };
#define ROWP(p, k0) ((p) + (unsigned)(k0) * (unsigned)LD)
#define VMW() asm volatile("s_waitcnt vmcnt(0)" ::: "memory")
#define VMWN(n) asm volatile("s_waitcnt vmcnt(%0)" :: "i"(n) : "memory")
#define LD8(p) (*reinterpret_cast<const bf16x8*>(p))
#define SLOAD_H(Kp, Vp, k0) do { S.st_v0 = LD8(ROWP(Vp, k0) + voff); S.st_v1 = LD8(ROWP(Vp, (k0) + 32) + voff);              \
                         S.st_k0 = LD8(ROWP(Kp, k0) + voff); S.st_k1 = LD8(ROWP(Kp, (k0) + 32) + voff); } while (0)
#define SWRITE_HK(bf) do { *(bf16x8*)(K_lds + (bf) * SHM_K + kws) = S.st_k0; *(bf16x8*)(K_lds + (bf) * SHM_K + kws + 32 * 256) = S.st_k1; } while (0)
#define SWRITE_HV(bf) do { *(bf16x8*)(V_lds + (bf) * SHM_V + vst0) = S.st_v0; *(bf16x8*)(V_lds + (bf) * SHM_V + vst0 + VST1) = S.st_v1; } while (0)
#define SWRITE_H(bf) do { SWRITE_HV(bf); SWRITE_HK(bf); } while (0)
__device__ __forceinline__ void prime(int wv, const Tensors& T, const BlockRef& cur, char* lds, Seam& S) {
    const int tid = otid(wv), wid = __builtin_amdgcn_readfirstlane(tid >> 6), lane = tid & 63, r32 = lane & 31, hi = lane >> 5;
    const int sr = tid >> 4, sc = (tid & 15) * 8, kws = KSWZ(sr, sc * 2); char* K_lds = lds + 2 * SHM_V;
    const unsigned voff = (unsigned)sr * LD + sc, qoff = (unsigned)(wid * QBLK + r32) * LD + hi * 8;
    const bf16_t* Qp = T.q + cur.q0; const bf16_t* Kh = T.k + cur.s0; const bf16_t* Vh = T.v + cur.s0;
#pragma unroll
    for (int d0 = 0; d0 < 8; ++d0) S.qr[d0] = LD8(Qp + qoff + d0 * 16);
    SLOAD_H(Kh, Vh, cur.jlo * KVBLK); VMW(); SWRITE_HK(0);
    __syncthreads();
}
__device__ __forceinline__ void block(int wv, const Tensors& T, const BlockRef& cur, const BlockRef& nxt, char* lds, Seam& S) {
    const int tid = otid(wv), wid = __builtin_amdgcn_readfirstlane(tid >> 6), lane = tid & 63, r32 = lane & 31, hi = lane >> 5;
    const int j_lo = cur.jlo, NT = (cur.P0 + QB) / KVBLK - j_lo;
    const int qlo = cur.P0 - j_lo * KVBLK + wid * QBLK, qm = qlo + r32 - 4 * hi;
    char* V_lds = lds; char* K_lds = lds + 2 * SHM_V;
    float* wsl = (float*)(lds + OFF_WS) + wid * 64; float* li_l = wsl, * al_l = wsl + 32;
    float* Fl = (float*)(lds + OFF_F);
    float m_reg = -1e30f, l_reg = 0; f32x16 o[4] = {};
    const int sr = tid >> 4, sc = (tid & 15) * 8, vst0 = v_st(sr, sc), kws = KSWZ(sr, sc * 2); constexpr int VST1 = 8192;
    const int vb0 = (int)(uintptr_t)V_lds + v_rd_base(lane);
    const bf16_t* Kh = T.k + cur.s0 + (unsigned)(j_lo * KVBLK) * LD; const bf16_t* Vh = T.v + cur.s0 + (unsigned)(j_lo * KVBLK) * LD;
    const unsigned voff = (unsigned)sr * LD + sc, qoff = (unsigned)(wid * QBLK + r32) * LD + hi * 8;
    const float* flb = Fl + j_lo * KVBLK + 4 * hi;
#define RESC(a) do { if (__any((a) < 1.f)) { if (hi == 0) al_l[r32] = (a); asm volatile("s_waitcnt lgkmcnt(0)" ::: "memory");              \
                     for (int d_ = 0; d_ < 4; ++d_) for (int r = 0; r < 16; ++r) o[d_][r] *= al_l[crow(r, hi)]; } } while (0)
#define KBASE(t) ((t) * KVBLK)
#define MASKT(P0_, P1_, t) do { const int kb_ = KBASE(t); if (kb_ + KVBLK - 1 > qlo) mask_tile(P0_, P1_, qm - kb_); } while (0)
#define SEAM_K0() do { VMWN(8); SWRITE_HK(0); SBAR(); } while (0)
    f32x16 pA0, pA1, pB0, pB1; float mnA, mnB, alA, alB; bf16x8 pa0, pa1, pa2, pa3;
    SWRITE_HV(0); SBAR();
    if (NT > 1) { SLOAD_H(Kh, Vh, KBASE(1)); }
    SBAR(); qkt<0>(pA0, pA1, K_lds, flb + KBASE(0), r32, hi, S.qr);
    MASKT(pA0, pA1, 0); partialSM(pA0, pA1, m_reg, mnA, alA);
    if (NT > 1) { VMW(); SWRITE_H(1); }
    __syncthreads();
#define HALF_STEP(PX0, PX1, mnX, alX, PY0, PY1, alY, t, KB, VB, SB) do {                                                      \
        SBAR(); qkt<KB>(PX0, PX1, K_lds, flb + KBASE(t), r32, hi, S.qr);                                             \
        finishSM(PY0, PY1, alY, l_reg, pa0, pa1, pa2, pa3); SBAR();                                                           \
        if ((t) + 1 < NT) { SLOAD_H(Kh, Vh, KBASE((t) + 1)); SBAR(); }                                               \
        pv_tile<VB>(o, vb0, pa0, pa1, pa2, pa3); MASKT(PX0, PX1, (t)); partialSM(PX0, PX1, m_reg, mnX, alX);                                        \
        __syncthreads();                                                                                                      \
        if ((t) + 1 < NT) { VMW(); SWRITE_H(SB); }                                                                          \
        RESC(alX); __syncthreads(); } while (0)
    for (int t = 1; t + 1 < NT; t += 2) {
        HALF_STEP(pB0, pB1, mnB, alB, pA0, pA1, alA, t, 1, 0, 0);
        HALF_STEP(pA0, pA1, mnA, alA, pB0, pB1, alB, t + 1, 0, 1, 1);
    }
    const bool even = (NT & 1) == 0;
    if (even) { SBAR(); qkt<1>(pB0, pB1, K_lds, flb + KBASE(NT - 1), r32, hi, S.qr); SBAR(); }
    { const bf16_t* Kn = T.k + nxt.s0; const bf16_t* Vn = T.v + nxt.s0; SLOAD_H(Kn, Vn, nxt.jlo * KVBLK); } SBAR();
    { const bf16_t* Qn = T.q + nxt.q0;
#pragma unroll
      for (int d0 = 0; d0 < 8; ++d0) S.qr[d0] = LD8(Qn + qoff + d0 * 16); }
    SBAR();
    finishSM(pA0, pA1, alA, l_reg, pa0, pa1, pa2, pa3); SBAR();
    pv_tile<0>(o, vb0, pa0, pa1, pa2, pa3);
    if (even) { MASKT(pB0, pB1, NT - 1); partialSM(pB0, pB1, m_reg, mnB, alB); __syncthreads(); RESC(alB);
        finishSM(pB0, pB1, alB, l_reg, pa0, pa1, pa2, pa3); SBAR(); pv_tile<1>(o, vb0, pa0, pa1, pa2, pa3); }
    SBAR(); SEAM_K0();
    if (hi == 0) li_l[r32] = l_reg; asm volatile("s_waitcnt lgkmcnt(0)" ::: "memory");
    float rli[16];
#pragma unroll
    for (int r = 0; r < 16; ++r) rli[r] = __builtin_amdgcn_rcpf(li_l[crow(r, hi)]);
    { const unsigned eoff = (unsigned)(4 * hi) * LD + r32;
      unsigned gg[16][4];
#pragma unroll
      for (int r = 0; r < 16; ++r) { const bf16_t* Grow = T.sg + cur.q0 + (unsigned)(wid * QBLK + (r & 3) + 8 * (r >> 2)) * LD;
#pragma unroll
        for (int d0 = 0; d0 < 4; ++d0) gg[r][d0] = *(const unsigned*)(Grow + (eoff & ~1u) + d0 * 32); }
#pragma unroll
      for (int r = 0; r < 16; ++r) { bf16_t* Orow = T.og + cur.q0 + (unsigned)(wid * QBLK + (r & 3) + 8 * (r >> 2)) * LD;
#pragma unroll
        for (int d0 = 0; d0 < 4; ++d0) { const float v = o[d0][r] * rli[r];
            const float vn = __shfl_xor(v, 1);
            if ((r32 & 1) == 0) *(unsigned*)(Orow + eoff + d0 * 32) = cvtpk(v * bflo(gg[r][d0]), vn * bfhi(gg[r][d0])); } } }
    __syncthreads();
#undef RESC
#undef KBASE
#undef MASKT
#undef SEAM_K0
#undef HALF_STEP
}
#undef ROWP
#undef VMW
#undef VMWN
#undef SLOAD_H
#undef SWRITE_HK
#undef SWRITE_HV
#undef SWRITE_H
#undef LD8

__device__ __forceinline__ BlockRef mkref(int bh, int qb) {
    const int b = bh >> 4, h = bh & 15; BlockRef r; r.s0 = (unsigned)b * SEQ * LD + h * D; r.q0 = r.s0 + (unsigned)qb * QB * LD; r.jlo = 0; r.P0 = qb * QB; return r;
}
__device__ __forceinline__ void item_setup(int wv, const Tensors& T, const float* knrm, const float* qnrm, int bh, unsigned blks, int nb, char* lds) {
    const int tid = otid(wv), wid = __builtin_amdgcn_readfirstlane(tid >> 6), lane = tid & 63;
    float* Fl = (float*)(lds + OFF_F); float* scn = (float*)(lds + OFF_SC); float* Kt = (float*)(lds + OFF_KT); float* Qm = (float*)(lds + OFF_QM); int* JL = (int*)(lds + OFF_JL);
    const int b = bh >> 4, h = bh & 15, xmax = (int)((blks >> (4 * (nb - 1))) & 15u), nkeys = (xmax + 1) * QB, t0 = tid * 8;
    const float* LF = T.lft + (size_t)bh * SEQ;
    f32x4 a = {0.f, 0.f, 0.f, 0.f}, c = {0.f, 0.f, 0.f, 0.f};
    float kmx = 0.f;
    if (t0 < nkeys) { a = *(const f32x4*)(LF + t0); c = *(const f32x4*)(LF + t0 + 4);
        const float* kn = knrm + ((size_t)(b * SEQ + t0) * NH + h) * 4;
#pragma unroll
        for (int i = 0; i < 8; ++i) { const f32x4 p = *(const f32x4*)(kn + (size_t)i * NH * 4); kmx = fmaxf(kmx, (p[0] + p[1]) + (p[2] + p[3])); } }
    kmx = fmaxf(kmx, bperm(kmx, lane ^ 1)); kmx = fmaxf(kmx, bperm(kmx, lane ^ 2)); kmx = fmaxf(kmx, bperm(kmx, lane ^ 4));
    if ((tid & 7) == 0 && t0 < nkeys) Kt[tid >> 3] = sqrtf(kmx) * 1.01f;
#pragma unroll 1
    for (int bi = 0; bi < nb; bi += 2) { const int bsel = bi + (tid >> 8);
        if (bsel < nb) { const int x = (int)((blks >> (4 * bsel)) & 15u), qrow = b * SEQ + x * QB + (tid & 255);
            const f32x4 p = *(const f32x4*)(qnrm + ((size_t)qrow * NH + h) * 4); float qm = (p[0] + p[1]) + (p[2] + p[3]);
#pragma unroll
            for (int o = 1; o < 64; o <<= 1) qm = fmaxf(qm, bperm(qm, lane ^ o));
            if (lane == 0) Qm[bsel * 4 + (wid & 3)] = qm; } }
    a[1] += a[0]; a[2] += a[1]; a[3] += a[2]; c[0] += a[3]; c[1] += c[0]; c[2] += c[1]; c[3] += c[2];
    const float tot = c[3]; float inc = tot;
#pragma unroll
    for (int o = 1; o < 64; o <<= 1) { const float v = bperm(inc, (lane - o) & 63); if (lane >= o) inc += v; }
    if (lane == 63) scn[wid] = inc;
    if (tid < nb) JL[tid] = (int)((blks >> (4 * tid)) & 15u) * 4;
    __syncthreads();
    float base = inc - tot;
    for (int w = 0; w < wid; ++w) base += scn[w];
    a = (a + base) * (-LOG2E); c = (c + base) * (-LOG2E);
    if (t0 < nkeys) { *(f32x4*)(Fl + t0) = a; *(f32x4*)(Fl + t0 + 4) = c; }
    __syncthreads();
    { const int which = tid >> 6, j = tid & 63;
      if (which < nb) { const int x = (int)((blks >> (4 * which)) & 15u), nd = x * 4;
        if (j < nd) { const float qmax = sqrtf(fmaxf(fmaxf(Qm[which * 4], Qm[which * 4 + 1]), fmaxf(Qm[which * 4 + 2], Qm[which * 4 + 3]))) * 1.01f;
            const float kdiag = fmaxf(fmaxf(Kt[nd], Kt[nd + 1]), fmaxf(Kt[nd + 2], Kt[nd + 3]));
            const bool skip = qmax * (Kt[j] + kdiag) + Fl[64 * j + 63] - Fl[x * QB] < -SKIP_T;
            if (!skip) atomicMin(JL + which, j); } } }
    __syncthreads();
}
__device__ __forceinline__ void prompt_phase(int wv, char* lds, const Tensors& T, const float* knrm, const float* qnrm, int pw) {
    const int bh = pw / 3, gsel = pw - bh * 3;
    const unsigned blks = gsel == 0 ? 0xDA742u : (gsel == 1 ? 0xEB8510u : 0xFC963u); const int nb = gsel == 1 ? 6 : 5;
    item_setup(wv, T, knrm, qnrm, bh, blks, nb, lds);
    const int* JL = (const int*)(lds + OFF_JL);
    Seam S;
    BlockRef cur = mkref(bh, (int)(blks & 15u)); cur.jlo = __builtin_amdgcn_readfirstlane(JL[0]);
    prime(wv, T, cur, lds, S);
#pragma unroll 1
    for (int i = 0; i < nb; ++i) { const int in = i + 1 < nb ? i + 1 : i;
        BlockRef nxt = mkref(bh, (int)((blks >> (4 * in)) & 15u)); nxt.jlo = __builtin_amdgcn_readfirstlane(JL[in]);
        block(wv, T, cur, nxt, lds, S);
        cur = nxt; }
}
}

namespace sat {
constexpr int OFF_F = 0, OFF_SC = 8448, OFF_P = 8704, OFF_A = OFF_P + 8 * 4096, OFF_ML = OFF_A + 512, OFF_O = OFF_ML + 1024;
struct Tensors { const bf16_t* q; const bf16_t* kb; const bf16_t* vb; bf16_t* og; const bf16_t* sg; const float* ck; const float* cv; const float* clf; const float* lfts; };
__device__ __forceinline__ void item(int wv, char* lds, const Tensors& T, int b, int h) {
    const int tid = otid(wv), wid = __builtin_amdgcn_readfirstlane(tid >> 6), lane = tid & 63, fr = lane & 15, fq = lane >> 4;
    float* Fl = (float*)(lds + OFF_F); float* scn = (float*)(lds + OFF_SC);
    float* ML = (float*)(lds + OFF_ML); float* Op = (float*)(lds + OFF_O);
    { const float* cl = T.clf + ((size_t)b * PAST + tid * 4) * NH + h;
      float a0 = cl[0], a1 = cl[NH], a2 = cl[2 * NH], a3 = cl[3 * NH];
      a1 += a0; a2 += a1; a3 += a2;
      const float tot = a3; float inc = tot;
#pragma unroll
      for (int o = 1; o < 64; o <<= 1) { const float v = bperm(inc, (lane - o) & 63); if (lane >= o) inc += v; }
      if (lane == 63) scn[wid] = inc;
      __syncthreads();
      float base = inc - tot, all = 0.f;
      for (int w = 0; w < 8; ++w) { const float sw = scn[w]; if (w < wid) base += sw; all += sw; }
      *(f32x4*)(Fl + tid * 4) = (f32x4){(a0 + base) * (-LOG2E), (a1 + base) * (-LOG2E), (a2 + base) * (-LOG2E), (a3 + base) * (-LOG2E)};
      if (tid < DSEQ) { const float* nl = T.lfts + ((size_t)b * NH + h) * DSEQ; float s = all; for (int i = 0; i <= tid; ++i) s += nl[i]; Fl[PAST + tid] = s * (-LOG2E); }
      __syncthreads(); }
    const size_t qrow = (size_t)(MP + b * DSEQ);
    bf16x8 qf[4];
#pragma unroll
    for (int dc = 0; dc < 4; ++dc) qf[dc] = *(const bf16x8*)(T.q + (qrow + fr) * DM + h * HD + dc * 32 + fq * 8);
    float m_run = -1e30f, l_run = 0.f;
    f32x4 ot[8];
#pragma unroll
    for (int dt = 0; dt < 8; ++dt) ot[dt] = (f32x4){0.f, 0.f, 0.f, 0.f};
    const unsigned vlo = (unsigned)(fq * 4) * (NH * HD) + fr;
    for (int ch = 0; ch < 4; ++ch) {
        const int key0 = (ch * 8 + wid) * 64;
        f32x4 s4[4];
        { f32x4 kk[4][4][2];
#pragma unroll
          for (int tl = 0; tl < 4; ++tl) { const float* kp = T.ck + (((size_t)b * PAST + key0 + tl * 16 + fr) * NH + h) * HD + fq * 8;
#pragma unroll
            for (int dc = 0; dc < 4; ++dc) { kk[tl][dc][0] = *(const f32x4*)(kp + dc * 32); kk[tl][dc][1] = *(const f32x4*)(kp + dc * 32 + 4); } }
          __builtin_amdgcn_sched_barrier(0);
#pragma unroll
          for (int tl = 0; tl < 4; ++tl) { f32x4 acc = *(const f32x4*)(Fl + key0 + tl * 16 + fq * 4);
#pragma unroll
            for (int dc = 0; dc < 4; ++dc) acc = __builtin_amdgcn_mfma_f32_16x16x32_bf16(pack8(kk[tl][dc][0], kk[tl][dc][1]), qf[dc], acc, 0, 0, 0);
            s4[tl] = acc; } }
        __builtin_amdgcn_sched_barrier(0);
        float vv[2][8][8];
        { const float* vb_c = T.cv + (((size_t)b * PAST + key0) * NH + h) * HD;
#pragma unroll
          for (int hf = 0; hf < 2; ++hf)
#pragma unroll
            for (int dt = 0; dt < 8; ++dt)
#pragma unroll
                for (int i = 0; i < 4; ++i) { vv[hf][dt][i] = (vb_c + (size_t)(hf * 32 + i) * (NH * HD) + dt * 16)[vlo]; vv[hf][dt][4 + i] = (vb_c + (size_t)(hf * 32 + 16 + i) * (NH * HD) + dt * 16)[vlo]; } }
        float cm = s4[0][0];
#pragma unroll
        for (int tl = 0; tl < 4; ++tl)
#pragma unroll
            for (int j = 0; j < 4; ++j) cm = fmaxf(cm, s4[tl][j]);
        cm = xmax16(cm); cm = xmax32(cm);
        const float mn = fmaxf(m_run, cm), alpha = __builtin_amdgcn_exp2f(m_run - mn); m_run = mn;
        float ps = 0.f;
#pragma unroll
        for (int tl = 0; tl < 4; ++tl)
#pragma unroll
            for (int j = 0; j < 4; ++j) { s4[tl][j] = __builtin_amdgcn_exp2f(s4[tl][j] - mn); ps += s4[tl][j]; }
        ps = xsum16(ps); ps = xsum32(ps);
        l_run = l_run * alpha + ps;
#pragma unroll
        for (int dt = 0; dt < 8; ++dt) ot[dt] *= alpha;
#pragma unroll
        for (int hf = 0; hf < 2; ++hf) {
            const bf16x8 pb = pack8(s4[2 * hf], s4[2 * hf + 1]);
#pragma unroll
            for (int dt = 0; dt < 8; ++dt) { const f32x4 v0 = {vv[hf][dt][0], vv[hf][dt][1], vv[hf][dt][2], vv[hf][dt][3]}, v1 = {vv[hf][dt][4], vv[hf][dt][5], vv[hf][dt][6], vv[hf][dt][7]};
                ot[dt] = __builtin_amdgcn_mfma_f32_16x16x32_bf16(pack8(v0, v1), pb, ot[dt], 0, 0, 0); } }
    }
    if (wid == 0) {
        f32x4 acc = *(const f32x4*)(Fl + PAST + fq * 4);
        const bf16_t* kp = T.kb + (qrow + fr) * DM + h * HD + fq * 8;
#pragma unroll
        for (int dc = 0; dc < 4; ++dc) acc = __builtin_amdgcn_mfma_f32_16x16x32_bf16(*(const bf16x8*)(kp + dc * 32), qf[dc], acc, 0, 0, 0);
#pragma unroll
        for (int j = 0; j < 4; ++j) if (fq * 4 + j > fr) acc[j] = -__builtin_inff();
        float cm = fmaxf(fmaxf(acc[0], acc[1]), fmaxf(acc[2], acc[3]));
        cm = xmax16(cm); cm = xmax32(cm);
        const float mn = fmaxf(m_run, cm), alpha = __builtin_amdgcn_exp2f(m_run - mn); m_run = mn;
        float ps = 0.f;
#pragma unroll
        for (int j = 0; j < 4; ++j) { acc[j] = __builtin_amdgcn_exp2f(acc[j] - mn); ps += acc[j]; }
        ps = xsum16(ps); ps = xsum32(ps);
        l_run = l_run * alpha + ps;
        const bf16x8 pb = pack8(acc, (f32x4){0.f, 0.f, 0.f, 0.f});
        const bf16_t* vb_u = T.vb + qrow * DM + h * HD; const unsigned vlo2 = (unsigned)(fq * 4) * DM + fr;
#pragma unroll
        for (int dt = 0; dt < 8; ++dt) { ot[dt] *= alpha;
            unsigned w0 = (unsigned)(vb_u + dt * 16)[vlo2] | ((unsigned)(vb_u + DM + dt * 16)[vlo2] << 16), w1 = (unsigned)(vb_u + 2 * DM + dt * 16)[vlo2] | ((unsigned)(vb_u + 3 * DM + dt * 16)[vlo2] << 16);
            u32x4 w = {w0, w1, 0u, 0u};
            ot[dt] = __builtin_amdgcn_mfma_f32_16x16x32_bf16(*reinterpret_cast<bf16x8*>(&w), pb, ot[dt], 0, 0, 0); }
    }
#pragma unroll
    for (int dt = 0; dt < 8; ++dt) *(f32x4*)(Op + (wid * 16 + fr) * HD + dt * 16 + fq * 4) = ot[dt];
    if (fq == 0) { ML[(wid * 16 + fr) * 2] = m_run; ML[(wid * 16 + fr) * 2 + 1] = l_run; }
    __syncthreads();
    { const int q = tid >> 5, d4 = (tid & 31) * 4;
      float mx = ML[q * 2];
#pragma unroll
      for (int w = 1; w < 8; ++w) mx = fmaxf(mx, ML[(w * 16 + q) * 2]);
      float L = 0.f; f32x4 O = {0.f, 0.f, 0.f, 0.f};
#pragma unroll
      for (int w = 0; w < 8; ++w) { const float s = __builtin_amdgcn_exp2f(ML[(w * 16 + q) * 2] - mx); L += s * ML[(w * 16 + q) * 2 + 1]; O += *(const f32x4*)(Op + (w * 16 + q) * HD + d4) * s; }
      const float il = 1.0f / L; const size_t off = (qrow + q) * DM + h * HD + d4;
      const u32x2 gw = *(const u32x2*)(T.sg + off);
      u32x2 w; w.x = cvtpk(O[0] * il * bflo(gw.x), O[1] * il * bfhi(gw.x)); w.y = cvtpk(O[2] * il * bflo(gw.y), O[3] * il * bfhi(gw.y));
      *(u32x2*)(T.og + off) = w; }
    __syncthreads();
}
}

struct TrV { f32x4 v[8]; };
__device__ __forceinline__ void tr_load(const float* W, int ldw, int N, const float* g, int item, int lane, TrV& t) {
    const int nblk = (N + 31) / 32, kb = item / nblk, nb = item % nblk, k0 = 64 * kb, n0 = 32 * nb;
    const int c4 = (lane & 7) * 4, kr = lane >> 3; const bool nok = n0 + c4 < N;
#pragma unroll
    for (int i = 0; i < 8; ++i) t.v[i] = nok ? *(const f32x4*)(W + (size_t)(k0 + 8 * i + kr) * ldw + n0 + c4) : (f32x4){0.f, 0.f, 0.f, 0.f};
    if (g) {
#pragma unroll
        for (int i = 0; i < 8; ++i) t.v[i] *= g[k0 + 8 * i + kr]; }
}
__device__ __forceinline__ void tr_emit(int N, bf16_t* WT, int K, float* scr, int item, int lane, const TrV& t, bf16_t* plain) {
    const int nblk = (N + 31) / 32, kb = item / nblk, nb = item % nblk, k0 = 64 * kb, n0 = 32 * nb;
    const int c4 = (lane & 7) * 4, kr = lane >> 3;
#pragma unroll
    for (int i = 0; i < 8; ++i) { float* s = scr + (8 * i + kr) * 33 + c4; s[0] = t.v[i][0]; s[1] = t.v[i][1]; s[2] = t.v[i][2]; s[3] = t.v[i][3]; }
    if (plain && n0 + c4 < N) {
#pragma unroll
        for (int i = 0; i < 8; ++i) { u32x2 w; w.x = cvtpk(t.v[i][0], t.v[i][1]); w.y = cvtpk(t.v[i][2], t.v[i][3]); *(u32x2*)(plain + (size_t)(k0 + 8 * i + kr) * N + n0 + c4) = w; } }
    asm volatile("s_waitcnt lgkmcnt(0)" ::: "memory");
    const int c = lane & 7;
#pragma unroll
    for (int j = 0; j < 4; ++j) { const int nn = (lane >> 3) + 8 * j; const float* s = scr + (8 * c) * 33 + nn;
        u32x4 o; o.x = cvtpk(s[0 * 33], s[1 * 33]); o.y = cvtpk(s[2 * 33], s[3 * 33]); o.z = cvtpk(s[4 * 33], s[5 * 33]); o.w = cvtpk(s[6 * 33], s[7 * 33]);
        if (n0 + nn < N) *(u32x4*)(WT + (size_t)(n0 + nn) * K + k0 + 8 * c) = o; }
    asm volatile("s_waitcnt lgkmcnt(0)" ::: "memory");
}
struct TJob { const float* W; bf16_t* WT; const float* g; int K, N, ldw; bf16_t* plain; };
__device__ __forceinline__ TJob get_job(const Params& p, int j) {
    unsigned char* ws = p.ws; TJob t; t.g = nullptr; t.ldw = 0; t.plain = nullptr;
    if (j < 2) { t.W = p.in[7] + (size_t)j * DM * 2 * EA + EA; t.WT = (bf16_t*)(ws + WS_WINA) + (size_t)j * 2 * EA * DM + (size_t)EA * DM; t.g = p.in[6] + j * DM; t.K = DM; t.N = EA; t.ldw = 2 * EA; }
    else if (j >= 17) { const int l = j - 17; t.W = p.in[7] + (size_t)l * DM * 2 * EA; t.WT = (bf16_t*)(ws + WS_WINUT) + (size_t)l * EA * DM; t.g = p.in[6] + l * DM; t.K = DM; t.N = EA; t.ldw = 2 * EA; t.plain = (bf16_t*)(ws + WS_WINUS) + (size_t)l * DM * EA; }
    else if (j < 10) { const int i = j - 2; t.W = p.in[8] + (size_t)i * 1024 * 1024; t.WT = (bf16_t*)(ws + WS_WGRP) + (size_t)i * 1024 * 1024; t.K = 1024; t.N = 1024; }
    else if (j < 12) { const int l = j - 10; t.W = p.in[10] + (size_t)l * EA * DM; t.WT = (bf16_t*)(ws + WS_WOUTA) + (size_t)l * DM * EA; t.K = EA; t.N = DM; }
    else if (j == 12) { t.W = p.in[12]; t.WT = (bf16_t*)(ws + WS_W4); t.g = p.in[11]; t.K = DM; t.N = 2 * DM + NH; }
    else if (j == 13) { t.W = p.in[15]; t.WT = (bf16_t*)(ws + WS_W4) + (size_t)4352 * DM; t.g = p.in[14]; t.K = DM; t.N = 2 * DM; }
    else if (j == 14) { t.W = p.in[15] + (size_t)DM * 2 * DM; t.WT = (bf16_t*)(ws + WS_WINB1); t.g = p.in[14] + DM; t.K = DM; t.N = 2 * DM; }
    else { const int l = j - 15; t.W = p.in[16] + (size_t)l * DM * DM; t.WT = (bf16_t*)(ws + WS_WOUTB) + (size_t)l * DM * DM; t.K = DM; t.N = DM; }
    if (t.ldw == 0) t.ldw = t.N;
    return t;
}
__device__ __forceinline__ void prologue_phase(int wv, const Params& p, char* lds) {
    const int tid = otid(wv), lane = tid & 63, wid = tid >> 6, G = gridDim.x;
    const int gw = blockIdx.x * NWAVES + wid, NGW = G * NWAVES;
    float* scr = (float*)(lds + wid * 8704);
    int rot = 0;
    for (int j = 0; j < 19; ++j) { const TJob t = get_job(p, j); const int nitems = (t.K / 64) * ((t.N + 31) / 32);
        int start = gw - rot; if (start < 0) start += NGW;
        TrV cur_v, nxt_v;
        if (start < nitems) tr_load(t.W, t.ldw, t.N, t.g, start, lane, cur_v);
        for (int it = start; it < nitems; it += NGW) { const bool more = it + NGW < nitems;
            if (more) tr_load(t.W, t.ldw, t.N, t.g, it + NGW, lane, nxt_v);
            tr_emit(t.N, t.WT, t.K, scr, it, lane, cur_v, t.plain);
            if (more) {
#pragma unroll
                for (int i = 0; i < 8; ++i) cur_v.v[i] = nxt_v.v[i]; } }
        rot = (rot + nitems) % NGW; }
    float* ssq = (float*)(p.ws + WS_SSQ); bf16_t* xb = (bf16_t*)(p.ws + WS_XB);
    for (int m = gw; m < MT; m += NGW) { const float* xr = m < MP ? p.in[0] + (size_t)m * DM : p.in[1] + (size_t)(m - MP) * DM;
        float s = 0.f; unsigned long long* o8 = (unsigned long long*)(xb + (size_t)m * DM) + lane;
        f32x4 xv[8];
#pragma unroll
        for (int j = 0; j < 8; ++j) xv[j] = *((const f32x4*)xr + lane + 64 * j);
#pragma unroll
        for (int j = 0; j < 8; ++j) { const f32x4 v = xv[j]; s += (v[0] * v[0] + v[1] * v[1]) + (v[2] * v[2] + v[3] * v[3]);
            o8[64 * j] = (unsigned long long)cvtpk(v[0], v[1]) | ((unsigned long long)cvtpk(v[2], v[3]) << 32); }
        s = wave_sum(s); if (lane == 0) ssq[m] = s; }
    for (int i = blockIdx.x * NTHREADS + tid; i < 4 * MT; i += G * NTHREADS) ssq[MT + i] = 0.f;
    { f32x4* z = (f32x4*)(p.ws + WS_SPLIT); const size_t nz = (SPLIT_TILES * SPLIT_TILE + SPLIT_TILES * 8 * 4) / 16;
      for (size_t i = (size_t)blockIdx.x * NTHREADS + tid; i < nz; i += (size_t)G * NTHREADS) z[i] = (f32x4){0.f, 0.f, 0.f, 0.f}; }
    if (blockIdx.x == 0) { unsigned* bw = (unsigned*)(p.ws + WS_BAR); for (int i = tid; i < 3456; i += NTHREADS) bw[i] = 0u; }
    {
      bf16_t* pb = (bf16_t*)(p.ws + WS_PREVB);
      for (int i = blockIdx.x * NTHREADS + tid; i < 2 * 256 * (EA / 8); i += G * NTHREADS) { const int r = i >> 9, c = (i & 511) * 8, l = r >> 8, rr = r & 255;
          f32x4 a = {0.f, 0.f, 0.f, 0.f}, b = a;
          if (rr < NDB * PPAD) { const float* s = p.in[5] + ((size_t)l * NDB * PPAD + rr) * EA + c; a = *(const f32x4*)s; b = *(const f32x4*)(s + 4); }
          *(bf16x8*)(pb + (size_t)r * EA + c) = pack8(a, b); } }
}
template <int W>
__device__ __forceinline__ void poolmix_item(const bf16_t* tt, const bf16_t* sg, const float* scale, const bf16_t* prevt, bf16_t* yg, int row0, int ch) {
    constexpr int NR = 16 + W - 1;
    u32x4 rows[NR];
    const bool samp = row0 >= MP; const int t0 = samp ? 0 : (row0 & (SEQ - 1));
    const bf16_t* up = tt + (size_t)row0 * EA + ch;
    if (t0 != 0) {
#pragma unroll
        for (int i = 0; i < NR; ++i) rows[i] = *(const u32x4*)(up + (ptrdiff_t)(i - (W - 1)) * EA);
    } else {
#pragma unroll
        for (int i = W - 1; i < NR; ++i) rows[i] = *(const u32x4*)(up + (ptrdiff_t)(i - (W - 1)) * EA);
        if (samp) { const bf16_t* pp = prevt + ((size_t)((row0 - MP) >> 4) * PPAD + (PPAD - (W - 1))) * EA + ch;
#pragma unroll
            for (int i = 0; i < W - 1; ++i) rows[i] = *(const u32x4*)(pp + (size_t)i * EA); }
        else {
#pragma unroll
            for (int i = 0; i < W - 1; ++i) rows[i] = (u32x4){0u, 0u, 0u, 0u}; }
    }
    const f32x4 sc0 = *(const f32x4*)(scale + ch), sc1 = *(const f32x4*)(scale + ch + 4);
    float s[8] = {0.f, 0.f, 0.f, 0.f, 0.f, 0.f, 0.f, 0.f};
#define ROWF(v, f) const float f[8] = {bflo(v.x), bfhi(v.x), bflo(v.y), bfhi(v.y), bflo(v.z), bfhi(v.z), bflo(v.w), bfhi(v.w)}
#pragma unroll
    for (int i = 0; i < W - 1; ++i) { ROWF(rows[i], f);
#pragma unroll
        for (int c = 0; c < 8; ++c) s[c] += f[c]; }
    constexpr int GB = W == 16 ? 2 : (W == 8 ? 8 : 16);
    u32x4 gvs[GB];
#pragma unroll
    for (int j = 0; j < 16; ++j) { ROWF(rows[j + W - 1], f);
        if ((j & (GB - 1)) == 0) {
#pragma unroll
            for (int jj = 0; jj < GB; ++jj) gvs[jj] = *(const u32x4*)(sg + (size_t)(row0 + j + jj) * EA + ch); }
        const u32x4 gv = gvs[j & (GB - 1)]; ROWF(gv, gt);
#pragma unroll
        for (int c = 0; c < 8; ++c) s[c] += f[c];
        const int nv = (!samp && t0 + j + 1 < W) ? t0 + j + 1 : W; const float ic = 1.0f / (float)nv;
        u32x4 o; o.x = cvtpk((s[0] * ic - f[0]) * sc0[0] * gt[0], (s[1] * ic - f[1]) * sc0[1] * gt[1]); o.y = cvtpk((s[2] * ic - f[2]) * sc0[2] * gt[2], (s[3] * ic - f[3]) * sc0[3] * gt[3]);
        o.z = cvtpk((s[4] * ic - f[4]) * sc1[0] * gt[4], (s[5] * ic - f[5]) * sc1[1] * gt[5]); o.w = cvtpk((s[6] * ic - f[6]) * sc1[2] * gt[6], (s[7] * ic - f[7]) * sc1[3] * gt[7]);
        *(u32x4*)(yg + (size_t)(row0 + j) * EA + ch) = o;
        ROWF(rows[j], g);
#pragma unroll
        for (int c = 0; c < 8; ++c) s[c] -= g[c]; }
#undef ROWF
}
__device__ __forceinline__ void poolmix_phase(int wv, const Params& p, int l) {
    const bf16_t* tt = (const bf16_t*)(p.ws + WS_U); const bf16_t* sg = (const bf16_t*)(p.ws + WS_SG); bf16_t* yg = (bf16_t*)(p.ws + WS_D);
    const bf16_t* prevt = (const bf16_t*)(p.ws + WS_PREVT) + (size_t)l * 256 * EA; const float* scale = p.in[9] + (size_t)l * EA;
    const int tid = otid(wv), nth = gridDim.x * NTHREADS, total = (MT / 16) * (EA / 8), full = (total / nth) * nth;
    const bool deal = total - full <= (int)gridDim.x * 64;
    const int nmain = deal ? full : total;
    for (int base = 0; ; base += nth) {
        int idx;
        if (base < nmain) { idx = base + blockIdx.x * NTHREADS + tid; if (idx >= total) break; }
        else { if (!deal || base > full || tid >= 64 || full + (int)blockIdx.x * 64 >= total) break; idx = full + blockIdx.x * 64 + tid; }
        const int row0 = (idx >> 9) * 16, ch = (idx & 511) * 8, grp = __builtin_amdgcn_readfirstlane(ch >> 10);
        if (grp == 0) poolmix_item<2>(tt, sg, scale, prevt, yg, row0, ch);
        else if (grp == 1) poolmix_item<4>(tt, sg, scale, prevt, yg, row0, ch);
        else if (grp == 2) poolmix_item<8>(tt, sg, scale, prevt, yg, row0, ch);
        else poolmix_item<16>(tt, sg, scale, prevt, yg, row0, ch);
    }
}
__device__ __forceinline__ void final_phase(int wv, const Params& p) {
    const int tid = otid(wv), lane = tid & 63, gw = blockIdx.x * NWAVES + (tid >> 6), NGW = gridDim.x * NWAVES;
    const float* xres = (const float*)(p.ws + WS_XRES); const float* ssq = (const float*)(p.ws + WS_SSQ) + (size_t)4 * MT; const float* g = p.in[17];
    for (int m = gw; m < MT; m += NGW) { const float rr = rsqrtf(ssq[m] * (1.0f / DM) + EPS);
        const f32x4* xr = (const f32x4*)(xres + (size_t)m * DM) + lane; f32x4* o = (f32x4*)(p.out + (m < MP ? O_YP + (size_t)m * DM : O_YS + (size_t)(m - MP) * DM)) + lane;
        f32x4 xv[8];
#pragma unroll
        for (int j = 0; j < 8; ++j) xv[j] = xr[64 * j] * rr * ((const f32x4*)g)[lane + 64 * j];
#pragma unroll
        for (int j = 0; j < 8; ++j) o[64 * j] = xv[j]; }
}

#define XB_TMO      128
#define XB_XCNT(j)  (256  + 64 * (j))
#define XB_XSUB(j)  (1280 + 64 * (j))
#define XB_XGEN(j)  (2304 + 64 * (j))
#define XB_TOP      3328
#define XB_TOPGEN   3392
#define XCD_BAR_WORDS 3456
#define XB_SPIN_CAP (1u << 18)

__device__ __forceinline__ unsigned xb_ld(unsigned* p)              { return __hip_atomic_load(p, __ATOMIC_RELAXED, __HIP_MEMORY_SCOPE_AGENT); }
__device__ __forceinline__ unsigned xb_add(unsigned* p, unsigned v) { return __hip_atomic_fetch_add(p, v, __ATOMIC_RELAXED, __HIP_MEMORY_SCOPE_AGENT); }
__device__ __forceinline__ unsigned xb_xcc_id() { return (unsigned)__builtin_amdgcn_s_getreg((3 << 11) | 20) & 0xFu; }
#define XB_SPIN(cond, bar) do { unsigned _sp = 0; while (cond) { __builtin_amdgcn_s_sleep(1); \
    if ((++_sp & 255u) == 0u) { if (xb_ld(&(bar)[XB_TMO])) break; if (_sp > XB_SPIN_CAP) { atomicAdd(&(bar)[XB_TMO], 1u); break; } } } } while (0)

struct XcdBarrier {
    unsigned* bar; unsigned x;
    volatile LAS unsigned* st;
};

__device__ __forceinline__ XcdBarrier xcd_barrier_post(unsigned* bar, volatile LAS unsigned* st) {
    XcdBarrier b; b.bar = bar; b.x = xb_xcc_id(); b.st = st;
    if (threadIdx.x == 0) (void)xb_add(&bar[XB_XCNT(b.x)], 1u);
    return b;
}
__device__ __forceinline__ void xcd_barrier_complete(unsigned* bar, unsigned x, unsigned& nloc, unsigned& nx) {
    const unsigned G = gridDim.x * gridDim.y * gridDim.z;
    unsigned sum, cnt, mine, sp = 0u;
    for (;;) {
        sum = 0u; cnt = 0u; mine = 0u;
#pragma unroll
        for (unsigned j = 0; j < 16; ++j) { const unsigned c = xb_ld(&bar[XB_XCNT(j)]); sum += c; cnt += (c > 0u) ? 1u : 0u; mine = (j == x) ? c : mine; }
        if (sum == G) break;
        __builtin_amdgcn_s_sleep(1);
        if ((++sp & 255u) == 0u) { if (xb_ld(&bar[XB_TMO])) break; if (sp > XB_SPIN_CAP) { atomicAdd(&bar[XB_TMO], 1u); break; } }
    }
    nloc = mine > 0u ? mine : 1u; nx = cnt > 0u ? cnt : 1u;
}

__device__ __forceinline__ void xcd_barrier(const XcdBarrier& b) {
    asm volatile("s_waitcnt vmcnt(0)" ::: "memory");
    __syncthreads();
    if (threadIdx.x == 0) {
        unsigned* bar = b.bar;
        __builtin_amdgcn_s_waitcnt(0);
        unsigned nloc = b.st[0], nx = b.st[1];
        if (nloc == 0u) { xcd_barrier_complete(bar, b.x, nloc, nx); b.st[0] = nloc; b.st[1] = nx; }
        const unsigned old = xb_add(&bar[XB_XSUB(b.x)], 1u);
        const unsigned gen = old / nloc;
        if (old + 1u == (gen + 1u) * nloc) {
            __builtin_amdgcn_fence(__ATOMIC_RELEASE, "agent");
            asm volatile("s_waitcnt vmcnt(0)" ::: "memory");
            const unsigned og = xb_add(&bar[XB_TOP], 1u);
            const unsigned tg = og / nx;
            if (og + 1u == (tg + 1u) * nx) xb_add(&bar[XB_TOPGEN], 1u);
            else XB_SPIN(xb_ld(&bar[XB_TOPGEN]) == tg, bar);
            __builtin_amdgcn_fence(__ATOMIC_ACQUIRE, "agent");
            xb_add(&bar[XB_XGEN(b.x)], 1u);
            asm volatile("s_waitcnt vmcnt(0)" ::: "memory");
        } else {
            XB_SPIN(xb_ld(&bar[XB_XGEN(b.x)]) == gen, bar);
            __builtin_amdgcn_fence(__ATOMIC_ACQUIRE, "agent");
            asm volatile("s_waitcnt vmcnt(0)" ::: "memory");
        }
    }
    __syncthreads();
}


constexpr int NPHASES = 15;
typedef const __attribute__((address_space(4))) Params* KArgPtr;
#if defined(__HIP_DEVICE_COMPILE__)
#define LOADP_() KArgPtr kp_ = (KArgPtr)__builtin_amdgcn_kernarg_segment_ptr(); asm volatile("" : "+s"(kp_)); Params lp; _Pragma("unroll") for (int i_ = 0; i_ < 18; ++i_) lp.in[i_] = kp_->in[i_]; lp.out = kp_->out; lp.ws = kp_->ws; lp.ph_lo = 0; lp.ph_hi = 0
#else
#define LOADP_() const Params lp = p
#endif
#define LOADP() LOADP_(); unsigned char* const ws = lp.ws; \
    float* const ssq = (float*)(ws + WS_SSQ); bf16_t* const xb = (bf16_t*)(ws + WS_XB); float* const xres = (float*)(ws + WS_XRES); (void)ssq; (void)xb; (void)xres
__global__ void __launch_bounds__(NTHREADS, 2) yoco_fwd(Params p) {
    extern __shared__ __attribute__((aligned(16))) unsigned char lds_raw[];
    char* lds = (char*)lds_raw; LAS unsigned char* ldsl = (LAS unsigned char*)lds_raw;
    const int G = gridDim.x, bx = blockIdx.x, wv = __builtin_amdgcn_readfirstlane(threadIdx.x >> 6);
#ifndef ONLY_PHASE
#define ONLY_PHASE -1
#endif
#define IN(k) ((ONLY_PHASE < 0 || ONLY_PHASE == (k)) && p.ph_lo <= (k) && (k) < p.ph_hi)
#ifndef SAT_REP
#define SAT_REP 1
#endif
#ifndef REPEAT_MASK
#define REPEAT_MASK 0
#endif
#define NREP(k) (1 + (int)(((unsigned)(REPEAT_MASK) >> (k)) & 1u))
    XcdBarrier xbar; xbar.bar = nullptr; xbar.x = 0; xbar.st = (volatile LAS unsigned*)(ldsl + LDS_PHASE_BYTES);
#define SEAM(k) do { if (rep_ + 1 < NREP(k) || (k) + 1 < p.ph_hi) { \
        if ((k) == 0 || xbar.bar == nullptr) { cg::this_grid().sync(); \
            if ((k) == 0 && rep_ + 1 == NREP(k)) { KArgPtr kq_ = (KArgPtr)__builtin_amdgcn_kernarg_segment_ptr(); \
                if (threadIdx.x < 4) ((LAS unsigned*)(ldsl + LDS_PHASE_BYTES))[threadIdx.x] = 0u; __syncthreads(); \
                xbar = xcd_barrier_post((unsigned*)(kq_->ws + WS_BAR), (volatile LAS unsigned*)(ldsl + LDS_PHASE_BYTES)); } } \
        else xcd_barrier(xbar); } } while (0)
    if (IN(0)) for (int rep_ = 0; rep_ < NREP(0); ++rep_) { { LOADP(); prologue_phase(wv, lp, lds); } SEAM(0); }
    if (IN(1)) for (int rep_ = 0; rep_ < NREP(1); ++rep_) {
        { LOADP(); pg8::Gemm g{(const bf16_t*)(ws + WS_WGRP), (const bf16_t*)(ws + WS_WINUS), 1024, 1024, EA, 2, nullptr, nullptr}; pg8::StaticOrder S; S.init(32, 8, G, bx);
          pg8::EpiStore E{(bf16_t*)(ws + WS_WINA), DM, 1};
          pg8::gemm_phase<pg8::EpiStore, pg8::StaticOrder>(wv, ldsl, g, S, E); }
        SEAM(1); }
#pragma unroll 1
    for (int l = 0; l < 2; ++l) {
        int wv_o = wv, bx_o = bx, G_o = G; asm volatile("" : "+s"(wv_o), "+s"(bx_o), "+s"(G_o));
        const int wv = wv_o, bx = bx_o, G = G_o;
        if (IN(2 + 3 * l)) for (int rep_ = 0; rep_ < NREP(2 + 3 * l); ++rep_) {
            { LOADP(); bf16_t* u = (bf16_t*)(ws + WS_U); bf16_t* sg = (bf16_t*)(ws + WS_SG);
              pg8::Gemm g{xb, (const bf16_t*)(ws + WS_WINA) + (size_t)l * 2 * EA * DM, DM, DM, DM, 0, nullptr, nullptr}; pg8::StaticOrder S; S.init(65, 32, G, bx);
              pg8::EpiInA E{ssq + (size_t)l * MT, u, sg};
              pg8::gemm_phase<pg8::EpiInA, pg8::StaticOrder>(wv, ldsl, g, S, E); }
            { LOADP(); pg8::Gemm g{xb, (const bf16_t*)(ws + WS_WINUT) + (size_t)l * EA * DM, DM, DM, DM, 0, nullptr, nullptr}; pg8::StateOrder S{G, bx};
              pg8::EpiUState E{ssq + (size_t)l * MT, lp.out + O_PP + (size_t)l * NBATCH * PPAD * EA, lp.out + O_PS + (size_t)l * NDB * PPAD * EA};
              pg8::gemm_phase<pg8::EpiUState, pg8::StateOrder>(wv, ldsl, g, S, E); }
            if (l == 0) { LOADP(); pg8::Gemm g{(const bf16_t*)(ws + WS_PREVB), (const bf16_t*)(ws + WS_WGRP), 1024, EA, 1024, 3, nullptr, nullptr}; pg8::MidOrder S{bx};
              pg8::EpiStore E{(bf16_t*)(ws + WS_PREVT), EA, 0};
              pg8::gemm_phase<pg8::EpiStore, pg8::MidOrder>(wv, ldsl, g, S, E); }
            SEAM(2 + 3 * l); }
        if (IN(3 + 3 * l)) for (int rep_ = 0; rep_ < NREP(3 + 3 * l); ++rep_) { { LOADP(); poolmix_phase(wv, lp, l); } SEAM(3 + 3 * l); }
        if (IN(4 + 3 * l)) for (int rep_ = 0; rep_ < NREP(4 + 3 * l); ++rep_) { { LOADP(); bf16_t* yg = (bf16_t*)(ws + WS_D);
            pg8::Gemm g{yg, (const bf16_t*)(ws + WS_WOUTA) + (size_t)l * DM * EA, EA, EA, EA, 0, (float*)(ws + WS_SPLIT) + (size_t)l * 8 * 65536, (unsigned*)(ws + WS_SPCNT) + l * 64}; pg8::SplitOrder S; S.init(8, 8, G, bx);
            pg8::EpiRes E{l == 0 ? lp.in[0] : xres, l == 0 ? lp.in[1] : xres + (size_t)MP * DM, xres, xb, ssq + (size_t)(l + 1) * MT, 1};
            pg8::gemm_phase<pg8::EpiRes, pg8::SplitOrder>(wv, ldsl, g, S, E); } SEAM(4 + 3 * l); }
    }
#pragma unroll 1
    for (int lb = 0; lb < 2; ++lb) {
        int wv_o = wv, bx_o = bx, G_o = G; asm volatile("" : "+s"(wv_o), "+s"(bx_o), "+s"(G_o));
        const int wv = wv_o, bx = bx_o, G = G_o;
        if (IN(8 + 3 * lb)) for (int rep_ = 0; rep_ < NREP(8 + 3 * lb); ++rep_) { { LOADP();
            pg8::EpiKVQ E{lb == 0 ? 0 : 17, ssq + (size_t)(2 + lb) * MT, lp.out, ws, lp.in[13]};
            if (lb == 0) { pg8::Gemm g{xb, (const bf16_t*)(ws + WS_W4), DM, DM, DM, 0, nullptr, nullptr}; pg8::StaticOrder S; S.init(65, 33, G, bx);
                pg8::gemm_phase<pg8::EpiKVQ, pg8::StaticOrder>(wv, ldsl, g, S, E); }
            else { pg8::Gemm g{xb, (const bf16_t*)(ws + WS_WINB1), DM, DM, DM, 0, (float*)(ws + WS_SPLIT) + (size_t)32 * 65536, (unsigned*)(ws + WS_SPCNT) + 256}; pg8::SplitOrder S; S.init(16, 8, G, bx);
                pg8::gemm_phase<pg8::EpiKVQ, pg8::SplitOrder>(wv, ldsl, g, S, E); } } SEAM(8 + 3 * lb); }
        if (IN(9 + 3 * lb)) for (int rep_ = 0; rep_ < NREP(9 + 3 * lb); ++rep_) {
            { const int xcd = bx & 7, j = bx >> 3;
              if (G != 256 || j >= 24) { LOADP();
                  sat::Tensors ST{(const bf16_t*)(ws + WS_QB), (const bf16_t*)(ws + WS_KB), (const bf16_t*)(ws + WS_VB), (bf16_t*)(ws + WS_OG), (const bf16_t*)(ws + WS_SGB),
                                  lp.in[2], lp.in[3], lp.in[4], (const float*)(ws + WS_LFTS)};
                  const int s0 = G == 256 ? xcd * 8 + (j - 24) : bx, sstep = G == 256 ? 64 : G;
                  for (int it = s0; it < NDB * NH; it += sstep) sat::item(wv, lds, ST, it >> 4, it & 15); }
              if (G != 256 || j < 24) { LOADP();
                  att::Tensors AT{(const bf16_t*)(ws + WS_QB), (const bf16_t*)(ws + WS_KB), (const bf16_t*)(ws + WS_VB), (bf16_t*)(ws + WS_OG), (const bf16_t*)(ws + WS_SGB), (const float*)(ws + WS_LFTP)};
                  const int p0 = G == 256 ? xcd * 24 + j : bx, pstep = G == 256 ? 192 : G;
                  for (int pw = p0; pw < 192; pw += pstep) att::prompt_phase(wv, lds, AT, (const float*)(ws + WS_KNRM), (const float*)(ws + WS_QNRM), pw); } }
            SEAM(9 + 3 * lb); }
        if (IN(10 + 3 * lb)) for (int rep_ = 0; rep_ < NREP(10 + 3 * lb); ++rep_) { { LOADP();
            pg8::Gemm g{(const bf16_t*)(ws + WS_OG), (const bf16_t*)(ws + WS_WOUTB) + (size_t)lb * DM * DM, DM, DM, DM, 0, (float*)(ws + WS_SPLIT) + (size_t)(2 + lb) * 8 * 65536, (unsigned*)(ws + WS_SPCNT) + (2 + lb) * 64}; pg8::SplitOrder S; S.init(8, 8, G, bx);
            pg8::EpiRes E{xres, xres + (size_t)MP * DM, xres, xb, ssq + (size_t)(3 + lb) * MT, lb == 0 ? 1 : 0};
            pg8::gemm_phase<pg8::EpiRes, pg8::SplitOrder>(wv, ldsl, g, S, E); } SEAM(10 + 3 * lb); }
    }
    if (IN(14)) { LOADP(); final_phase(wv, lp); }
#undef IN
#undef SEAM
}

extern "C" void kernel_launch(void* const* d_in, const int* in_sizes, int n_in, void* d_out, int out_size, void* d_ws, size_t ws_size, hipStream_t stream) {
    static int grid = 0;
    if (grid == 0) {
        if (n_in != 18 || (size_t)out_size != O_END || ws_size < WS_END) { fprintf(stderr, "kernel_launch: unexpected shapes: n_in %d out %d (want %zu) ws %zu (need %zu)\n", n_in, out_size, (size_t)O_END, ws_size, (size_t)WS_END); grid = -1; return; }
        int dev = 0, cus = 0, per_cu = 0;
        (void)hipGetDevice(&dev); (void)hipDeviceGetAttribute(&cus, hipDeviceAttributeMultiprocessorCount, dev);
        if (hipFuncSetAttribute((const void*)yoco_fwd, hipFuncAttributeMaxDynamicSharedMemorySize, LDS_BYTES) != hipSuccess) { fprintf(stderr, "kernel_launch: hipFuncSetAttribute failed\n"); grid = -1; return; }
        if (hipOccupancyMaxActiveBlocksPerMultiprocessor(&per_cu, (const void*)yoco_fwd, NTHREADS, LDS_BYTES) != hipSuccess || per_cu < 1) { fprintf(stderr, "kernel_launch: occupancy query gave %d\n", per_cu); per_cu = 1; }
        (void)hipGetLastError();
        grid = cus > 0 ? cus : 256;
    }
    if (grid < 0) return;
    Params p{};
    for (int i = 0; i < 18; ++i) p.in[i] = (const float*)d_in[i];
    p.out = (float*)d_out; p.ws = (unsigned char*)d_ws;
#if MULTI_LAUNCH
    for (int ph = 0; ph < NPHASES; ++ph) { p.ph_lo = ph; p.ph_hi = ph + 1; hipLaunchKernelGGL(yoco_fwd, dim3(grid), dim3(NTHREADS), LDS_BYTES, stream, p); }
#else
    p.ph_lo = 0; p.ph_hi = NPHASES;
    void* args[] = {&p};
    hipError_t e = hipLaunchCooperativeKernel((const void*)yoco_fwd, dim3(grid), dim3(NTHREADS), args, LDS_BYTES, stream);
    if (e != hipSuccess) fprintf(stderr, "kernel_launch: cooperative launch failed: %s (grid %d)\n", hipGetErrorString(e), grid);
#endif
}
```
